# Optimizing an MI355X kernel written in HIP

```python
import jax, jax.numpy as jnp
from jax import lax
import numpy as np

D_MODEL = 2048
BATCH = 2
SEQ = 16384
DEPTH = 2

GLA_HEADS = 4
GLA_DK = 64
GLA_DV = 128
GLA_GATE_RANK = 16
GLA_GATE_TEMP = 16.0
HGRN_HEADS = 4
HGRN_DK = 128
HGRN_DV = 128
MLA_HEADS = 8
MLA_Q_RANK = 512
MLA_KV_RANK = 512
MLA_NOPE = 128
MLA_ROPE = 64
MLA_DV = 128
ROPE_THETA = 10000.0
GLA_WIDTH = GLA_HEADS * GLA_DV
HGRN_WIDTH = HGRN_HEADS * HGRN_DV
MLA_WIDTH = MLA_HEADS * MLA_DV
MIX_WIDTH = GLA_WIDTH + HGRN_WIDTH + MLA_WIDTH
IN_SPLITS = (
    GLA_HEADS * GLA_DK,
    GLA_HEADS * GLA_DK,
    GLA_WIDTH,
    GLA_GATE_RANK,
    GLA_GATE_RANK,
    GLA_WIDTH,
    HGRN_HEADS * HGRN_DK,
    HGRN_HEADS * HGRN_DK,
    HGRN_HEADS * HGRN_DK,
    HGRN_WIDTH,
    HGRN_WIDTH,
    MLA_Q_RANK,
    MLA_KV_RANK,
    MLA_ROPE,
)
D_IN = sum(IN_SPLITS)
D_FF = ((8 * D_MODEL // 3 + 255) // 256) * 256
CHUNK = 64
Q_BLOCK = 128
EPS = 1e-6

kernel_name = "hybrid_gla_hgrn2_mla_parallel_heads_encoder"


def rmsnorm(x, g):
    xf = x.astype(jnp.float32)
    y = xf * lax.rsqrt(jnp.mean(xf * xf, axis=-1, keepdims=True) + EPS) * g.astype(jnp.float32)
    return y.astype(x.dtype)


def to_heads(a, n_heads):
    b, t, _ = a.shape
    return a.reshape(b, t, n_heads, -1).transpose(0, 2, 1, 3).astype(jnp.float32)


def chunk_gated_scan(q, k, v, log_g):
    b, h, t, dk = q.shape
    dv = v.shape[-1]
    n = t // CHUNK

    def to_chunks(a):
        return a.reshape(b, h, n, CHUNK, a.shape[-1]).transpose(2, 0, 1, 3, 4)

    qc, kc, vc = to_chunks(q), to_chunks(k), to_chunks(v)
    gc = jnp.cumsum(to_chunks(log_g), axis=3)
    mask = jnp.tril(jnp.ones((CHUNK, CHUNK), dtype=bool))

    def step(state, inp):
        q_, k_, v_, g_ = inp
        diff = g_[:, :, :, None, :] - g_[:, :, None, :, :]
        decay = jnp.exp(jnp.where(mask[:, :, None], diff, -jnp.inf))
        att = jnp.einsum('bhid,bhjd,bhijd->bhij', q_, k_, decay)
        o = (jnp.einsum('bhij,bhjv->bhiv', att, v_)
             + jnp.einsum('bhid,bhdv->bhiv', q_ * jnp.exp(g_), state))
        g_last = g_[:, :, -1:, :]
        k_dec = k_ * jnp.exp(g_last - g_)
        state = (state * jnp.exp(g_last[:, :, 0, :])[..., None]
                 + jnp.einsum('bhjd,bhjv->bhdv', k_dec, v_))
        return state, o

    s0 = jnp.zeros((b, h, dk, dv), jnp.float32)
    _, o = lax.scan(step, s0, (qc, kc, vc, gc))
    return o.transpose(1, 2, 0, 3, 4).reshape(b, h, t, dv)


def bidir_gated(q, k_f, k_b, v, lg_f, lg_b):
    def flip(a):
        return jnp.flip(a, axis=2)
    o_f = chunk_gated_scan(q, k_f, v, lg_f)
    o_b = flip(chunk_gated_scan(flip(q), flip(k_b), flip(v), flip(lg_b)))
    return o_f + o_b


def gated_out_norm(o, u_g, gain, n_heads):
    b, h, t, dv = o.shape
    o = o.transpose(0, 2, 1, 3)
    g = u_g.astype(jnp.float32).reshape(b, t, h, dv)
    return (rmsnorm(o, gain) * jax.nn.silu(g)).reshape(b, t, h * dv)


def gla_mixer(u_q, u_k, u_v, u_af, u_ab, u_g, gate_up, gate_bias, out_norm):
    q = to_heads(u_q, GLA_HEADS) * (GLA_DK ** -0.5)
    k = to_heads(u_k, GLA_HEADS)
    v = to_heads(u_v, GLA_HEADS)

    def log_decay(u_a, d):
        z = u_a.astype(jnp.float32) @ gate_up[d].astype(jnp.float32) + gate_bias[d].astype(jnp.float32)
        return to_heads(jax.nn.log_sigmoid(z) / GLA_GATE_TEMP, GLA_HEADS)

    o = bidir_gated(q, k, k, v, log_decay(u_af, 0), log_decay(u_ab, 1))
    return gated_out_norm(o, u_g, out_norm, GLA_HEADS).astype(u_q.dtype)


def hgrn2_mixer(u_q, u_ff, u_fb, u_i, u_g, lower_bound, out_norm):
    q = to_heads(jax.nn.silu(u_q.astype(jnp.float32)), HGRN_HEADS)
    v = to_heads(u_i, HGRN_HEADS)

    def gates(u_f, lb):
        z = to_heads(u_f, HGRN_HEADS)
        lb = lb.reshape(1, HGRN_HEADS, 1, HGRN_DK)
        key = (1.0 - lb) * jax.nn.sigmoid(-z)
        log_f = jnp.logaddexp(jnp.log(lb), jnp.log1p(-lb) + jax.nn.log_sigmoid(z))
        return key, log_f

    k_f, lf_f = gates(u_ff, lower_bound[0])
    k_b, lf_b = gates(u_fb, lower_bound[1])
    o = bidir_gated(q, k_f, k_b, v, lf_f, lf_b)
    return gated_out_norm(o, u_g, out_norm, HGRN_HEADS).astype(u_q.dtype)


def rope(x, cos, sin):
    x1, x2 = jnp.split(x, 2, axis=-1)
    return jnp.concatenate([x1 * cos - x2 * sin, x2 * cos + x1 * sin], axis=-1)


def mla_mixer(u_cq, u_ckv, u_kr, cos, sin, qa_norm, w_qb, kva_norm, w_kvb):
    b, t, _ = u_cq.shape
    dqk = MLA_NOPE + MLA_ROPE
    q = (rmsnorm(u_cq, qa_norm) @ w_qb).reshape(b, t, MLA_HEADS, dqk)
    q_rope = rope(q[..., MLA_NOPE:], cos[:, :, None, :], sin[:, :, None, :])
    q = jnp.concatenate([q[..., :MLA_NOPE], q_rope], axis=-1)
    kv = (rmsnorm(u_ckv, kva_norm) @ w_kvb).reshape(b, t, MLA_HEADS, MLA_NOPE + MLA_DV)
    k_rope = rope(u_kr, cos, sin)
    k = jnp.concatenate(
        [kv[..., :MLA_NOPE], jnp.broadcast_to(k_rope[:, :, None, :], (b, t, MLA_HEADS, MLA_ROPE))], axis=-1)
    kh = k.transpose(0, 2, 1, 3)
    vh = kv[..., MLA_NOPE:].transpose(0, 2, 1, 3)
    scale = dqk ** -0.5
    nb = t // Q_BLOCK
    qb = q.reshape(b, nb, Q_BLOCK, MLA_HEADS, dqk).transpose(1, 0, 3, 2, 4)

    def attend(qi):
        s = jnp.einsum('bhqd,bhkd->bhqk', qi, kh).astype(jnp.float32) * scale
        p = jax.nn.softmax(s, axis=-1).astype(vh.dtype)
        return jnp.einsum('bhqk,bhkd->bhqd', p, vh)

    o = lax.map(attend, qb)
    return o.transpose(1, 0, 3, 2, 4).reshape(b, t, MLA_WIDTH)


def swiglu(h, w1, w3, w2):
    return (jax.nn.silu(h @ w1) * (h @ w3)) @ w2


def setup_inputs(seed: int = 0) -> dict:
    key = jax.random.key(seed)
    ks = jax.random.split(key, 20)
    f32 = jnp.float32

    def nrm(k, shape, fan_in):
        return jax.random.normal(k, shape, f32) * (fan_in ** -0.5)

    def gain(k, shape):
        return 1.0 + 0.02 * jax.random.normal(k, shape, f32)

    x = jax.random.normal(ks[0], (BATCH, SEQ, D_MODEL), f32)
    offsets = jax.random.randint(ks[1], (BATCH, 1), 0, 4096)
    positions = (jnp.arange(SEQ, dtype=jnp.int32)[None, :] + offsets).astype(jnp.int32)
    return {
        "x": x,
        "positions": positions,
        "w_in": nrm(ks[2], (DEPTH, D_MODEL, D_IN), D_MODEL),
        "gla_gate_up": nrm(ks[3], (DEPTH, 2, GLA_GATE_RANK, GLA_HEADS * GLA_DK), GLA_GATE_RANK),
        "gla_gate_bias": 0.1 * jax.random.normal(ks[4], (DEPTH, 2, GLA_HEADS * GLA_DK), f32),
        "gla_out_norm": gain(ks[5], (DEPTH, GLA_DV)),
        "hgrn_lb_logits": 0.5 * jax.random.normal(ks[6], (2, DEPTH, HGRN_HEADS * HGRN_DK), f32),
        "hgrn_out_norm": gain(ks[7], (DEPTH, HGRN_DV)),
        "mla_qa_norm": gain(ks[8], (DEPTH, MLA_Q_RANK)),
        "mla_w_qb": nrm(ks[9], (DEPTH, MLA_Q_RANK, MLA_HEADS * (MLA_NOPE + MLA_ROPE)), MLA_Q_RANK),
        "mla_kva_norm": gain(ks[10], (DEPTH, MLA_KV_RANK)),
        "mla_w_kvb": nrm(ks[11], (DEPTH, MLA_KV_RANK, MLA_HEADS * (MLA_NOPE + MLA_DV)), MLA_KV_RANK),
        "w_out": nrm(ks[12], (DEPTH, MIX_WIDTH, D_MODEL), MIX_WIDTH),
        "norm_mix": gain(ks[13], (DEPTH, D_MODEL)),
        "norm_ffn": gain(ks[14], (DEPTH, D_MODEL)),
        "ffn_w1": nrm(ks[15], (DEPTH, D_MODEL, D_FF), D_MODEL),
        "ffn_w3": nrm(ks[16], (DEPTH, D_MODEL, D_FF), D_MODEL),
        "ffn_w2": nrm(ks[17], (DEPTH, D_FF, D_MODEL), D_FF),
        "norm_final": gain(ks[18], (D_MODEL,)),
    }


def reference(x, positions, w_in, gla_gate_up, gla_gate_bias, gla_out_norm, hgrn_lb_logits,
              hgrn_out_norm, mla_qa_norm, mla_w_qb, mla_kva_norm, mla_w_kvb, w_out,
              norm_mix, norm_ffn, ffn_w1, ffn_w3, ffn_w2, norm_final):
    inv_freq = 1.0 / (ROPE_THETA ** (jnp.arange(0, MLA_ROPE, 2, dtype=jnp.float32) / MLA_ROPE))
    ang = positions.astype(jnp.float32)[..., None] * inv_freq
    cos = jnp.cos(ang).astype(x.dtype)
    sin = jnp.sin(ang).astype(x.dtype)
    lb_cum = jnp.cumsum(jax.nn.softmax(hgrn_lb_logits.astype(jnp.float32), axis=1), axis=1)
    lower_bounds = lb_cum - lb_cum[:, :1]
    split_idx = np.cumsum(IN_SPLITS)[:-1].tolist()

    h = x
    for l in range(DEPTH):
        u = rmsnorm(h, norm_mix[l]) @ w_in[l]
        (gq, gk, gv, gaf, gab, gg, hq, hff, hfb, hi, hg, cq, ckv, kr) = jnp.split(u, split_idx, axis=-1)
        y_gla = gla_mixer(gq, gk, gv, gaf, gab, gg, gla_gate_up[l], gla_gate_bias[l], gla_out_norm[l])
        y_hgrn = hgrn2_mixer(hq, hff, hfb, hi, hg, lower_bounds[:, l], hgrn_out_norm[l])
        y_mla = mla_mixer(cq, ckv, kr, cos, sin, mla_qa_norm[l], mla_w_qb[l], mla_kva_norm[l], mla_w_kvb[l])
        mixed = jnp.concatenate([y_gla, y_hgrn, y_mla.astype(h.dtype)], axis=-1)
        h = h + mixed @ w_out[l]
        h = h + swiglu(rmsnorm(h, norm_ffn[l]), ffn_w1[l], ffn_w3[l], ffn_w2[l])
    return rmsnorm(h, norm_final)
```

```cpp
#include <hip/hip_runtime.h>
#include <hip/hip_cooperative_groups.h>
#include <cstdint>
#include <cstdio>
namespace cg = cooperative_groups;
#ifndef PH_ATT
#define PH_ATT 1
#endif
#ifndef PH_S1
#define PH_S1 1
#endif
#ifndef PH_S2
#define PH_S2 1
#endif
#ifndef PH_S3
#define PH_S3 1
#endif
#ifndef PH_GEMM
#define PH_GEMM 63
#endif
#ifndef PH_MISC
#define PH_MISC 1
#endif

#define LAS __attribute__((address_space(3)))
typedef unsigned short bf16_t;
typedef short bf16x8 __attribute__((ext_vector_type(8)));
typedef short s16x4 __attribute__((ext_vector_type(4)));
typedef float f32x2 __attribute__((ext_vector_type(2)));
typedef float f32x4 __attribute__((ext_vector_type(4)));
typedef float f32x16 __attribute__((ext_vector_type(16)));
typedef unsigned u32x2 __attribute__((ext_vector_type(2)));
typedef unsigned u32x4 __attribute__((ext_vector_type(4)));

constexpr int NB = 2, T = 16384, M = NB * T, DM = 2048, DIN = 5216, DINP = 5376, DFF = 5632, DEPTH = 2;
constexpr int C_GQ = 0, C_GK = 256, C_GV = 512, C_GAF = 1024, C_GAB = 1040, C_GG = 1056, C_HQ = 1568, C_HFF = 2080, C_HFB = 2592, C_HI = 3104, C_HG = 3616,
              C_CQ = 4128, C_CKV = 4640, C_KR = 5152;
constexpr float EPS = 1e-6f;
constexpr int NCH = T / 64;
constexpr size_t MiB = 1048576;
constexpr size_t WS_WIN = 0, WS_WQB = 21 * MiB, WS_WKVB = WS_WQB + 3 * MiB / 2, WS_WOUT = WS_WKVB + 2 * MiB, WS_W13 = WS_WOUT + 8 * MiB, WS_W2 = WS_W13 + 44 * MiB;
constexpr size_t WS_XN = 99 * MiB, WS_U = 227 * MiB, WS_Q = 563 * MiB, WS_KN = 659 * MiB, WS_V = 723 * MiB, WS_KR = 787 * MiB, WS_SG = 791 * MiB, WS_SH = 855 * MiB,
                 WS_DG = 983 * MiB, WS_DH = 984 * MiB, WS_COS = 986 * MiB, WS_SIN = 990 * MiB, WS_LB = 994 * MiB, WS_BAR = 995 * MiB, WS_END = 996 * MiB, WS_HID = WS_U;
static_assert(WS_W2 + 22 * MiB <= WS_XN, "weights");
constexpr int LDS_BYTES = 131072;

struct KArgs { const void* in[19]; float* out; unsigned char* ws; };

__device__ __forceinline__ float bf2f(unsigned v) { return __uint_as_float(v << 16); }
__device__ __forceinline__ unsigned f2bf(float f) { unsigned u = __float_as_uint(f); return (u + 0x7fffu + ((u >> 16) & 1u)) >> 16; }
__device__ __forceinline__ unsigned pk2(float lo, float hi) { return f2bf(lo) | (f2bf(hi) << 16); }
typedef __bf16 bf16x2_t __attribute__((ext_vector_type(2)));
__device__ __forceinline__ unsigned cvt_pk_bf16(float lo, float hi) { f32x2 v = {lo, hi}; bf16x2_t b = __builtin_convertvector(v, bf16x2_t); return __builtin_bit_cast(unsigned, b); }
__device__ __forceinline__ float wave_sum(float v) {
#pragma unroll
    for (int o = 1; o < 64; o <<= 1) v += __shfl_xor(v, o);
    return v;
}
__device__ __forceinline__ unsigned char* opq(unsigned char* q) { asm volatile("" : "+s"(q)); return q; }
__device__ __forceinline__ int opaque_tid() { int t = threadIdx.x; asm volatile("" : "+v"(t)); return t; }
#define DBGF(ws_, cond_, bit_) do { if (cond_) atomicOr((unsigned*)((ws_) + WS_BAR) + 32, (unsigned)(bit_)); } while (0)
__device__ __forceinline__ bool badf(float v) { return !(fabsf(v) < 1e30f); }
__device__ __forceinline__ float sigmoid_(float z) { return 1.f / (1.f + __expf(-z)); }
__device__ __forceinline__ float silu_(float z) { return z * sigmoid_(z); }
__device__ __forceinline__ float logsigmoid_(float z) { return fminf(z, 0.f) - log1pf(__expf(-fabsf(z))); }
__device__ __forceinline__ void unpack8(bf16x8 v, float* f) {
#pragma unroll
    for (int e = 0; e < 8; ++e) f[e] = bf2f((unsigned)(unsigned short)v[e]);
}
__device__ __forceinline__ bf16x8 pack8(const float* f) {
    u32x4 w = {cvt_pk_bf16(f[0], f[1]), cvt_pk_bf16(f[2], f[3]), cvt_pk_bf16(f[4], f[5]), cvt_pk_bf16(f[6], f[7])};
    return __builtin_bit_cast(bf16x8, w);
}

namespace pg8 {
#define PG8_LAS __attribute__((address_space(3)))
constexpr int BM = 256, BK = 64, HALF = 128, HTB = HALF * BK * 2, STAGE_BYTES = 8 * HTB, NXCD = 8, WGM = 8;
__host__ __device__ __forceinline__ int lds_byte(int r, int c) { const int st = (r >> 4) * 2 + (c >> 5), rr = r & 15, cc = c & 31, ob = rr * 64 + cc * 2; return st * 1024 + (ob ^ (((ob >> 9) & 1) << 5)); }
__host__ __device__ __forceinline__ void stage_rc(int b, int& R, int& C) { const int st = b / 1024, sb = b % 1024, swz = sb ^ (((sb >> 9) & 1) << 5); R = (st >> 1) * 16 + swz / 64; C = (st & 1) * 32 + (swz % 64) / 2; }
__host__ __device__ __forceinline__ int perm32(int rho) { const int n = rho >> 4, i = rho & 15; return 8 * (i >> 2) + 4 * n + (i & 3); }
struct Unit { int pm, pn; };
struct Gemm { const bf16_t* A; const bf16_t* Bt; int M, N, K, lda, ldb; };
struct StaticOrder {
    int nM, nN, nwg, G, c;
    __host__ __device__ void init(int M_, int N_, int G_, int c_) { nM = M_ / BM; nN = N_ / BM; nwg = nM * nN; G = G_; c = c_; }
    __host__ __device__ bool next(int i, Unit& u) const {
        const long L = (long)i * G + c; if (L >= nwg) return false;
        int wgid = (int)L; { const int q = nwg / NXCD, r = nwg % NXCD, xcd = wgid % NXCD, off = wgid / NXCD; wgid = (xcd < r ? xcd * (q + 1) : r * (q + 1) + (xcd - r) * q) + off; }
        const int nig = WGM * nN, gid = wgid / nig, fm = gid * WGM, gsz = (nM - fm) < WGM ? (nM - fm) : WGM;
        u.pm = fm + ((wgid % nig) % gsz); u.pn = (wgid % nig) / gsz; return true;
    }
    __device__ __forceinline__ void a_ready(const Unit&) const {}
    __device__ __forceinline__ void done(const Unit&) const {}
};
template <class Epi, class Sched, bool ALIGN_EPI = false, bool SP2 = false>
__device__ __forceinline__ void gemm_phase(PG8_LAS unsigned char* lds, const Gemm g, const Sched& S, const Epi& E) {
    const int tid = opaque_tid(), wid = __builtin_amdgcn_readfirstlane(tid >> 6), lane = tid & 63, wr = wid >> 2, wc = wid & 3, fr = lane & 15, fq = lane >> 4;
    const int K = g.K, nt = K / BK;
    unsigned voffA[2], voffB[2];
#pragma unroll
    for (int i = 0; i < 2; ++i) { int R, C; stage_rc(tid * 16 + i * 8192, R, C); const int Rb = Epi::PERM ? ((R & ~31) + perm32(R & 31)) : R;
        voffA[i] = (unsigned)(R * g.lda + C) * 2u; voffB[i] = (unsigned)(Rb * g.ldb + C) * 2u; }
    const size_t kstep = (size_t)(BK * 2);
    const size_t hstepA = (size_t)HALF * g.lda * 2, hstepB = (size_t)HALF * g.ldb * 2;
    const size_t tstepA = 2 * hstepA, tstepB = 2 * hstepB;
    const unsigned ldsw = (unsigned)wid * 1024u;
    const int aoff = lds_byte(wr * 64 + fr, fq * 8), boff = lds_byte(wc * 32 + fr, fq * 8);
#define PG8_SA(b, h) (((b) * 2 + (h)) * HTB)
#define PG8_SB(b, h) ((4 + (b) * 2 + (h)) * HTB)
#define PG8_STAGE(bufoff, gbase, voff) do { _Pragma("unroll") for (int _i = 0; _i < 2; ++_i) \
        __builtin_amdgcn_global_load_lds((const unsigned*)((const char*)(gbase) + (voff)[_i]), (PG8_LAS unsigned*)(lds + (bufoff) + ldsw + _i * 8192), 16, 0, 0); } while (0)
#define PG8_LDA(dst, b, h) do { _Pragma("unroll") for (int m = 0; m < 4; ++m) _Pragma("unroll") for (int k = 0; k < 2; ++k) dst[m][k] = *(const PG8_LAS bf16x8*)(lds + PG8_SA(b, h) + aoff + m * 2048 + k * 1024); } while (0)
#define PG8_LDB(dst, b, h) do { _Pragma("unroll") for (int n = 0; n < 2; ++n) _Pragma("unroll") for (int k = 0; k < 2; ++k) dst[n][k] = *(const PG8_LAS bf16x8*)(lds + PG8_SB(b, h) + boff + n * 2048 + k * 1024); } while (0)
#define PG8_MMA(ai, bj, At, Bt) do { __builtin_amdgcn_s_setprio(1); _Pragma("unroll") for (int m = 0; m < 4; ++m) _Pragma("unroll") for (int n = 0; n < 2; ++n) _Pragma("unroll") for (int k = 0; k < 2; ++k) \
        acc[ai][bj][m][n] = __builtin_amdgcn_mfma_f32_16x16x32_bf16(Bt[n][k], At[m][k], acc[ai][bj][m][n], 0, 0, 0); __builtin_amdgcn_s_setprio(0); } while (0)
#define PG8_WAIT_V(n) asm volatile("s_waitcnt vmcnt(" #n ")" ::: "memory")
#define PG8_WAIT_L(n) asm volatile("s_waitcnt lgkmcnt(" #n ")" ::: "memory")
#define PG8_BAR __builtin_amdgcn_s_barrier()
#define PG8_SCHED __builtin_amdgcn_sched_barrier(0)
    Unit cur, nxt; int ui = 0;
    if (!S.next(0, cur)) return;
    f32x4 acc[2][2][4][2];
#pragma unroll
    for (int a = 0; a < 2; ++a)
#pragma unroll
        for (int b = 0; b < 2; ++b)
#pragma unroll
            for (int m = 0; m < 4; ++m)
#pragma unroll
                for (int n = 0; n < 2; ++n) acc[a][b][m][n] = (f32x4){0.f, 0.f, 0.f, 0.f};
    bf16x8 At[4][2], B0[2][2], B1[2][2];
    const char* cA = (const char*)g.A + (size_t)cur.pm * tstepA; const char* cB = (const char*)g.Bt + (size_t)cur.pn * tstepB;
    S.a_ready(cur);
    if constexpr (SP2) {
        PG8_STAGE(PG8_SB(0, 0), cB, voffB); PG8_STAGE(PG8_SB(0, 1), cB + hstepB, voffB); PG8_STAGE(PG8_SA(0, 0), cA, voffA); PG8_STAGE(PG8_SA(0, 1), cA + hstepA, voffA);
        if (wr == 1) PG8_BAR;
        PG8_WAIT_V(2); PG8_BAR;
        PG8_STAGE(PG8_SB(1, 0), cB + kstep, voffB); PG8_STAGE(PG8_SA(1, 0), cA + kstep, voffA); PG8_STAGE(PG8_SB(1, 1), cB + hstepB + kstep, voffB);
        PG8_WAIT_V(6); PG8_BAR;
    } else {
        PG8_STAGE(PG8_SB(0, 0), cB, voffB); PG8_STAGE(PG8_SA(0, 0), cA, voffA); PG8_STAGE(PG8_SB(0, 1), cB + hstepB, voffB); PG8_STAGE(PG8_SA(0, 1), cA + hstepA, voffA);
        if (wr == 1) PG8_BAR;
        PG8_WAIT_V(4); PG8_BAR;
        PG8_STAGE(PG8_SB(1, 0), cB + kstep, voffB); PG8_STAGE(PG8_SA(1, 0), cA + kstep, voffA); PG8_STAGE(PG8_SB(1, 1), cB + hstepB + kstep, voffB);
        PG8_WAIT_V(6); PG8_BAR;
    }
    for (;;) {
        const bool has_next = S.next(ui + 1, nxt);
        const char* nA = has_next ? (const char*)g.A + (size_t)nxt.pm * tstepA : cA; const char* nB = has_next ? (const char*)g.Bt + (size_t)nxt.pn * tstepB : cB;
        for (int t = 0; t < nt; t += 2) {
            const bool last = (t == nt - 2);
            const char* a1 = cA + (size_t)(t + 1) * kstep;
            const char* a2 = last ? nA : cA + (size_t)(t + 2) * kstep; const char* b2 = last ? nB : cB + (size_t)(t + 2) * kstep;
            const char* a3 = a2 + kstep; const char* b3 = b2 + kstep;
            if (last && has_next) S.a_ready(nxt);
            if constexpr (SP2) {
            PG8_LDB(B0, 0, 0); PG8_LDB(B1, 0, 1); PG8_SCHED; PG8_LDA(At, 0, 0); PG8_STAGE(PG8_SA(1, 1), a1 + hstepA, voffA);
            PG8_WAIT_V(8); PG8_WAIT_L(0); PG8_BAR; PG8_MMA(0, 0, At, B0); PG8_MMA(0, 1, At, B1); PG8_BAR; PG8_SCHED;
            PG8_LDA(At, 0, 1); PG8_STAGE(PG8_SB(0, 0), b2, voffB); PG8_STAGE(PG8_SB(0, 1), b2 + hstepB, voffB); PG8_STAGE(PG8_SA(0, 0), a2, voffA);
            PG8_WAIT_V(8); PG8_WAIT_L(0); PG8_BAR; PG8_MMA(1, 0, At, B0); PG8_MMA(1, 1, At, B1); PG8_BAR; PG8_SCHED;
            PG8_LDB(B0, 1, 0); PG8_LDB(B1, 1, 1); PG8_SCHED; PG8_LDA(At, 1, 0); PG8_STAGE(PG8_SA(0, 1), a2 + hstepA, voffA);
            PG8_WAIT_V(8); PG8_WAIT_L(0); PG8_BAR; PG8_MMA(0, 0, At, B0); PG8_MMA(0, 1, At, B1); PG8_BAR; PG8_SCHED;
            PG8_LDA(At, 1, 1); PG8_STAGE(PG8_SB(1, 0), b3, voffB); PG8_STAGE(PG8_SB(1, 1), b3 + hstepB, voffB); PG8_STAGE(PG8_SA(1, 0), a3, voffA);
            PG8_WAIT_V(8); PG8_WAIT_L(0); PG8_BAR; PG8_MMA(1, 0, At, B0); PG8_MMA(1, 1, At, B1); PG8_BAR; PG8_SCHED;
            } else {
            PG8_LDB(B0, 0, 0); PG8_SCHED; PG8_LDA(At, 0, 0); PG8_STAGE(PG8_SA(1, 1), a1 + hstepA, voffA);
            PG8_WAIT_L(8); PG8_BAR; PG8_WAIT_L(0); PG8_MMA(0, 0, At, B0); PG8_BAR; PG8_SCHED;
            PG8_LDB(B1, 0, 1); PG8_STAGE(PG8_SB(0, 0), b2, voffB);
            PG8_BAR; PG8_WAIT_L(0); PG8_MMA(0, 1, At, B1); PG8_BAR;
            PG8_LDA(At, 0, 1); PG8_STAGE(PG8_SA(0, 0), a2, voffA);
            PG8_BAR; PG8_WAIT_L(0); PG8_MMA(1, 0, At, B0); PG8_BAR; PG8_SCHED;
            PG8_STAGE(PG8_SB(0, 1), b2 + hstepB, voffB);
            PG8_WAIT_V(6); PG8_BAR; PG8_MMA(1, 1, At, B1); PG8_BAR;
            PG8_LDB(B0, 1, 0); PG8_SCHED; PG8_LDA(At, 1, 0); PG8_STAGE(PG8_SA(0, 1), a2 + hstepA, voffA);
            PG8_WAIT_L(8); PG8_BAR; PG8_WAIT_L(0); PG8_MMA(0, 0, At, B0); PG8_BAR; PG8_SCHED;
            PG8_LDB(B1, 1, 1); PG8_STAGE(PG8_SB(1, 0), b3, voffB);
            PG8_BAR; PG8_WAIT_L(0); PG8_MMA(0, 1, At, B1); PG8_BAR;
            PG8_LDA(At, 1, 1); PG8_STAGE(PG8_SA(1, 0), a3, voffA);
            PG8_BAR; PG8_WAIT_L(0); PG8_MMA(1, 0, At, B0); PG8_BAR; PG8_SCHED;
            PG8_STAGE(PG8_SB(1, 1), b3 + hstepB, voffB);
            PG8_WAIT_V(6); PG8_BAR; PG8_MMA(1, 1, At, B1); PG8_BAR;
            }
        }
        if constexpr (ALIGN_EPI) { if (wr == 0) PG8_BAR; }
        if constexpr (!Epi::AFTER_DRAIN) { E(acc, cur, wr, wc, fr, fq); S.done(cur); }
        if (!has_next) break;
#pragma unroll
        for (int a = 0; a < 2; ++a)
#pragma unroll
            for (int b = 0; b < 2; ++b)
#pragma unroll
                for (int m = 0; m < 4; ++m)
#pragma unroll
                    for (int n = 0; n < 2; ++n) acc[a][b][m][n] = (f32x4){0.f, 0.f, 0.f, 0.f};
        cur = nxt; cA = nA; cB = nB; ++ui;
        if constexpr (ALIGN_EPI) { if (wr == 1) PG8_BAR; }
    }
    PG8_WAIT_V(0);
    if constexpr (!ALIGN_EPI) { if (wr == 0) PG8_BAR; }
    PG8_BAR;
    if constexpr (Epi::AFTER_DRAIN) { E.fused(acc, cur, wr, wc, fr, fq, lds, wid, lane); S.done(cur); }
#undef PG8_SA
#undef PG8_SB
#undef PG8_STAGE
#undef PG8_LDA
#undef PG8_LDB
#undef PG8_MMA
#undef PG8_WAIT_V
#undef PG8_WAIT_L
#undef PG8_BAR
#undef PG8_SCHED
}
struct EpiU {
    static constexpr bool PERM = true, AFTER_DRAIN = false;
    bf16_t* O; int ldc;
    __device__ __forceinline__ void operator()(const f32x4 (&acc)[2][2][4][2], const Unit& u, int wr, int wc, int fr, int fq) const {
        const int row0 = u.pm * BM + wr * 64 + fr, col0 = u.pn * BM + wc * 32 + 8 * fq;
#pragma unroll
        for (int ai = 0; ai < 2; ++ai)
#pragma unroll
            for (int m = 0; m < 4; ++m) { bf16_t* rowp = O + (size_t)(row0 + ai * HALF + m * 16) * ldc + col0;
#pragma unroll
                for (int bj = 0; bj < 2; ++bj) { const f32x4 v0 = acc[ai][bj][m][0], v1 = acc[ai][bj][m][1];
                    u32x4 w; w.x = cvt_pk_bf16(v0[0], v0[1]); w.y = cvt_pk_bf16(v0[2], v0[3]); w.z = cvt_pk_bf16(v1[0], v1[1]); w.w = cvt_pk_bf16(v1[2], v1[3]);
                    *(u32x4*)(rowp + bj * HALF) = w; } }
    }
};
struct EpiQ {
    static constexpr bool PERM = true, AFTER_DRAIN = false;
    bf16_t* Q; const float* cs; const float* sn;
    __device__ __forceinline__ void operator()(const f32x4 (&acc)[2][2][4][2], const Unit& u, int wr, int wc, int fr, int fq) const {
        const int row0 = u.pm * BM + wr * 64 + fr;
#pragma unroll
        for (int ai = 0; ai < 2; ++ai)
#pragma unroll
            for (int m = 0; m < 4; ++m) { const int row = row0 + ai * HALF + m * 16, b = row / T, t = row % T;
#pragma unroll
                for (int bj = 0; bj < 2; ++bj) { const int c = u.pn * BM + bj * HALF + wc * 32 + 8 * fq, hh = c / 192, e = c % 192;
                    const f32x4 v0 = acc[ai][bj][m][0], v1 = acc[ai][bj][m][1];
                    float vals[8] = {v0[0], v0[1], v0[2], v0[3], v1[0], v1[1], v1[2], v1[3]};
                    if (e >= 128) { const int i0 = (e - 128) >> 1; const f32x4 cc = *(const f32x4*)(cs + (size_t)row * 32 + i0), ss = *(const f32x4*)(sn + (size_t)row * 32 + i0);
#pragma unroll
                        for (int p = 0; p < 4; ++p) { const float x1 = vals[2 * p], x2 = vals[2 * p + 1]; vals[2 * p] = x1 * cc[p] - x2 * ss[p]; vals[2 * p + 1] = x2 * cc[p] + x1 * ss[p]; } }
                    u32x4 w; w.x = cvt_pk_bf16(vals[0], vals[1]); w.y = cvt_pk_bf16(vals[2], vals[3]); w.z = cvt_pk_bf16(vals[4], vals[5]); w.w = cvt_pk_bf16(vals[6], vals[7]);
                    *(u32x4*)(Q + ((size_t)(b * 8 + hh) * T + t) * 192 + e) = w; } }
    }
};
struct EpiKV {
    static constexpr bool PERM = true, AFTER_DRAIN = false;
    bf16_t* KN; bf16_t* V;
    __device__ __forceinline__ void operator()(const f32x4 (&acc)[2][2][4][2], const Unit& u, int wr, int wc, int fr, int fq) const {
        const int row0 = u.pm * BM + wr * 64 + fr, e = wc * 32 + 8 * fq;
#pragma unroll
        for (int ai = 0; ai < 2; ++ai)
#pragma unroll
            for (int m = 0; m < 4; ++m) { const int row = row0 + ai * HALF + m * 16, b = row / T, t = row % T;
                const size_t off = ((size_t)(b * 8 + u.pn) * T + t) * 128 + e;
#pragma unroll
                for (int bj = 0; bj < 2; ++bj) { const f32x4 v0 = acc[ai][bj][m][0], v1 = acc[ai][bj][m][1];
                    u32x4 w; w.x = cvt_pk_bf16(v0[0], v0[1]); w.y = cvt_pk_bf16(v0[2], v0[3]); w.z = cvt_pk_bf16(v1[0], v1[1]); w.w = cvt_pk_bf16(v1[2], v1[3]);
                    *(u32x4*)((bj ? V : KN) + off) = w; } }
    }
};
struct EpiSwi {
    static constexpr bool PERM = false, AFTER_DRAIN = false;
    bf16_t* H;
    __device__ __forceinline__ void operator()(const f32x4 (&acc)[2][2][4][2], const Unit& u, int wr, int wc, int fr, int fq) const {
        const int row0 = u.pm * BM + wr * 64 + fr;
#pragma unroll
        for (int ai = 0; ai < 2; ++ai)
#pragma unroll
            for (int m = 0; m < 4; ++m) { bf16_t* rowp = H + (size_t)(row0 + ai * HALF + m * 16) * DFF;
#pragma unroll
                for (int bj = 0; bj < 2; ++bj) { const f32x4 a = acc[ai][bj][m][0], g = acc[ai][bj][m][1];
                    const int col = 16 * (8 * u.pn + 4 * bj + wc) + 4 * fq;
                    u32x2 w; w.x = cvt_pk_bf16(silu_(a[0]) * g[0], silu_(a[1]) * g[1]); w.y = cvt_pk_bf16(silu_(a[2]) * g[2], silu_(a[3]) * g[3]);
                    *(u32x2*)(rowp + col) = w; } }
    }
};
struct EpiRes {
    static constexpr bool PERM = false, AFTER_DRAIN = false;
    const float* base; float* out;
    __device__ __forceinline__ void operator()(const f32x4 (&acc)[2][2][4][2], const Unit& u, int wr, int wc, int fr, int fq) const {
        const int row0 = u.pm * BM + wr * 64 + fr, col0 = u.pn * BM + wc * 32 + 4 * fq;
#pragma unroll
        for (int ai = 0; ai < 2; ++ai)
#pragma unroll
            for (int m = 0; m < 4; ++m) { const size_t off = (size_t)(row0 + ai * HALF + m * 16) * DM + col0;
#pragma unroll
                for (int bj = 0; bj < 2; ++bj)
#pragma unroll
                    for (int n = 0; n < 2; ++n) { const f32x4 bs = *(const f32x4*)(base + off + bj * HALF + n * 16); *(f32x4*)(out + off + bj * HALF + n * 16) = bs + acc[ai][bj][m][n]; } }
    }
};

}
namespace att {
constexpr int KVBLK = 64;
constexpr float SCALE = 0.07216878364870322f;
constexpr float THR = 8.f;
constexpr int SHM_V = KVBLK * 128 * 2, SHM_K = KVBLK * 192 * 2;
#ifndef ATT_SDEPTH
#define ATT_SDEPTH 1
#endif
constexpr int SDEPTH = ATT_SDEPTH;
#define KSWZ(row, colB) ((row) * 384 + ((colB) ^ (((row) & 7) << 4)))
#define SBAR() __builtin_amdgcn_sched_barrier(0)
__device__ __forceinline__ int crow(int r, int hi) { return (r & 3) + 8 * (r >> 2) + 4 * hi; }
__device__ __forceinline__ unsigned cvtpk(float lo, float hi) { return cvt_pk_bf16(lo, hi); }
__device__ __forceinline__ void partialSM(f32x16& p0, f32x16& p1, float& m_reg, float& mn, float& alpha) {
  constexpr float C = SCALE * 1.4426950408889634f;
  float pmax = p0[0];
#pragma unroll
  for (int r = 1; r < 16; ++r) pmax = fmaxf(pmax, p0[r]);
#pragma unroll
  for (int r = 0; r < 16; ++r) pmax = fmaxf(pmax, p1[r]);
  { auto rr = __builtin_amdgcn_permlane32_swap(__float_as_uint(pmax), __float_as_uint(pmax), false, false);
    pmax = fmaxf(__uint_as_float(rr[0]), __uint_as_float(rr[1])); }
  if (__builtin_expect(__all(pmax - m_reg <= THR / SCALE), 1)) { mn = m_reg; alpha = 1.f; }
  else { mn = fmaxf(m_reg, pmax); alpha = __builtin_amdgcn_exp2f((m_reg - mn) * C); m_reg = mn; }
  float mnC = -mn * C;
#pragma unroll
  for (int r = 0; r < 16; ++r) p0[r] = fmaf(p0[r], C, mnC);
#pragma unroll
  for (int r = 0; r < 16; ++r) p1[r] = fmaf(p1[r], C, mnC);
#pragma unroll
  for (int r = 0; r < 16; ++r) p0[r] = __builtin_amdgcn_exp2f(p0[r]);
}
__device__ __forceinline__ void finishSM(f32x16& p0, f32x16& p1, float alpha, float& l_reg, bf16x8& pa0, bf16x8& pa1, bf16x8& pa2, bf16x8& pa3) {
#pragma unroll
  for (int r = 0; r < 16; ++r) p1[r] = __builtin_amdgcn_exp2f(p1[r]);
  float ps = 0;
#pragma unroll
  for (int r = 0; r < 16; ++r) ps += p0[r];
#pragma unroll
  for (int r = 0; r < 16; ++r) ps += p1[r];
  { auto rr = __builtin_amdgcn_permlane32_swap(__float_as_uint(ps), __float_as_uint(ps), false, false);
    ps = __uint_as_float(rr[0]) + __uint_as_float(rr[1]); }
  l_reg = l_reg * alpha + ps;
#define PK4(P, BASE, OUT) do { unsigned a0 = cvtpk(P[BASE + 0], P[BASE + 1]), a1 = cvtpk(P[BASE + 2], P[BASE + 3]);   \
    unsigned b0 = cvtpk(P[BASE + 4], P[BASE + 5]), b1 = cvtpk(P[BASE + 6], P[BASE + 7]);                              \
    auto r0 = __builtin_amdgcn_permlane32_swap(a0, b0, false, false); auto r1 = __builtin_amdgcn_permlane32_swap(a1, b1, false, false); \
    u32x4 w = {r0[0], r1[0], r0[1], r1[1]}; OUT = __builtin_bit_cast(bf16x8, w); } while (0)
  PK4(p0, 0, pa0); PK4(p0, 8, pa1); PK4(p1, 0, pa2); PK4(p1, 8, pa3);
#undef PK4
}
__device__ __forceinline__ void qkt(f32x16& p0, f32x16& p1, const char* Ks, const bf16x8* qr, const char* qL, int r32, int hi) {
  p0 = f32x16{}; p1 = f32x16{};
#pragma unroll
  for (int d0 = 0; d0 < 12; ++d0) { int cb = (d0 * 16 + hi * 8) * 2;
    bf16x8 b0 = *reinterpret_cast<const bf16x8*>(Ks + KSWZ(r32, cb));
    bf16x8 b1 = *reinterpret_cast<const bf16x8*>(Ks + KSWZ(32 + r32, cb));
    const bf16x8 q = d0 < 8 ? qr[d0 < 8 ? d0 : 0] : *reinterpret_cast<const bf16x8*>(qL + (d0 - 8) * 1024);
    p0 = __builtin_amdgcn_mfma_f32_32x32x16_bf16(b0, q, p0, 0, 0, 0);
    p1 = __builtin_amdgcn_mfma_f32_32x32x16_bf16(b1, q, p1, 0, 0, 0); }
}
__device__ __forceinline__ int v_st(int k, int c) { const int kk = (k & ~0xC) | ((k & 4) << 1) | ((k & 8) >> 1); return ((kk >> 3) * 4 + (c >> 5)) * 512 + ((kk & 7) * 32 + (c & 31)) * 2; }
__device__ __forceinline__ int v_rd_base(int lane) { return ((lane & 3) << 3) | (((lane >> 2) & 3) << 6) | (((lane >> 4) & 1) << 5) | (((lane >> 5) & 1) << 8); }
constexpr int v_rd_off(int d0, int ks, int half) { return d0 * 512 + ks * 4096 + half * 2048; }
template <int OFF> __device__ __forceinline__ s16x4 tr_read(int vb) {
  s16x4 r; asm volatile("ds_read_b64_tr_b16 %0, %1 offset:%2" : "=&v"(r) : "v"(vb), "i"(OFF) : "memory"); return r;
}
template <int D0> __device__ __forceinline__ void pv_one(f32x16& od, int vb, bf16x8 pa0, bf16x8 pa1, bf16x8 pa2, bf16x8 pa3) {
  const s16x4 l0 = tr_read<v_rd_off(D0, 0, 0)>(vb), h0 = tr_read<v_rd_off(D0, 0, 1)>(vb), l1 = tr_read<v_rd_off(D0, 1, 0)>(vb), h1 = tr_read<v_rd_off(D0, 1, 1)>(vb);
  const s16x4 l2 = tr_read<v_rd_off(D0, 2, 0)>(vb), h2 = tr_read<v_rd_off(D0, 2, 1)>(vb), l3 = tr_read<v_rd_off(D0, 3, 0)>(vb), h3 = tr_read<v_rd_off(D0, 3, 1)>(vb);
  asm volatile("s_waitcnt lgkmcnt(0)" ::: "memory"); SBAR();
#define PK(L, H) (bf16x8){L[0], L[1], L[2], L[3], H[0], H[1], H[2], H[3]}
  od = __builtin_amdgcn_mfma_f32_32x32x16_bf16(pa0, PK(l0, h0), od, 0, 0, 0);
  od = __builtin_amdgcn_mfma_f32_32x32x16_bf16(pa1, PK(l1, h1), od, 0, 0, 0);
  od = __builtin_amdgcn_mfma_f32_32x32x16_bf16(pa2, PK(l2, h2), od, 0, 0, 0);
  od = __builtin_amdgcn_mfma_f32_32x32x16_bf16(pa3, PK(l3, h3), od, 0, 0, 0);
#undef PK
}
__device__ __forceinline__ void pv_d0(f32x16* o, int vb, bf16x8 pa0, bf16x8 pa1, bf16x8 pa2, bf16x8 pa3) {
  pv_one<0>(o[0], vb, pa0, pa1, pa2, pa3); pv_one<1>(o[1], vb, pa0, pa1, pa2, pa3); pv_one<2>(o[2], vb, pa0, pa1, pa2, pa3); pv_one<3>(o[3], vb, pa0, pa1, pa2, pa3);
}
__device__ __forceinline__ void attn_unit(const bf16_t* __restrict__ Qb, const bf16_t* __restrict__ Kn, const bf16_t* __restrict__ Kr, const bf16_t* __restrict__ Vh,
                                          bf16_t* __restrict__ Ob, char* lds) {
  const int tid = opaque_tid(), wid = tid >> 6, lane = tid & 63, r32 = lane & 31, hi = lane >> 5;
  char* V_lds = lds; char* K_lds = lds + 2 * SHM_V;
  float* ws = (float*)(lds + 2 * SHM_V + 2 * SHM_K) + wid * 64; float* li_l = ws; float* al_l = ws + 32;
  float m_reg = -1e30f, l_reg = 0; f32x16 o[4] = {}; bf16x8 qr[8];
  char* qL = lds + 2 * SHM_V + 2 * SHM_K + 2048 + wid * 4096 + lane * 16;
  const bf16_t* Qw = Qb + (long)(wid * 32 + r32) * 192 + hi * 8;
#pragma unroll
  for (int d0 = 0; d0 < 8; ++d0) qr[d0] = *reinterpret_cast<const bf16x8*>(Qw + d0 * 16);
#pragma unroll
  for (int d0 = 8; d0 < 12; ++d0) *reinterpret_cast<bf16x8*>(qL + (d0 - 8) * 1024) = *reinterpret_cast<const bf16x8*>(Qw + d0 * 16);
  const int sr = tid >> 4, sc = (tid & 15) * 8, vst0 = v_st(sr, sc), vst1 = v_st(32 + sr, sc);
  const int rr = tid >> 3, rc = (tid & 7) * 8;
  const int kst0 = KSWZ(sr, sc * 2), kst1 = KSWZ(32 + sr, sc * 2), kst2 = KSWZ(rr, 256 + rc * 2);
  const int vb0 = (int)(uintptr_t)V_lds + v_rd_base(lane);
  struct { bf16x8 vs0, vs1, ks0, ks1, ks2; } sr_[SDEPTH];
#define SLOAD(i, k0) do { sr_[i].vs0 = *(const bf16x8*)(&Vh[(long)((k0) + sr) * 128 + sc]); sr_[i].vs1 = *(const bf16x8*)(&Vh[(long)((k0) + 32 + sr) * 128 + sc]); \
    sr_[i].ks0 = *(const bf16x8*)(&Kn[(long)((k0) + sr) * 128 + sc]); sr_[i].ks1 = *(const bf16x8*)(&Kn[(long)((k0) + 32 + sr) * 128 + sc]); \
    sr_[i].ks2 = *(const bf16x8*)(&Kr[(long)((k0) + rr) * 64 + rc]); } while (0)
#define SWRITE(b, i) do { *(bf16x8*)(V_lds + (b) * SHM_V + vst0) = sr_[i].vs0; *(bf16x8*)(V_lds + (b) * SHM_V + vst1) = sr_[i].vs1; \
    *(bf16x8*)(K_lds + (b) * SHM_K + kst0) = sr_[i].ks0; *(bf16x8*)(K_lds + (b) * SHM_K + kst1) = sr_[i].ks1; *(bf16x8*)(K_lds + (b) * SHM_K + kst2) = sr_[i].ks2; } while (0)
#define SWAIT() do { if constexpr (SDEPTH == 2) asm volatile("s_waitcnt vmcnt(5)" ::: "memory"); else asm volatile("s_waitcnt vmcnt(0)" ::: "memory"); } while (0)
#define RESC(a) do { if (__any((a) < 1.f)) { if (hi == 0) al_l[r32] = (a); asm volatile("s_waitcnt lgkmcnt(0)" ::: "memory"); \
    _Pragma("unroll") for (int d = 0; d < 4; ++d) _Pragma("unroll") for (int r = 0; r < 16; ++r) o[d][r] *= al_l[crow(r, hi)]; } } while (0)
  f32x16 pA0, pA1, pB0, pB1; float mnA, mnB, alA, alB; bf16x8 pa0, pa1, pa2, pa3; const int NT = T / KVBLK;
  constexpr int SE = 0, SO = SDEPTH - 1;
  SLOAD(SE, 0); asm volatile("s_waitcnt vmcnt(0)" ::: "memory"); SWRITE(0, SE); __syncthreads();
  qkt(pA0, pA1, K_lds, qr, qL, r32, hi); partialSM(pA0, pA1, m_reg, mnA, alA);
  SLOAD(SO, KVBLK); if constexpr (SDEPTH == 2) { if (2 < NT) SLOAD(SE, 2 * KVBLK); }
  SWAIT(); SWRITE(1, SO); __syncthreads();
  for (int j = 1; j + 1 < NT; j += 2) {
    SBAR(); qkt(pB0, pB1, K_lds + SHM_K, qr, qL, r32, hi);
    finishSM(pA0, pA1, alA, l_reg, pa0, pa1, pa2, pa3); SBAR();
    SLOAD(SO, (j + SDEPTH) * KVBLK); SBAR();
    pv_d0(o, vb0, pa0, pa1, pa2, pa3); partialSM(pB0, pB1, m_reg, mnB, alB);
    __syncthreads(); SWAIT(); SWRITE(0, SE);
    RESC(alB); __syncthreads();
    SBAR(); qkt(pA0, pA1, K_lds, qr, qL, r32, hi);
    finishSM(pB0, pB1, alB, l_reg, pa0, pa1, pa2, pa3); SBAR();
    if (SDEPTH == 1 || j + 3 < NT) SLOAD(SE, (j + 1 + SDEPTH) * KVBLK); SBAR();
    pv_d0(o, vb0 + (int)SHM_V, pa0, pa1, pa2, pa3); partialSM(pA0, pA1, m_reg, mnA, alA);
    __syncthreads(); SWAIT(); SWRITE(1, SO);
    RESC(alA); __syncthreads();
  }
  SBAR(); qkt(pB0, pB1, K_lds + SHM_K, qr, qL, r32, hi);
  finishSM(pA0, pA1, alA, l_reg, pa0, pa1, pa2, pa3); SBAR();
  pv_d0(o, vb0, pa0, pa1, pa2, pa3); partialSM(pB0, pB1, m_reg, mnB, alB);
  __syncthreads(); RESC(alB);
  finishSM(pB0, pB1, alB, l_reg, pa0, pa1, pa2, pa3); SBAR();
  pv_d0(o, vb0 + (int)SHM_V, pa0, pa1, pa2, pa3);
  if (hi == 0) li_l[r32] = l_reg; asm volatile("s_waitcnt lgkmcnt(0)" ::: "memory");
  float rli[16];
#pragma unroll
  for (int r = 0; r < 16; ++r) rli[r] = __builtin_amdgcn_rcpf(li_l[crow(r, hi)]);
  bf16_t* Ow = Ob + (long)(wid * 32) * DM;
#pragma unroll
  for (int r = 0; r < 16; ++r) { int orow = crow(r, hi);
#pragma unroll
    for (int d0 = 0; d0 < 4; ++d0) Ow[(long)orow * DM + d0 * 32 + r32] = (bf16_t)f2bf(o[d0][r] * rli[r]); }
#undef SLOAD
#undef SWRITE
#undef SWAIT
#undef RESC
  __syncthreads();
}
}
namespace scan {
constexpr int LDT = 72;
constexpr int SC_G = 0, SC_K = 33792, SC_QT = SC_K + 17408, SC_QG = SC_QT + 17408, SC_VT = SC_QG + 17408, SC_P = SC_VT + 18432, SC_SEG = SC_P + 9216, SC_RSQ = SC_SEG + 4096,
              SC_END = SC_RSQ + 2048, SC_KDT = SC_QT;
static_assert(SC_END <= LDS_BYTES, "scan LDS");

template <int TYPE> struct Cfg { static constexpr int DK = TYPE ? 128 : 64, LDG = DK + 4, LDK_ = DK + 8, ND8 = DK / 8; };

template <int TYPE>
__device__ __forceinline__ void load_lg_k(const KArgs& a, int l, int h, int dir, size_t tok0, LAS unsigned char* lds, int tid) {
    unsigned char* const wsb = opq(a.ws);
    using C = Cfg<TYPE>;
    const bf16_t* u = (const bf16_t*)(wsb + WS_U);
    LAS float* G = (LAS float*)(lds + SC_G); LAS bf16_t* Kb = (LAS bf16_t*)(lds + SC_K);
    if constexpr (TYPE == 1) {
        const float* lbp = (const float*)(wsb + WS_LB) + (dir * DEPTH + l) * 512 + h * 128;
#pragma unroll
        for (int e2 = 0; e2 < 2; ++e2) { const int task = tid + 512 * e2, i = task >> 4, d8 = task & 15;
            const bf16x8 z8 = *(const bf16x8*)(u + (tok0 + i) * DINP + (dir ? C_HFB : C_HFF) + h * 128 + d8 * 8);
            float z[8], lg[8], kk[8]; unpack8(z8, z);
            const f32x4 lb0 = *(const f32x4*)(lbp + d8 * 8), lb1 = *(const f32x4*)(lbp + d8 * 8 + 4);
            const float lb[8] = {lb0[0], lb0[1], lb0[2], lb0[3], lb1[0], lb1[1], lb1[2], lb1[3]};
#pragma unroll
            for (int e = 0; e < 8; ++e) { const float sg = sigmoid_(fmaxf(z[e], -80.f)); lg[e] = __logf(lb[e] + (1.f - lb[e]) * sg); kk[e] = (1.f - lb[e]) * (1.f - sg); }
            *(LAS f32x4*)(G + i * C::LDG + d8 * 8) = (f32x4){lg[0], lg[1], lg[2], lg[3]}; *(LAS f32x4*)(G + i * C::LDG + d8 * 8 + 4) = (f32x4){lg[4], lg[5], lg[6], lg[7]};
            *(LAS bf16x8*)(Kb + i * C::LDK_ + d8 * 8) = pack8(kk); }
    } else {
        const int i = tid >> 3, d8 = tid & 7;
        const bf16_t* ur = u + (tok0 + i) * DINP;
        float ua[16]; unpack8(*(const bf16x8*)(ur + (dir ? C_GAB : C_GAF)), ua); unpack8(*(const bf16x8*)(ur + (dir ? C_GAB : C_GAF) + 8), ua + 8);
        const float* up = (const float*)a.in[3] + (size_t)((l * 2 + dir) * 16) * 256 + h * 64 + d8 * 8;
        const float* bs = (const float*)a.in[4] + (l * 2 + dir) * 256 + h * 64 + d8 * 8;
        f32x4 z0 = *(const f32x4*)bs, z1 = *(const f32x4*)(bs + 4);
#pragma unroll
        for (int r = 0; r < 16; ++r) { z0 += ua[r] * *(const f32x4*)(up + r * 256); z1 += ua[r] * *(const f32x4*)(up + r * 256 + 4); }
        f32x4 g0, g1;
#pragma unroll
        for (int e = 0; e < 4; ++e) { g0[e] = logsigmoid_(z0[e]) * (1.f / 16.f); g1[e] = logsigmoid_(z1[e]) * (1.f / 16.f); }
        *(LAS f32x4*)(G + i * C::LDG + d8 * 8) = g0; *(LAS f32x4*)(G + i * C::LDG + d8 * 8 + 4) = g1;
        *(LAS bf16x8*)(Kb + i * C::LDK_ + d8 * 8) = *(const bf16x8*)(ur + C_GK + h * 64 + d8 * 8);
    }
}
template <int TYPE>
__device__ __forceinline__ void cumsum_g(int dir, LAS unsigned char* lds, int tid) {
    using C = Cfg<TYPE>; constexpr int NSEG = 512 / C::DK, SEGL = 64 / NSEG;
    LAS float* G = (LAS float*)(lds + SC_G); LAS float* SG = (LAS float*)(lds + SC_SEG);
    const int d = tid % C::DK, seg = tid / C::DK;
    __syncthreads();
    float run = 0.f;
#pragma unroll
    for (int ii = 0; ii < SEGL; ++ii) { const int i = seg * SEGL + (dir ? SEGL - 1 - ii : ii); run += G[i * C::LDG + d]; G[i * C::LDG + d] = run; }
    SG[seg * 128 + d] = run;
    __syncthreads();
    float off = 0.f;
#pragma unroll
    for (int s = 0; s < NSEG; ++s) { const bool before = dir ? (s > seg) : (s < seg); if (before) off += SG[s * 128 + d]; }
#pragma unroll
    for (int ii = 0; ii < SEGL; ++ii) { const int i = seg * SEGL + ii; G[i * C::LDG + d] += off; }
    __syncthreads();
}
__device__ __forceinline__ void load_vT(const bf16_t* vsrc, LAS unsigned char* lds, int tid, unsigned char* wsd) {
    LAS bf16_t* VT = (LAS bf16_t*)(lds + SC_VT);
#pragma unroll
    for (int e2 = 0; e2 < 2; ++e2) { const int task = tid + 512 * e2, i = task & 63, v8 = task >> 6;
        const bf16x8 x = *(const bf16x8*)(vsrc + (size_t)i * DINP + v8 * 8);
#pragma unroll
        for (int e = 0; e < 8; ++e) { VT[(v8 * 8 + e) * LDT + i] = (bf16_t)x[e]; } }
}

template <int TYPE>
__device__ __forceinline__ void pass1_item(const KArgs& a, int l, int item, LAS unsigned char* lds) {
    unsigned char* const wsb = opq(a.ws);
    const int tid = opaque_tid();
    using C = Cfg<TYPE>; constexpr int DK = C::DK;
    const int c = item & (NCH - 1), dir = (item >> 8) & 1, h = (item >> 9) & 3, b = item >> 11;
    const size_t tok0 = (size_t)b * T + (size_t)c * 64;
    const bf16_t* u = (const bf16_t*)(wsb + WS_U);
    const int wid = tid >> 6, lane = tid & 63, fr = lane & 15, fq = lane >> 4;
    __syncthreads();
    load_lg_k<TYPE>(a, l, h, dir, tok0, lds, tid);
    load_vT(u + tok0 * DINP + (TYPE ? C_HI : C_GV) + h * 128, lds, tid, wsb);
    cumsum_g<TYPE>(dir, lds, tid);
    LAS float* G = (LAS float*)(lds + SC_G); LAS bf16_t* Kb = (LAS bf16_t*)(lds + SC_K); LAS bf16_t* KDT = (LAS bf16_t*)(lds + SC_KDT); LAS bf16_t* VT = (LAS bf16_t*)(lds + SC_VT);
    const int last = dir ? 0 : 63;
    float* Dout = (float*)(wsb + (TYPE ? WS_DH : WS_DG)) + (size_t)item * DK;
#pragma unroll
    for (int e2 = 0; e2 < DK / 64; ++e2) { const int task = tid + 512 * e2, i = task & 63, d8 = task >> 6;
        const f32x4 g0 = *(LAS f32x4*)(G + i * C::LDG + d8 * 8), g1 = *(LAS f32x4*)(G + i * C::LDG + d8 * 8 + 4);
        const f32x4 t0 = *(LAS f32x4*)(G + last * C::LDG + d8 * 8), t1 = *(LAS f32x4*)(G + last * C::LDG + d8 * 8 + 4);
        float kk[8]; unpack8(*(LAS bf16x8*)(Kb + i * C::LDK_ + d8 * 8), kk);
#pragma unroll
        for (int e = 0; e < 8; ++e) { const float gg = e < 4 ? g0[e] : g1[e - 4], tt = e < 4 ? t0[e] : t1[e - 4];
            KDT[(d8 * 8 + e) * LDT + i] = (bf16_t)f2bf(kk[e] * __expf(tt - gg)); }
        if (i == 0) { *(f32x4*)(Dout + d8 * 8) = (f32x4){__expf(t0[0]), __expf(t0[1]), __expf(t0[2]), __expf(t0[3])};
                      *(f32x4*)(Dout + d8 * 8 + 4) = (f32x4){__expf(t1[0]), __expf(t1[1]), __expf(t1[2]), __expf(t1[3])}; } }
    __syncthreads();
    bf16_t* ST = (bf16_t*)(wsb + (TYPE ? WS_SH : WS_SG)) + (size_t)item * 128 * DK;
    const bf16x8 b0 = *(LAS bf16x8*)(VT + (wid * 16 + fr) * LDT + fq * 8), b1 = *(LAS bf16x8*)(VT + (wid * 16 + fr) * LDT + 32 + fq * 8);
#pragma unroll
    for (int dt = 0; dt < DK / 16; ++dt) {
        const bf16x8 a0 = *(LAS bf16x8*)(KDT + (dt * 16 + fr) * LDT + fq * 8), a1 = *(LAS bf16x8*)(KDT + (dt * 16 + fr) * LDT + 32 + fq * 8);
        f32x4 acc = {0.f, 0.f, 0.f, 0.f};
        acc = __builtin_amdgcn_mfma_f32_16x16x32_bf16(a0, b0, acc, 0, 0, 0);
        acc = __builtin_amdgcn_mfma_f32_16x16x32_bf16(a1, b1, acc, 0, 0, 0);
        u32x2 w; w.x = cvt_pk_bf16(acc[0], acc[1]); w.y = cvt_pk_bf16(acc[2], acc[3]);
        *(u32x2*)(ST + (size_t)(wid * 16 + fr) * DK + dt * 16 + fq * 4) = w;
    }
}

template <int TYPE>
__device__ __forceinline__ void pass2_task(const KArgs& a, int task) {
    unsigned char* const wsb = opq(a.ws);
    constexpr int DK = Cfg<TYPE>::DK, PPI = 128 * DK / 2;
    const int chain = task / PPI, e = task % PPI, dir = chain & 1, d = (2 * e) % DK;
    unsigned* ST = (unsigned*)(wsb + (TYPE ? WS_SH : WS_SG)) + (size_t)chain * NCH * PPI + e;
    const float* Dp = (const float*)(wsb + (TYPE ? WS_DH : WS_DG)) + (size_t)chain * NCH * DK + d;
    float s0 = 0.f, s1 = 0.f;
    for (int sb = 0; sb < NCH; sb += 8) {
        unsigned uv[8]; f32x2 dv[8];
#pragma unroll
        for (int k = 0; k < 8; ++k) { const int ci = dir ? NCH - 1 - (sb + k) : sb + k; uv[k] = ST[(size_t)ci * PPI]; dv[k] = *(const f32x2*)(Dp + (size_t)ci * DK); }
#pragma unroll
        for (int k = 0; k < 8; ++k) { const int ci = dir ? NCH - 1 - (sb + k) : sb + k;
            ST[(size_t)ci * PPI] = pk2(s0, s1);
            s0 = dv[k][0] * s0 + bf2f(uv[k] & 0xffffu); s1 = dv[k][1] * s1 + bf2f(uv[k] >> 16); }
    }
}

template <int TYPE>
__device__ __forceinline__ void pass3_item(const KArgs& a, int l, int item, LAS unsigned char* lds) {
    unsigned char* const wsb = opq(a.ws);
    const int tid = opaque_tid();
    using C = Cfg<TYPE>; constexpr int DK = C::DK;
    const int c = item & (NCH - 1), h = (item >> 8) & 3, b = item >> 10;
    const size_t tok0 = (size_t)b * T + (size_t)c * 64;
    const bf16_t* u = (const bf16_t*)(wsb + WS_U);
    const int wid = tid >> 6, lane = tid & 63, fr = lane & 15, fq = lane >> 4;
    LAS float* G = (LAS float*)(lds + SC_G); LAS bf16_t* Kb = (LAS bf16_t*)(lds + SC_K); LAS bf16_t* QT = (LAS bf16_t*)(lds + SC_QT); LAS bf16_t* QG = (LAS bf16_t*)(lds + SC_QG);
    LAS bf16_t* VT = (LAS bf16_t*)(lds + SC_VT); LAS bf16_t* P = (LAS bf16_t*)(lds + SC_P); LAS float* RSQ = (LAS float*)(lds + SC_RSQ);
    __syncthreads();
    load_vT(u + tok0 * DINP + (TYPE ? C_HI : C_GV) + h * 128, lds, tid, wsb);
    f32x4 o[4];
#pragma unroll
    for (int it = 0; it < 4; ++it) o[it] = (f32x4){0.f, 0.f, 0.f, 0.f};
#pragma unroll 1
    for (int dir = 0; dir < 2; ++dir) {
        const int sitem = ((b * 4 + h) * 2 + dir) * NCH + c;
        const bf16_t* ST = (const bf16_t*)(wsb + (TYPE ? WS_SH : WS_SG)) + (size_t)sitem * 128 * DK + (size_t)(wid * 16 + fr) * DK + fq * 8;
        bf16x8 sf[DK / 32];
#pragma unroll
        for (int ks = 0; ks < DK / 32; ++ks) sf[ks] = *(const bf16x8*)(ST + ks * 32);
        if (dir) __syncthreads();
        load_lg_k<TYPE>(a, l, h, dir, tok0, lds, tid);
        cumsum_g<TYPE>(dir, lds, tid);
#pragma unroll
        for (int e2 = 0; e2 < DK / 64; ++e2) { const int task = tid + 512 * e2, i = task / C::ND8, d8 = task % C::ND8;
            const f32x4 g0 = *(LAS f32x4*)(G + i * C::LDG + d8 * 8), g1 = *(LAS f32x4*)(G + i * C::LDG + d8 * 8 + 4);
            const f32x4 m0 = *(LAS f32x4*)(G + 32 * C::LDG + d8 * 8), m1 = *(LAS f32x4*)(G + 32 * C::LDG + d8 * 8 + 4);
            float kk[8], qq[8], qt[8], qg[8]; unpack8(*(LAS bf16x8*)(Kb + i * C::LDK_ + d8 * 8), kk);
            unpack8(*(const bf16x8*)(u + (tok0 + i) * DINP + (TYPE ? C_HQ + h * 128 : C_GQ + h * 64) + d8 * 8), qq);
#pragma unroll
            for (int e = 0; e < 8; ++e) { const float gg = e < 4 ? g0[e] : g1[e - 4], gm = e < 4 ? m0[e] : m1[e - 4];
                const float q = TYPE ? silu_(qq[e]) : qq[e] * 0.125f;
                qt[e] = q * __expf(gg - gm); qg[e] = q * __expf(gg); kk[e] = kk[e] * __expf(gm - gg); }
            *(LAS bf16x8*)(QT + i * C::LDK_ + d8 * 8) = pack8(qt); *(LAS bf16x8*)(QG + i * C::LDK_ + d8 * 8) = pack8(qg); *(LAS bf16x8*)(Kb + i * C::LDK_ + d8 * 8) = pack8(kk); }
        __syncthreads();
        { const int it = wid >> 1;
#pragma unroll
          for (int jj = 0; jj < 2; ++jj) { const int jt = 2 * (wid & 1) + jj;
            f32x4 acc = {0.f, 0.f, 0.f, 0.f};
#pragma unroll
            for (int ks = 0; ks < DK / 32; ++ks) {
                const bf16x8 af = *(LAS bf16x8*)(QT + (it * 16 + fr) * C::LDK_ + ks * 32 + fq * 8), bfr = *(LAS bf16x8*)(Kb + (jt * 16 + fr) * C::LDK_ + ks * 32 + fq * 8);
                acc = __builtin_amdgcn_mfma_f32_16x16x32_bf16(af, bfr, acc, 0, 0, 0); }
#pragma unroll
            for (int r = 0; r < 4; ++r) { const int i = it * 16 + fq * 4 + r, j = jt * 16 + fr; const bool keep = dir ? (j >= i) : (j <= i);
                P[i * LDT + j] = (bf16_t)f2bf(keep ? acc[r] : 0.f); } } }
        __syncthreads();
        const bf16x8 vb0 = *(LAS bf16x8*)(VT + (wid * 16 + fr) * LDT + fq * 8), vb1 = *(LAS bf16x8*)(VT + (wid * 16 + fr) * LDT + 32 + fq * 8);
#pragma unroll
        for (int it = 0; it < 4; ++it) {
            const bf16x8 p0 = *(LAS bf16x8*)(P + (it * 16 + fr) * LDT + fq * 8), p1 = *(LAS bf16x8*)(P + (it * 16 + fr) * LDT + 32 + fq * 8);
            o[it] = __builtin_amdgcn_mfma_f32_16x16x32_bf16(p0, vb0, o[it], 0, 0, 0);
            o[it] = __builtin_amdgcn_mfma_f32_16x16x32_bf16(p1, vb1, o[it], 0, 0, 0);
#pragma unroll
            for (int ks = 0; ks < DK / 32; ++ks) { const bf16x8 af = *(LAS bf16x8*)(QG + (it * 16 + fr) * C::LDK_ + ks * 32 + fq * 8);
                o[it] = __builtin_amdgcn_mfma_f32_16x16x32_bf16(af, sf[ks], o[it], 0, 0, 0); }
        }
    }
#pragma unroll
    for (int it = 0; it < 4; ++it)
#pragma unroll
        for (int r = 0; r < 4; ++r) { float s = o[it][r] * o[it][r]; s += __shfl_xor(s, 1); s += __shfl_xor(s, 2); s += __shfl_xor(s, 4); s += __shfl_xor(s, 8);
            if (fr == 0) RSQ[wid * 64 + it * 16 + fq * 4 + r] = s; }
    __syncthreads();
    const float gain = ((const float*)a.in[TYPE ? 7 : 5])[l * 128 + wid * 16 + fr];
    bf16_t* mix = (bf16_t*)(wsb + WS_XN);
#pragma unroll
    for (int it = 0; it < 4; ++it)
#pragma unroll
        for (int r = 0; r < 4; ++r) { const int i = it * 16 + fq * 4 + r; float s = 0.f;
#pragma unroll
            for (int w = 0; w < 8; ++w) s += RSQ[w * 64 + i];
            const float rstd = rsqrtf(s * (1.f / 128.f) + EPS);
            const float gt = bf2f(u[(tok0 + i) * DINP + (TYPE ? C_HG : C_GG) + h * 128 + wid * 16 + fr]);
            const float yv = o[it][r] * rstd * gain * silu_(gt);
            mix[(tok0 + i) * DM + (TYPE ? 512 : 0) + h * 128 + wid * 16 + fr] = (bf16_t)f2bf(yv); }
}
}
__device__ __forceinline__ void rmsnorm_rows_bf16(const float* src, const float* gain, bf16_t* dst) {
    const int tid = opaque_tid(), lane = tid & 63, gw = blockIdx.x * 8 + (tid >> 6), ngw = gridDim.x * 8;
    for (int m = gw; m < M; m += ngw) {
        const f32x4* xr = (const f32x4*)(src + (size_t)m * DM) + lane;
        f32x4 v[8]; float s = 0.f;
#pragma unroll
        for (int j = 0; j < 8; ++j) { v[j] = xr[64 * j]; s += (v[j][0] * v[j][0] + v[j][1] * v[j][1]) + (v[j][2] * v[j][2] + v[j][3] * v[j][3]); }
        const float rstd = rsqrtf(wave_sum(s) * (1.f / DM) + EPS);
        u32x2* o8 = (u32x2*)(dst + (size_t)m * DM) + lane;
#pragma unroll
        for (int j = 0; j < 8; ++j) { const f32x4 g = ((const f32x4*)gain)[lane + 64 * j];
            u32x2 w; w.x = cvt_pk_bf16(v[j][0] * rstd * g[0], v[j][1] * rstd * g[1]); w.y = cvt_pk_bf16(v[j][2] * rstd * g[2], v[j][3] * rstd * g[3]); o8[64 * j] = w; }
    }
}
__device__ __forceinline__ void rmsnorm_rows_f32_inplace(float* buf, const float* gain) {
    const int tid = opaque_tid(), lane = tid & 63, gw = blockIdx.x * 8 + (tid >> 6), ngw = gridDim.x * 8;
    for (int m = gw; m < M; m += ngw) {
        f32x4* xr = (f32x4*)(buf + (size_t)m * DM) + lane;
        f32x4 v[8]; float s = 0.f;
#pragma unroll
        for (int j = 0; j < 8; ++j) { v[j] = xr[64 * j]; s += (v[j][0] * v[j][0] + v[j][1] * v[j][1]) + (v[j][2] * v[j][2] + v[j][3] * v[j][3]); }
        const float rstd = rsqrtf(wave_sum(s) * (1.f / DM) + EPS);
#pragma unroll
        for (int j = 0; j < 8; ++j) { const f32x4 g = ((const f32x4*)gain)[lane + 64 * j]; xr[64 * j] = v[j] * rstd * g; }
    }
}
__device__ __forceinline__ void convert_weights(const KArgs& a, int l, LAS unsigned char* lds) {
    unsigned char* const wsb = opq(a.ws);
    const int tid = opaque_tid();
    LAS float* tile = (LAS float*)lds;
    constexpr int I_IN = 32 * 84, I_QB = 8 * 24, I_KVB = 8 * 32, I_OUT = 32 * 32, I_13 = 32 * 176, I_2 = 88 * 32, NIT = I_IN + I_QB + I_KVB + I_OUT + I_13 + I_2;
    for (int it = blockIdx.x; it < NIT; it += gridDim.x) {
        int r = it, mode = 0, N, K, nkt; const float* w0; const float* w1 = nullptr; bf16_t* WT;
        if (r < I_IN) { w0 = (const float*)a.in[2] + (size_t)l * DM * DIN; N = DIN; K = DM; nkt = 32; WT = (bf16_t*)(wsb + WS_WIN); }
        else if ((r -= I_IN) < I_QB) { w0 = (const float*)a.in[9] + (size_t)l * 512 * 1536; N = 1536; K = 512; nkt = 8; mode = 1; WT = (bf16_t*)(wsb + WS_WQB); }
        else if ((r -= I_QB) < I_KVB) { w0 = (const float*)a.in[11] + (size_t)l * 512 * 2048; N = 2048; K = 512; nkt = 8; WT = (bf16_t*)(wsb + WS_WKVB); }
        else if ((r -= I_KVB) < I_OUT) { w0 = (const float*)a.in[12] + (size_t)l * DM * DM; N = DM; K = DM; nkt = 32; WT = (bf16_t*)(wsb + WS_WOUT); }
        else if ((r -= I_OUT) < I_13) { w0 = (const float*)a.in[15] + (size_t)l * DM * DFF; w1 = (const float*)a.in[16] + (size_t)l * DM * DFF; N = DFF; K = DM; nkt = 32; mode = 2; WT = (bf16_t*)(wsb + WS_W13); }
        else { r -= I_13; w0 = (const float*)a.in[17] + (size_t)l * DFF * DM; N = DM; K = DFF; nkt = 88; WT = (bf16_t*)(wsb + WS_W2); }
        const int kt = r % nkt, rt = r / nkt, r0 = rt * 64, k0 = kt * 64;
        __syncthreads();
#pragma unroll
        for (int e = 0; e < 8; ++e) { const int idx = tid + 512 * e, rl = idx & 63, kl = idx >> 6, rr = r0 + rl, k = k0 + kl; float v;
            if (mode == 0) v = rr < N ? w0[(size_t)k * N + rr] : 0.f;
            else if (mode == 1) { const int hh = rr / 192, ee = rr % 192; const int col = ee < 128 ? hh * 192 + ee : hh * 192 + 128 + ((ee - 128) & 1) * 32 + ((ee - 128) >> 1); v = w0[(size_t)k * N + col]; }
            else { const int g = rr >> 5, n = (rr >> 4) & 1, i = rr & 15; v = (n ? w1 : w0)[(size_t)k * N + 16 * g + i]; }
            tile[kl * 65 + rl] = v; }
        __syncthreads();
#pragma unroll
        for (int e = 0; e < 4; ++e) { const int idx = tid + 512 * e, kp = idx & 31, rl = idx >> 5;
            *(unsigned*)(WT + (size_t)(r0 + rl) * K + k0 + 2 * kp) = pk2(tile[(2 * kp) * 65 + rl], tile[(2 * kp + 1) * 65 + rl]); }
    }
    __syncthreads();
}
__device__ __forceinline__ void tables_phase(const KArgs& a) {
    unsigned char* const wsb = opq(a.ws);
    const int tid = opaque_tid();
    const int* pos = (const int*)a.in[1];
    float* cs = (float*)(wsb + WS_COS); float* sn = (float*)(wsb + WS_SIN);
    const int gt = blockIdx.x * 512 + tid, ngt = gridDim.x * 512;
    for (int idx = gt; idx < M * 32; idx += ngt) { const int tok = idx >> 5, i = idx & 31;
        const float inv = 1.0f / exp2f((float)(2 * i) * (1.f / 64.f) * 13.287712379549449f);
        const float ang = (float)pos[tok] * inv;
        double rev = (double)ang * 0.15915494309189535; rev -= rint(rev);
        const float f = (float)rev;
        cs[idx] = __builtin_amdgcn_cosf(f); sn[idx] = __builtin_amdgcn_sinf(f); }
    if (blockIdx.x == 0) { const float* lg = (const float*)a.in[6]; float* lb = (float*)(wsb + WS_LB);
        for (int p = tid; p < 2 * 512; p += 512) { const int dir = p >> 9, c = p & 511;
            float mx = -1e30f;
#pragma unroll
            for (int l = 0; l < DEPTH; ++l) mx = fmaxf(mx, lg[(dir * DEPTH + l) * 512 + c]);
            float den = 0.f;
#pragma unroll
            for (int l = 0; l < DEPTH; ++l) den += __expf(lg[(dir * DEPTH + l) * 512 + c] - mx);
            float cum = 0.f;
#pragma unroll
            for (int l = 0; l < DEPTH; ++l) { if (l > 0) cum += __expf(lg[(dir * DEPTH + l) * 512 + c] - mx) / den; lb[(dir * DEPTH + l) * 512 + c] = cum; } } }
}
__device__ __forceinline__ void mla_prep(const KArgs& a, int l) {
    unsigned char* const wsb = opq(a.ws);
    const int tid = opaque_tid(), lane = tid & 63, gw = blockIdx.x * 8 + (tid >> 6), ngw = gridDim.x * 8;
    bf16_t* u = (bf16_t*)(wsb + WS_U); bf16_t* kr = (bf16_t*)(wsb + WS_KR);
    const float* cs = (const float*)(wsb + WS_COS); const float* sn = (const float*)(wsb + WS_SIN);
    const float* gq = (const float*)a.in[8] + l * 512 + lane * 8; const float* gkv = (const float*)a.in[10] + l * 512 + lane * 8;
    for (int tok = gw; tok < M; tok += ngw) {
        bf16_t* ur = u + (size_t)tok * DINP;
#pragma unroll
        for (int w = 0; w < 2; ++w) { bf16_t* p = ur + (w ? C_CKV : C_CQ) + lane * 8; const float* g = w ? gkv : gq;
            float f[8]; unpack8(*(const bf16x8*)p, f); float s = 0.f;
#pragma unroll
            for (int e = 0; e < 8; ++e) s += f[e] * f[e];
            const float rstd = rsqrtf(wave_sum(s) * (1.f / 512.f) + EPS);
#pragma unroll
            for (int e = 0; e < 8; ++e) f[e] = f[e] * rstd * g[e];
            *(bf16x8*)p = pack8(f); }
        if (lane < 32) { const float x1 = bf2f(ur[C_KR + lane]), x2 = bf2f(ur[C_KR + 32 + lane]), c = cs[(size_t)tok * 32 + lane], s = sn[(size_t)tok * 32 + lane];
            *(unsigned*)(kr + (size_t)tok * 64 + 2 * lane) = pk2(x1 * c - x2 * s, x2 * c + x1 * s); }
    }
}

__device__ __forceinline__ void grid_barrier(unsigned* bar, unsigned nblk, unsigned& epoch) {
    __builtin_amdgcn_fence(__ATOMIC_RELEASE, "agent");
    asm volatile("s_waitcnt vmcnt(0) lgkmcnt(0)" ::: "memory");
    __syncthreads();
    epoch += nblk;
    if (threadIdx.x == 0) {
        __hip_atomic_fetch_add(bar, 1u, __ATOMIC_RELEASE, __HIP_MEMORY_SCOPE_AGENT);
        while (__hip_atomic_load(bar, __ATOMIC_ACQUIRE, __HIP_MEMORY_SCOPE_AGENT) < epoch) __builtin_amdgcn_s_sleep(2);
    }
    __syncthreads();
    __builtin_amdgcn_fence(__ATOMIC_ACQUIRE, "agent");
}
__global__ void __launch_bounds__(512, 2) mega_fwd(KArgs a) {
    extern __shared__ __attribute__((aligned(16))) unsigned char smem[];
    cg::grid_group grid = cg::this_grid();
    LAS unsigned char* lds = (LAS unsigned char*)smem;
    const int G = gridDim.x, bx = blockIdx.x;
    const float* x = (const float*)a.in[0];
    unsigned epoch = 0; unsigned* const gbar = (unsigned*)(a.ws + WS_BAR);
#define GBAR() grid_barrier(gbar, (unsigned)G, epoch)

#if PH_MISC
    tables_phase(a);
    convert_weights(a, 0, lds);
#endif
    rmsnorm_rows_bf16(x, (const float*)a.in[13], (bf16_t*)(opq(a.ws) + WS_XN));
    grid.sync();
    GBAR();
#pragma unroll 1
    for (int l = 0; l < DEPTH; ++l) {
        if (l > 0) {
#if PH_MISC
            convert_weights(a, l, lds);
#endif
            rmsnorm_rows_bf16(a.out, (const float*)a.in[13] + l * DM, (bf16_t*)(opq(a.ws) + WS_XN));
            GBAR();
        }
        { pg8::Gemm g{(const bf16_t*)(opq(a.ws) + WS_XN), (const bf16_t*)(opq(a.ws) + WS_WIN), M, DINP, DM, DM, DM}; pg8::StaticOrder S; S.init(M, DINP, G, bx);
          pg8::EpiU E{(bf16_t*)(opq(a.ws) + WS_U), DINP};
          __syncthreads(); if (PH_GEMM & 1) pg8::gemm_phase<pg8::EpiU, pg8::StaticOrder, true, true>(lds, g, S, E); }
        GBAR();
#if PH_MISC
        mla_prep(a, l);
#endif
#if PH_S1
        for (int it = bx; it < 4096; it += G) scan::pass1_item<1>(a, l, it, lds);
        for (int it = bx; it < 4096; it += G) scan::pass1_item<0>(a, l, it, lds);
#endif
        GBAR();
#if PH_S2
        for (int t = bx * 512 + opaque_tid(); t < 131072; t += G * 512) scan::pass2_task<1>(a, t);
        for (int t = bx * 512 + opaque_tid(); t < 65536; t += G * 512) scan::pass2_task<0>(a, t);
#endif
        { pg8::Gemm g{(const bf16_t*)(opq(a.ws) + WS_U) + C_CQ, (const bf16_t*)(opq(a.ws) + WS_WQB), M, 1536, 512, DINP, 512}; pg8::StaticOrder S; S.init(M, 1536, G, bx);
          pg8::EpiQ E{(bf16_t*)(opq(a.ws) + WS_Q), (const float*)(opq(a.ws) + WS_COS), (const float*)(opq(a.ws) + WS_SIN)};
          __syncthreads(); if (PH_GEMM & 2) pg8::gemm_phase<pg8::EpiQ, pg8::StaticOrder, true, true>(lds, g, S, E); }
        { pg8::Gemm g{(const bf16_t*)(opq(a.ws) + WS_U) + C_CKV, (const bf16_t*)(opq(a.ws) + WS_WKVB), M, 2048, 512, DINP, 512}; pg8::StaticOrder S; S.init(M, 2048, G, bx);
          pg8::EpiKV E{(bf16_t*)(opq(a.ws) + WS_KN), (bf16_t*)(opq(a.ws) + WS_V)};
          __syncthreads(); if (PH_GEMM & 4) pg8::gemm_phase<pg8::EpiKV, pg8::StaticOrder, true, true>(lds, g, S, E); }
        GBAR();
        { const bool x8 = (G % 8) == 0; const int xcd = bx & 7, slot = bx >> 3, nslot = G >> 3;
          for (int pr = 0; pr < (x8 ? 2 : 16); ++pr) { const int p = x8 ? xcd + 8 * pr : pr, b = p >> 3, h = p & 7;
            for (int qb = x8 ? slot : bx; qb < 64; qb += x8 ? nslot : G) {
              const bf16_t* Qb = (const bf16_t*)(opq(a.ws) + WS_Q) + ((size_t)(b * 8 + h) * T + (size_t)qb * 256) * 192;
              const bf16_t* Kn = (const bf16_t*)(opq(a.ws) + WS_KN) + (size_t)(b * 8 + h) * T * 128;
              const bf16_t* Kr = (const bf16_t*)(opq(a.ws) + WS_KR) + (size_t)b * T * 64;
              const bf16_t* Vh = (const bf16_t*)(opq(a.ws) + WS_V) + (size_t)(b * 8 + h) * T * 128;
              bf16_t* Ob = (bf16_t*)(opq(a.ws) + WS_XN) + ((size_t)b * T + (size_t)qb * 256) * DM + 1024 + h * 128;
#if PH_ATT
              att::attn_unit(Qb, Kn, Kr, Vh, Ob, (char*)smem);
#else
              { const int t_ = opaque_tid(); bf16_t* zp = Ob + (size_t)(t_ >> 1) * DM + (t_ & 1) * 64; (void)Qb; (void)Kn; (void)Kr; (void)Vh;
                for (int z_ = 0; z_ < 8; ++z_) *(u32x4*)(zp + z_ * 8) = (u32x4){0u, 0u, 0u, 0u}; }
#endif
 } } }
#if PH_S3
        for (int it = bx; it < 2048; it += G) scan::pass3_item<1>(a, l, it, lds);
        for (int it = bx; it < 2048; it += G) scan::pass3_item<0>(a, l, it, lds);
#else
        { bf16_t* mz = (bf16_t*)(opq(a.ws) + WS_XN); for (size_t z_ = (size_t)bx * 512 + opaque_tid(); z_ < (size_t)M * 128; z_ += (size_t)G * 512) *(u32x4*)(mz + (z_ >> 7) * DM + (z_ & 127) * 8) = (u32x4){0u, 0u, 0u, 0u}; }
#endif
        GBAR();
        { pg8::Gemm g{(const bf16_t*)(opq(a.ws) + WS_XN), (const bf16_t*)(opq(a.ws) + WS_WOUT), M, DM, DM, DM, DM}; pg8::StaticOrder S; S.init(M, DM, G, bx);
          pg8::EpiRes E{l == 0 ? x : (const float*)a.out, a.out};
          __syncthreads(); if (PH_GEMM & 8) pg8::gemm_phase<pg8::EpiRes, pg8::StaticOrder, true, true>(lds, g, S, E); }
        GBAR();
        rmsnorm_rows_bf16(a.out, (const float*)a.in[14] + l * DM, (bf16_t*)(opq(a.ws) + WS_XN));
        GBAR();
        { pg8::Gemm g{(const bf16_t*)(opq(a.ws) + WS_XN), (const bf16_t*)(opq(a.ws) + WS_W13), M, 2 * DFF, DM, DM, DM}; pg8::StaticOrder S; S.init(M, 2 * DFF, G, bx);
          pg8::EpiSwi E{(bf16_t*)(opq(a.ws) + WS_HID)};
          __syncthreads(); if (PH_GEMM & 16) pg8::gemm_phase<pg8::EpiSwi, pg8::StaticOrder, true, true>(lds, g, S, E); }
        GBAR();
        { pg8::Gemm g{(const bf16_t*)(opq(a.ws) + WS_HID), (const bf16_t*)(opq(a.ws) + WS_W2), M, DM, DFF, DFF, DFF}; pg8::StaticOrder S; S.init(M, DM, G, bx);
          pg8::EpiRes E{(const float*)a.out, a.out};
          __syncthreads(); if (PH_GEMM & 32) pg8::gemm_phase<pg8::EpiRes, pg8::StaticOrder, true, true>(lds, g, S, E); }
        GBAR();
    }
    rmsnorm_rows_f32_inplace(a.out, (const float*)a.in[18]);
}

extern "C" void kernel_launch(void* const* d_in, const int* in_sizes, int n_in, void* d_out, int out_size, void* d_ws, size_t ws_size, hipStream_t stream) {
    static int grid = 0;
    if (grid == 0) {
        if (n_in != 19 || out_size != M * DM || ws_size < WS_END) { fprintf(stderr, "kernel_launch: unexpected shapes (n_in %d out %d ws %zu)\n", n_in, out_size, ws_size); grid = -1; return; }
        int dev = 0, cus = 0, per_cu = 0;
        hipGetDevice(&dev); hipDeviceGetAttribute(&cus, hipDeviceAttributeMultiprocessorCount, dev);
        if (hipFuncSetAttribute((const void*)mega_fwd, hipFuncAttributeMaxDynamicSharedMemorySize, LDS_BYTES) != hipSuccess) { fprintf(stderr, "kernel_launch: hipFuncSetAttribute failed\n"); grid = -1; return; }
        if (hipOccupancyMaxActiveBlocksPerMultiprocessor(&per_cu, (const void*)mega_fwd, 512, LDS_BYTES) != hipSuccess || per_cu < 1) { fprintf(stderr, "kernel_launch: occupancy query says %d\n", per_cu); per_cu = 1; }
        (void)hipGetLastError();
        grid = cus * (per_cu > 1 ? 1 : per_cu);
    }
    if (grid < 0) return;
    KArgs a{};
    for (int i = 0; i < 19; ++i) a.in[i] = d_in[i];
    a.out = (float*)d_out; a.ws = (unsigned char*)d_ws;
    if (hipMemsetAsync((char*)d_ws + WS_BAR, 0, 256, stream) != hipSuccess) { fprintf(stderr, "kernel_launch: memset failed\n"); return; }
    void* args[] = {&a};
    hipError_t e = hipLaunchCooperativeKernel((const void*)mega_fwd, dim3(grid), dim3(512), args, LDS_BYTES, stream);
    if (e != hipSuccess) fprintf(stderr, "kernel_launch: cooperative launch failed: %s (grid %d)\n", hipGetErrorString(e), grid);
}
```

```cpp
#include <hip/hip_runtime.h>
#include <hip/hip_cooperative_groups.h>
#include <cstdint>
#include <cstdio>
namespace cg = cooperative_groups;
#ifndef PROBE_GEMM_REP
#define PROBE_GEMM_REP 1
#endif
#ifndef PROBE_SCAN_REP
#define PROBE_SCAN_REP 1
#endif
#ifndef PROBE_CVT_REP
#define PROBE_CVT_REP 1
#endif
#ifndef PROBE_ATT_REP
#define PROBE_ATT_REP 1
#endif
#ifndef PH_ATT
#define PH_ATT 1
#endif
#ifndef PH_S1
#define PH_S1 1
#endif
#ifndef PH_S2
#define PH_S2 1
#endif
#ifndef PH_S3
#define PH_S3 1
#endif
#ifndef PH_GEMM
#define PH_GEMM 63
#endif
#ifndef PH_MISC
#define PH_MISC 1
#endif

#define LAS __attribute__((address_space(3)))
typedef unsigned short bf16_t;
typedef short bf16x8 __attribute__((ext_vector_type(8)));
typedef short s16x4 __attribute__((ext_vector_type(4)));
typedef float f32x2 __attribute__((ext_vector_type(2)));
typedef float f32x4 __attribute__((ext_vector_type(4)));
typedef float f32x16 __attribute__((ext_vector_type(16)));
typedef unsigned u32x2 __attribute__((ext_vector_type(2)));
typedef unsigned u32x4 __attribute__((ext_vector_type(4)));

constexpr int NB = 2, T = 16384, M = NB * T, DM = 2048, DIN = 5216, DINP = 5376, DFF = 5632, DEPTH = 2;
constexpr int C_GQ = 0, C_GK = 256, C_GV = 512, C_GAF = 1024, C_GAB = 1040, C_GG = 1056, C_HQ = 1568, C_HFF = 2080, C_HFB = 2592, C_HI = 3104, C_HG = 3616,
              C_CQ = 4128, C_CKV = 4640, C_KR = 5152;
constexpr float EPS = 1e-6f;
constexpr int NCH = T / 64;
constexpr size_t MiB = 1048576;
constexpr size_t WS_WIN = 0, WS_WQB = 21 * MiB, WS_WKVB = WS_WQB + 3 * MiB / 2, WS_WOUT = WS_WKVB + 2 * MiB, WS_W13 = WS_WOUT + 8 * MiB, WS_W2 = WS_W13 + 44 * MiB;
constexpr size_t WS_XN = 99 * MiB, WS_U = 227 * MiB, WS_Q = 563 * MiB, WS_KN = 659 * MiB, WS_V = 723 * MiB, WS_KR = 787 * MiB, WS_SG = 791 * MiB, WS_SH = 855 * MiB,
                 WS_DG = 983 * MiB, WS_DH = 984 * MiB, WS_COS = 986 * MiB, WS_SIN = 990 * MiB, WS_LB = 994 * MiB, WS_BAR = 995 * MiB, WS_END = 996 * MiB, WS_HID = WS_U;
static_assert(WS_W2 + 22 * MiB <= WS_XN, "weights");
constexpr int LDS_BYTES = 131072;

struct KArgs { const void* in[19]; float* out; unsigned char* ws; };

__device__ __forceinline__ float bf2f(unsigned v) { return __uint_as_float(v << 16); }
__device__ __forceinline__ unsigned f2bf(float f) { unsigned u = __float_as_uint(f); return (u + 0x7fffu + ((u >> 16) & 1u)) >> 16; }
__device__ __forceinline__ unsigned pk2(float lo, float hi) { return f2bf(lo) | (f2bf(hi) << 16); }
typedef __bf16 bf16x2_t __attribute__((ext_vector_type(2)));
__device__ __forceinline__ unsigned cvt_pk_bf16(float lo, float hi) { f32x2 v = {lo, hi}; bf16x2_t b = __builtin_convertvector(v, bf16x2_t); return __builtin_bit_cast(unsigned, b); }
__device__ __forceinline__ float wave_sum(float v) {
#pragma unroll
    for (int o = 1; o < 64; o <<= 1) v += __shfl_xor(v, o);
    return v;
}
__device__ __forceinline__ unsigned char* opq(unsigned char* q) { asm volatile("" : "+s"(q)); return q; }
__device__ __forceinline__ int opaque_tid() { int t = threadIdx.x; asm volatile("" : "+v"(t)); return t; }
#define DBGF(ws_, cond_, bit_) do { if (cond_) atomicOr((unsigned*)((ws_) + WS_BAR) + 32, (unsigned)(bit_)); } while (0)
__device__ __forceinline__ bool badf(float v) { return !(fabsf(v) < 1e30f); }
__device__ __forceinline__ float sigmoid_(float z) { return 1.f / (1.f + __expf(-z)); }
__device__ __forceinline__ float silu_(float z) { return z * sigmoid_(z); }
__device__ __forceinline__ float logsigmoid_(float z) { return fminf(z, 0.f) - log1pf(__expf(-fabsf(z))); }
__device__ __forceinline__ void unpack8(bf16x8 v, float* f) {
#pragma unroll
    for (int e = 0; e < 8; ++e) f[e] = bf2f((unsigned)(unsigned short)v[e]);
}
__device__ __forceinline__ bf16x8 pack8(const float* f) {
    u32x4 w = {cvt_pk_bf16(f[0], f[1]), cvt_pk_bf16(f[2], f[3]), cvt_pk_bf16(f[4], f[5]), cvt_pk_bf16(f[6], f[7])};
    return __builtin_bit_cast(bf16x8, w);
}

namespace pg8 {
#define PG8_LAS __attribute__((address_space(3)))
constexpr int BM = 256, BK = 64, HALF = 128, HTB = HALF * BK * 2, STAGE_BYTES = 8 * HTB, NXCD = 8, WGM = 8;
__host__ __device__ __forceinline__ int lds_byte(int r, int c) { const int st = (r >> 4) * 2 + (c >> 5), rr = r & 15, cc = c & 31, ob = rr * 64 + cc * 2; return st * 1024 + (ob ^ (((ob >> 9) & 1) << 5)); }
__host__ __device__ __forceinline__ void stage_rc(int b, int& R, int& C) { const int st = b / 1024, sb = b % 1024, swz = sb ^ (((sb >> 9) & 1) << 5); R = (st >> 1) * 16 + swz / 64; C = (st & 1) * 32 + (swz % 64) / 2; }
__host__ __device__ __forceinline__ int perm32(int rho) { const int n = rho >> 4, i = rho & 15; return 8 * (i >> 2) + 4 * n + (i & 3); }
struct Unit { int pm, pn; };
struct Gemm { const bf16_t* A; const bf16_t* Bt; int M, N, K, lda, ldb; };
struct StaticOrder {
    int nM, nN, nwg, G, c;
    __host__ __device__ void init(int M_, int N_, int G_, int c_) { nM = M_ / BM; nN = N_ / BM; nwg = nM * nN; G = G_; c = c_; }
    __host__ __device__ bool next(int i, Unit& u) const {
        const long L = (long)i * G + c; if (L >= nwg) return false;
        int wgid = (int)L; { const int q = nwg / NXCD, r = nwg % NXCD, xcd = wgid % NXCD, off = wgid / NXCD; wgid = (xcd < r ? xcd * (q + 1) : r * (q + 1) + (xcd - r) * q) + off; }
        const int nig = WGM * nN, gid = wgid / nig, fm = gid * WGM, gsz = (nM - fm) < WGM ? (nM - fm) : WGM;
        u.pm = fm + ((wgid % nig) % gsz); u.pn = (wgid % nig) / gsz; return true;
    }
    __device__ __forceinline__ void a_ready(const Unit&) const {}
    __device__ __forceinline__ void done(const Unit&) const {}
};
template <class Epi, class Sched, bool ALIGN_EPI = false, bool SP2 = false>
__device__ __forceinline__ void gemm_phase(PG8_LAS unsigned char* lds, const Gemm g, const Sched& S, const Epi& E) {
    const int tid = opaque_tid(), wid = __builtin_amdgcn_readfirstlane(tid >> 6), lane = tid & 63, wr = wid >> 2, wc = wid & 3, fr = lane & 15, fq = lane >> 4;
    const int K = g.K, nt = K / BK;
    unsigned voffA[2], voffB[2];
#pragma unroll
    for (int i = 0; i < 2; ++i) { int R, C; stage_rc(tid * 16 + i * 8192, R, C); const int Rb = Epi::PERM ? ((R & ~31) + perm32(R & 31)) : R;
        voffA[i] = (unsigned)(R * g.lda + C) * 2u; voffB[i] = (unsigned)(Rb * g.ldb + C) * 2u; }
    const size_t kstep = (size_t)(BK * 2);
    const size_t hstepA = (size_t)HALF * g.lda * 2, hstepB = (size_t)HALF * g.ldb * 2;
    const size_t tstepA = 2 * hstepA, tstepB = 2 * hstepB;
    const unsigned ldsw = (unsigned)wid * 1024u;
    const int aoff = lds_byte(wr * 64 + fr, fq * 8), boff = lds_byte(wc * 32 + fr, fq * 8);
#define PG8_SA(b, h) (((b) * 2 + (h)) * HTB)
#define PG8_SB(b, h) ((4 + (b) * 2 + (h)) * HTB)
#define PG8_STAGE(bufoff, gbase, voff) do { _Pragma("unroll") for (int _i = 0; _i < 2; ++_i) \
        __builtin_amdgcn_global_load_lds((const unsigned*)((const char*)(gbase) + (voff)[_i]), (PG8_LAS unsigned*)(lds + (bufoff) + ldsw + _i * 8192), 16, 0, 0); } while (0)
#define PG8_LDA(dst, b, h) do { _Pragma("unroll") for (int m = 0; m < 4; ++m) _Pragma("unroll") for (int k = 0; k < 2; ++k) dst[m][k] = *(const PG8_LAS bf16x8*)(lds + PG8_SA(b, h) + aoff + m * 2048 + k * 1024); } while (0)
#define PG8_LDB(dst, b, h) do { _Pragma("unroll") for (int n = 0; n < 2; ++n) _Pragma("unroll") for (int k = 0; k < 2; ++k) dst[n][k] = *(const PG8_LAS bf16x8*)(lds + PG8_SB(b, h) + boff + n * 2048 + k * 1024); } while (0)
#define PG8_MMA(ai, bj, At, Bt) do { __builtin_amdgcn_s_setprio(1); _Pragma("unroll") for (int m = 0; m < 4; ++m) _Pragma("unroll") for (int n = 0; n < 2; ++n) _Pragma("unroll") for (int k = 0; k < 2; ++k) \
        acc[ai][bj][m][n] = __builtin_amdgcn_mfma_f32_16x16x32_bf16(Bt[n][k], At[m][k], acc[ai][bj][m][n], 0, 0, 0); __builtin_amdgcn_s_setprio(0); } while (0)
#define PG8_WAIT_V(n) asm volatile("s_waitcnt vmcnt(" #n ")" ::: "memory")
#define PG8_WAIT_L(n) asm volatile("s_waitcnt lgkmcnt(" #n ")" ::: "memory")
#define PG8_BAR __builtin_amdgcn_s_barrier()
#define PG8_SCHED __builtin_amdgcn_sched_barrier(0)
    Unit cur, nxt; int ui = 0;
    if (!S.next(0, cur)) return;
    f32x4 acc[2][2][4][2];
#pragma unroll
    for (int a = 0; a < 2; ++a)
#pragma unroll
        for (int b = 0; b < 2; ++b)
#pragma unroll
            for (int m = 0; m < 4; ++m)
#pragma unroll
                for (int n = 0; n < 2; ++n) acc[a][b][m][n] = (f32x4){0.f, 0.f, 0.f, 0.f};
    bf16x8 At[4][2], B0[2][2], B1[2][2];
    const char* cA = (const char*)g.A + (size_t)cur.pm * tstepA; const char* cB = (const char*)g.Bt + (size_t)cur.pn * tstepB;
    S.a_ready(cur);
    if constexpr (SP2) {
        PG8_STAGE(PG8_SB(0, 0), cB, voffB); PG8_STAGE(PG8_SB(0, 1), cB + hstepB, voffB); PG8_STAGE(PG8_SA(0, 0), cA, voffA); PG8_STAGE(PG8_SA(0, 1), cA + hstepA, voffA);
        if (wr == 1) PG8_BAR;
        PG8_WAIT_V(2); PG8_BAR;
        PG8_STAGE(PG8_SB(1, 0), cB + kstep, voffB); PG8_STAGE(PG8_SA(1, 0), cA + kstep, voffA); PG8_STAGE(PG8_SB(1, 1), cB + hstepB + kstep, voffB);
        PG8_WAIT_V(6); PG8_BAR;
    } else {
        PG8_STAGE(PG8_SB(0, 0), cB, voffB); PG8_STAGE(PG8_SA(0, 0), cA, voffA); PG8_STAGE(PG8_SB(0, 1), cB + hstepB, voffB); PG8_STAGE(PG8_SA(0, 1), cA + hstepA, voffA);
        if (wr == 1) PG8_BAR;
        PG8_WAIT_V(4); PG8_BAR;
        PG8_STAGE(PG8_SB(1, 0), cB + kstep, voffB); PG8_STAGE(PG8_SA(1, 0), cA + kstep, voffA); PG8_STAGE(PG8_SB(1, 1), cB + hstepB + kstep, voffB);
        PG8_WAIT_V(6); PG8_BAR;
    }
    for (;;) {
        const bool has_next = S.next(ui + 1, nxt);
        const char* nA = has_next ? (const char*)g.A + (size_t)nxt.pm * tstepA : cA; const char* nB = has_next ? (const char*)g.Bt + (size_t)nxt.pn * tstepB : cB;
        for (int t = 0; t < nt; t += 2) {
            const bool last = (t == nt - 2);
            const char* a1 = cA + (size_t)(t + 1) * kstep;
            const char* a2 = last ? nA : cA + (size_t)(t + 2) * kstep; const char* b2 = last ? nB : cB + (size_t)(t + 2) * kstep;
            const char* a3 = a2 + kstep; const char* b3 = b2 + kstep;
            if (last && has_next) S.a_ready(nxt);
            if constexpr (SP2) {
            PG8_LDB(B0, 0, 0); PG8_LDB(B1, 0, 1); PG8_SCHED; PG8_LDA(At, 0, 0); PG8_STAGE(PG8_SA(1, 1), a1 + hstepA, voffA);
            PG8_WAIT_V(8); PG8_WAIT_L(0); PG8_BAR; PG8_MMA(0, 0, At, B0); PG8_MMA(0, 1, At, B1); PG8_BAR; PG8_SCHED;
            PG8_LDA(At, 0, 1); PG8_STAGE(PG8_SB(0, 0), b2, voffB); PG8_STAGE(PG8_SB(0, 1), b2 + hstepB, voffB); PG8_STAGE(PG8_SA(0, 0), a2, voffA);
            PG8_WAIT_V(8); PG8_WAIT_L(0); PG8_BAR; PG8_MMA(1, 0, At, B0); PG8_MMA(1, 1, At, B1); PG8_BAR; PG8_SCHED;
            PG8_LDB(B0, 1, 0); PG8_LDB(B1, 1, 1); PG8_SCHED; PG8_LDA(At, 1, 0); PG8_STAGE(PG8_SA(0, 1), a2 + hstepA, voffA);
            PG8_WAIT_V(8); PG8_WAIT_L(0); PG8_BAR; PG8_MMA(0, 0, At, B0); PG8_MMA(0, 1, At, B1); PG8_BAR; PG8_SCHED;
            PG8_LDA(At, 1, 1); PG8_STAGE(PG8_SB(1, 0), b3, voffB); PG8_STAGE(PG8_SB(1, 1), b3 + hstepB, voffB); PG8_STAGE(PG8_SA(1, 0), a3, voffA);
            PG8_WAIT_V(8); PG8_WAIT_L(0); PG8_BAR; PG8_MMA(1, 0, At, B0); PG8_MMA(1, 1, At, B1); PG8_BAR; PG8_SCHED;
            } else {
            PG8_LDB(B0, 0, 0); PG8_SCHED; PG8_LDA(At, 0, 0); PG8_STAGE(PG8_SA(1, 1), a1 + hstepA, voffA);
            PG8_WAIT_L(8); PG8_BAR; PG8_WAIT_L(0); PG8_MMA(0, 0, At, B0); PG8_BAR; PG8_SCHED;
            PG8_LDB(B1, 0, 1); PG8_STAGE(PG8_SB(0, 0), b2, voffB);
            PG8_BAR; PG8_WAIT_L(0); PG8_MMA(0, 1, At, B1); PG8_BAR;
            PG8_LDA(At, 0, 1); PG8_STAGE(PG8_SA(0, 0), a2, voffA);
            PG8_BAR; PG8_WAIT_L(0); PG8_MMA(1, 0, At, B0); PG8_BAR; PG8_SCHED;
            PG8_STAGE(PG8_SB(0, 1), b2 + hstepB, voffB);
            PG8_WAIT_V(6); PG8_BAR; PG8_MMA(1, 1, At, B1); PG8_BAR;
            PG8_LDB(B0, 1, 0); PG8_SCHED; PG8_LDA(At, 1, 0); PG8_STAGE(PG8_SA(0, 1), a2 + hstepA, voffA);
            PG8_WAIT_L(8); PG8_BAR; PG8_WAIT_L(0); PG8_MMA(0, 0, At, B0); PG8_BAR; PG8_SCHED;
            PG8_LDB(B1, 1, 1); PG8_STAGE(PG8_SB(1, 0), b3, voffB);
            PG8_BAR; PG8_WAIT_L(0); PG8_MMA(0, 1, At, B1); PG8_BAR;
            PG8_LDA(At, 1, 1); PG8_STAGE(PG8_SA(1, 0), a3, voffA);
            PG8_BAR; PG8_WAIT_L(0); PG8_MMA(1, 0, At, B0); PG8_BAR; PG8_SCHED;
            PG8_STAGE(PG8_SB(1, 1), b3 + hstepB, voffB);
            PG8_WAIT_V(6); PG8_BAR; PG8_MMA(1, 1, At, B1); PG8_BAR;
            }
        }
        if constexpr (ALIGN_EPI) { if (wr == 0) PG8_BAR; }
        if constexpr (!Epi::AFTER_DRAIN) { E(acc, cur, wr, wc, fr, fq); S.done(cur); }
        if (!has_next) break;
#pragma unroll
        for (int a = 0; a < 2; ++a)
#pragma unroll
            for (int b = 0; b < 2; ++b)
#pragma unroll
                for (int m = 0; m < 4; ++m)
#pragma unroll
                    for (int n = 0; n < 2; ++n) acc[a][b][m][n] = (f32x4){0.f, 0.f, 0.f, 0.f};
        cur = nxt; cA = nA; cB = nB; ++ui;
        if constexpr (ALIGN_EPI) { if (wr == 1) PG8_BAR; }
    }
    PG8_WAIT_V(0);
    if constexpr (!ALIGN_EPI) { if (wr == 0) PG8_BAR; }
    PG8_BAR;
    if constexpr (Epi::AFTER_DRAIN) { E.fused(acc, cur, wr, wc, fr, fq, lds, wid, lane); S.done(cur); }
#undef PG8_SA
#undef PG8_SB
#undef PG8_STAGE
#undef PG8_LDA
#undef PG8_LDB
#undef PG8_MMA
#undef PG8_WAIT_V
#undef PG8_WAIT_L
#undef PG8_BAR
#undef PG8_SCHED
}
struct EpiU {
    static constexpr bool PERM = true, AFTER_DRAIN = false;
    bf16_t* O; int ldc;
    __device__ __forceinline__ void operator()(const f32x4 (&acc)[2][2][4][2], const Unit& u, int wr, int wc, int fr, int fq) const {
        const int row0 = u.pm * BM + wr * 64 + fr, col0 = u.pn * BM + wc * 32 + 8 * fq;
#pragma unroll
        for (int ai = 0; ai < 2; ++ai)
#pragma unroll
            for (int m = 0; m < 4; ++m) { bf16_t* rowp = O + (size_t)(row0 + ai * HALF + m * 16) * ldc + col0;
#pragma unroll
                for (int bj = 0; bj < 2; ++bj) { const f32x4 v0 = acc[ai][bj][m][0], v1 = acc[ai][bj][m][1];
                    u32x4 w; w.x = cvt_pk_bf16(v0[0], v0[1]); w.y = cvt_pk_bf16(v0[2], v0[3]); w.z = cvt_pk_bf16(v1[0], v1[1]); w.w = cvt_pk_bf16(v1[2], v1[3]);
                    *(u32x4*)(rowp + bj * HALF) = w; } }
    }
};
struct EpiQ {
    static constexpr bool PERM = true, AFTER_DRAIN = false;
    bf16_t* Q; const float* cs; const float* sn;
    __device__ __forceinline__ void operator()(const f32x4 (&acc)[2][2][4][2], const Unit& u, int wr, int wc, int fr, int fq) const {
        const int row0 = u.pm * BM + wr * 64 + fr;
#pragma unroll
        for (int ai = 0; ai < 2; ++ai)
#pragma unroll
            for (int m = 0; m < 4; ++m) { const int row = row0 + ai * HALF + m * 16, b = row / T, t = row % T;
#pragma unroll
                for (int bj = 0; bj < 2; ++bj) { const int c = u.pn * BM + bj * HALF + wc * 32 + 8 * fq, hh = c / 192, e = c % 192;
                    const f32x4 v0 = acc[ai][bj][m][0], v1 = acc[ai][bj][m][1];
                    float vals[8] = {v0[0], v0[1], v0[2], v0[3], v1[0], v1[1], v1[2], v1[3]};
                    if (e >= 128) { const int i0 = (e - 128) >> 1; const f32x4 cc = *(const f32x4*)(cs + (size_t)row * 32 + i0), ss = *(const f32x4*)(sn + (size_t)row * 32 + i0);
#pragma unroll
                        for (int p = 0; p < 4; ++p) { const float x1 = vals[2 * p], x2 = vals[2 * p + 1]; vals[2 * p] = x1 * cc[p] - x2 * ss[p]; vals[2 * p + 1] = x2 * cc[p] + x1 * ss[p]; } }
                    u32x4 w; w.x = cvt_pk_bf16(vals[0], vals[1]); w.y = cvt_pk_bf16(vals[2], vals[3]); w.z = cvt_pk_bf16(vals[4], vals[5]); w.w = cvt_pk_bf16(vals[6], vals[7]);
                    *(u32x4*)(Q + ((size_t)(b * 8 + hh) * T + t) * 192 + e) = w; } }
    }
};
struct EpiKV {
    static constexpr bool PERM = true, AFTER_DRAIN = false;
    bf16_t* KN; bf16_t* V;
    __device__ __forceinline__ void operator()(const f32x4 (&acc)[2][2][4][2], const Unit& u, int wr, int wc, int fr, int fq) const {
        const int row0 = u.pm * BM + wr * 64 + fr, e = wc * 32 + 8 * fq;
#pragma unroll
        for (int ai = 0; ai < 2; ++ai)
#pragma unroll
            for (int m = 0; m < 4; ++m) { const int row = row0 + ai * HALF + m * 16, b = row / T, t = row % T;
                const size_t off = ((size_t)(b * 8 + u.pn) * T + t) * 128 + e;
#pragma unroll
                for (int bj = 0; bj < 2; ++bj) { const f32x4 v0 = acc[ai][bj][m][0], v1 = acc[ai][bj][m][1];
                    u32x4 w; w.x = cvt_pk_bf16(v0[0], v0[1]); w.y = cvt_pk_bf16(v0[2], v0[3]); w.z = cvt_pk_bf16(v1[0], v1[1]); w.w = cvt_pk_bf16(v1[2], v1[3]);
                    *(u32x4*)((bj ? V : KN) + off) = w; } }
    }
};
struct EpiSwi {
    static constexpr bool PERM = false, AFTER_DRAIN = false;
    bf16_t* H;
    __device__ __forceinline__ void operator()(const f32x4 (&acc)[2][2][4][2], const Unit& u, int wr, int wc, int fr, int fq) const {
        const int row0 = u.pm * BM + wr * 64 + fr;
#pragma unroll
        for (int ai = 0; ai < 2; ++ai)
#pragma unroll
            for (int m = 0; m < 4; ++m) { bf16_t* rowp = H + (size_t)(row0 + ai * HALF + m * 16) * DFF;
#pragma unroll
                for (int bj = 0; bj < 2; ++bj) { const f32x4 a = acc[ai][bj][m][0], g = acc[ai][bj][m][1];
                    const int col = 16 * (8 * u.pn + 4 * bj + wc) + 4 * fq;
                    u32x2 w; w.x = cvt_pk_bf16(silu_(a[0]) * g[0], silu_(a[1]) * g[1]); w.y = cvt_pk_bf16(silu_(a[2]) * g[2], silu_(a[3]) * g[3]);
                    *(u32x2*)(rowp + col) = w; } }
    }
};
struct EpiRes {
    static constexpr bool PERM = false, AFTER_DRAIN = false;
    const float* base; float* out;
    __device__ __forceinline__ void operator()(const f32x4 (&acc)[2][2][4][2], const Unit& u, int wr, int wc, int fr, int fq) const {
        const int row0 = u.pm * BM + wr * 64 + fr, col0 = u.pn * BM + wc * 32 + 4 * fq;
#pragma unroll
        for (int ai = 0; ai < 2; ++ai)
#pragma unroll
            for (int m = 0; m < 4; ++m) { const size_t off = (size_t)(row0 + ai * HALF + m * 16) * DM + col0;
#pragma unroll
                for (int bj = 0; bj < 2; ++bj)
#pragma unroll
                    for (int n = 0; n < 2; ++n) { const f32x4 bs = *(const f32x4*)(base + off + bj * HALF + n * 16); *(f32x4*)(out + off + bj * HALF + n * 16) = bs + acc[ai][bj][m][n]; } }
    }
};

}
namespace att {
constexpr int KVBLK = 64;
constexpr float SCALE = 0.07216878364870322f;
constexpr float THR = 8.f;
constexpr int SHM_V = KVBLK * 128 * 2, SHM_K = KVBLK * 192 * 2;
#ifndef ATT_SDEPTH
#define ATT_SDEPTH 1
#endif
constexpr int SDEPTH = ATT_SDEPTH;
#define KSWZ(row, colB) ((row) * 384 + ((colB) ^ (((row) & 7) << 4)))
#define SBAR() __builtin_amdgcn_sched_barrier(0)
__device__ __forceinline__ int crow(int r, int hi) { return (r & 3) + 8 * (r >> 2) + 4 * hi; }
__device__ __forceinline__ unsigned cvtpk(float lo, float hi) { return cvt_pk_bf16(lo, hi); }
__device__ __forceinline__ void partialSM(f32x16& p0, f32x16& p1, float& m_reg, float& mn, float& alpha) {
  constexpr float C = SCALE * 1.4426950408889634f;
  float pmax = p0[0];
#pragma unroll
  for (int r = 1; r < 16; ++r) pmax = fmaxf(pmax, p0[r]);
#pragma unroll
  for (int r = 0; r < 16; ++r) pmax = fmaxf(pmax, p1[r]);
  { auto rr = __builtin_amdgcn_permlane32_swap(__float_as_uint(pmax), __float_as_uint(pmax), false, false);
    pmax = fmaxf(__uint_as_float(rr[0]), __uint_as_float(rr[1])); }
  if (__builtin_expect(__all(pmax - m_reg <= THR / SCALE), 1)) { mn = m_reg; alpha = 1.f; }
  else { mn = fmaxf(m_reg, pmax); alpha = __builtin_amdgcn_exp2f((m_reg - mn) * C); m_reg = mn; }
  float mnC = -mn * C;
#pragma unroll
  for (int r = 0; r < 16; ++r) p0[r] = fmaf(p0[r], C, mnC);
#pragma unroll
  for (int r = 0; r < 16; ++r) p1[r] = fmaf(p1[r], C, mnC);
#pragma unroll
  for (int r = 0; r < 16; ++r) p0[r] = __builtin_amdgcn_exp2f(p0[r]);
}
__device__ __forceinline__ void finishSM(f32x16& p0, f32x16& p1, float alpha, float& l_reg, bf16x8& pa0, bf16x8& pa1, bf16x8& pa2, bf16x8& pa3) {
#pragma unroll
  for (int r = 0; r < 16; ++r) p1[r] = __builtin_amdgcn_exp2f(p1[r]);
  float ps = 0;
#pragma unroll
  for (int r = 0; r < 16; ++r) ps += p0[r];
#pragma unroll
  for (int r = 0; r < 16; ++r) ps += p1[r];
  { auto rr = __builtin_amdgcn_permlane32_swap(__float_as_uint(ps), __float_as_uint(ps), false, false);
    ps = __uint_as_float(rr[0]) + __uint_as_float(rr[1]); }
  l_reg = l_reg * alpha + ps;
#define PK4(P, BASE, OUT) do { unsigned a0 = cvtpk(P[BASE + 0], P[BASE + 1]), a1 = cvtpk(P[BASE + 2], P[BASE + 3]);   \
    unsigned b0 = cvtpk(P[BASE + 4], P[BASE + 5]), b1 = cvtpk(P[BASE + 6], P[BASE + 7]);                              \
    auto r0 = __builtin_amdgcn_permlane32_swap(a0, b0, false, false); auto r1 = __builtin_amdgcn_permlane32_swap(a1, b1, false, false); \
    u32x4 w = {r0[0], r1[0], r0[1], r1[1]}; OUT = __builtin_bit_cast(bf16x8, w); } while (0)
  PK4(p0, 0, pa0); PK4(p0, 8, pa1); PK4(p1, 0, pa2); PK4(p1, 8, pa3);
#undef PK4
}
__device__ __forceinline__ void qkt(f32x16& p0, f32x16& p1, const char* Ks, const bf16x8* qr, const char* qL, int r32, int hi) {
  p0 = f32x16{}; p1 = f32x16{};
#pragma unroll
  for (int d0 = 0; d0 < 12; ++d0) { int cb = (d0 * 16 + hi * 8) * 2;
    bf16x8 b0 = *reinterpret_cast<const bf16x8*>(Ks + KSWZ(r32, cb));
    bf16x8 b1 = *reinterpret_cast<const bf16x8*>(Ks + KSWZ(32 + r32, cb));
    const bf16x8 q = d0 < 8 ? qr[d0 < 8 ? d0 : 0] : *reinterpret_cast<const bf16x8*>(qL + (d0 - 8) * 1024);
    p0 = __builtin_amdgcn_mfma_f32_32x32x16_bf16(b0, q, p0, 0, 0, 0);
    p1 = __builtin_amdgcn_mfma_f32_32x32x16_bf16(b1, q, p1, 0, 0, 0); }
}
__device__ __forceinline__ int v_st(int k, int c) { const int kk = (k & ~0xC) | ((k & 4) << 1) | ((k & 8) >> 1); return ((kk >> 3) * 4 + (c >> 5)) * 512 + ((kk & 7) * 32 + (c & 31)) * 2; }
__device__ __forceinline__ int v_rd_base(int lane) { return ((lane & 3) << 3) | (((lane >> 2) & 3) << 6) | (((lane >> 4) & 1) << 5) | (((lane >> 5) & 1) << 8); }
constexpr int v_rd_off(int d0, int ks, int half) { return d0 * 512 + ks * 4096 + half * 2048; }
template <int OFF> __device__ __forceinline__ s16x4 tr_read(int vb) {
  s16x4 r; asm volatile("ds_read_b64_tr_b16 %0, %1 offset:%2" : "=&v"(r) : "v"(vb), "i"(OFF) : "memory"); return r;
}
template <int D0> __device__ __forceinline__ void pv_one(f32x16& od, int vb, bf16x8 pa0, bf16x8 pa1, bf16x8 pa2, bf16x8 pa3) {
  const s16x4 l0 = tr_read<v_rd_off(D0, 0, 0)>(vb), h0 = tr_read<v_rd_off(D0, 0, 1)>(vb), l1 = tr_read<v_rd_off(D0, 1, 0)>(vb), h1 = tr_read<v_rd_off(D0, 1, 1)>(vb);
  const s16x4 l2 = tr_read<v_rd_off(D0, 2, 0)>(vb), h2 = tr_read<v_rd_off(D0, 2, 1)>(vb), l3 = tr_read<v_rd_off(D0, 3, 0)>(vb), h3 = tr_read<v_rd_off(D0, 3, 1)>(vb);
  asm volatile("s_waitcnt lgkmcnt(0)" ::: "memory"); SBAR();
#define PK(L, H) (bf16x8){L[0], L[1], L[2], L[3], H[0], H[1], H[2], H[3]}
  od = __builtin_amdgcn_mfma_f32_32x32x16_bf16(pa0, PK(l0, h0), od, 0, 0, 0);
  od = __builtin_amdgcn_mfma_f32_32x32x16_bf16(pa1, PK(l1, h1), od, 0, 0, 0);
  od = __builtin_amdgcn_mfma_f32_32x32x16_bf16(pa2, PK(l2, h2), od, 0, 0, 0);
  od = __builtin_amdgcn_mfma_f32_32x32x16_bf16(pa3, PK(l3, h3), od, 0, 0, 0);
#undef PK
}
__device__ __forceinline__ void pv_d0(f32x16* o, int vb, bf16x8 pa0, bf16x8 pa1, bf16x8 pa2, bf16x8 pa3) {
  pv_one<0>(o[0], vb, pa0, pa1, pa2, pa3); pv_one<1>(o[1], vb, pa0, pa1, pa2, pa3); pv_one<2>(o[2], vb, pa0, pa1, pa2, pa3); pv_one<3>(o[3], vb, pa0, pa1, pa2, pa3);
}
__device__ __forceinline__ void attn_unit(const bf16_t* __restrict__ Qb, const bf16_t* __restrict__ Kn, const bf16_t* __restrict__ Kr, const bf16_t* __restrict__ Vh,
                                          bf16_t* __restrict__ Ob, char* lds) {
  const int tid = opaque_tid(), wid = tid >> 6, lane = tid & 63, r32 = lane & 31, hi = lane >> 5;
  char* V_lds = lds; char* K_lds = lds + 2 * SHM_V;
  float* ws = (float*)(lds + 2 * SHM_V + 2 * SHM_K) + wid * 64; float* li_l = ws; float* al_l = ws + 32;
  float m_reg = -1e30f, l_reg = 0; f32x16 o[4] = {}; bf16x8 qr[8];
  char* qL = lds + 2 * SHM_V + 2 * SHM_K + 2048 + wid * 4096 + lane * 16;
  const bf16_t* Qw = Qb + (long)(wid * 32 + r32) * 192 + hi * 8;
#pragma unroll
  for (int d0 = 0; d0 < 8; ++d0) qr[d0] = *reinterpret_cast<const bf16x8*>(Qw + d0 * 16);
#pragma unroll
  for (int d0 = 8; d0 < 12; ++d0) *reinterpret_cast<bf16x8*>(qL + (d0 - 8) * 1024) = *reinterpret_cast<const bf16x8*>(Qw + d0 * 16);
  const int sr = tid >> 4, sc = (tid & 15) * 8, vst0 = v_st(sr, sc), vst1 = v_st(32 + sr, sc);
  const int rr = tid >> 3, rc = (tid & 7) * 8;
  const int kst0 = KSWZ(sr, sc * 2), kst1 = KSWZ(32 + sr, sc * 2), kst2 = KSWZ(rr, 256 + rc * 2);
  const int vb0 = (int)(uintptr_t)V_lds + v_rd_base(lane);
  struct { bf16x8 vs0, vs1, ks0, ks1, ks2; } sr_[SDEPTH];
#define SLOAD(i, k0) do { sr_[i].vs0 = *(const bf16x8*)(&Vh[(long)((k0) + sr) * 128 + sc]); sr_[i].vs1 = *(const bf16x8*)(&Vh[(long)((k0) + 32 + sr) * 128 + sc]); \
    sr_[i].ks0 = *(const bf16x8*)(&Kn[(long)((k0) + sr) * 128 + sc]); sr_[i].ks1 = *(const bf16x8*)(&Kn[(long)((k0) + 32 + sr) * 128 + sc]); \
    sr_[i].ks2 = *(const bf16x8*)(&Kr[(long)((k0) + rr) * 64 + rc]); } while (0)
#define SWRITE(b, i) do { *(bf16x8*)(V_lds + (b) * SHM_V + vst0) = sr_[i].vs0; *(bf16x8*)(V_lds + (b) * SHM_V + vst1) = sr_[i].vs1; \
    *(bf16x8*)(K_lds + (b) * SHM_K + kst0) = sr_[i].ks0; *(bf16x8*)(K_lds + (b) * SHM_K + kst1) = sr_[i].ks1; *(bf16x8*)(K_lds + (b) * SHM_K + kst2) = sr_[i].ks2; } while (0)
#define SWAIT() do { if constexpr (SDEPTH == 2) asm volatile("s_waitcnt vmcnt(5)" ::: "memory"); else asm volatile("s_waitcnt vmcnt(0)" ::: "memory"); } while (0)
#define RESC(a) do { if (__any((a) < 1.f)) { if (hi == 0) al_l[r32] = (a); asm volatile("s_waitcnt lgkmcnt(0)" ::: "memory"); \
    _Pragma("unroll") for (int d = 0; d < 4; ++d) _Pragma("unroll") for (int r = 0; r < 16; ++r) o[d][r] *= al_l[crow(r, hi)]; } } while (0)
  f32x16 pA0, pA1, pB0, pB1; float mnA, mnB, alA, alB; bf16x8 pa0, pa1, pa2, pa3; const int NT = T / KVBLK;
  constexpr int SE = 0, SO = SDEPTH - 1;
  SLOAD(SE, 0); asm volatile("s_waitcnt vmcnt(0)" ::: "memory"); SWRITE(0, SE); __syncthreads();
  qkt(pA0, pA1, K_lds, qr, qL, r32, hi); partialSM(pA0, pA1, m_reg, mnA, alA);
  SLOAD(SO, KVBLK); if constexpr (SDEPTH == 2) { if (2 < NT) SLOAD(SE, 2 * KVBLK); }
  SWAIT(); SWRITE(1, SO); __syncthreads();
  for (int j = 1; j + 1 < NT; j += 2) {
    SBAR(); qkt(pB0, pB1, K_lds + SHM_K, qr, qL, r32, hi);
    finishSM(pA0, pA1, alA, l_reg, pa0, pa1, pa2, pa3); SBAR();
    SLOAD(SO, (j + SDEPTH) * KVBLK); SBAR();
    pv_d0(o, vb0, pa0, pa1, pa2, pa3); partialSM(pB0, pB1, m_reg, mnB, alB);
    __syncthreads(); SWAIT(); SWRITE(0, SE);
    RESC(alB); __syncthreads();
    SBAR(); qkt(pA0, pA1, K_lds, qr, qL, r32, hi);
    finishSM(pB0, pB1, alB, l_reg, pa0, pa1, pa2, pa3); SBAR();
    if (SDEPTH == 1 || j + 3 < NT) SLOAD(SE, (j + 1 + SDEPTH) * KVBLK); SBAR();
    pv_d0(o, vb0 + (int)SHM_V, pa0, pa1, pa2, pa3); partialSM(pA0, pA1, m_reg, mnA, alA);
    __syncthreads(); SWAIT(); SWRITE(1, SO);
    RESC(alA); __syncthreads();
  }
  SBAR(); qkt(pB0, pB1, K_lds + SHM_K, qr, qL, r32, hi);
  finishSM(pA0, pA1, alA, l_reg, pa0, pa1, pa2, pa3); SBAR();
  pv_d0(o, vb0, pa0, pa1, pa2, pa3); partialSM(pB0, pB1, m_reg, mnB, alB);
  __syncthreads(); RESC(alB);
  finishSM(pB0, pB1, alB, l_reg, pa0, pa1, pa2, pa3); SBAR();
  pv_d0(o, vb0 + (int)SHM_V, pa0, pa1, pa2, pa3);
  if (hi == 0) li_l[r32] = l_reg; asm volatile("s_waitcnt lgkmcnt(0)" ::: "memory");
  float rli[16];
#pragma unroll
  for (int r = 0; r < 16; ++r) rli[r] = __builtin_amdgcn_rcpf(li_l[crow(r, hi)]);
  bf16_t* Ow = Ob + (long)(wid * 32) * DM;
#pragma unroll
  for (int r = 0; r < 16; ++r) { int orow = crow(r, hi);
#pragma unroll
    for (int d0 = 0; d0 < 4; ++d0) Ow[(long)orow * DM + d0 * 32 + r32] = (bf16_t)f2bf(o[d0][r] * rli[r]); }
#undef SLOAD
#undef SWRITE
#undef SWAIT
#undef RESC
  __syncthreads();
}
}
namespace scan {
constexpr int LDT = 72;
constexpr int SC_G = 0, SC_K = 33792, SC_QT = SC_K + 17408, SC_QG = SC_QT + 17408, SC_VT = SC_QG + 17408, SC_P = SC_VT + 18432, SC_SEG = SC_P + 9216, SC_RSQ = SC_SEG + 4096,
              SC_END = SC_RSQ + 2048, SC_KDT = SC_QT;
static_assert(SC_END <= LDS_BYTES, "scan LDS");

template <int TYPE> struct Cfg { static constexpr int DK = TYPE ? 128 : 64, LDG = DK + 4, LDK_ = DK + 8, ND8 = DK / 8; };

template <int TYPE>
__device__ __forceinline__ void load_lg_k(const KArgs& a, int l, int h, int dir, size_t tok0, LAS unsigned char* lds, int tid) {
    unsigned char* const wsb = opq(a.ws);
    using C = Cfg<TYPE>;
    const bf16_t* u = (const bf16_t*)(wsb + WS_U);
    LAS float* G = (LAS float*)(lds + SC_G); LAS bf16_t* Kb = (LAS bf16_t*)(lds + SC_K);
    if constexpr (TYPE == 1) {
        const float* lbp = (const float*)(wsb + WS_LB) + (dir * DEPTH + l) * 512 + h * 128;
#pragma unroll
        for (int e2 = 0; e2 < 2; ++e2) { const int task = tid + 512 * e2, i = task >> 4, d8 = task & 15;
            const bf16x8 z8 = *(const bf16x8*)(u + (tok0 + i) * DINP + (dir ? C_HFB : C_HFF) + h * 128 + d8 * 8);
            float z[8], lg[8], kk[8]; unpack8(z8, z);
            const f32x4 lb0 = *(const f32x4*)(lbp + d8 * 8), lb1 = *(const f32x4*)(lbp + d8 * 8 + 4);
            const float lb[8] = {lb0[0], lb0[1], lb0[2], lb0[3], lb1[0], lb1[1], lb1[2], lb1[3]};
#pragma unroll
            for (int e = 0; e < 8; ++e) { const float sg = sigmoid_(fmaxf(z[e], -80.f)); lg[e] = __logf(lb[e] + (1.f - lb[e]) * sg); kk[e] = (1.f - lb[e]) * (1.f - sg); }
            *(LAS f32x4*)(G + i * C::LDG + d8 * 8) = (f32x4){lg[0], lg[1], lg[2], lg[3]}; *(LAS f32x4*)(G + i * C::LDG + d8 * 8 + 4) = (f32x4){lg[4], lg[5], lg[6], lg[7]};
            *(LAS bf16x8*)(Kb + i * C::LDK_ + d8 * 8) = pack8(kk); }
    } else {
        const int i = tid >> 3, d8 = tid & 7;
        const bf16_t* ur = u + (tok0 + i) * DINP;
        float ua[16]; unpack8(*(const bf16x8*)(ur + (dir ? C_GAB : C_GAF)), ua); unpack8(*(const bf16x8*)(ur + (dir ? C_GAB : C_GAF) + 8), ua + 8);
        const float* up = (const float*)a.in[3] + (size_t)((l * 2 + dir) * 16) * 256 + h * 64 + d8 * 8;
        const float* bs = (const float*)a.in[4] + (l * 2 + dir) * 256 + h * 64 + d8 * 8;
        f32x4 z0 = *(const f32x4*)bs, z1 = *(const f32x4*)(bs + 4);
#pragma unroll
        for (int r = 0; r < 16; ++r) { z0 += ua[r] * *(const f32x4*)(up + r * 256); z1 += ua[r] * *(const f32x4*)(up + r * 256 + 4); }
        f32x4 g0, g1;
#pragma unroll
        for (int e = 0; e < 4; ++e) { g0[e] = logsigmoid_(z0[e]) * (1.f / 16.f); g1[e] = logsigmoid_(z1[e]) * (1.f / 16.f); }
        *(LAS f32x4*)(G + i * C::LDG + d8 * 8) = g0; *(LAS f32x4*)(G + i * C::LDG + d8 * 8 + 4) = g1;
        *(LAS bf16x8*)(Kb + i * C::LDK_ + d8 * 8) = *(const bf16x8*)(ur + C_GK + h * 64 + d8 * 8);
    }
}
template <int TYPE>
__device__ __forceinline__ void cumsum_g(int dir, LAS unsigned char* lds, int tid) {
    using C = Cfg<TYPE>; constexpr int NSEG = 512 / C::DK, SEGL = 64 / NSEG;
    LAS float* G = (LAS float*)(lds + SC_G); LAS float* SG = (LAS float*)(lds + SC_SEG);
    const int d = tid % C::DK, seg = tid / C::DK;
    __syncthreads();
    float run = 0.f;
#pragma unroll
    for (int ii = 0; ii < SEGL; ++ii) { const int i = seg * SEGL + (dir ? SEGL - 1 - ii : ii); run += G[i * C::LDG + d]; G[i * C::LDG + d] = run; }
    SG[seg * 128 + d] = run;
    __syncthreads();
    float off = 0.f;
#pragma unroll
    for (int s = 0; s < NSEG; ++s) { const bool before = dir ? (s > seg) : (s < seg); if (before) off += SG[s * 128 + d]; }
#pragma unroll
    for (int ii = 0; ii < SEGL; ++ii) { const int i = seg * SEGL + ii; G[i * C::LDG + d] += off; }
    __syncthreads();
}
__device__ __forceinline__ void load_vT(const bf16_t* vsrc, LAS unsigned char* lds, int tid, unsigned char* wsd) {
    LAS bf16_t* VT = (LAS bf16_t*)(lds + SC_VT);
#pragma unroll
    for (int e2 = 0; e2 < 2; ++e2) { const int task = tid + 512 * e2, i = task & 63, v8 = task >> 6;
        const bf16x8 x = *(const bf16x8*)(vsrc + (size_t)i * DINP + v8 * 8);
#pragma unroll
        for (int e = 0; e < 8; ++e) { VT[(v8 * 8 + e) * LDT + i] = (bf16_t)x[e]; } }
}

template <int TYPE>
__device__ __forceinline__ void pass1_item(const KArgs& a, int l, int item, LAS unsigned char* lds) {
    unsigned char* const wsb = opq(a.ws);
    const int tid = opaque_tid();
    using C = Cfg<TYPE>; constexpr int DK = C::DK;
    const int c = item & (NCH - 1), dir = (item >> 8) & 1, h = (item >> 9) & 3, b = item >> 11;
    const size_t tok0 = (size_t)b * T + (size_t)c * 64;
    const bf16_t* u = (const bf16_t*)(wsb + WS_U);
    const int wid = tid >> 6, lane = tid & 63, fr = lane & 15, fq = lane >> 4;
    __syncthreads();
    load_lg_k<TYPE>(a, l, h, dir, tok0, lds, tid);
    load_vT(u + tok0 * DINP + (TYPE ? C_HI : C_GV) + h * 128, lds, tid, wsb);
    cumsum_g<TYPE>(dir, lds, tid);
    LAS float* G = (LAS float*)(lds + SC_G); LAS bf16_t* Kb = (LAS bf16_t*)(lds + SC_K); LAS bf16_t* KDT = (LAS bf16_t*)(lds + SC_KDT); LAS bf16_t* VT = (LAS bf16_t*)(lds + SC_VT);
    const int last = dir ? 0 : 63;
    float* Dout = (float*)(wsb + (TYPE ? WS_DH : WS_DG)) + (size_t)item * DK;
#pragma unroll
    for (int e2 = 0; e2 < DK / 64; ++e2) { const int task = tid + 512 * e2, i = task & 63, d8 = task >> 6;
        const f32x4 g0 = *(LAS f32x4*)(G + i * C::LDG + d8 * 8), g1 = *(LAS f32x4*)(G + i * C::LDG + d8 * 8 + 4);
        const f32x4 t0 = *(LAS f32x4*)(G + last * C::LDG + d8 * 8), t1 = *(LAS f32x4*)(G + last * C::LDG + d8 * 8 + 4);
        float kk[8]; unpack8(*(LAS bf16x8*)(Kb + i * C::LDK_ + d8 * 8), kk);
#pragma unroll
        for (int e = 0; e < 8; ++e) { const float gg = e < 4 ? g0[e] : g1[e - 4], tt = e < 4 ? t0[e] : t1[e - 4];
            KDT[(d8 * 8 + e) * LDT + i] = (bf16_t)f2bf(kk[e] * __expf(tt - gg)); }
        if (i == 0) { *(f32x4*)(Dout + d8 * 8) = (f32x4){__expf(t0[0]), __expf(t0[1]), __expf(t0[2]), __expf(t0[3])};
                      *(f32x4*)(Dout + d8 * 8 + 4) = (f32x4){__expf(t1[0]), __expf(t1[1]), __expf(t1[2]), __expf(t1[3])}; } }
    __syncthreads();
    bf16_t* ST = (bf16_t*)(wsb + (TYPE ? WS_SH : WS_SG)) + (size_t)item * 128 * DK;
    const bf16x8 b0 = *(LAS bf16x8*)(VT + (wid * 16 + fr) * LDT + fq * 8), b1 = *(LAS bf16x8*)(VT + (wid * 16 + fr) * LDT + 32 + fq * 8);
#pragma unroll
    for (int dt = 0; dt < DK / 16; ++dt) {
        const bf16x8 a0 = *(LAS bf16x8*)(KDT + (dt * 16 + fr) * LDT + fq * 8), a1 = *(LAS bf16x8*)(KDT + (dt * 16 + fr) * LDT + 32 + fq * 8);
        f32x4 acc = {0.f, 0.f, 0.f, 0.f};
        acc = __builtin_amdgcn_mfma_f32_16x16x32_bf16(a0, b0, acc, 0, 0, 0);
        acc = __builtin_amdgcn_mfma_f32_16x16x32_bf16(a1, b1, acc, 0, 0, 0);
        u32x2 w; w.x = cvt_pk_bf16(acc[0], acc[1]); w.y = cvt_pk_bf16(acc[2], acc[3]);
        *(u32x2*)(ST + (size_t)(wid * 16 + fr) * DK + dt * 16 + fq * 4) = w;
    }
}

struct P2Chain { bf16_t* st; const float* dp; size_t sstride; int dstride; int dir; };
__device__ __forceinline__ P2Chain p2_chain(unsigned char* wsb, int type, int E) {
    const int DK = type ? 128 : 64, IPI = 128 * DK;
    const int chain = E / IPI, e = E % IPI;
    P2Chain c; c.st = (bf16_t*)(wsb + (type ? WS_SH : WS_SG)) + (size_t)chain * NCH * IPI + e;
    c.dp = (const float*)(wsb + (type ? WS_DH : WS_DG)) + (size_t)chain * NCH * DK + (e % DK);
    c.sstride = (size_t)IPI; c.dstride = DK; c.dir = chain & 1; return c;
}
__device__ __forceinline__ void pass2_triple(const KArgs& a, int t) {
    unsigned char* const wsb = opq(a.ws);
    const P2Chain c0 = p2_chain(wsb, 1, t), c1 = p2_chain(wsb, 1, t + 131072), c2 = p2_chain(wsb, 0, t);
    float s0 = 0.f, s1 = 0.f, s2 = 0.f;
    unsigned short uA[3][4], uB[3][4]; float dA[3][4], dB[3][4];
#define P2_CI(c, s) ((c).dir ? NCH - 1 - (s) : (s))
#define P2_LOAD(U, D, sb) do { _Pragma("unroll") for (int k = 0; k < 4; ++k) { \
        const int i0_ = P2_CI(c0, (sb) + k), i1_ = P2_CI(c1, (sb) + k), i2_ = P2_CI(c2, (sb) + k); \
        U[0][k] = c0.st[(size_t)i0_ * c0.sstride]; D[0][k] = c0.dp[(size_t)i0_ * c0.dstride]; \
        U[1][k] = c1.st[(size_t)i1_ * c1.sstride]; D[1][k] = c1.dp[(size_t)i1_ * c1.dstride]; \
        U[2][k] = c2.st[(size_t)i2_ * c2.sstride]; D[2][k] = c2.dp[(size_t)i2_ * c2.dstride]; } } while (0)
#define P2_STEP(U, D, sb) do { _Pragma("unroll") for (int k = 0; k < 4; ++k) { \
        const int i0_ = P2_CI(c0, (sb) + k), i1_ = P2_CI(c1, (sb) + k), i2_ = P2_CI(c2, (sb) + k); \
        c0.st[(size_t)i0_ * c0.sstride] = (bf16_t)f2bf(s0); s0 = D[0][k] * s0 + bf2f(U[0][k]); \
        c1.st[(size_t)i1_ * c1.sstride] = (bf16_t)f2bf(s1); s1 = D[1][k] * s1 + bf2f(U[1][k]); \
        c2.st[(size_t)i2_ * c2.sstride] = (bf16_t)f2bf(s2); s2 = D[2][k] * s2 + bf2f(U[2][k]); } } while (0)
    P2_LOAD(uA, dA, 0);
#pragma unroll 1
    for (int sb = 0; sb < NCH; sb += 8) {
        P2_LOAD(uB, dB, sb + 4);
        P2_STEP(uA, dA, sb);
        if (sb + 8 < NCH) P2_LOAD(uA, dA, sb + 8);
        P2_STEP(uB, dB, sb + 4);
    }
#undef P2_CI
#undef P2_LOAD
#undef P2_STEP
}

template <int TYPE>
__device__ __forceinline__ void pass3_item(const KArgs& a, int l, int item, LAS unsigned char* lds) {
    unsigned char* const wsb = opq(a.ws);
    const int tid = opaque_tid();
    using C = Cfg<TYPE>; constexpr int DK = C::DK;
    const int c = item & (NCH - 1), h = (item >> 8) & 3, b = item >> 10;
    const size_t tok0 = (size_t)b * T + (size_t)c * 64;
    const bf16_t* u = (const bf16_t*)(wsb + WS_U);
    const int wid = tid >> 6, lane = tid & 63, fr = lane & 15, fq = lane >> 4;
    LAS float* G = (LAS float*)(lds + SC_G); LAS bf16_t* Kb = (LAS bf16_t*)(lds + SC_K); LAS bf16_t* QT = (LAS bf16_t*)(lds + SC_QT); LAS bf16_t* QG = (LAS bf16_t*)(lds + SC_QG);
    LAS bf16_t* VT = (LAS bf16_t*)(lds + SC_VT); LAS bf16_t* P = (LAS bf16_t*)(lds + SC_P); LAS float* RSQ = (LAS float*)(lds + SC_RSQ);
    __syncthreads();
    load_vT(u + tok0 * DINP + (TYPE ? C_HI : C_GV) + h * 128, lds, tid, wsb);
    f32x4 o[4];
#pragma unroll
    for (int it = 0; it < 4; ++it) o[it] = (f32x4){0.f, 0.f, 0.f, 0.f};
#pragma unroll 1
    for (int dir = 0; dir < 2; ++dir) {
        const int sitem = ((b * 4 + h) * 2 + dir) * NCH + c;
        const bf16_t* ST = (const bf16_t*)(wsb + (TYPE ? WS_SH : WS_SG)) + (size_t)sitem * 128 * DK + (size_t)(wid * 16 + fr) * DK + fq * 8;
        bf16x8 sf[DK / 32];
#pragma unroll
        for (int ks = 0; ks < DK / 32; ++ks) sf[ks] = *(const bf16x8*)(ST + ks * 32);
        if (dir) __syncthreads();
        load_lg_k<TYPE>(a, l, h, dir, tok0, lds, tid);
        cumsum_g<TYPE>(dir, lds, tid);
#pragma unroll
        for (int e2 = 0; e2 < DK / 64; ++e2) { const int task = tid + 512 * e2, i = task / C::ND8, d8 = task % C::ND8;
            const f32x4 g0 = *(LAS f32x4*)(G + i * C::LDG + d8 * 8), g1 = *(LAS f32x4*)(G + i * C::LDG + d8 * 8 + 4);
            const f32x4 m0 = *(LAS f32x4*)(G + 32 * C::LDG + d8 * 8), m1 = *(LAS f32x4*)(G + 32 * C::LDG + d8 * 8 + 4);
            float kk[8], qq[8], qt[8], qg[8]; unpack8(*(LAS bf16x8*)(Kb + i * C::LDK_ + d8 * 8), kk);
            unpack8(*(const bf16x8*)(u + (tok0 + i) * DINP + (TYPE ? C_HQ + h * 128 : C_GQ + h * 64) + d8 * 8), qq);
#pragma unroll
            for (int e = 0; e < 8; ++e) { const float gg = e < 4 ? g0[e] : g1[e - 4], gm = e < 4 ? m0[e] : m1[e - 4];
                const float q = TYPE ? silu_(qq[e]) : qq[e] * 0.125f;
                qt[e] = q * __expf(gg - gm); qg[e] = q * __expf(gg); kk[e] = kk[e] * __expf(gm - gg); }
            *(LAS bf16x8*)(QT + i * C::LDK_ + d8 * 8) = pack8(qt); *(LAS bf16x8*)(QG + i * C::LDK_ + d8 * 8) = pack8(qg); *(LAS bf16x8*)(Kb + i * C::LDK_ + d8 * 8) = pack8(kk); }
        __syncthreads();
        { const int it = wid >> 1;
#pragma unroll
          for (int jj = 0; jj < 2; ++jj) { const int jt = 2 * (wid & 1) + jj;
            f32x4 acc = {0.f, 0.f, 0.f, 0.f};
#pragma unroll
            for (int ks = 0; ks < DK / 32; ++ks) {
                const bf16x8 af = *(LAS bf16x8*)(QT + (it * 16 + fr) * C::LDK_ + ks * 32 + fq * 8), bfr = *(LAS bf16x8*)(Kb + (jt * 16 + fr) * C::LDK_ + ks * 32 + fq * 8);
                acc = __builtin_amdgcn_mfma_f32_16x16x32_bf16(af, bfr, acc, 0, 0, 0); }
#pragma unroll
            for (int r = 0; r < 4; ++r) { const int i = it * 16 + fq * 4 + r, j = jt * 16 + fr; const bool keep = dir ? (j >= i) : (j <= i);
                P[i * LDT + j] = (bf16_t)f2bf(keep ? acc[r] : 0.f); } } }
        __syncthreads();
        const bf16x8 vb0 = *(LAS bf16x8*)(VT + (wid * 16 + fr) * LDT + fq * 8), vb1 = *(LAS bf16x8*)(VT + (wid * 16 + fr) * LDT + 32 + fq * 8);
#pragma unroll
        for (int it = 0; it < 4; ++it) {
            const bf16x8 p0 = *(LAS bf16x8*)(P + (it * 16 + fr) * LDT + fq * 8), p1 = *(LAS bf16x8*)(P + (it * 16 + fr) * LDT + 32 + fq * 8);
            o[it] = __builtin_amdgcn_mfma_f32_16x16x32_bf16(p0, vb0, o[it], 0, 0, 0);
            o[it] = __builtin_amdgcn_mfma_f32_16x16x32_bf16(p1, vb1, o[it], 0, 0, 0);
#pragma unroll
            for (int ks = 0; ks < DK / 32; ++ks) { const bf16x8 af = *(LAS bf16x8*)(QG + (it * 16 + fr) * C::LDK_ + ks * 32 + fq * 8);
                o[it] = __builtin_amdgcn_mfma_f32_16x16x32_bf16(af, sf[ks], o[it], 0, 0, 0); }
        }
    }
#pragma unroll
    for (int it = 0; it < 4; ++it)
#pragma unroll
        for (int r = 0; r < 4; ++r) { float s = o[it][r] * o[it][r]; s += __shfl_xor(s, 1); s += __shfl_xor(s, 2); s += __shfl_xor(s, 4); s += __shfl_xor(s, 8);
            if (fr == 0) RSQ[wid * 64 + it * 16 + fq * 4 + r] = s; }
    __syncthreads();
    const float gain = ((const float*)a.in[TYPE ? 7 : 5])[l * 128 + wid * 16 + fr];
    bf16_t* mix = (bf16_t*)(wsb + WS_XN);
#pragma unroll
    for (int it = 0; it < 4; ++it)
#pragma unroll
        for (int r = 0; r < 4; ++r) { const int i = it * 16 + fq * 4 + r; float s = 0.f;
#pragma unroll
            for (int w = 0; w < 8; ++w) s += RSQ[w * 64 + i];
            const float rstd = rsqrtf(s * (1.f / 128.f) + EPS);
            const float gt = bf2f(u[(tok0 + i) * DINP + (TYPE ? C_HG : C_GG) + h * 128 + wid * 16 + fr]);
            const float yv = o[it][r] * rstd * gain * silu_(gt);
            mix[(tok0 + i) * DM + (TYPE ? 512 : 0) + h * 128 + wid * 16 + fr] = (bf16_t)f2bf(yv); }
}
}
__device__ __forceinline__ void rmsnorm_rows_bf16(const float* src, const float* gain, bf16_t* dst) {
    const int tid = opaque_tid(), lane = tid & 63, gw = blockIdx.x * 8 + (tid >> 6), ngw = gridDim.x * 8;
    for (int m = gw; m < M; m += ngw) {
        const f32x4* xr = (const f32x4*)(src + (size_t)m * DM) + lane;
        f32x4 v[8]; float s = 0.f;
#pragma unroll
        for (int j = 0; j < 8; ++j) { v[j] = xr[64 * j]; s += (v[j][0] * v[j][0] + v[j][1] * v[j][1]) + (v[j][2] * v[j][2] + v[j][3] * v[j][3]); }
        const float rstd = rsqrtf(wave_sum(s) * (1.f / DM) + EPS);
        u32x2* o8 = (u32x2*)(dst + (size_t)m * DM) + lane;
#pragma unroll
        for (int j = 0; j < 8; ++j) { const f32x4 g = ((const f32x4*)gain)[lane + 64 * j];
            u32x2 w; w.x = cvt_pk_bf16(v[j][0] * rstd * g[0], v[j][1] * rstd * g[1]); w.y = cvt_pk_bf16(v[j][2] * rstd * g[2], v[j][3] * rstd * g[3]); o8[64 * j] = w; }
    }
}
__device__ __forceinline__ void rmsnorm_rows_f32_inplace(float* buf, const float* gain) {
    const int tid = opaque_tid(), lane = tid & 63, gw = blockIdx.x * 8 + (tid >> 6), ngw = gridDim.x * 8;
    for (int m = gw; m < M; m += ngw) {
        f32x4* xr = (f32x4*)(buf + (size_t)m * DM) + lane;
        f32x4 v[8]; float s = 0.f;
#pragma unroll
        for (int j = 0; j < 8; ++j) { v[j] = xr[64 * j]; s += (v[j][0] * v[j][0] + v[j][1] * v[j][1]) + (v[j][2] * v[j][2] + v[j][3] * v[j][3]); }
        const float rstd = rsqrtf(wave_sum(s) * (1.f / DM) + EPS);
#pragma unroll
        for (int j = 0; j < 8; ++j) { const f32x4 g = ((const f32x4*)gain)[lane + 64 * j]; xr[64 * j] = v[j] * rstd * g; }
    }
}
__device__ __forceinline__ void convert_weights(const KArgs& a, int l, LAS unsigned char* lds) {
    unsigned char* const wsb = opq(a.ws);
    const int tid = opaque_tid();
    LAS float* tile = (LAS float*)lds;
    constexpr int I_IN = 32 * 84, I_QB = 8 * 24, I_KVB = 8 * 32, I_OUT = 32 * 32, I_13 = 32 * 176, I_2 = 88 * 32, NIT = I_IN + I_QB + I_KVB + I_OUT + I_13 + I_2;
    for (int it = blockIdx.x; it < NIT; it += gridDim.x) {
        int r = it, mode = 0, N, K, nkt; const float* w0; const float* w1 = nullptr; bf16_t* WT;
        if (r < I_IN) { w0 = (const float*)a.in[2] + (size_t)l * DM * DIN; N = DIN; K = DM; nkt = 32; WT = (bf16_t*)(wsb + WS_WIN); }
        else if ((r -= I_IN) < I_QB) { w0 = (const float*)a.in[9] + (size_t)l * 512 * 1536; N = 1536; K = 512; nkt = 8; mode = 1; WT = (bf16_t*)(wsb + WS_WQB); }
        else if ((r -= I_QB) < I_KVB) { w0 = (const float*)a.in[11] + (size_t)l * 512 * 2048; N = 2048; K = 512; nkt = 8; WT = (bf16_t*)(wsb + WS_WKVB); }
        else if ((r -= I_KVB) < I_OUT) { w0 = (const float*)a.in[12] + (size_t)l * DM * DM; N = DM; K = DM; nkt = 32; WT = (bf16_t*)(wsb + WS_WOUT); }
        else if ((r -= I_OUT) < I_13) { w0 = (const float*)a.in[15] + (size_t)l * DM * DFF; w1 = (const float*)a.in[16] + (size_t)l * DM * DFF; N = DFF; K = DM; nkt = 32; mode = 2; WT = (bf16_t*)(wsb + WS_W13); }
        else { r -= I_13; w0 = (const float*)a.in[17] + (size_t)l * DFF * DM; N = DM; K = DFF; nkt = 88; WT = (bf16_t*)(wsb + WS_W2); }
        const int kt = r % nkt, rt = r / nkt, r0 = rt * 64, k0 = kt * 64;
        __syncthreads();
        if (mode == 1) {
#pragma unroll
            for (int e = 0; e < 8; ++e) { const int idx = tid + 512 * e, rl = idx & 63, kl = idx >> 6, rr = r0 + rl, k = k0 + kl;
                const int hh = rr / 192, ee = rr % 192; const int col = ee < 128 ? hh * 192 + ee : hh * 192 + 128 + ((ee - 128) & 1) * 32 + ((ee - 128) >> 1);
                tile[kl * 65 + rl] = w0[(size_t)k * N + col]; }
        } else {
#pragma unroll
            for (int e = 0; e < 2; ++e) { const int idx = tid + 512 * e, r4 = (idx & 15) * 4, kl = idx >> 4, rr = r0 + r4, k = k0 + kl;
                f32x4 v = {0.f, 0.f, 0.f, 0.f};
                if (mode == 0) { if (rr < N) v = *(const f32x4*)(w0 + (size_t)k * N + rr); }
                else { const int g = rr >> 5, n = (rr >> 4) & 1, i = rr & 15; v = *(const f32x4*)((n ? w1 : w0) + (size_t)k * N + 16 * g + i); }
                tile[kl * 65 + r4] = v[0]; tile[kl * 65 + r4 + 1] = v[1]; tile[kl * 65 + r4 + 2] = v[2]; tile[kl * 65 + r4 + 3] = v[3]; }
        }
        __syncthreads();
        { const int k8 = tid & 7, rl = tid >> 3;
          u32x4 w; w.x = pk2(tile[(8 * k8 + 0) * 65 + rl], tile[(8 * k8 + 1) * 65 + rl]); w.y = pk2(tile[(8 * k8 + 2) * 65 + rl], tile[(8 * k8 + 3) * 65 + rl]);
          w.z = pk2(tile[(8 * k8 + 4) * 65 + rl], tile[(8 * k8 + 5) * 65 + rl]); w.w = pk2(tile[(8 * k8 + 6) * 65 + rl], tile[(8 * k8 + 7) * 65 + rl]);
          *(u32x4*)(WT + (size_t)(r0 + rl) * K + k0 + 8 * k8) = w; }
    }
    __syncthreads();
}
__device__ __forceinline__ void tables_phase(const KArgs& a) {
    unsigned char* const wsb = opq(a.ws);
    const int tid = opaque_tid();
    const int* pos = (const int*)a.in[1];
    float* cs = (float*)(wsb + WS_COS); float* sn = (float*)(wsb + WS_SIN);
    const int gt = blockIdx.x * 512 + tid, ngt = gridDim.x * 512;
    for (int idx = gt; idx < M * 32; idx += ngt) { const int tok = idx >> 5, i = idx & 31;
        const float inv = 1.0f / exp2f((float)(2 * i) * (1.f / 64.f) * 13.287712379549449f);
        const float ang = (float)pos[tok] * inv;
        double rev = (double)ang * 0.15915494309189535; rev -= rint(rev);
        const float f = (float)rev;
        cs[idx] = __builtin_amdgcn_cosf(f); sn[idx] = __builtin_amdgcn_sinf(f); }
    if (blockIdx.x == 0) { const float* lg = (const float*)a.in[6]; float* lb = (float*)(wsb + WS_LB);
        for (int p = tid; p < 2 * 512; p += 512) { const int dir = p >> 9, c = p & 511;
            float mx = -1e30f;
#pragma unroll
            for (int l = 0; l < DEPTH; ++l) mx = fmaxf(mx, lg[(dir * DEPTH + l) * 512 + c]);
            float den = 0.f;
#pragma unroll
            for (int l = 0; l < DEPTH; ++l) den += __expf(lg[(dir * DEPTH + l) * 512 + c] - mx);
            float cum = 0.f;
#pragma unroll
            for (int l = 0; l < DEPTH; ++l) { if (l > 0) cum += __expf(lg[(dir * DEPTH + l) * 512 + c] - mx) / den; lb[(dir * DEPTH + l) * 512 + c] = cum; } } }
}
__device__ __forceinline__ void mla_prep(const KArgs& a, int l) {
    unsigned char* const wsb = opq(a.ws);
    const int tid = opaque_tid(), lane = tid & 63, gw = blockIdx.x * 8 + (tid >> 6), ngw = gridDim.x * 8;
    bf16_t* u = (bf16_t*)(wsb + WS_U); bf16_t* kr = (bf16_t*)(wsb + WS_KR);
    const float* cs = (const float*)(wsb + WS_COS); const float* sn = (const float*)(wsb + WS_SIN);
    const float* gq = (const float*)a.in[8] + l * 512 + lane * 8; const float* gkv = (const float*)a.in[10] + l * 512 + lane * 8;
    for (int tok = gw; tok < M; tok += ngw) {
        bf16_t* ur = u + (size_t)tok * DINP;
#pragma unroll
        for (int w = 0; w < 2; ++w) { bf16_t* p = ur + (w ? C_CKV : C_CQ) + lane * 8; const float* g = w ? gkv : gq;
            float f[8]; unpack8(*(const bf16x8*)p, f); float s = 0.f;
#pragma unroll
            for (int e = 0; e < 8; ++e) s += f[e] * f[e];
            const float rstd = rsqrtf(wave_sum(s) * (1.f / 512.f) + EPS);
#pragma unroll
            for (int e = 0; e < 8; ++e) f[e] = f[e] * rstd * g[e];
            *(bf16x8*)p = pack8(f); }
        if (lane < 32) { const float x1 = bf2f(ur[C_KR + lane]), x2 = bf2f(ur[C_KR + 32 + lane]), c = cs[(size_t)tok * 32 + lane], s = sn[(size_t)tok * 32 + lane];
            *(unsigned*)(kr + (size_t)tok * 64 + 2 * lane) = pk2(x1 * c - x2 * s, x2 * c + x1 * s); }
    }
}

__device__ __forceinline__ void grid_barrier(unsigned* bar, unsigned nblk, unsigned& epoch) {
    __builtin_amdgcn_fence(__ATOMIC_RELEASE, "agent");
    asm volatile("s_waitcnt vmcnt(0) lgkmcnt(0)" ::: "memory");
    __syncthreads();
    epoch += nblk;
    if (threadIdx.x == 0) {
        __hip_atomic_fetch_add(bar, 1u, __ATOMIC_RELEASE, __HIP_MEMORY_SCOPE_AGENT);
        while (__hip_atomic_load(bar, __ATOMIC_ACQUIRE, __HIP_MEMORY_SCOPE_AGENT) < epoch) __builtin_amdgcn_s_sleep(2);
    }
    __syncthreads();
    __builtin_amdgcn_fence(__ATOMIC_ACQUIRE, "agent");
}
__global__ void __launch_bounds__(512, 2) mega_fwd(KArgs a) {
    extern __shared__ __attribute__((aligned(16))) unsigned char smem[];
    cg::grid_group grid = cg::this_grid();
    LAS unsigned char* lds = (LAS unsigned char*)smem;
    const int G = gridDim.x, bx = blockIdx.x;
    const float* x = (const float*)a.in[0];
    unsigned epoch = 0; unsigned* const gbar = (unsigned*)(a.ws + WS_BAR);
#define GBAR() grid_barrier(gbar, (unsigned)G, epoch)

#if PH_MISC
    tables_phase(a);
    convert_weights(a, 0, lds);
#if PROBE_CVT_REP > 1
    convert_weights(a, 0, lds);
#endif
#endif
    rmsnorm_rows_bf16(x, (const float*)a.in[13], (bf16_t*)(opq(a.ws) + WS_XN));
    grid.sync();
    GBAR();
#pragma unroll 1
    for (int l = 0; l < DEPTH; ++l) {
        if (l > 0) {
#if PH_MISC
            convert_weights(a, l, lds);
#if PROBE_CVT_REP > 1
            convert_weights(a, l, lds);
#endif
#endif
            rmsnorm_rows_bf16(a.out, (const float*)a.in[13] + l * DM, (bf16_t*)(opq(a.ws) + WS_XN));
            GBAR();
        }
        { pg8::Gemm g{(const bf16_t*)(opq(a.ws) + WS_XN), (const bf16_t*)(opq(a.ws) + WS_WIN), M, DINP, DM, DM, DM}; pg8::StaticOrder S; S.init(M, DINP, G, bx);
          pg8::EpiU E{(bf16_t*)(opq(a.ws) + WS_U), DINP};
          __syncthreads(); if (PH_GEMM & 1) pg8::gemm_phase<pg8::EpiU, pg8::StaticOrder, true, true>(lds, g, S, E);
#if PROBE_GEMM_REP > 1
          __syncthreads(); if (PH_GEMM & 1) pg8::gemm_phase<pg8::EpiU, pg8::StaticOrder, true, true>(lds, g, S, E);
#endif
 }
        GBAR();
#if PH_MISC
        mla_prep(a, l);
#endif
#if PH_S1
        for (int it = bx; it < 4096; it += G) scan::pass1_item<1>(a, l, it, lds);
        for (int it = bx; it < 4096; it += G) scan::pass1_item<0>(a, l, it, lds);
#if PROBE_SCAN_REP > 1
        for (int it = bx; it < 4096; it += G) scan::pass1_item<1>(a, l, it, lds);
        for (int it = bx; it < 4096; it += G) scan::pass1_item<0>(a, l, it, lds);
#endif
#endif
        GBAR();
#if PH_S2
        for (int t = bx * 512 + opaque_tid(); t < 131072; t += G * 512) scan::pass2_triple(a, t);
#endif
        { pg8::Gemm g{(const bf16_t*)(opq(a.ws) + WS_U) + C_CQ, (const bf16_t*)(opq(a.ws) + WS_WQB), M, 1536, 512, DINP, 512}; pg8::StaticOrder S; S.init(M, 1536, G, bx);
          pg8::EpiQ E{(bf16_t*)(opq(a.ws) + WS_Q), (const float*)(opq(a.ws) + WS_COS), (const float*)(opq(a.ws) + WS_SIN)};
          __syncthreads(); if (PH_GEMM & 2) pg8::gemm_phase<pg8::EpiQ, pg8::StaticOrder, true, true>(lds, g, S, E);
#if PROBE_GEMM_REP > 1
          __syncthreads(); if (PH_GEMM & 2) pg8::gemm_phase<pg8::EpiQ, pg8::StaticOrder, true, true>(lds, g, S, E);
#endif
 }
        { pg8::Gemm g{(const bf16_t*)(opq(a.ws) + WS_U) + C_CKV, (const bf16_t*)(opq(a.ws) + WS_WKVB), M, 2048, 512, DINP, 512}; pg8::StaticOrder S; S.init(M, 2048, G, bx);
          pg8::EpiKV E{(bf16_t*)(opq(a.ws) + WS_KN), (bf16_t*)(opq(a.ws) + WS_V)};
          __syncthreads(); if (PH_GEMM & 4) pg8::gemm_phase<pg8::EpiKV, pg8::StaticOrder, true, true>(lds, g, S, E);
#if PROBE_GEMM_REP > 1
          __syncthreads(); if (PH_GEMM & 4) pg8::gemm_phase<pg8::EpiKV, pg8::StaticOrder, true, true>(lds, g, S, E);
#endif
 }
        GBAR();
        { const bool x8 = (G % 8) == 0; const int xcd = bx & 7, slot = bx >> 3, nslot = G >> 3;
          for (int pr = 0; pr < (x8 ? 2 : 16); ++pr) { const int p = x8 ? xcd + 8 * pr : pr, b = p >> 3, h = p & 7;
            for (int qb = x8 ? slot : bx; qb < 64; qb += x8 ? nslot : G) {
              const bf16_t* Qb = (const bf16_t*)(opq(a.ws) + WS_Q) + ((size_t)(b * 8 + h) * T + (size_t)qb * 256) * 192;
              const bf16_t* Kn = (const bf16_t*)(opq(a.ws) + WS_KN) + (size_t)(b * 8 + h) * T * 128;
              const bf16_t* Kr = (const bf16_t*)(opq(a.ws) + WS_KR) + (size_t)b * T * 64;
              const bf16_t* Vh = (const bf16_t*)(opq(a.ws) + WS_V) + (size_t)(b * 8 + h) * T * 128;
              bf16_t* Ob = (bf16_t*)(opq(a.ws) + WS_XN) + ((size_t)b * T + (size_t)qb * 256) * DM + 1024 + h * 128;
#if PH_ATT
              for (int rep_ = 0; rep_ < PROBE_ATT_REP; ++rep_) att::attn_unit(Qb, Kn, Kr, Vh, Ob, (char*)smem);
#else
              { const int t_ = opaque_tid(); bf16_t* zp = Ob + (size_t)(t_ >> 1) * DM + (t_ & 1) * 64; (void)Qb; (void)Kn; (void)Kr; (void)Vh;
                for (int z_ = 0; z_ < 8; ++z_) *(u32x4*)(zp + z_ * 8) = (u32x4){0u, 0u, 0u, 0u}; }
#endif
 } } }
#if PH_S3
        for (int it = bx; it < 2048; it += G) scan::pass3_item<1>(a, l, it, lds);
        for (int it = bx; it < 2048; it += G) scan::pass3_item<0>(a, l, it, lds);
#if PROBE_SCAN_REP > 1
        for (int it = bx; it < 2048; it += G) scan::pass3_item<1>(a, l, it, lds);
        for (int it = bx; it < 2048; it += G) scan::pass3_item<0>(a, l, it, lds);
#endif
#else
        { bf16_t* mz = (bf16_t*)(opq(a.ws) + WS_XN); for (size_t z_ = (size_t)bx * 512 + opaque_tid(); z_ < (size_t)M * 128; z_ += (size_t)G * 512) *(u32x4*)(mz + (z_ >> 7) * DM + (z_ & 127) * 8) = (u32x4){0u, 0u, 0u, 0u}; }
#endif
        GBAR();
        { pg8::Gemm g{(const bf16_t*)(opq(a.ws) + WS_XN), (const bf16_t*)(opq(a.ws) + WS_WOUT), M, DM, DM, DM, DM}; pg8::StaticOrder S; S.init(M, DM, G, bx);
          pg8::EpiRes E{l == 0 ? x : (const float*)a.out, a.out};
          __syncthreads(); if (PH_GEMM & 8) pg8::gemm_phase<pg8::EpiRes, pg8::StaticOrder, true, true>(lds, g, S, E); }
        GBAR();
        rmsnorm_rows_bf16(a.out, (const float*)a.in[14] + l * DM, (bf16_t*)(opq(a.ws) + WS_XN));
        GBAR();
        { pg8::Gemm g{(const bf16_t*)(opq(a.ws) + WS_XN), (const bf16_t*)(opq(a.ws) + WS_W13), M, 2 * DFF, DM, DM, DM}; pg8::StaticOrder S; S.init(M, 2 * DFF, G, bx);
          pg8::EpiSwi E{(bf16_t*)(opq(a.ws) + WS_HID)};
          __syncthreads(); if (PH_GEMM & 16) pg8::gemm_phase<pg8::EpiSwi, pg8::StaticOrder, true, true>(lds, g, S, E);
#if PROBE_GEMM_REP > 1
          __syncthreads(); if (PH_GEMM & 16) pg8::gemm_phase<pg8::EpiSwi, pg8::StaticOrder, true, true>(lds, g, S, E);
#endif
 }
        GBAR();
        { pg8::Gemm g{(const bf16_t*)(opq(a.ws) + WS_HID), (const bf16_t*)(opq(a.ws) + WS_W2), M, DM, DFF, DFF, DFF}; pg8::StaticOrder S; S.init(M, DM, G, bx);
          pg8::EpiRes E{(const float*)a.out, a.out};
          __syncthreads(); if (PH_GEMM & 32) pg8::gemm_phase<pg8::EpiRes, pg8::StaticOrder, true, true>(lds, g, S, E); }
        GBAR();
    }
    rmsnorm_rows_f32_inplace(a.out, (const float*)a.in[18]);
}

extern "C" void kernel_launch(void* const* d_in, const int* in_sizes, int n_in, void* d_out, int out_size, void* d_ws, size_t ws_size, hipStream_t stream) {
    static int grid = 0;
    if (grid == 0) {
        if (n_in != 19 || out_size != M * DM || ws_size < WS_END) { fprintf(stderr, "kernel_launch: unexpected shapes (n_in %d out %d ws %zu)\n", n_in, out_size, ws_size); grid = -1; return; }
        int dev = 0, cus = 0, per_cu = 0;
        hipGetDevice(&dev); hipDeviceGetAttribute(&cus, hipDeviceAttributeMultiprocessorCount, dev);
        if (hipFuncSetAttribute((const void*)mega_fwd, hipFuncAttributeMaxDynamicSharedMemorySize, LDS_BYTES) != hipSuccess) { fprintf(stderr, "kernel_launch: hipFuncSetAttribute failed\n"); grid = -1; return; }
        if (hipOccupancyMaxActiveBlocksPerMultiprocessor(&per_cu, (const void*)mega_fwd, 512, LDS_BYTES) != hipSuccess || per_cu < 1) { fprintf(stderr, "kernel_launch: occupancy query says %d\n", per_cu); per_cu = 1; }
        (void)hipGetLastError();
        grid = cus * (per_cu > 1 ? 1 : per_cu);
    }
    if (grid < 0) return;
    KArgs a{};
    for (int i = 0; i < 19; ++i) a.in[i] = d_in[i];
    a.out = (float*)d_out; a.ws = (unsigned char*)d_ws;
    if (hipMemsetAsync((char*)d_ws + WS_BAR, 0, 256, stream) != hipSuccess) { fprintf(stderr, "kernel_launch: memset failed\n"); return; }
    void* args[] = {&a};
    hipError_t e = hipLaunchCooperativeKernel((const void*)mega_fwd, dim3(grid), dim3(512), args, LDS_BYTES, stream);
    if (e != hipSuccess) fprintf(stderr, "kernel_launch: cooperative launch failed: %s (grid %d)\n", hipGetErrorString(e), grid);
}
```

```cpp
#include <hip/hip_runtime.h>
#include <hip/hip_cooperative_groups.h>
#include <cstdint>
#include <cstdio>
namespace cg = cooperative_groups;
#ifndef PROBE_GEMM_REP
#define PROBE_GEMM_REP 1
#endif
#ifndef PROBE_SCAN_REP
#define PROBE_SCAN_REP 1
#endif
#ifndef PROBE_CVT_REP
#define PROBE_CVT_REP 1
#endif
#ifndef PROBE_ATT_REP
#define PROBE_ATT_REP 1
#endif
#ifndef PH_ATT
#define PH_ATT 1
#endif
#ifndef PH_S1
#define PH_S1 1
#endif
#ifndef PH_S2
#define PH_S2 1
#endif
#ifndef PH_S3
#define PH_S3 1
#endif
#ifndef PH_GEMM
#define PH_GEMM 63
#endif
#ifndef PH_MISC
#define PH_MISC 1
#endif

#define LAS __attribute__((address_space(3)))
typedef unsigned short bf16_t;
typedef short bf16x8 __attribute__((ext_vector_type(8)));
typedef short s16x4 __attribute__((ext_vector_type(4)));
typedef float f32x2 __attribute__((ext_vector_type(2)));
typedef float f32x4 __attribute__((ext_vector_type(4)));
typedef float f32x16 __attribute__((ext_vector_type(16)));
typedef unsigned u32x2 __attribute__((ext_vector_type(2)));
typedef unsigned u32x4 __attribute__((ext_vector_type(4)));

constexpr int NB = 2, T = 16384, M = NB * T, DM = 2048, DIN = 5216, DINP = 5376, DFF = 5632, DEPTH = 2;
constexpr int C_GQ = 0, C_GK = 256, C_GV = 512, C_GAF = 1024, C_GAB = 1040, C_GG = 1056, C_HQ = 1568, C_HFF = 2080, C_HFB = 2592, C_HI = 3104, C_HG = 3616,
              C_CQ = 4128, C_CKV = 4640, C_KR = 5152;
constexpr float EPS = 1e-6f;
constexpr int NCH = T / 64;
constexpr size_t MiB = 1048576;
constexpr size_t WS_WIN = 0, WS_WQB = 21 * MiB, WS_WKVB = WS_WQB + 3 * MiB / 2, WS_WOUT = WS_WKVB + 2 * MiB, WS_W13 = WS_WOUT + 8 * MiB, WS_W2 = WS_W13 + 44 * MiB;
constexpr size_t WS_XN = 99 * MiB, WS_U = 227 * MiB, WS_Q = 563 * MiB, WS_KN = 659 * MiB, WS_V = 723 * MiB, WS_KR = 787 * MiB, WS_SG = 791 * MiB, WS_SH = 855 * MiB,
                 WS_DG = 983 * MiB, WS_DH = 984 * MiB, WS_COS = 986 * MiB, WS_SIN = 990 * MiB, WS_LB = 994 * MiB, WS_BAR = 995 * MiB, WS_RSQ = WS_BAR + 4096, WS_END = 996 * MiB, WS_HB = WS_U, WS_HID = WS_U + 128 * MiB;
static_assert(WS_W2 + 22 * MiB <= WS_XN, "weights");
constexpr int LDS_BYTES = 131072;

struct KArgs { const void* in[19]; float* out; unsigned char* ws; };

__device__ __forceinline__ float bf2f(unsigned v) { return __uint_as_float(v << 16); }
__device__ __forceinline__ unsigned f2bf(float f) { unsigned u = __float_as_uint(f); return (u + 0x7fffu + ((u >> 16) & 1u)) >> 16; }
__device__ __forceinline__ unsigned pk2(float lo, float hi) { return f2bf(lo) | (f2bf(hi) << 16); }
typedef __bf16 bf16x2_t __attribute__((ext_vector_type(2)));
__device__ __forceinline__ unsigned cvt_pk_bf16(float lo, float hi) { f32x2 v = {lo, hi}; bf16x2_t b = __builtin_convertvector(v, bf16x2_t); return __builtin_bit_cast(unsigned, b); }
__device__ __forceinline__ float wave_sum(float v) {
#pragma unroll
    for (int o = 1; o < 64; o <<= 1) v += __shfl_xor(v, o);
    return v;
}
__device__ __forceinline__ unsigned char* opq(unsigned char* q) { asm volatile("" : "+s"(q)); return q; }
__device__ __forceinline__ int opaque_tid() { int t = threadIdx.x; asm volatile("" : "+v"(t)); return t; }
#define DBGF(ws_, cond_, bit_) do { if (cond_) atomicOr((unsigned*)((ws_) + WS_BAR) + 32, (unsigned)(bit_)); } while (0)
__device__ __forceinline__ bool badf(float v) { return !(fabsf(v) < 1e30f); }
__device__ __forceinline__ float sigmoid_(float z) { return 1.f / (1.f + __expf(-z)); }
__device__ __forceinline__ float silu_(float z) { return z * sigmoid_(z); }
__device__ __forceinline__ float logsigmoid_(float z) { return fminf(z, 0.f) - log1pf(__expf(-fabsf(z))); }
__device__ __forceinline__ void unpack8(bf16x8 v, float* f) {
#pragma unroll
    for (int e = 0; e < 8; ++e) f[e] = bf2f((unsigned)(unsigned short)v[e]);
}
__device__ __forceinline__ bf16x8 pack8(const float* f) {
    u32x4 w = {cvt_pk_bf16(f[0], f[1]), cvt_pk_bf16(f[2], f[3]), cvt_pk_bf16(f[4], f[5]), cvt_pk_bf16(f[6], f[7])};
    return __builtin_bit_cast(bf16x8, w);
}

namespace pg8 {
#define PG8_LAS __attribute__((address_space(3)))
constexpr int BM = 256, BK = 64, HALF = 128, HTB = HALF * BK * 2, STAGE_BYTES = 8 * HTB, NXCD = 8, WGM = 8;
__host__ __device__ __forceinline__ int lds_byte(int r, int c) { const int st = (r >> 4) * 2 + (c >> 5), rr = r & 15, cc = c & 31, ob = rr * 64 + cc * 2; return st * 1024 + (ob ^ (((ob >> 9) & 1) << 5)); }
__host__ __device__ __forceinline__ void stage_rc(int b, int& R, int& C) { const int st = b / 1024, sb = b % 1024, swz = sb ^ (((sb >> 9) & 1) << 5); R = (st >> 1) * 16 + swz / 64; C = (st & 1) * 32 + (swz % 64) / 2; }
__host__ __device__ __forceinline__ int perm32(int rho) { const int n = rho >> 4, i = rho & 15; return 8 * (i >> 2) + 4 * n + (i & 3); }
struct Unit { int pm, pn; };
struct Gemm { const bf16_t* A; const bf16_t* Bt; int M, N, K, lda, ldb; };
struct StaticOrder {
    int nM, nN, nwg, G, c;
    __host__ __device__ void init(int M_, int N_, int G_, int c_) { nM = M_ / BM; nN = N_ / BM; nwg = nM * nN; G = G_; c = c_; }
    __host__ __device__ bool next(int i, Unit& u) const {
        const long L = (long)i * G + c; if (L >= nwg) return false;
        int wgid = (int)L; { const int q = nwg / NXCD, r = nwg % NXCD, xcd = wgid % NXCD, off = wgid / NXCD; wgid = (xcd < r ? xcd * (q + 1) : r * (q + 1) + (xcd - r) * q) + off; }
        const int nig = WGM * nN, gid = wgid / nig, fm = gid * WGM, gsz = (nM - fm) < WGM ? (nM - fm) : WGM;
        u.pm = fm + ((wgid % nig) % gsz); u.pn = (wgid % nig) / gsz; return true;
    }
    __device__ __forceinline__ void a_ready(const Unit&) const {}
    __device__ __forceinline__ void done(const Unit&) const {}
};
template <class Epi, class Sched, bool ALIGN_EPI = false, bool SP2 = false>
__device__ __forceinline__ void gemm_phase(PG8_LAS unsigned char* lds, const Gemm g, const Sched& S, const Epi& E) {
    const int tid = opaque_tid(), wid = __builtin_amdgcn_readfirstlane(tid >> 6), lane = tid & 63, wr = wid >> 2, wc = wid & 3, fr = lane & 15, fq = lane >> 4;
    const int K = g.K, nt = K / BK;
    unsigned voffA[2], voffB[2];
#pragma unroll
    for (int i = 0; i < 2; ++i) { int R, C; stage_rc(tid * 16 + i * 8192, R, C); const int Rb = Epi::PERM ? ((R & ~31) + perm32(R & 31)) : R;
        voffA[i] = (unsigned)(R * g.lda + C) * 2u; voffB[i] = (unsigned)(Rb * g.ldb + C) * 2u; }
    const size_t kstep = (size_t)(BK * 2);
    const size_t hstepA = (size_t)HALF * g.lda * 2, hstepB = (size_t)HALF * g.ldb * 2;
    const size_t tstepA = 2 * hstepA, tstepB = 2 * hstepB;
    const unsigned ldsw = (unsigned)wid * 1024u;
    const int aoff = lds_byte(wr * 64 + fr, fq * 8), boff = lds_byte(wc * 32 + fr, fq * 8);
#define PG8_SA(b, h) (((b) * 2 + (h)) * HTB)
#define PG8_SB(b, h) ((4 + (b) * 2 + (h)) * HTB)
#define PG8_STAGE(bufoff, gbase, voff) do { _Pragma("unroll") for (int _i = 0; _i < 2; ++_i) \
        __builtin_amdgcn_global_load_lds((const unsigned*)((const char*)(gbase) + (voff)[_i]), (PG8_LAS unsigned*)(lds + (bufoff) + ldsw + _i * 8192), 16, 0, 0); } while (0)
#define PG8_LDA(dst, b, h) do { _Pragma("unroll") for (int m = 0; m < 4; ++m) _Pragma("unroll") for (int k = 0; k < 2; ++k) dst[m][k] = *(const PG8_LAS bf16x8*)(lds + PG8_SA(b, h) + aoff + m * 2048 + k * 1024); } while (0)
#define PG8_LDB(dst, b, h) do { _Pragma("unroll") for (int n = 0; n < 2; ++n) _Pragma("unroll") for (int k = 0; k < 2; ++k) dst[n][k] = *(const PG8_LAS bf16x8*)(lds + PG8_SB(b, h) + boff + n * 2048 + k * 1024); } while (0)
#define PG8_MMA(ai, bj, At, Bt) do { __builtin_amdgcn_s_setprio(1); _Pragma("unroll") for (int m = 0; m < 4; ++m) _Pragma("unroll") for (int n = 0; n < 2; ++n) _Pragma("unroll") for (int k = 0; k < 2; ++k) \
        acc[ai][bj][m][n] = __builtin_amdgcn_mfma_f32_16x16x32_bf16(Bt[n][k], At[m][k], acc[ai][bj][m][n], 0, 0, 0); __builtin_amdgcn_s_setprio(0); } while (0)
#define PG8_WAIT_V(n) asm volatile("s_waitcnt vmcnt(" #n ")" ::: "memory")
#define PG8_WAIT_L(n) asm volatile("s_waitcnt lgkmcnt(" #n ")" ::: "memory")
#define PG8_BAR __builtin_amdgcn_s_barrier()
#define PG8_SCHED __builtin_amdgcn_sched_barrier(0)
    Unit cur, nxt; int ui = 0;
    if (!S.next(0, cur)) return;
    f32x4 acc[2][2][4][2];
#pragma unroll
    for (int a = 0; a < 2; ++a)
#pragma unroll
        for (int b = 0; b < 2; ++b)
#pragma unroll
            for (int m = 0; m < 4; ++m)
#pragma unroll
                for (int n = 0; n < 2; ++n) acc[a][b][m][n] = (f32x4){0.f, 0.f, 0.f, 0.f};
    bf16x8 At[4][2], B0[2][2], B1[2][2];
    const char* cA = (const char*)g.A + (size_t)cur.pm * tstepA; const char* cB = (const char*)g.Bt + (size_t)cur.pn * tstepB;
    S.a_ready(cur);
    if constexpr (SP2) {
        PG8_STAGE(PG8_SB(0, 0), cB, voffB); PG8_STAGE(PG8_SB(0, 1), cB + hstepB, voffB); PG8_STAGE(PG8_SA(0, 0), cA, voffA); PG8_STAGE(PG8_SA(0, 1), cA + hstepA, voffA);
        if (wr == 1) PG8_BAR;
        PG8_WAIT_V(2); PG8_BAR;
        PG8_STAGE(PG8_SB(1, 0), cB + kstep, voffB); PG8_STAGE(PG8_SA(1, 0), cA + kstep, voffA); PG8_STAGE(PG8_SB(1, 1), cB + hstepB + kstep, voffB);
        PG8_WAIT_V(6); PG8_BAR;
    } else {
        PG8_STAGE(PG8_SB(0, 0), cB, voffB); PG8_STAGE(PG8_SA(0, 0), cA, voffA); PG8_STAGE(PG8_SB(0, 1), cB + hstepB, voffB); PG8_STAGE(PG8_SA(0, 1), cA + hstepA, voffA);
        if (wr == 1) PG8_BAR;
        PG8_WAIT_V(4); PG8_BAR;
        PG8_STAGE(PG8_SB(1, 0), cB + kstep, voffB); PG8_STAGE(PG8_SA(1, 0), cA + kstep, voffA); PG8_STAGE(PG8_SB(1, 1), cB + hstepB + kstep, voffB);
        PG8_WAIT_V(6); PG8_BAR;
    }
    for (;;) {
        const bool has_next = S.next(ui + 1, nxt);
        const char* nA = has_next ? (const char*)g.A + (size_t)nxt.pm * tstepA : cA; const char* nB = has_next ? (const char*)g.Bt + (size_t)nxt.pn * tstepB : cB;
        for (int t = 0; t < nt; t += 2) {
            const bool last = (t == nt - 2);
            const char* a1 = cA + (size_t)(t + 1) * kstep;
            const char* a2 = last ? nA : cA + (size_t)(t + 2) * kstep; const char* b2 = last ? nB : cB + (size_t)(t + 2) * kstep;
            const char* a3 = a2 + kstep; const char* b3 = b2 + kstep;
            if (last && has_next) S.a_ready(nxt);
            if constexpr (SP2) {
            PG8_LDB(B0, 0, 0); PG8_LDB(B1, 0, 1); PG8_SCHED; PG8_LDA(At, 0, 0); PG8_STAGE(PG8_SA(1, 1), a1 + hstepA, voffA);
            PG8_WAIT_V(8); PG8_WAIT_L(0); PG8_BAR; PG8_MMA(0, 0, At, B0); PG8_MMA(0, 1, At, B1); PG8_BAR; PG8_SCHED;
            PG8_LDA(At, 0, 1); PG8_STAGE(PG8_SB(0, 0), b2, voffB); PG8_STAGE(PG8_SB(0, 1), b2 + hstepB, voffB); PG8_STAGE(PG8_SA(0, 0), a2, voffA);
            PG8_WAIT_V(8); PG8_WAIT_L(0); PG8_BAR; PG8_MMA(1, 0, At, B0); PG8_MMA(1, 1, At, B1); PG8_BAR; PG8_SCHED;
            PG8_LDB(B0, 1, 0); PG8_LDB(B1, 1, 1); PG8_SCHED; PG8_LDA(At, 1, 0); PG8_STAGE(PG8_SA(0, 1), a2 + hstepA, voffA);
            PG8_WAIT_V(8); PG8_WAIT_L(0); PG8_BAR; PG8_MMA(0, 0, At, B0); PG8_MMA(0, 1, At, B1); PG8_BAR; PG8_SCHED;
            PG8_LDA(At, 1, 1); PG8_STAGE(PG8_SB(1, 0), b3, voffB); PG8_STAGE(PG8_SB(1, 1), b3 + hstepB, voffB); PG8_STAGE(PG8_SA(1, 0), a3, voffA);
            PG8_WAIT_V(8); PG8_WAIT_L(0); PG8_BAR; PG8_MMA(1, 0, At, B0); PG8_MMA(1, 1, At, B1); PG8_BAR; PG8_SCHED;
            } else {
            PG8_LDB(B0, 0, 0); PG8_SCHED; PG8_LDA(At, 0, 0); PG8_STAGE(PG8_SA(1, 1), a1 + hstepA, voffA);
            PG8_WAIT_L(8); PG8_BAR; PG8_WAIT_L(0); PG8_MMA(0, 0, At, B0); PG8_BAR; PG8_SCHED;
            PG8_LDB(B1, 0, 1); PG8_STAGE(PG8_SB(0, 0), b2, voffB);
            PG8_BAR; PG8_WAIT_L(0); PG8_MMA(0, 1, At, B1); PG8_BAR;
            PG8_LDA(At, 0, 1); PG8_STAGE(PG8_SA(0, 0), a2, voffA);
            PG8_BAR; PG8_WAIT_L(0); PG8_MMA(1, 0, At, B0); PG8_BAR; PG8_SCHED;
            PG8_STAGE(PG8_SB(0, 1), b2 + hstepB, voffB);
            PG8_WAIT_V(6); PG8_BAR; PG8_MMA(1, 1, At, B1); PG8_BAR;
            PG8_LDB(B0, 1, 0); PG8_SCHED; PG8_LDA(At, 1, 0); PG8_STAGE(PG8_SA(0, 1), a2 + hstepA, voffA);
            PG8_WAIT_L(8); PG8_BAR; PG8_WAIT_L(0); PG8_MMA(0, 0, At, B0); PG8_BAR; PG8_SCHED;
            PG8_LDB(B1, 1, 1); PG8_STAGE(PG8_SB(1, 0), b3, voffB);
            PG8_BAR; PG8_WAIT_L(0); PG8_MMA(0, 1, At, B1); PG8_BAR;
            PG8_LDA(At, 1, 1); PG8_STAGE(PG8_SA(1, 0), a3, voffA);
            PG8_BAR; PG8_WAIT_L(0); PG8_MMA(1, 0, At, B0); PG8_BAR; PG8_SCHED;
            PG8_STAGE(PG8_SB(1, 1), b3 + hstepB, voffB);
            PG8_WAIT_V(6); PG8_BAR; PG8_MMA(1, 1, At, B1); PG8_BAR;
            }
        }
        if constexpr (ALIGN_EPI) { if (wr == 0) PG8_BAR; }
        if constexpr (!Epi::AFTER_DRAIN) { E(acc, cur, wr, wc, fr, fq); S.done(cur); }
        if (!has_next) break;
#pragma unroll
        for (int a = 0; a < 2; ++a)
#pragma unroll
            for (int b = 0; b < 2; ++b)
#pragma unroll
                for (int m = 0; m < 4; ++m)
#pragma unroll
                    for (int n = 0; n < 2; ++n) acc[a][b][m][n] = (f32x4){0.f, 0.f, 0.f, 0.f};
        cur = nxt; cA = nA; cB = nB; ++ui;
        if constexpr (ALIGN_EPI) { if (wr == 1) PG8_BAR; }
    }
    PG8_WAIT_V(0);
    if constexpr (!ALIGN_EPI) { if (wr == 0) PG8_BAR; }
    PG8_BAR;
    if constexpr (Epi::AFTER_DRAIN) { E.fused(acc, cur, wr, wc, fr, fq, lds, wid, lane); S.done(cur); }
#undef PG8_SA
#undef PG8_SB
#undef PG8_STAGE
#undef PG8_LDA
#undef PG8_LDB
#undef PG8_MMA
#undef PG8_WAIT_V
#undef PG8_WAIT_L
#undef PG8_BAR
#undef PG8_SCHED
}
struct EpiU {
    static constexpr bool PERM = true, AFTER_DRAIN = false;
    bf16_t* O; int ldc; const float* rsq;
    __device__ __forceinline__ void operator()(const f32x4 (&acc)[2][2][4][2], const Unit& u, int wr, int wc, int fr, int fq) const {
        const int row0 = u.pm * BM + wr * 64 + fr, col0 = u.pn * BM + wc * 32 + 8 * fq;
#pragma unroll
        for (int ai = 0; ai < 2; ++ai)
#pragma unroll
            for (int m = 0; m < 4; ++m) { bf16_t* rowp = O + (size_t)(row0 + ai * HALF + m * 16) * ldc + col0;
                const float rs = rsqrtf(rsq[row0 + ai * HALF + m * 16] * (1.f / DM) + EPS);
#pragma unroll
                for (int bj = 0; bj < 2; ++bj) { const f32x4 v0 = acc[ai][bj][m][0] * rs, v1 = acc[ai][bj][m][1] * rs;
                    u32x4 w; w.x = cvt_pk_bf16(v0[0], v0[1]); w.y = cvt_pk_bf16(v0[2], v0[3]); w.z = cvt_pk_bf16(v1[0], v1[1]); w.w = cvt_pk_bf16(v1[2], v1[3]);
                    *(u32x4*)(rowp + bj * HALF) = w; } }
    }
};
struct EpiQ {
    static constexpr bool PERM = true, AFTER_DRAIN = false;
    bf16_t* Q; const float* cs; const float* sn;
    __device__ __forceinline__ void operator()(const f32x4 (&acc)[2][2][4][2], const Unit& u, int wr, int wc, int fr, int fq) const {
        const int row0 = u.pm * BM + wr * 64 + fr;
#pragma unroll
        for (int ai = 0; ai < 2; ++ai)
#pragma unroll
            for (int m = 0; m < 4; ++m) { const int row = row0 + ai * HALF + m * 16, b = row / T, t = row % T;
#pragma unroll
                for (int bj = 0; bj < 2; ++bj) { const int c = u.pn * BM + bj * HALF + wc * 32 + 8 * fq, hh = c / 192, e = c % 192;
                    const f32x4 v0 = acc[ai][bj][m][0], v1 = acc[ai][bj][m][1];
                    float vals[8] = {v0[0], v0[1], v0[2], v0[3], v1[0], v1[1], v1[2], v1[3]};
                    if (e >= 128) { const int i0 = (e - 128) >> 1; const f32x4 cc = *(const f32x4*)(cs + (size_t)row * 32 + i0), ss = *(const f32x4*)(sn + (size_t)row * 32 + i0);
#pragma unroll
                        for (int p = 0; p < 4; ++p) { const float x1 = vals[2 * p], x2 = vals[2 * p + 1]; vals[2 * p] = x1 * cc[p] - x2 * ss[p]; vals[2 * p + 1] = x2 * cc[p] + x1 * ss[p]; } }
                    u32x4 w; w.x = cvt_pk_bf16(vals[0], vals[1]); w.y = cvt_pk_bf16(vals[2], vals[3]); w.z = cvt_pk_bf16(vals[4], vals[5]); w.w = cvt_pk_bf16(vals[6], vals[7]);
                    *(u32x4*)(Q + ((size_t)(b * 8 + hh) * T + t) * 192 + e) = w; } }
    }
};
struct EpiKV {
    static constexpr bool PERM = true, AFTER_DRAIN = false;
    bf16_t* KN; bf16_t* V;
    __device__ __forceinline__ void operator()(const f32x4 (&acc)[2][2][4][2], const Unit& u, int wr, int wc, int fr, int fq) const {
        const int row0 = u.pm * BM + wr * 64 + fr, e = wc * 32 + 8 * fq;
#pragma unroll
        for (int ai = 0; ai < 2; ++ai)
#pragma unroll
            for (int m = 0; m < 4; ++m) { const int row = row0 + ai * HALF + m * 16, b = row / T, t = row % T;
                const size_t off = ((size_t)(b * 8 + u.pn) * T + t) * 128 + e;
#pragma unroll
                for (int bj = 0; bj < 2; ++bj) { const f32x4 v0 = acc[ai][bj][m][0], v1 = acc[ai][bj][m][1];
                    u32x4 w; w.x = cvt_pk_bf16(v0[0], v0[1]); w.y = cvt_pk_bf16(v0[2], v0[3]); w.z = cvt_pk_bf16(v1[0], v1[1]); w.w = cvt_pk_bf16(v1[2], v1[3]);
                    *(u32x4*)((bj ? V : KN) + off) = w; } }
    }
};
struct EpiSwi {
    static constexpr bool PERM = false, AFTER_DRAIN = false;
    bf16_t* H; const float* rsq;
    __device__ __forceinline__ void operator()(const f32x4 (&acc)[2][2][4][2], const Unit& u, int wr, int wc, int fr, int fq) const {
        const int row0 = u.pm * BM + wr * 64 + fr;
#pragma unroll
        for (int ai = 0; ai < 2; ++ai)
#pragma unroll
            for (int m = 0; m < 4; ++m) { bf16_t* rowp = H + (size_t)(row0 + ai * HALF + m * 16) * DFF;
                const float rs = rsqrtf(rsq[row0 + ai * HALF + m * 16] * (1.f / DM) + EPS);
#pragma unroll
                for (int bj = 0; bj < 2; ++bj) { const f32x4 a = acc[ai][bj][m][0] * rs, g = acc[ai][bj][m][1] * rs;
                    const int col = 16 * (8 * u.pn + 4 * bj + wc) + 4 * fq;
                    u32x2 w; w.x = cvt_pk_bf16(silu_(a[0]) * g[0], silu_(a[1]) * g[1]); w.y = cvt_pk_bf16(silu_(a[2]) * g[2], silu_(a[3]) * g[3]);
                    *(u32x2*)(rowp + col) = w; } }
    }
};
struct EpiRes {
    static constexpr bool PERM = false, AFTER_DRAIN = false;
    const float* base; float* out; bf16_t* hb; float* rsq;
    __device__ __forceinline__ void operator()(const f32x4 (&acc)[2][2][4][2], const Unit& u, int wr, int wc, int fr, int fq) const {
        const int row0 = u.pm * BM + wr * 64 + fr, col0 = u.pn * BM + wc * 32 + 4 * fq;
#pragma unroll
        for (int ai = 0; ai < 2; ++ai)
#pragma unroll
            for (int m = 0; m < 4; ++m) { const size_t off = (size_t)(row0 + ai * HALF + m * 16) * DM + col0; float ss = 0.f;
#pragma unroll
                for (int bj = 0; bj < 2; ++bj)
#pragma unroll
                    for (int n = 0; n < 2; ++n) { const f32x4 bs = *(const f32x4*)(base + off + bj * HALF + n * 16); const f32x4 o = bs + acc[ai][bj][m][n];
                        *(f32x4*)(out + off + bj * HALF + n * 16) = o;
                        u32x2 w; w.x = cvt_pk_bf16(o[0], o[1]); w.y = cvt_pk_bf16(o[2], o[3]); *(u32x2*)(hb + off + bj * HALF + n * 16) = w;
                        ss += (o[0] * o[0] + o[1] * o[1]) + (o[2] * o[2] + o[3] * o[3]); }
                ss += __shfl_xor(ss, 16); ss += __shfl_xor(ss, 32);
                if (fq == 0) unsafeAtomicAdd(rsq + row0 + ai * HALF + m * 16, ss); }
    }
};

}
namespace att {
constexpr int KVBLK = 64;
constexpr float SCALE = 0.07216878364870322f;
constexpr float THR = 8.f;
constexpr int SHM_V = KVBLK * 128 * 2, SHM_K = KVBLK * 192 * 2;
#ifndef ATT_SDEPTH
#define ATT_SDEPTH 1
#endif
constexpr int SDEPTH = ATT_SDEPTH;
#define KSWZ(row, colB) ((row) * 384 + ((colB) ^ (((row) & 7) << 4)))
#define SBAR() __builtin_amdgcn_sched_barrier(0)
__device__ __forceinline__ int crow(int r, int hi) { return (r & 3) + 8 * (r >> 2) + 4 * hi; }
__device__ __forceinline__ unsigned cvtpk(float lo, float hi) { return cvt_pk_bf16(lo, hi); }
__device__ __forceinline__ void partialSM(f32x16& p0, f32x16& p1, float& m_reg, float& mn, float& alpha) {
  constexpr float C = SCALE * 1.4426950408889634f;
  float pmax = p0[0];
#pragma unroll
  for (int r = 1; r < 16; ++r) pmax = fmaxf(pmax, p0[r]);
#pragma unroll
  for (int r = 0; r < 16; ++r) pmax = fmaxf(pmax, p1[r]);
  { auto rr = __builtin_amdgcn_permlane32_swap(__float_as_uint(pmax), __float_as_uint(pmax), false, false);
    pmax = fmaxf(__uint_as_float(rr[0]), __uint_as_float(rr[1])); }
  if (__builtin_expect(__all(pmax - m_reg <= THR / SCALE), 1)) { mn = m_reg; alpha = 1.f; }
  else { mn = fmaxf(m_reg, pmax); alpha = __builtin_amdgcn_exp2f((m_reg - mn) * C); m_reg = mn; }
  float mnC = -mn * C;
#pragma unroll
  for (int r = 0; r < 16; ++r) p0[r] = fmaf(p0[r], C, mnC);
#pragma unroll
  for (int r = 0; r < 16; ++r) p1[r] = fmaf(p1[r], C, mnC);
#pragma unroll
  for (int r = 0; r < 16; ++r) p0[r] = __builtin_amdgcn_exp2f(p0[r]);
}
__device__ __forceinline__ void finishSM(f32x16& p0, f32x16& p1, float alpha, float& l_reg, bf16x8& pa0, bf16x8& pa1, bf16x8& pa2, bf16x8& pa3) {
#pragma unroll
  for (int r = 0; r < 16; ++r) p1[r] = __builtin_amdgcn_exp2f(p1[r]);
  float ps = 0;
#pragma unroll
  for (int r = 0; r < 16; ++r) ps += p0[r];
#pragma unroll
  for (int r = 0; r < 16; ++r) ps += p1[r];
  { auto rr = __builtin_amdgcn_permlane32_swap(__float_as_uint(ps), __float_as_uint(ps), false, false);
    ps = __uint_as_float(rr[0]) + __uint_as_float(rr[1]); }
  l_reg = l_reg * alpha + ps;
#define PK4(P, BASE, OUT) do { unsigned a0 = cvtpk(P[BASE + 0], P[BASE + 1]), a1 = cvtpk(P[BASE + 2], P[BASE + 3]);   \
    unsigned b0 = cvtpk(P[BASE + 4], P[BASE + 5]), b1 = cvtpk(P[BASE + 6], P[BASE + 7]);                              \
    auto r0 = __builtin_amdgcn_permlane32_swap(a0, b0, false, false); auto r1 = __builtin_amdgcn_permlane32_swap(a1, b1, false, false); \
    u32x4 w = {r0[0], r1[0], r0[1], r1[1]}; OUT = __builtin_bit_cast(bf16x8, w); } while (0)
  PK4(p0, 0, pa0); PK4(p0, 8, pa1); PK4(p1, 0, pa2); PK4(p1, 8, pa3);
#undef PK4
}
__device__ __forceinline__ void qkt(f32x16& p0, f32x16& p1, const char* Ks, const bf16x8* qr, const char* qL, int r32, int hi) {
  p0 = f32x16{}; p1 = f32x16{};
#pragma unroll
  for (int d0 = 0; d0 < 12; ++d0) { int cb = (d0 * 16 + hi * 8) * 2;
    bf16x8 b0 = *reinterpret_cast<const bf16x8*>(Ks + KSWZ(r32, cb));
    bf16x8 b1 = *reinterpret_cast<const bf16x8*>(Ks + KSWZ(32 + r32, cb));
    const bf16x8 q = d0 < 8 ? qr[d0 < 8 ? d0 : 0] : *reinterpret_cast<const bf16x8*>(qL + (d0 - 8) * 1024);
    p0 = __builtin_amdgcn_mfma_f32_32x32x16_bf16(b0, q, p0, 0, 0, 0);
    p1 = __builtin_amdgcn_mfma_f32_32x32x16_bf16(b1, q, p1, 0, 0, 0); }
}
__device__ __forceinline__ int v_st(int k, int c) { const int kk = (k & ~0xC) | ((k & 4) << 1) | ((k & 8) >> 1); return ((kk >> 3) * 4 + (c >> 5)) * 512 + ((kk & 7) * 32 + (c & 31)) * 2; }
__device__ __forceinline__ int v_rd_base(int lane) { return ((lane & 3) << 3) | (((lane >> 2) & 3) << 6) | (((lane >> 4) & 1) << 5) | (((lane >> 5) & 1) << 8); }
constexpr int v_rd_off(int d0, int ks, int half) { return d0 * 512 + ks * 4096 + half * 2048; }
template <int OFF> __device__ __forceinline__ s16x4 tr_read(int vb) {
  s16x4 r; asm volatile("ds_read_b64_tr_b16 %0, %1 offset:%2" : "=&v"(r) : "v"(vb), "i"(OFF) : "memory"); return r;
}
template <int D0> __device__ __forceinline__ void pv_one(f32x16& od, int vb, bf16x8 pa0, bf16x8 pa1, bf16x8 pa2, bf16x8 pa3) {
  const s16x4 l0 = tr_read<v_rd_off(D0, 0, 0)>(vb), h0 = tr_read<v_rd_off(D0, 0, 1)>(vb), l1 = tr_read<v_rd_off(D0, 1, 0)>(vb), h1 = tr_read<v_rd_off(D0, 1, 1)>(vb);
  const s16x4 l2 = tr_read<v_rd_off(D0, 2, 0)>(vb), h2 = tr_read<v_rd_off(D0, 2, 1)>(vb), l3 = tr_read<v_rd_off(D0, 3, 0)>(vb), h3 = tr_read<v_rd_off(D0, 3, 1)>(vb);
  asm volatile("s_waitcnt lgkmcnt(0)" ::: "memory"); SBAR();
#define PK(L, H) (bf16x8){L[0], L[1], L[2], L[3], H[0], H[1], H[2], H[3]}
  od = __builtin_amdgcn_mfma_f32_32x32x16_bf16(pa0, PK(l0, h0), od, 0, 0, 0);
  od = __builtin_amdgcn_mfma_f32_32x32x16_bf16(pa1, PK(l1, h1), od, 0, 0, 0);
  od = __builtin_amdgcn_mfma_f32_32x32x16_bf16(pa2, PK(l2, h2), od, 0, 0, 0);
  od = __builtin_amdgcn_mfma_f32_32x32x16_bf16(pa3, PK(l3, h3), od, 0, 0, 0);
#undef PK
}
__device__ __forceinline__ void pv_d0(f32x16* o, int vb, bf16x8 pa0, bf16x8 pa1, bf16x8 pa2, bf16x8 pa3) {
  pv_one<0>(o[0], vb, pa0, pa1, pa2, pa3); pv_one<1>(o[1], vb, pa0, pa1, pa2, pa3); pv_one<2>(o[2], vb, pa0, pa1, pa2, pa3); pv_one<3>(o[3], vb, pa0, pa1, pa2, pa3);
}
__device__ __forceinline__ void attn_unit(const bf16_t* __restrict__ Qb, const bf16_t* __restrict__ Kn, const bf16_t* __restrict__ Kr, const bf16_t* __restrict__ Vh,
                                          bf16_t* __restrict__ Ob, char* lds) {
  const int tid = opaque_tid(), wid = tid >> 6, lane = tid & 63, r32 = lane & 31, hi = lane >> 5;
  char* V_lds = lds; char* K_lds = lds + 2 * SHM_V;
  float* ws = (float*)(lds + 2 * SHM_V + 2 * SHM_K) + wid * 64; float* li_l = ws; float* al_l = ws + 32;
  float m_reg = -1e30f, l_reg = 0; f32x16 o[4] = {}; bf16x8 qr[8];
  char* qL = lds + 2 * SHM_V + 2 * SHM_K + 2048 + wid * 4096 + lane * 16;
  const bf16_t* Qw = Qb + (long)(wid * 32 + r32) * 192 + hi * 8;
#pragma unroll
  for (int d0 = 0; d0 < 8; ++d0) qr[d0] = *reinterpret_cast<const bf16x8*>(Qw + d0 * 16);
#pragma unroll
  for (int d0 = 8; d0 < 12; ++d0) *reinterpret_cast<bf16x8*>(qL + (d0 - 8) * 1024) = *reinterpret_cast<const bf16x8*>(Qw + d0 * 16);
  const int sr = tid >> 4, sc = (tid & 15) * 8, vst0 = v_st(sr, sc), vst1 = v_st(32 + sr, sc);
  const int rr = tid >> 3, rc = (tid & 7) * 8;
  const int kst0 = KSWZ(sr, sc * 2), kst1 = KSWZ(32 + sr, sc * 2), kst2 = KSWZ(rr, 256 + rc * 2);
  const int vb0 = (int)(uintptr_t)V_lds + v_rd_base(lane);
  struct { bf16x8 vs0, vs1, ks0, ks1, ks2; } sr_[SDEPTH];
#define SLOAD(i, k0) do { sr_[i].vs0 = *(const bf16x8*)(&Vh[(long)((k0) + sr) * 128 + sc]); sr_[i].vs1 = *(const bf16x8*)(&Vh[(long)((k0) + 32 + sr) * 128 + sc]); \
    sr_[i].ks0 = *(const bf16x8*)(&Kn[(long)((k0) + sr) * 128 + sc]); sr_[i].ks1 = *(const bf16x8*)(&Kn[(long)((k0) + 32 + sr) * 128 + sc]); \
    sr_[i].ks2 = *(const bf16x8*)(&Kr[(long)((k0) + rr) * 64 + rc]); } while (0)
#define SWRITE(b, i) do { *(bf16x8*)(V_lds + (b) * SHM_V + vst0) = sr_[i].vs0; *(bf16x8*)(V_lds + (b) * SHM_V + vst1) = sr_[i].vs1; \
    *(bf16x8*)(K_lds + (b) * SHM_K + kst0) = sr_[i].ks0; *(bf16x8*)(K_lds + (b) * SHM_K + kst1) = sr_[i].ks1; *(bf16x8*)(K_lds + (b) * SHM_K + kst2) = sr_[i].ks2; } while (0)
#define SWAIT() do { if constexpr (SDEPTH == 2) asm volatile("s_waitcnt vmcnt(5)" ::: "memory"); else asm volatile("s_waitcnt vmcnt(0)" ::: "memory"); } while (0)
#define RESC(a) do { if (__any((a) < 1.f)) { if (hi == 0) al_l[r32] = (a); asm volatile("s_waitcnt lgkmcnt(0)" ::: "memory"); \
    _Pragma("unroll") for (int d = 0; d < 4; ++d) _Pragma("unroll") for (int r = 0; r < 16; ++r) o[d][r] *= al_l[crow(r, hi)]; } } while (0)
  f32x16 pA0, pA1, pB0, pB1; float mnA, mnB, alA, alB; bf16x8 pa0, pa1, pa2, pa3; const int NT = T / KVBLK;
  constexpr int SE = 0, SO = SDEPTH - 1;
  SLOAD(SE, 0); asm volatile("s_waitcnt vmcnt(0)" ::: "memory"); SWRITE(0, SE); __syncthreads();
  qkt(pA0, pA1, K_lds, qr, qL, r32, hi); partialSM(pA0, pA1, m_reg, mnA, alA);
  SLOAD(SO, KVBLK); if constexpr (SDEPTH == 2) { if (2 < NT) SLOAD(SE, 2 * KVBLK); }
  SWAIT(); SWRITE(1, SO); __syncthreads();
  for (int j = 1; j + 1 < NT; j += 2) {
    SBAR(); qkt(pB0, pB1, K_lds + SHM_K, qr, qL, r32, hi);
    finishSM(pA0, pA1, alA, l_reg, pa0, pa1, pa2, pa3); SBAR();
    SLOAD(SO, (j + SDEPTH) * KVBLK); SBAR();
    pv_d0(o, vb0, pa0, pa1, pa2, pa3); partialSM(pB0, pB1, m_reg, mnB, alB);
    __syncthreads(); SWAIT(); SWRITE(0, SE);
    RESC(alB); __syncthreads();
    SBAR(); qkt(pA0, pA1, K_lds, qr, qL, r32, hi);
    finishSM(pB0, pB1, alB, l_reg, pa0, pa1, pa2, pa3); SBAR();
    if (SDEPTH == 1 || j + 3 < NT) SLOAD(SE, (j + 1 + SDEPTH) * KVBLK); SBAR();
    pv_d0(o, vb0 + (int)SHM_V, pa0, pa1, pa2, pa3); partialSM(pA0, pA1, m_reg, mnA, alA);
    __syncthreads(); SWAIT(); SWRITE(1, SO);
    RESC(alA); __syncthreads();
  }
  SBAR(); qkt(pB0, pB1, K_lds + SHM_K, qr, qL, r32, hi);
  finishSM(pA0, pA1, alA, l_reg, pa0, pa1, pa2, pa3); SBAR();
  pv_d0(o, vb0, pa0, pa1, pa2, pa3); partialSM(pB0, pB1, m_reg, mnB, alB);
  __syncthreads(); RESC(alB);
  finishSM(pB0, pB1, alB, l_reg, pa0, pa1, pa2, pa3); SBAR();
  pv_d0(o, vb0 + (int)SHM_V, pa0, pa1, pa2, pa3);
  if (hi == 0) li_l[r32] = l_reg; asm volatile("s_waitcnt lgkmcnt(0)" ::: "memory");
  float rli[16];
#pragma unroll
  for (int r = 0; r < 16; ++r) rli[r] = __builtin_amdgcn_rcpf(li_l[crow(r, hi)]);
  bf16_t* Ow = Ob + (long)(wid * 32) * DM;
#pragma unroll
  for (int r = 0; r < 16; ++r) { int orow = crow(r, hi);
#pragma unroll
    for (int d0 = 0; d0 < 4; ++d0) Ow[(long)orow * DM + d0 * 32 + r32] = (bf16_t)f2bf(o[d0][r] * rli[r]); }
#undef SLOAD
#undef SWRITE
#undef SWAIT
#undef RESC
  __syncthreads();
}
}
namespace scan {
constexpr int LDT = 72;
constexpr int SC_G = 0, SC_K = 33792, SC_QT = SC_K + 17408, SC_QG = SC_QT + 17408, SC_VT = SC_QG + 17408, SC_P = SC_VT + 18432, SC_SEG = SC_P + 9216, SC_RSQ = SC_SEG + 4096,
              SC_END = SC_RSQ + 2048, SC_KDT = SC_QT;
static_assert(SC_END <= LDS_BYTES, "scan LDS");

template <int TYPE> struct Cfg { static constexpr int DK = TYPE ? 128 : 64, LDG = DK + 4, LDK_ = DK + 8, ND8 = DK / 8; };

template <int TYPE>
__device__ __forceinline__ void load_lg_k(const KArgs& a, int l, int h, int dir, size_t tok0, LAS unsigned char* lds, int tid) {
    unsigned char* const wsb = opq(a.ws);
    using C = Cfg<TYPE>;
    const bf16_t* u = (const bf16_t*)(wsb + WS_U);
    LAS float* G = (LAS float*)(lds + SC_G); LAS bf16_t* Kb = (LAS bf16_t*)(lds + SC_K);
    if constexpr (TYPE == 1) {
        const float* lbp = (const float*)(wsb + WS_LB) + (dir * DEPTH + l) * 512 + h * 128;
#pragma unroll
        for (int e2 = 0; e2 < 2; ++e2) { const int task = tid + 512 * e2, i = task >> 4, d8 = task & 15;
            const bf16x8 z8 = *(const bf16x8*)(u + (tok0 + i) * DINP + (dir ? C_HFB : C_HFF) + h * 128 + d8 * 8);
            float z[8], lg[8], kk[8]; unpack8(z8, z);
            const f32x4 lb0 = *(const f32x4*)(lbp + d8 * 8), lb1 = *(const f32x4*)(lbp + d8 * 8 + 4);
            const float lb[8] = {lb0[0], lb0[1], lb0[2], lb0[3], lb1[0], lb1[1], lb1[2], lb1[3]};
#pragma unroll
            for (int e = 0; e < 8; ++e) { const float sg = sigmoid_(fmaxf(z[e], -80.f)); lg[e] = __logf(lb[e] + (1.f - lb[e]) * sg); kk[e] = (1.f - lb[e]) * (1.f - sg); }
            *(LAS f32x4*)(G + i * C::LDG + d8 * 8) = (f32x4){lg[0], lg[1], lg[2], lg[3]}; *(LAS f32x4*)(G + i * C::LDG + d8 * 8 + 4) = (f32x4){lg[4], lg[5], lg[6], lg[7]};
            *(LAS bf16x8*)(Kb + i * C::LDK_ + d8 * 8) = pack8(kk); }
    } else {
        const int i = tid >> 3, d8 = tid & 7;
        const bf16_t* ur = u + (tok0 + i) * DINP;
        float ua[16]; unpack8(*(const bf16x8*)(ur + (dir ? C_GAB : C_GAF)), ua); unpack8(*(const bf16x8*)(ur + (dir ? C_GAB : C_GAF) + 8), ua + 8);
        const float* up = (const float*)a.in[3] + (size_t)((l * 2 + dir) * 16) * 256 + h * 64 + d8 * 8;
        const float* bs = (const float*)a.in[4] + (l * 2 + dir) * 256 + h * 64 + d8 * 8;
        f32x4 z0 = *(const f32x4*)bs, z1 = *(const f32x4*)(bs + 4);
#pragma unroll
        for (int r = 0; r < 16; ++r) { z0 += ua[r] * *(const f32x4*)(up + r * 256); z1 += ua[r] * *(const f32x4*)(up + r * 256 + 4); }
        f32x4 g0, g1;
#pragma unroll
        for (int e = 0; e < 4; ++e) { g0[e] = logsigmoid_(z0[e]) * (1.f / 16.f); g1[e] = logsigmoid_(z1[e]) * (1.f / 16.f); }
        *(LAS f32x4*)(G + i * C::LDG + d8 * 8) = g0; *(LAS f32x4*)(G + i * C::LDG + d8 * 8 + 4) = g1;
        *(LAS bf16x8*)(Kb + i * C::LDK_ + d8 * 8) = *(const bf16x8*)(ur + C_GK + h * 64 + d8 * 8);
    }
}
template <int TYPE>
__device__ __forceinline__ void cumsum_g(int dir, LAS unsigned char* lds, int tid) {
    using C = Cfg<TYPE>; constexpr int NSEG = 512 / C::DK, SEGL = 64 / NSEG;
    LAS float* G = (LAS float*)(lds + SC_G); LAS float* SG = (LAS float*)(lds + SC_SEG);
    const int d = tid % C::DK, seg = tid / C::DK;
    __syncthreads();
    float run = 0.f;
#pragma unroll
    for (int ii = 0; ii < SEGL; ++ii) { const int i = seg * SEGL + (dir ? SEGL - 1 - ii : ii); run += G[i * C::LDG + d]; G[i * C::LDG + d] = run; }
    SG[seg * 128 + d] = run;
    __syncthreads();
    float off = 0.f;
#pragma unroll
    for (int s = 0; s < NSEG; ++s) { const bool before = dir ? (s > seg) : (s < seg); if (before) off += SG[s * 128 + d]; }
#pragma unroll
    for (int ii = 0; ii < SEGL; ++ii) { const int i = seg * SEGL + ii; G[i * C::LDG + d] += off; }
    __syncthreads();
}
__device__ __forceinline__ void load_vT(const bf16_t* vsrc, LAS unsigned char* lds, int tid, unsigned char* wsd) {
    LAS bf16_t* VT = (LAS bf16_t*)(lds + SC_VT);
#pragma unroll
    for (int e2 = 0; e2 < 2; ++e2) { const int task = tid + 512 * e2, i = task & 63, v8 = task >> 6;
        const bf16x8 x = *(const bf16x8*)(vsrc + (size_t)i * DINP + v8 * 8);
#pragma unroll
        for (int e = 0; e < 8; ++e) { VT[(v8 * 8 + e) * LDT + i] = (bf16_t)x[e]; } }
}

template <int TYPE>
__device__ __forceinline__ void pass1_item(const KArgs& a, int l, int item, LAS unsigned char* lds) {
    unsigned char* const wsb = opq(a.ws);
    const int tid = opaque_tid();
    using C = Cfg<TYPE>; constexpr int DK = C::DK;
    const int c = item & (NCH - 1), dir = (item >> 8) & 1, h = (item >> 9) & 3, b = item >> 11;
    const size_t tok0 = (size_t)b * T + (size_t)c * 64;
    const bf16_t* u = (const bf16_t*)(wsb + WS_U);
    const int wid = tid >> 6, lane = tid & 63, fr = lane & 15, fq = lane >> 4;
    __syncthreads();
    load_lg_k<TYPE>(a, l, h, dir, tok0, lds, tid);
    load_vT(u + tok0 * DINP + (TYPE ? C_HI : C_GV) + h * 128, lds, tid, wsb);
    cumsum_g<TYPE>(dir, lds, tid);
    LAS float* G = (LAS float*)(lds + SC_G); LAS bf16_t* Kb = (LAS bf16_t*)(lds + SC_K); LAS bf16_t* KDT = (LAS bf16_t*)(lds + SC_KDT); LAS bf16_t* VT = (LAS bf16_t*)(lds + SC_VT);
    const int last = dir ? 0 : 63;
    float* Dout = (float*)(wsb + (TYPE ? WS_DH : WS_DG)) + (size_t)item * DK;
#pragma unroll
    for (int e2 = 0; e2 < DK / 64; ++e2) { const int task = tid + 512 * e2, i = task & 63, d8 = task >> 6;
        const f32x4 g0 = *(LAS f32x4*)(G + i * C::LDG + d8 * 8), g1 = *(LAS f32x4*)(G + i * C::LDG + d8 * 8 + 4);
        const f32x4 t0 = *(LAS f32x4*)(G + last * C::LDG + d8 * 8), t1 = *(LAS f32x4*)(G + last * C::LDG + d8 * 8 + 4);
        float kk[8]; unpack8(*(LAS bf16x8*)(Kb + i * C::LDK_ + d8 * 8), kk);
#pragma unroll
        for (int e = 0; e < 8; ++e) { const float gg = e < 4 ? g0[e] : g1[e - 4], tt = e < 4 ? t0[e] : t1[e - 4];
            KDT[(d8 * 8 + e) * LDT + i] = (bf16_t)f2bf(kk[e] * __expf(tt - gg)); }
        if (i == 0) { *(f32x4*)(Dout + d8 * 8) = (f32x4){__expf(t0[0]), __expf(t0[1]), __expf(t0[2]), __expf(t0[3])};
                      *(f32x4*)(Dout + d8 * 8 + 4) = (f32x4){__expf(t1[0]), __expf(t1[1]), __expf(t1[2]), __expf(t1[3])}; } }
    __syncthreads();
    bf16_t* ST = (bf16_t*)(wsb + (TYPE ? WS_SH : WS_SG)) + (size_t)item * 128 * DK;
    const bf16x8 b0 = *(LAS bf16x8*)(VT + (wid * 16 + fr) * LDT + fq * 8), b1 = *(LAS bf16x8*)(VT + (wid * 16 + fr) * LDT + 32 + fq * 8);
#pragma unroll
    for (int dt = 0; dt < DK / 16; ++dt) {
        const bf16x8 a0 = *(LAS bf16x8*)(KDT + (dt * 16 + fr) * LDT + fq * 8), a1 = *(LAS bf16x8*)(KDT + (dt * 16 + fr) * LDT + 32 + fq * 8);
        f32x4 acc = {0.f, 0.f, 0.f, 0.f};
        acc = __builtin_amdgcn_mfma_f32_16x16x32_bf16(a0, b0, acc, 0, 0, 0);
        acc = __builtin_amdgcn_mfma_f32_16x16x32_bf16(a1, b1, acc, 0, 0, 0);
        u32x2 w; w.x = cvt_pk_bf16(acc[0], acc[1]); w.y = cvt_pk_bf16(acc[2], acc[3]);
        *(u32x2*)(ST + (size_t)(wid * 16 + fr) * DK + dt * 16 + fq * 4) = w;
    }
}

struct P2Chain { bf16_t* st; const float* dp; size_t sstride; int dstride; int dir; };
__device__ __forceinline__ P2Chain p2_chain(unsigned char* wsb, int type, int E) {
    const int DK = type ? 128 : 64, IPI = 128 * DK;
    const int chain = E / IPI, e = E % IPI;
    P2Chain c; c.st = (bf16_t*)(wsb + (type ? WS_SH : WS_SG)) + (size_t)chain * NCH * IPI + e;
    c.dp = (const float*)(wsb + (type ? WS_DH : WS_DG)) + (size_t)chain * NCH * DK + (e % DK);
    c.sstride = (size_t)IPI; c.dstride = DK; c.dir = chain & 1; return c;
}
__device__ __forceinline__ void pass2_triple(const KArgs& a, int t) {
    unsigned char* const wsb = opq(a.ws);
    const P2Chain c0 = p2_chain(wsb, 1, t), c1 = p2_chain(wsb, 1, t + 131072), c2 = p2_chain(wsb, 0, t);
    float s0 = 0.f, s1 = 0.f, s2 = 0.f;
    unsigned short uA[3][4], uB[3][4]; float dA[3][4], dB[3][4];
#define P2_CI(c, s) ((c).dir ? NCH - 1 - (s) : (s))
#define P2_LOAD(U, D, sb) do { _Pragma("unroll") for (int k = 0; k < 4; ++k) { \
        const int i0_ = P2_CI(c0, (sb) + k), i1_ = P2_CI(c1, (sb) + k), i2_ = P2_CI(c2, (sb) + k); \
        U[0][k] = c0.st[(size_t)i0_ * c0.sstride]; D[0][k] = c0.dp[(size_t)i0_ * c0.dstride]; \
        U[1][k] = c1.st[(size_t)i1_ * c1.sstride]; D[1][k] = c1.dp[(size_t)i1_ * c1.dstride]; \
        U[2][k] = c2.st[(size_t)i2_ * c2.sstride]; D[2][k] = c2.dp[(size_t)i2_ * c2.dstride]; } } while (0)
#define P2_STEP(U, D, sb) do { _Pragma("unroll") for (int k = 0; k < 4; ++k) { \
        const int i0_ = P2_CI(c0, (sb) + k), i1_ = P2_CI(c1, (sb) + k), i2_ = P2_CI(c2, (sb) + k); \
        c0.st[(size_t)i0_ * c0.sstride] = (bf16_t)f2bf(s0); s0 = D[0][k] * s0 + bf2f(U[0][k]); \
        c1.st[(size_t)i1_ * c1.sstride] = (bf16_t)f2bf(s1); s1 = D[1][k] * s1 + bf2f(U[1][k]); \
        c2.st[(size_t)i2_ * c2.sstride] = (bf16_t)f2bf(s2); s2 = D[2][k] * s2 + bf2f(U[2][k]); } } while (0)
    P2_LOAD(uA, dA, 0);
#pragma unroll 1
    for (int sb = 0; sb < NCH; sb += 8) {
        P2_LOAD(uB, dB, sb + 4);
        P2_STEP(uA, dA, sb);
        if (sb + 8 < NCH) P2_LOAD(uA, dA, sb + 8);
        P2_STEP(uB, dB, sb + 4);
    }
#undef P2_CI
#undef P2_LOAD
#undef P2_STEP
}

template <int TYPE>
__device__ __forceinline__ void pass3_item(const KArgs& a, int l, int item, LAS unsigned char* lds) {
    unsigned char* const wsb = opq(a.ws);
    const int tid = opaque_tid();
    using C = Cfg<TYPE>; constexpr int DK = C::DK;
    const int c = item & (NCH - 1), h = (item >> 8) & 3, b = item >> 10;
    const size_t tok0 = (size_t)b * T + (size_t)c * 64;
    const bf16_t* u = (const bf16_t*)(wsb + WS_U);
    const int wid = tid >> 6, lane = tid & 63, fr = lane & 15, fq = lane >> 4;
    LAS float* G = (LAS float*)(lds + SC_G); LAS bf16_t* Kb = (LAS bf16_t*)(lds + SC_K); LAS bf16_t* QT = (LAS bf16_t*)(lds + SC_QT); LAS bf16_t* QG = (LAS bf16_t*)(lds + SC_QG);
    LAS bf16_t* VT = (LAS bf16_t*)(lds + SC_VT); LAS bf16_t* P = (LAS bf16_t*)(lds + SC_P); LAS float* RSQ = (LAS float*)(lds + SC_RSQ);
    __syncthreads();
    load_vT(u + tok0 * DINP + (TYPE ? C_HI : C_GV) + h * 128, lds, tid, wsb);
    f32x4 o[4];
#pragma unroll
    for (int it = 0; it < 4; ++it) o[it] = (f32x4){0.f, 0.f, 0.f, 0.f};
#pragma unroll 1
    for (int dir = 0; dir < 2; ++dir) {
        const int sitem = ((b * 4 + h) * 2 + dir) * NCH + c;
        const bf16_t* ST = (const bf16_t*)(wsb + (TYPE ? WS_SH : WS_SG)) + (size_t)sitem * 128 * DK + (size_t)(wid * 16 + fr) * DK + fq * 8;
        bf16x8 sf[DK / 32];
#pragma unroll
        for (int ks = 0; ks < DK / 32; ++ks) sf[ks] = *(const bf16x8*)(ST + ks * 32);
        if (dir) __syncthreads();
        load_lg_k<TYPE>(a, l, h, dir, tok0, lds, tid);
        cumsum_g<TYPE>(dir, lds, tid);
#pragma unroll
        for (int e2 = 0; e2 < DK / 64; ++e2) { const int task = tid + 512 * e2, i = task / C::ND8, d8 = task % C::ND8;
            const f32x4 g0 = *(LAS f32x4*)(G + i * C::LDG + d8 * 8), g1 = *(LAS f32x4*)(G + i * C::LDG + d8 * 8 + 4);
            const f32x4 m0 = *(LAS f32x4*)(G + 32 * C::LDG + d8 * 8), m1 = *(LAS f32x4*)(G + 32 * C::LDG + d8 * 8 + 4);
            float kk[8], qq[8], qt[8], qg[8]; unpack8(*(LAS bf16x8*)(Kb + i * C::LDK_ + d8 * 8), kk);
            unpack8(*(const bf16x8*)(u + (tok0 + i) * DINP + (TYPE ? C_HQ + h * 128 : C_GQ + h * 64) + d8 * 8), qq);
#pragma unroll
            for (int e = 0; e < 8; ++e) { const float gg = e < 4 ? g0[e] : g1[e - 4], gm = e < 4 ? m0[e] : m1[e - 4];
                const float q = TYPE ? silu_(qq[e]) : qq[e] * 0.125f;
                qt[e] = q * __expf(gg - gm); qg[e] = q * __expf(gg); kk[e] = kk[e] * __expf(gm - gg); }
            *(LAS bf16x8*)(QT + i * C::LDK_ + d8 * 8) = pack8(qt); *(LAS bf16x8*)(QG + i * C::LDK_ + d8 * 8) = pack8(qg); *(LAS bf16x8*)(Kb + i * C::LDK_ + d8 * 8) = pack8(kk); }
        __syncthreads();
        { const int it = wid >> 1;
#pragma unroll
          for (int jj = 0; jj < 2; ++jj) { const int jt = 2 * (wid & 1) + jj;
            f32x4 acc = {0.f, 0.f, 0.f, 0.f};
#pragma unroll
            for (int ks = 0; ks < DK / 32; ++ks) {
                const bf16x8 af = *(LAS bf16x8*)(QT + (it * 16 + fr) * C::LDK_ + ks * 32 + fq * 8), bfr = *(LAS bf16x8*)(Kb + (jt * 16 + fr) * C::LDK_ + ks * 32 + fq * 8);
                acc = __builtin_amdgcn_mfma_f32_16x16x32_bf16(af, bfr, acc, 0, 0, 0); }
#pragma unroll
            for (int r = 0; r < 4; ++r) { const int i = it * 16 + fq * 4 + r, j = jt * 16 + fr; const bool keep = dir ? (j >= i) : (j <= i);
                P[i * LDT + j] = (bf16_t)f2bf(keep ? acc[r] : 0.f); } } }
        __syncthreads();
        const bf16x8 vb0 = *(LAS bf16x8*)(VT + (wid * 16 + fr) * LDT + fq * 8), vb1 = *(LAS bf16x8*)(VT + (wid * 16 + fr) * LDT + 32 + fq * 8);
#pragma unroll
        for (int it = 0; it < 4; ++it) {
            const bf16x8 p0 = *(LAS bf16x8*)(P + (it * 16 + fr) * LDT + fq * 8), p1 = *(LAS bf16x8*)(P + (it * 16 + fr) * LDT + 32 + fq * 8);
            o[it] = __builtin_amdgcn_mfma_f32_16x16x32_bf16(p0, vb0, o[it], 0, 0, 0);
            o[it] = __builtin_amdgcn_mfma_f32_16x16x32_bf16(p1, vb1, o[it], 0, 0, 0);
#pragma unroll
            for (int ks = 0; ks < DK / 32; ++ks) { const bf16x8 af = *(LAS bf16x8*)(QG + (it * 16 + fr) * C::LDK_ + ks * 32 + fq * 8);
                o[it] = __builtin_amdgcn_mfma_f32_16x16x32_bf16(af, sf[ks], o[it], 0, 0, 0); }
        }
    }
#pragma unroll
    for (int it = 0; it < 4; ++it)
#pragma unroll
        for (int r = 0; r < 4; ++r) { float s = o[it][r] * o[it][r]; s += __shfl_xor(s, 1); s += __shfl_xor(s, 2); s += __shfl_xor(s, 4); s += __shfl_xor(s, 8);
            if (fr == 0) RSQ[wid * 64 + it * 16 + fq * 4 + r] = s; }
    __syncthreads();
    const float gain = ((const float*)a.in[TYPE ? 7 : 5])[l * 128 + wid * 16 + fr];
    bf16_t* mix = (bf16_t*)(wsb + WS_XN);
#pragma unroll
    for (int it = 0; it < 4; ++it)
#pragma unroll
        for (int r = 0; r < 4; ++r) { const int i = it * 16 + fq * 4 + r; float s = 0.f;
#pragma unroll
            for (int w = 0; w < 8; ++w) s += RSQ[w * 64 + i];
            const float rstd = rsqrtf(s * (1.f / 128.f) + EPS);
            const float gt = bf2f(u[(tok0 + i) * DINP + (TYPE ? C_HG : C_GG) + h * 128 + wid * 16 + fr]);
            const float yv = o[it][r] * rstd * gain * silu_(gt);
            mix[(tok0 + i) * DM + (TYPE ? 512 : 0) + h * 128 + wid * 16 + fr] = (bf16_t)f2bf(yv); }
}
}
__device__ __forceinline__ void rmsnorm_rows_bf16(const float* src, const float* gain, bf16_t* dst) {
    const int tid = opaque_tid(), lane = tid & 63, gw = blockIdx.x * 8 + (tid >> 6), ngw = gridDim.x * 8;
    for (int m = gw; m < M; m += ngw) {
        const f32x4* xr = (const f32x4*)(src + (size_t)m * DM) + lane;
        f32x4 v[8]; float s = 0.f;
#pragma unroll
        for (int j = 0; j < 8; ++j) { v[j] = xr[64 * j]; s += (v[j][0] * v[j][0] + v[j][1] * v[j][1]) + (v[j][2] * v[j][2] + v[j][3] * v[j][3]); }
        const float rstd = rsqrtf(wave_sum(s) * (1.f / DM) + EPS);
        u32x2* o8 = (u32x2*)(dst + (size_t)m * DM) + lane;
#pragma unroll
        for (int j = 0; j < 8; ++j) { const f32x4 g = ((const f32x4*)gain)[lane + 64 * j];
            u32x2 w; w.x = cvt_pk_bf16(v[j][0] * rstd * g[0], v[j][1] * rstd * g[1]); w.y = cvt_pk_bf16(v[j][2] * rstd * g[2], v[j][3] * rstd * g[3]); o8[64 * j] = w; }
    }
}
__device__ __forceinline__ void cast_rows_bf16(const float* src, bf16_t* dst, float* rsq) {
    const int tid = opaque_tid(), lane = tid & 63, gw = blockIdx.x * 8 + (tid >> 6), ngw = gridDim.x * 8;
    for (int m = gw; m < M; m += ngw) {
        const f32x4* xr = (const f32x4*)(src + (size_t)m * DM) + lane;
        f32x4 v[8]; float s = 0.f;
#pragma unroll
        for (int j = 0; j < 8; ++j) { v[j] = xr[64 * j]; s += (v[j][0] * v[j][0] + v[j][1] * v[j][1]) + (v[j][2] * v[j][2] + v[j][3] * v[j][3]); }
        s = wave_sum(s);
        if (lane == 0) rsq[m] = s;
        u32x2* o8 = (u32x2*)(dst + (size_t)m * DM) + lane;
#pragma unroll
        for (int j = 0; j < 8; ++j) { u32x2 w; w.x = cvt_pk_bf16(v[j][0], v[j][1]); w.y = cvt_pk_bf16(v[j][2], v[j][3]); o8[64 * j] = w; }
    }
}
__device__ __forceinline__ void rmsnorm_rows_f32_inplace(float* buf, const float* gain) {
    const int tid = opaque_tid(), lane = tid & 63, gw = blockIdx.x * 8 + (tid >> 6), ngw = gridDim.x * 8;
    for (int m = gw; m < M; m += ngw) {
        f32x4* xr = (f32x4*)(buf + (size_t)m * DM) + lane;
        f32x4 v[8]; float s = 0.f;
#pragma unroll
        for (int j = 0; j < 8; ++j) { v[j] = xr[64 * j]; s += (v[j][0] * v[j][0] + v[j][1] * v[j][1]) + (v[j][2] * v[j][2] + v[j][3] * v[j][3]); }
        const float rstd = rsqrtf(wave_sum(s) * (1.f / DM) + EPS);
#pragma unroll
        for (int j = 0; j < 8; ++j) { const f32x4 g = ((const f32x4*)gain)[lane + 64 * j]; xr[64 * j] = v[j] * rstd * g; }
    }
}
__device__ __forceinline__ void convert_weights(const KArgs& a, int l, LAS unsigned char* lds) {
    unsigned char* const wsb = opq(a.ws);
    const int tid = opaque_tid();
    LAS float* tile = (LAS float*)lds;
    constexpr int I_IN = 32 * 84, I_QB = 8 * 24, I_KVB = 8 * 32, I_OUT = 32 * 32, I_13 = 32 * 176, I_2 = 88 * 32, NIT = I_IN + I_QB + I_KVB + I_OUT + I_13 + I_2;
    for (int it = blockIdx.x; it < NIT; it += gridDim.x) {
        int r = it, mode = 0, N, K, nkt; const float* w0; const float* w1 = nullptr; const float* gk = nullptr; bf16_t* WT;
        if (r < I_IN) { w0 = (const float*)a.in[2] + (size_t)l * DM * DIN; N = DIN; K = DM; nkt = 32; gk = (const float*)a.in[13] + l * DM; WT = (bf16_t*)(wsb + WS_WIN); }
        else if ((r -= I_IN) < I_QB) { w0 = (const float*)a.in[9] + (size_t)l * 512 * 1536; N = 1536; K = 512; nkt = 8; mode = 1; WT = (bf16_t*)(wsb + WS_WQB); }
        else if ((r -= I_QB) < I_KVB) { w0 = (const float*)a.in[11] + (size_t)l * 512 * 2048; N = 2048; K = 512; nkt = 8; WT = (bf16_t*)(wsb + WS_WKVB); }
        else if ((r -= I_KVB) < I_OUT) { w0 = (const float*)a.in[12] + (size_t)l * DM * DM; N = DM; K = DM; nkt = 32; WT = (bf16_t*)(wsb + WS_WOUT); }
        else if ((r -= I_OUT) < I_13) { w0 = (const float*)a.in[15] + (size_t)l * DM * DFF; w1 = (const float*)a.in[16] + (size_t)l * DM * DFF; N = DFF; K = DM; nkt = 32; mode = 2; gk = (const float*)a.in[14] + l * DM; WT = (bf16_t*)(wsb + WS_W13); }
        else { r -= I_13; w0 = (const float*)a.in[17] + (size_t)l * DFF * DM; N = DM; K = DFF; nkt = 88; WT = (bf16_t*)(wsb + WS_W2); }
        const int kt = r % nkt, rt = r / nkt, r0 = rt * 64, k0 = kt * 64;
        __syncthreads();
        if (mode == 1) {
#pragma unroll
            for (int e = 0; e < 8; ++e) { const int idx = tid + 512 * e, rl = idx & 63, kl = idx >> 6, rr = r0 + rl, k = k0 + kl;
                const int hh = rr / 192, ee = rr % 192; const int col = ee < 128 ? hh * 192 + ee : hh * 192 + 128 + ((ee - 128) & 1) * 32 + ((ee - 128) >> 1);
                tile[kl * 65 + rl] = w0[(size_t)k * N + col]; }
        } else {
#pragma unroll
            for (int e = 0; e < 2; ++e) { const int idx = tid + 512 * e, r4 = (idx & 15) * 4, kl = idx >> 4, rr = r0 + r4, k = k0 + kl;
                f32x4 v = {0.f, 0.f, 0.f, 0.f};
                if (mode == 0) { if (rr < N) v = *(const f32x4*)(w0 + (size_t)k * N + rr); }
                else { const int g = rr >> 5, n = (rr >> 4) & 1, i = rr & 15; v = *(const f32x4*)((n ? w1 : w0) + (size_t)k * N + 16 * g + i); }
                if (gk) v = v * gk[k];
                tile[kl * 65 + r4] = v[0]; tile[kl * 65 + r4 + 1] = v[1]; tile[kl * 65 + r4 + 2] = v[2]; tile[kl * 65 + r4 + 3] = v[3]; }
        }
        __syncthreads();
        { const int k8 = tid & 7, rl = tid >> 3;
          u32x4 w; w.x = pk2(tile[(8 * k8 + 0) * 65 + rl], tile[(8 * k8 + 1) * 65 + rl]); w.y = pk2(tile[(8 * k8 + 2) * 65 + rl], tile[(8 * k8 + 3) * 65 + rl]);
          w.z = pk2(tile[(8 * k8 + 4) * 65 + rl], tile[(8 * k8 + 5) * 65 + rl]); w.w = pk2(tile[(8 * k8 + 6) * 65 + rl], tile[(8 * k8 + 7) * 65 + rl]);
          *(u32x4*)(WT + (size_t)(r0 + rl) * K + k0 + 8 * k8) = w; }
    }
    __syncthreads();
}
__device__ __forceinline__ void tables_phase(const KArgs& a) {
    unsigned char* const wsb = opq(a.ws);
    const int tid = opaque_tid();
    const int* pos = (const int*)a.in[1];
    float* cs = (float*)(wsb + WS_COS); float* sn = (float*)(wsb + WS_SIN);
    const int gt = blockIdx.x * 512 + tid, ngt = gridDim.x * 512;
    for (int idx = gt; idx < M * 32; idx += ngt) { const int tok = idx >> 5, i = idx & 31;
        const float inv = 1.0f / exp2f((float)(2 * i) * (1.f / 64.f) * 13.287712379549449f);
        const float ang = (float)pos[tok] * inv;
        double rev = (double)ang * 0.15915494309189535; rev -= rint(rev);
        const float f = (float)rev;
        cs[idx] = __builtin_amdgcn_cosf(f); sn[idx] = __builtin_amdgcn_sinf(f); }
    if (blockIdx.x == 0) { const float* lg = (const float*)a.in[6]; float* lb = (float*)(wsb + WS_LB);
        for (int p = tid; p < 2 * 512; p += 512) { const int dir = p >> 9, c = p & 511;
            float mx = -1e30f;
#pragma unroll
            for (int l = 0; l < DEPTH; ++l) mx = fmaxf(mx, lg[(dir * DEPTH + l) * 512 + c]);
            float den = 0.f;
#pragma unroll
            for (int l = 0; l < DEPTH; ++l) den += __expf(lg[(dir * DEPTH + l) * 512 + c] - mx);
            float cum = 0.f;
#pragma unroll
            for (int l = 0; l < DEPTH; ++l) { if (l > 0) cum += __expf(lg[(dir * DEPTH + l) * 512 + c] - mx) / den; lb[(dir * DEPTH + l) * 512 + c] = cum; } } }
}
__device__ __forceinline__ void mla_prep(const KArgs& a, int l) {
    unsigned char* const wsb = opq(a.ws);
    const int tid = opaque_tid(), lane = tid & 63, gw = blockIdx.x * 8 + (tid >> 6), ngw = gridDim.x * 8;
    bf16_t* u = (bf16_t*)(wsb + WS_U); bf16_t* kr = (bf16_t*)(wsb + WS_KR);
    const float* cs = (const float*)(wsb + WS_COS); const float* sn = (const float*)(wsb + WS_SIN);
    const float* gq = (const float*)a.in[8] + l * 512 + lane * 8; const float* gkv = (const float*)a.in[10] + l * 512 + lane * 8;
    for (int tok = gw; tok < M; tok += ngw) {
        bf16_t* ur = u + (size_t)tok * DINP;
#pragma unroll
        for (int w = 0; w < 2; ++w) { bf16_t* p = ur + (w ? C_CKV : C_CQ) + lane * 8; const float* g = w ? gkv : gq;
            float f[8]; unpack8(*(const bf16x8*)p, f); float s = 0.f;
#pragma unroll
            for (int e = 0; e < 8; ++e) s += f[e] * f[e];
            const float rstd = rsqrtf(wave_sum(s) * (1.f / 512.f) + EPS);
#pragma unroll
            for (int e = 0; e < 8; ++e) f[e] = f[e] * rstd * g[e];
            *(bf16x8*)p = pack8(f); }
        if (lane < 32) { const float x1 = bf2f(ur[C_KR + lane]), x2 = bf2f(ur[C_KR + 32 + lane]), c = cs[(size_t)tok * 32 + lane], s = sn[(size_t)tok * 32 + lane];
            *(unsigned*)(kr + (size_t)tok * 64 + 2 * lane) = pk2(x1 * c - x2 * s, x2 * c + x1 * s); }
    }
}

__device__ __forceinline__ void grid_barrier(unsigned* bar, unsigned nblk, unsigned& epoch) {
    __builtin_amdgcn_fence(__ATOMIC_RELEASE, "agent");
    asm volatile("s_waitcnt vmcnt(0) lgkmcnt(0)" ::: "memory");
    __syncthreads();
    epoch += nblk;
    if (threadIdx.x == 0) {
        __hip_atomic_fetch_add(bar, 1u, __ATOMIC_RELEASE, __HIP_MEMORY_SCOPE_AGENT);
        while (__hip_atomic_load(bar, __ATOMIC_ACQUIRE, __HIP_MEMORY_SCOPE_AGENT) < epoch) __builtin_amdgcn_s_sleep(2);
    }
    __syncthreads();
    __builtin_amdgcn_fence(__ATOMIC_ACQUIRE, "agent");
}
__global__ void __launch_bounds__(512, 2) mega_fwd(KArgs a) {
    extern __shared__ __attribute__((aligned(16))) unsigned char smem[];
    cg::grid_group grid = cg::this_grid();
    LAS unsigned char* lds = (LAS unsigned char*)smem;
    const int G = gridDim.x, bx = blockIdx.x;
    const float* x = (const float*)a.in[0];
    unsigned epoch = 0; unsigned* const gbar = (unsigned*)(a.ws + WS_BAR);
#define GBAR() grid_barrier(gbar, (unsigned)G, epoch)

#if PH_MISC
    tables_phase(a);
    convert_weights(a, 0, lds);
#if PROBE_CVT_REP > 1
    convert_weights(a, 0, lds);
#endif
#endif
    { float* rz = (float*)(opq(a.ws) + WS_RSQ); for (int z_ = bx * 512 + opaque_tid(); z_ < 4 * M; z_ += G * 512) rz[z_] = 0.f; }
    cast_rows_bf16(x, (bf16_t*)(opq(a.ws) + WS_XN), (float*)(opq(a.ws) + WS_RSQ) + 4 * M);
    grid.sync();
    GBAR();
#pragma unroll 1
    for (int l = 0; l < DEPTH; ++l) {
        if (l > 0) {
#if PH_MISC
            convert_weights(a, l, lds);
#if PROBE_CVT_REP > 1
            convert_weights(a, l, lds);
#endif
#endif
            GBAR();
        }
        { pg8::Gemm g{(const bf16_t*)(opq(a.ws) + WS_XN), (const bf16_t*)(opq(a.ws) + WS_WIN), M, DINP, DM, DM, DM}; pg8::StaticOrder S; S.init(M, DINP, G, bx);
          pg8::EpiU E{(bf16_t*)(opq(a.ws) + WS_U), DINP, (const float*)(opq(a.ws) + WS_RSQ) + (size_t)(l == 0 ? 4 : 2 + (l - 1)) * M};
          __syncthreads(); if (PH_GEMM & 1) pg8::gemm_phase<pg8::EpiU, pg8::StaticOrder, true, true>(lds, g, S, E);
#if PROBE_GEMM_REP > 1
          __syncthreads(); if (PH_GEMM & 1) pg8::gemm_phase<pg8::EpiU, pg8::StaticOrder, true, true>(lds, g, S, E);
#endif
 }
        GBAR();
#if PH_MISC
        mla_prep(a, l);
#endif
#if PH_S1
        for (int it = bx; it < 4096; it += G) scan::pass1_item<1>(a, l, it, lds);
        for (int it = bx; it < 4096; it += G) scan::pass1_item<0>(a, l, it, lds);
#if PROBE_SCAN_REP > 1
        for (int it = bx; it < 4096; it += G) scan::pass1_item<1>(a, l, it, lds);
        for (int it = bx; it < 4096; it += G) scan::pass1_item<0>(a, l, it, lds);
#endif
#endif
        GBAR();
#if PH_S2
        for (int t = bx * 512 + opaque_tid(); t < 131072; t += G * 512) scan::pass2_triple(a, t);
#endif
        { pg8::Gemm g{(const bf16_t*)(opq(a.ws) + WS_U) + C_CQ, (const bf16_t*)(opq(a.ws) + WS_WQB), M, 1536, 512, DINP, 512}; pg8::StaticOrder S; S.init(M, 1536, G, bx);
          pg8::EpiQ E{(bf16_t*)(opq(a.ws) + WS_Q), (const float*)(opq(a.ws) + WS_COS), (const float*)(opq(a.ws) + WS_SIN)};
          __syncthreads(); if (PH_GEMM & 2) pg8::gemm_phase<pg8::EpiQ, pg8::StaticOrder, true, true>(lds, g, S, E);
#if PROBE_GEMM_REP > 1
          __syncthreads(); if (PH_GEMM & 2) pg8::gemm_phase<pg8::EpiQ, pg8::StaticOrder, true, true>(lds, g, S, E);
#endif
 }
        { pg8::Gemm g{(const bf16_t*)(opq(a.ws) + WS_U) + C_CKV, (const bf16_t*)(opq(a.ws) + WS_WKVB), M, 2048, 512, DINP, 512}; pg8::StaticOrder S; S.init(M, 2048, G, bx);
          pg8::EpiKV E{(bf16_t*)(opq(a.ws) + WS_KN), (bf16_t*)(opq(a.ws) + WS_V)};
          __syncthreads(); if (PH_GEMM & 4) pg8::gemm_phase<pg8::EpiKV, pg8::StaticOrder, true, true>(lds, g, S, E);
#if PROBE_GEMM_REP > 1
          __syncthreads(); if (PH_GEMM & 4) pg8::gemm_phase<pg8::EpiKV, pg8::StaticOrder, true, true>(lds, g, S, E);
#endif
 }
        GBAR();
        { const bool x8 = (G % 8) == 0; const int xcd = bx & 7, slot = bx >> 3, nslot = G >> 3;
          for (int pr = 0; pr < (x8 ? 2 : 16); ++pr) { const int p = x8 ? xcd + 8 * pr : pr, b = p >> 3, h = p & 7;
            for (int qb = x8 ? slot : bx; qb < 64; qb += x8 ? nslot : G) {
              const bf16_t* Qb = (const bf16_t*)(opq(a.ws) + WS_Q) + ((size_t)(b * 8 + h) * T + (size_t)qb * 256) * 192;
              const bf16_t* Kn = (const bf16_t*)(opq(a.ws) + WS_KN) + (size_t)(b * 8 + h) * T * 128;
              const bf16_t* Kr = (const bf16_t*)(opq(a.ws) + WS_KR) + (size_t)b * T * 64;
              const bf16_t* Vh = (const bf16_t*)(opq(a.ws) + WS_V) + (size_t)(b * 8 + h) * T * 128;
              bf16_t* Ob = (bf16_t*)(opq(a.ws) + WS_XN) + ((size_t)b * T + (size_t)qb * 256) * DM + 1024 + h * 128;
#if PH_ATT
              for (int rep_ = 0; rep_ < PROBE_ATT_REP; ++rep_) att::attn_unit(Qb, Kn, Kr, Vh, Ob, (char*)smem);
#else
              { const int t_ = opaque_tid(); bf16_t* zp = Ob + (size_t)(t_ >> 1) * DM + (t_ & 1) * 64; (void)Qb; (void)Kn; (void)Kr; (void)Vh;
                for (int z_ = 0; z_ < 8; ++z_) *(u32x4*)(zp + z_ * 8) = (u32x4){0u, 0u, 0u, 0u}; }
#endif
 } } }
#if PH_S3
        for (int it = bx; it < 2048; it += G) scan::pass3_item<1>(a, l, it, lds);
        for (int it = bx; it < 2048; it += G) scan::pass3_item<0>(a, l, it, lds);
#if PROBE_SCAN_REP > 1
        for (int it = bx; it < 2048; it += G) scan::pass3_item<1>(a, l, it, lds);
        for (int it = bx; it < 2048; it += G) scan::pass3_item<0>(a, l, it, lds);
#endif
#else
        { bf16_t* mz = (bf16_t*)(opq(a.ws) + WS_XN); for (size_t z_ = (size_t)bx * 512 + opaque_tid(); z_ < (size_t)M * 128; z_ += (size_t)G * 512) *(u32x4*)(mz + (z_ >> 7) * DM + (z_ & 127) * 8) = (u32x4){0u, 0u, 0u, 0u}; }
#endif
        GBAR();
        { pg8::Gemm g{(const bf16_t*)(opq(a.ws) + WS_XN), (const bf16_t*)(opq(a.ws) + WS_WOUT), M, DM, DM, DM, DM}; pg8::StaticOrder S; S.init(M, DM, G, bx);
          pg8::EpiRes E{l == 0 ? x : (const float*)a.out, a.out, (bf16_t*)(opq(a.ws) + WS_HB), (float*)(opq(a.ws) + WS_RSQ) + (size_t)l * M};
          __syncthreads(); if (PH_GEMM & 8) pg8::gemm_phase<pg8::EpiRes, pg8::StaticOrder, true, true>(lds, g, S, E); }
        GBAR();
        { pg8::Gemm g{(const bf16_t*)(opq(a.ws) + WS_HB), (const bf16_t*)(opq(a.ws) + WS_W13), M, 2 * DFF, DM, DM, DM}; pg8::StaticOrder S; S.init(M, 2 * DFF, G, bx);
          pg8::EpiSwi E{(bf16_t*)(opq(a.ws) + WS_HID), (const float*)(opq(a.ws) + WS_RSQ) + (size_t)l * M};
          __syncthreads(); if (PH_GEMM & 16) pg8::gemm_phase<pg8::EpiSwi, pg8::StaticOrder, true, true>(lds, g, S, E);
#if PROBE_GEMM_REP > 1
          __syncthreads(); if (PH_GEMM & 16) pg8::gemm_phase<pg8::EpiSwi, pg8::StaticOrder, true, true>(lds, g, S, E);
#endif
 }
        GBAR();
        { pg8::Gemm g{(const bf16_t*)(opq(a.ws) + WS_HID), (const bf16_t*)(opq(a.ws) + WS_W2), M, DM, DFF, DFF, DFF}; pg8::StaticOrder S; S.init(M, DM, G, bx);
          pg8::EpiRes E{(const float*)a.out, a.out, (bf16_t*)(opq(a.ws) + WS_XN), (float*)(opq(a.ws) + WS_RSQ) + (size_t)(2 + l) * M};
          __syncthreads(); if (PH_GEMM & 32) pg8::gemm_phase<pg8::EpiRes, pg8::StaticOrder, true, true>(lds, g, S, E); }
        GBAR();
    }
    rmsnorm_rows_f32_inplace(a.out, (const float*)a.in[18]);
}

extern "C" void kernel_launch(void* const* d_in, const int* in_sizes, int n_in, void* d_out, int out_size, void* d_ws, size_t ws_size, hipStream_t stream) {
    static int grid = 0;
    if (grid == 0) {
        if (n_in != 19 || out_size != M * DM || ws_size < WS_END) { fprintf(stderr, "kernel_launch: unexpected shapes (n_in %d out %d ws %zu)\n", n_in, out_size, ws_size); grid = -1; return; }
        int dev = 0, cus = 0, per_cu = 0;
        hipGetDevice(&dev); hipDeviceGetAttribute(&cus, hipDeviceAttributeMultiprocessorCount, dev);
        if (hipFuncSetAttribute((const void*)mega_fwd, hipFuncAttributeMaxDynamicSharedMemorySize, LDS_BYTES) != hipSuccess) { fprintf(stderr, "kernel_launch: hipFuncSetAttribute failed\n"); grid = -1; return; }
        if (hipOccupancyMaxActiveBlocksPerMultiprocessor(&per_cu, (const void*)mega_fwd, 512, LDS_BYTES) != hipSuccess || per_cu < 1) { fprintf(stderr, "kernel_launch: occupancy query says %d\n", per_cu); per_cu = 1; }
        (void)hipGetLastError();
        grid = cus * (per_cu > 1 ? 1 : per_cu);
    }
    if (grid < 0) return;
    KArgs a{};
    for (int i = 0; i < 19; ++i) a.in[i] = d_in[i];
    a.out = (float*)d_out; a.ws = (unsigned char*)d_ws;
    if (hipMemsetAsync((char*)d_ws + WS_BAR, 0, 256, stream) != hipSuccess) { fprintf(stderr, "kernel_launch: memset failed\n"); return; }
    void* args[] = {&a};
    hipError_t e = hipLaunchCooperativeKernel((const void*)mega_fwd, dim3(grid), dim3(512), args, LDS_BYTES, stream);
    if (e != hipSuccess) fprintf(stderr, "kernel_launch: cooperative launch failed: %s (grid %d)\n", hipGetErrorString(e), grid);
}
```

```cpp
#include <hip/hip_runtime.h>
#include <hip/hip_cooperative_groups.h>
#include <cstdint>
#include <cstdio>
namespace cg = cooperative_groups;
#ifndef PROBE_GEMM_REP
#define PROBE_GEMM_REP 1
#endif
#ifndef PROBE_SCAN_REP
#define PROBE_SCAN_REP 1
#endif
#ifndef PROBE_CVT_REP
#define PROBE_CVT_REP 1
#endif
#ifndef PROBE_ATT_REP
#define PROBE_ATT_REP 1
#endif
#ifndef PH_ATT
#define PH_ATT 1
#endif
#ifndef PH_S1
#define PH_S1 1
#endif
#ifndef PH_S2
#define PH_S2 1
#endif
#ifndef PH_S3
#define PH_S3 1
#endif
#ifndef PH_GEMM
#define PH_GEMM 63
#endif
#ifndef PH_MISC
#define PH_MISC 1
#endif

#define LAS __attribute__((address_space(3)))
typedef unsigned short bf16_t;
typedef short bf16x8 __attribute__((ext_vector_type(8)));
typedef short s16x4 __attribute__((ext_vector_type(4)));
typedef float f32x2 __attribute__((ext_vector_type(2)));
typedef float f32x4 __attribute__((ext_vector_type(4)));
typedef float f32x16 __attribute__((ext_vector_type(16)));
typedef unsigned u32x2 __attribute__((ext_vector_type(2)));
typedef unsigned u32x4 __attribute__((ext_vector_type(4)));

constexpr int NB = 2, T = 16384, M = NB * T, DM = 2048, DIN = 5216, DINP = 5376, DFF = 5632, DEPTH = 2;
constexpr int C_GQ = 0, C_GK = 256, C_GV = 512, C_GAF = 1024, C_GAB = 1040, C_GG = 1056, C_HQ = 1568, C_HFF = 2080, C_HFB = 2592, C_HI = 3104, C_HG = 3616,
              C_CQ = 4128, C_CKV = 4640, C_KR = 5152;
constexpr float EPS = 1e-6f;
constexpr int NCH = T / 64;
constexpr size_t MiB = 1048576;
constexpr size_t WS_WIN = 0, WS_WQB = 21 * MiB, WS_WKVB = WS_WQB + 3 * MiB / 2, WS_WOUT = WS_WKVB + 2 * MiB, WS_W13 = WS_WOUT + 8 * MiB, WS_W2 = WS_W13 + 44 * MiB;
constexpr size_t WS_XN = 99 * MiB, WS_U = 227 * MiB, WS_Q = 563 * MiB, WS_KN = 659 * MiB, WS_V = 723 * MiB, WS_KR = 787 * MiB, WS_SG = 791 * MiB, WS_SH = 855 * MiB,
                 WS_DG = 983 * MiB, WS_DH = 984 * MiB, WS_COS = 986 * MiB, WS_SIN = 990 * MiB, WS_LB = 994 * MiB, WS_BAR = 995 * MiB, WS_RSQ = WS_BAR + 4096, WS_END = 996 * MiB, WS_HB = WS_U, WS_HID = WS_U + 128 * MiB;
static_assert(WS_W2 + 22 * MiB <= WS_XN, "weights");
constexpr int LDS_BYTES = 131072;

struct KArgs { const void* in[19]; float* out; unsigned char* ws; };

__device__ __forceinline__ float bf2f(unsigned v) { return __uint_as_float(v << 16); }
__device__ __forceinline__ unsigned f2bf(float f) { unsigned u = __float_as_uint(f); return (u + 0x7fffu + ((u >> 16) & 1u)) >> 16; }
__device__ __forceinline__ unsigned pk2(float lo, float hi) { return f2bf(lo) | (f2bf(hi) << 16); }
typedef __bf16 bf16x2_t __attribute__((ext_vector_type(2)));
__device__ __forceinline__ unsigned cvt_pk_bf16(float lo, float hi) { f32x2 v = {lo, hi}; bf16x2_t b = __builtin_convertvector(v, bf16x2_t); return __builtin_bit_cast(unsigned, b); }
__device__ __forceinline__ float wave_sum(float v) {
#pragma unroll
    for (int o = 1; o < 64; o <<= 1) v += __shfl_xor(v, o);
    return v;
}
__device__ __forceinline__ unsigned char* opq(unsigned char* q) { asm volatile("" : "+s"(q)); return q; }
__device__ __forceinline__ int opaque_tid() { int t = threadIdx.x; asm volatile("" : "+v"(t)); return t; }
#define DBGF(ws_, cond_, bit_) do { if (cond_) atomicOr((unsigned*)((ws_) + WS_BAR) + 32, (unsigned)(bit_)); } while (0)
__device__ __forceinline__ bool badf(float v) { return !(fabsf(v) < 1e30f); }
__device__ __forceinline__ float sigmoid_(float z) { return __builtin_amdgcn_rcpf(1.f + __expf(-z)); }
__device__ __forceinline__ float silu_(float z) { return z * sigmoid_(z); }
__device__ __forceinline__ float logsigmoid_(float z) { return fminf(z, 0.f) - __logf(1.f + __expf(-fabsf(z))); }
__device__ __forceinline__ void unpack8(bf16x8 v, float* f) {
#pragma unroll
    for (int e = 0; e < 8; ++e) f[e] = bf2f((unsigned)(unsigned short)v[e]);
}
__device__ __forceinline__ bf16x8 pack8(const float* f) {
    u32x4 w = {cvt_pk_bf16(f[0], f[1]), cvt_pk_bf16(f[2], f[3]), cvt_pk_bf16(f[4], f[5]), cvt_pk_bf16(f[6], f[7])};
    return __builtin_bit_cast(bf16x8, w);
}

namespace pg8 {
#define PG8_LAS __attribute__((address_space(3)))
constexpr int BM = 256, BK = 64, HALF = 128, HTB = HALF * BK * 2, STAGE_BYTES = 8 * HTB, NXCD = 8, WGM = 8;
__host__ __device__ __forceinline__ int lds_byte(int r, int c) { const int st = (r >> 4) * 2 + (c >> 5), rr = r & 15, cc = c & 31, ob = rr * 64 + cc * 2; return st * 1024 + (ob ^ (((ob >> 9) & 1) << 5)); }
__host__ __device__ __forceinline__ void stage_rc(int b, int& R, int& C) { const int st = b / 1024, sb = b % 1024, swz = sb ^ (((sb >> 9) & 1) << 5); R = (st >> 1) * 16 + swz / 64; C = (st & 1) * 32 + (swz % 64) / 2; }
__host__ __device__ __forceinline__ int perm32(int rho) { const int n = rho >> 4, i = rho & 15; return 8 * (i >> 2) + 4 * n + (i & 3); }
struct Unit { int pm, pn; };
struct Gemm { const bf16_t* A; const bf16_t* Bt; int M, N, K, lda, ldb; };
struct StaticOrder {
    int nM, nN, nwg, G, c;
    __host__ __device__ void init(int M_, int N_, int G_, int c_) { nM = M_ / BM; nN = N_ / BM; nwg = nM * nN; G = G_; c = c_; }
    __host__ __device__ bool next(int i, Unit& u) const {
        const long L = (long)i * G + c; if (L >= nwg) return false;
        int wgid = (int)L; { const int q = nwg / NXCD, r = nwg % NXCD, xcd = wgid % NXCD, off = wgid / NXCD; wgid = (xcd < r ? xcd * (q + 1) : r * (q + 1) + (xcd - r) * q) + off; }
        const int nig = WGM * nN, gid = wgid / nig, fm = gid * WGM, gsz = (nM - fm) < WGM ? (nM - fm) : WGM;
        u.pm = fm + ((wgid % nig) % gsz); u.pn = (wgid % nig) / gsz; return true;
    }
    __device__ __forceinline__ void a_ready(const Unit&) const {}
    __device__ __forceinline__ void done(const Unit&) const {}
};
template <class Epi, class Sched, bool ALIGN_EPI = false, bool SP2 = false>
__device__ __forceinline__ void gemm_phase(PG8_LAS unsigned char* lds, const Gemm g, const Sched& S, const Epi& E) {
    const int tid = opaque_tid(), wid = __builtin_amdgcn_readfirstlane(tid >> 6), lane = tid & 63, wr = wid >> 2, wc = wid & 3, fr = lane & 15, fq = lane >> 4;
    const int K = g.K, nt = K / BK;
    unsigned voffA[2], voffB[2];
#pragma unroll
    for (int i = 0; i < 2; ++i) { int R, C; stage_rc(tid * 16 + i * 8192, R, C); const int Rb = Epi::PERM ? ((R & ~31) + perm32(R & 31)) : R;
        voffA[i] = (unsigned)(R * g.lda + C) * 2u; voffB[i] = (unsigned)(Rb * g.ldb + C) * 2u; }
    const size_t kstep = (size_t)(BK * 2);
    const size_t hstepA = (size_t)HALF * g.lda * 2, hstepB = (size_t)HALF * g.ldb * 2;
    const size_t tstepA = 2 * hstepA, tstepB = 2 * hstepB;
    const unsigned ldsw = (unsigned)wid * 1024u;
    const int aoff = lds_byte(wr * 64 + fr, fq * 8), boff = lds_byte(wc * 32 + fr, fq * 8);
#define PG8_SA(b, h) (((b) * 2 + (h)) * HTB)
#define PG8_SB(b, h) ((4 + (b) * 2 + (h)) * HTB)
#define PG8_STAGE(bufoff, gbase, voff) do { _Pragma("unroll") for (int _i = 0; _i < 2; ++_i) \
        __builtin_amdgcn_global_load_lds((const unsigned*)((const char*)(gbase) + (voff)[_i]), (PG8_LAS unsigned*)(lds + (bufoff) + ldsw + _i * 8192), 16, 0, 0); } while (0)
#define PG8_LDA(dst, b, h) do { _Pragma("unroll") for (int m = 0; m < 4; ++m) _Pragma("unroll") for (int k = 0; k < 2; ++k) dst[m][k] = *(const PG8_LAS bf16x8*)(lds + PG8_SA(b, h) + aoff + m * 2048 + k * 1024); } while (0)
#define PG8_LDB(dst, b, h) do { _Pragma("unroll") for (int n = 0; n < 2; ++n) _Pragma("unroll") for (int k = 0; k < 2; ++k) dst[n][k] = *(const PG8_LAS bf16x8*)(lds + PG8_SB(b, h) + boff + n * 2048 + k * 1024); } while (0)
#define PG8_MMA(ai, bj, At, Bt) do { __builtin_amdgcn_s_setprio(1); _Pragma("unroll") for (int m = 0; m < 4; ++m) _Pragma("unroll") for (int n = 0; n < 2; ++n) _Pragma("unroll") for (int k = 0; k < 2; ++k) \
        acc[ai][bj][m][n] = __builtin_amdgcn_mfma_f32_16x16x32_bf16(Bt[n][k], At[m][k], acc[ai][bj][m][n], 0, 0, 0); __builtin_amdgcn_s_setprio(0); } while (0)
#define PG8_WAIT_V(n) asm volatile("s_waitcnt vmcnt(" #n ")" ::: "memory")
#define PG8_WAIT_L(n) asm volatile("s_waitcnt lgkmcnt(" #n ")" ::: "memory")
#define PG8_BAR __builtin_amdgcn_s_barrier()
#define PG8_SCHED __builtin_amdgcn_sched_barrier(0)
    Unit cur, nxt; int ui = 0;
    if (!S.next(0, cur)) return;
    f32x4 acc[2][2][4][2];
#pragma unroll
    for (int a = 0; a < 2; ++a)
#pragma unroll
        for (int b = 0; b < 2; ++b)
#pragma unroll
            for (int m = 0; m < 4; ++m)
#pragma unroll
                for (int n = 0; n < 2; ++n) acc[a][b][m][n] = (f32x4){0.f, 0.f, 0.f, 0.f};
    bf16x8 At[4][2], B0[2][2], B1[2][2];
    const char* cA = (const char*)g.A + (size_t)cur.pm * tstepA; const char* cB = (const char*)g.Bt + (size_t)cur.pn * tstepB;
    S.a_ready(cur);
    if constexpr (SP2) {
        PG8_STAGE(PG8_SB(0, 0), cB, voffB); PG8_STAGE(PG8_SB(0, 1), cB + hstepB, voffB); PG8_STAGE(PG8_SA(0, 0), cA, voffA); PG8_STAGE(PG8_SA(0, 1), cA + hstepA, voffA);
        if (wr == 1) PG8_BAR;
        PG8_WAIT_V(2); PG8_BAR;
        PG8_STAGE(PG8_SB(1, 0), cB + kstep, voffB); PG8_STAGE(PG8_SA(1, 0), cA + kstep, voffA); PG8_STAGE(PG8_SB(1, 1), cB + hstepB + kstep, voffB);
        PG8_WAIT_V(6); PG8_BAR;
    } else {
        PG8_STAGE(PG8_SB(0, 0), cB, voffB); PG8_STAGE(PG8_SA(0, 0), cA, voffA); PG8_STAGE(PG8_SB(0, 1), cB + hstepB, voffB); PG8_STAGE(PG8_SA(0, 1), cA + hstepA, voffA);
        if (wr == 1) PG8_BAR;
        PG8_WAIT_V(4); PG8_BAR;
        PG8_STAGE(PG8_SB(1, 0), cB + kstep, voffB); PG8_STAGE(PG8_SA(1, 0), cA + kstep, voffA); PG8_STAGE(PG8_SB(1, 1), cB + hstepB + kstep, voffB);
        PG8_WAIT_V(6); PG8_BAR;
    }
    for (;;) {
        const bool has_next = S.next(ui + 1, nxt);
        const char* nA = has_next ? (const char*)g.A + (size_t)nxt.pm * tstepA : cA; const char* nB = has_next ? (const char*)g.Bt + (size_t)nxt.pn * tstepB : cB;
        for (int t = 0; t < nt; t += 2) {
            const bool last = (t == nt - 2);
            const char* a1 = cA + (size_t)(t + 1) * kstep;
            const char* a2 = last ? nA : cA + (size_t)(t + 2) * kstep; const char* b2 = last ? nB : cB + (size_t)(t + 2) * kstep;
            const char* a3 = a2 + kstep; const char* b3 = b2 + kstep;
            if (last && has_next) S.a_ready(nxt);
            if constexpr (SP2) {
            PG8_LDB(B0, 0, 0); PG8_LDB(B1, 0, 1); PG8_SCHED; PG8_LDA(At, 0, 0); PG8_STAGE(PG8_SA(1, 1), a1 + hstepA, voffA);
            PG8_WAIT_V(8); PG8_WAIT_L(0); PG8_BAR; PG8_MMA(0, 0, At, B0); PG8_MMA(0, 1, At, B1); PG8_BAR; PG8_SCHED;
            PG8_LDA(At, 0, 1); PG8_STAGE(PG8_SB(0, 0), b2, voffB); PG8_STAGE(PG8_SB(0, 1), b2 + hstepB, voffB); PG8_STAGE(PG8_SA(0, 0), a2, voffA);
            PG8_WAIT_V(8); PG8_WAIT_L(0); PG8_BAR; PG8_MMA(1, 0, At, B0); PG8_MMA(1, 1, At, B1); PG8_BAR; PG8_SCHED;
            PG8_LDB(B0, 1, 0); PG8_LDB(B1, 1, 1); PG8_SCHED; PG8_LDA(At, 1, 0); PG8_STAGE(PG8_SA(0, 1), a2 + hstepA, voffA);
            PG8_WAIT_V(8); PG8_WAIT_L(0); PG8_BAR; PG8_MMA(0, 0, At, B0); PG8_MMA(0, 1, At, B1); PG8_BAR; PG8_SCHED;
            PG8_LDA(At, 1, 1); PG8_STAGE(PG8_SB(1, 0), b3, voffB); PG8_STAGE(PG8_SB(1, 1), b3 + hstepB, voffB); PG8_STAGE(PG8_SA(1, 0), a3, voffA);
            PG8_WAIT_V(8); PG8_WAIT_L(0); PG8_BAR; PG8_MMA(1, 0, At, B0); PG8_MMA(1, 1, At, B1); PG8_BAR; PG8_SCHED;
            } else {
            PG8_LDB(B0, 0, 0); PG8_SCHED; PG8_LDA(At, 0, 0); PG8_STAGE(PG8_SA(1, 1), a1 + hstepA, voffA);
            PG8_WAIT_L(8); PG8_BAR; PG8_WAIT_L(0); PG8_MMA(0, 0, At, B0); PG8_BAR; PG8_SCHED;
            PG8_LDB(B1, 0, 1); PG8_STAGE(PG8_SB(0, 0), b2, voffB);
            PG8_BAR; PG8_WAIT_L(0); PG8_MMA(0, 1, At, B1); PG8_BAR;
            PG8_LDA(At, 0, 1); PG8_STAGE(PG8_SA(0, 0), a2, voffA);
            PG8_BAR; PG8_WAIT_L(0); PG8_MMA(1, 0, At, B0); PG8_BAR; PG8_SCHED;
            PG8_STAGE(PG8_SB(0, 1), b2 + hstepB, voffB);
            PG8_WAIT_V(6); PG8_BAR; PG8_MMA(1, 1, At, B1); PG8_BAR;
            PG8_LDB(B0, 1, 0); PG8_SCHED; PG8_LDA(At, 1, 0); PG8_STAGE(PG8_SA(0, 1), a2 + hstepA, voffA);
            PG8_WAIT_L(8); PG8_BAR; PG8_WAIT_L(0); PG8_MMA(0, 0, At, B0); PG8_BAR; PG8_SCHED;
            PG8_LDB(B1, 1, 1); PG8_STAGE(PG8_SB(1, 0), b3, voffB);
            PG8_BAR; PG8_WAIT_L(0); PG8_MMA(0, 1, At, B1); PG8_BAR;
            PG8_LDA(At, 1, 1); PG8_STAGE(PG8_SA(1, 0), a3, voffA);
            PG8_BAR; PG8_WAIT_L(0); PG8_MMA(1, 0, At, B0); PG8_BAR; PG8_SCHED;
            PG8_STAGE(PG8_SB(1, 1), b3 + hstepB, voffB);
            PG8_WAIT_V(6); PG8_BAR; PG8_MMA(1, 1, At, B1); PG8_BAR;
            }
        }
        if constexpr (ALIGN_EPI) { if (wr == 0) PG8_BAR; }
        if constexpr (!Epi::AFTER_DRAIN) { E(acc, cur, wr, wc, fr, fq); S.done(cur); }
        if (!has_next) break;
#pragma unroll
        for (int a = 0; a < 2; ++a)
#pragma unroll
            for (int b = 0; b < 2; ++b)
#pragma unroll
                for (int m = 0; m < 4; ++m)
#pragma unroll
                    for (int n = 0; n < 2; ++n) acc[a][b][m][n] = (f32x4){0.f, 0.f, 0.f, 0.f};
        cur = nxt; cA = nA; cB = nB; ++ui;
        if constexpr (ALIGN_EPI) { if (wr == 1) PG8_BAR; }
    }
    PG8_WAIT_V(0);
    if constexpr (!ALIGN_EPI) { if (wr == 0) PG8_BAR; }
    PG8_BAR;
    if constexpr (Epi::AFTER_DRAIN) { E.fused(acc, cur, wr, wc, fr, fq, lds, wid, lane); S.done(cur); }
#undef PG8_SA
#undef PG8_SB
#undef PG8_STAGE
#undef PG8_LDA
#undef PG8_LDB
#undef PG8_MMA
#undef PG8_WAIT_V
#undef PG8_WAIT_L
#undef PG8_BAR
#undef PG8_SCHED
}
struct EpiU {
    static constexpr bool PERM = true, AFTER_DRAIN = false;
    bf16_t* O; int ldc; const float* rsq;
    __device__ __forceinline__ void operator()(const f32x4 (&acc)[2][2][4][2], const Unit& u, int wr, int wc, int fr, int fq) const {
        const int row0 = u.pm * BM + wr * 64 + fr, col0 = u.pn * BM + wc * 32 + 8 * fq;
#pragma unroll
        for (int ai = 0; ai < 2; ++ai)
#pragma unroll
            for (int m = 0; m < 4; ++m) { bf16_t* rowp = O + (size_t)(row0 + ai * HALF + m * 16) * ldc + col0;
                const float rs = rsqrtf(rsq[row0 + ai * HALF + m * 16] * (1.f / DM) + EPS);
#pragma unroll
                for (int bj = 0; bj < 2; ++bj) { const f32x4 v0 = acc[ai][bj][m][0] * rs, v1 = acc[ai][bj][m][1] * rs;
                    u32x4 w; w.x = cvt_pk_bf16(v0[0], v0[1]); w.y = cvt_pk_bf16(v0[2], v0[3]); w.z = cvt_pk_bf16(v1[0], v1[1]); w.w = cvt_pk_bf16(v1[2], v1[3]);
                    *(u32x4*)(rowp + bj * HALF) = w; } }
    }
};
struct EpiQ {
    static constexpr bool PERM = true, AFTER_DRAIN = false;
    bf16_t* Q; const float* cs; const float* sn;
    __device__ __forceinline__ void operator()(const f32x4 (&acc)[2][2][4][2], const Unit& u, int wr, int wc, int fr, int fq) const {
        const int row0 = u.pm * BM + wr * 64 + fr;
#pragma unroll
        for (int ai = 0; ai < 2; ++ai)
#pragma unroll
            for (int m = 0; m < 4; ++m) { const int row = row0 + ai * HALF + m * 16, b = row / T, t = row % T;
#pragma unroll
                for (int bj = 0; bj < 2; ++bj) { const int c = u.pn * BM + bj * HALF + wc * 32 + 8 * fq, hh = c / 192, e = c % 192;
                    const f32x4 v0 = acc[ai][bj][m][0], v1 = acc[ai][bj][m][1];
                    float vals[8] = {v0[0], v0[1], v0[2], v0[3], v1[0], v1[1], v1[2], v1[3]};
                    if (e >= 128) { const int i0 = (e - 128) >> 1; const f32x4 cc = *(const f32x4*)(cs + (size_t)row * 32 + i0), ss = *(const f32x4*)(sn + (size_t)row * 32 + i0);
#pragma unroll
                        for (int p = 0; p < 4; ++p) { const float x1 = vals[2 * p], x2 = vals[2 * p + 1]; vals[2 * p] = x1 * cc[p] - x2 * ss[p]; vals[2 * p + 1] = x2 * cc[p] + x1 * ss[p]; } }
                    u32x4 w; w.x = cvt_pk_bf16(vals[0], vals[1]); w.y = cvt_pk_bf16(vals[2], vals[3]); w.z = cvt_pk_bf16(vals[4], vals[5]); w.w = cvt_pk_bf16(vals[6], vals[7]);
                    *(u32x4*)(Q + ((size_t)(b * 8 + hh) * T + t) * 192 + e) = w; } }
    }
};
struct EpiKV {
    static constexpr bool PERM = true, AFTER_DRAIN = false;
    bf16_t* KN; bf16_t* V;
    __device__ __forceinline__ void operator()(const f32x4 (&acc)[2][2][4][2], const Unit& u, int wr, int wc, int fr, int fq) const {
        const int row0 = u.pm * BM + wr * 64 + fr, e = wc * 32 + 8 * fq;
#pragma unroll
        for (int ai = 0; ai < 2; ++ai)
#pragma unroll
            for (int m = 0; m < 4; ++m) { const int row = row0 + ai * HALF + m * 16, b = row / T, t = row % T;
                const size_t off = ((size_t)(b * 8 + u.pn) * T + t) * 128 + e;
#pragma unroll
                for (int bj = 0; bj < 2; ++bj) { const f32x4 v0 = acc[ai][bj][m][0], v1 = acc[ai][bj][m][1];
                    u32x4 w; w.x = cvt_pk_bf16(v0[0], v0[1]); w.y = cvt_pk_bf16(v0[2], v0[3]); w.z = cvt_pk_bf16(v1[0], v1[1]); w.w = cvt_pk_bf16(v1[2], v1[3]);
                    *(u32x4*)((bj ? V : KN) + off) = w; } }
    }
};
struct EpiSwi {
    static constexpr bool PERM = false, AFTER_DRAIN = false;
    bf16_t* H; const float* rsq;
    __device__ __forceinline__ void operator()(const f32x4 (&acc)[2][2][4][2], const Unit& u, int wr, int wc, int fr, int fq) const {
        const int row0 = u.pm * BM + wr * 64 + fr;
#pragma unroll
        for (int ai = 0; ai < 2; ++ai)
#pragma unroll
            for (int m = 0; m < 4; ++m) { bf16_t* rowp = H + (size_t)(row0 + ai * HALF + m * 16) * DFF;
                const float rs = rsqrtf(rsq[row0 + ai * HALF + m * 16] * (1.f / DM) + EPS);
#pragma unroll
                for (int bj = 0; bj < 2; ++bj) { const f32x4 a = acc[ai][bj][m][0] * rs, g = acc[ai][bj][m][1] * rs;
                    const int col = 16 * (8 * u.pn + 4 * bj + wc) + 4 * fq;
                    u32x2 w; w.x = cvt_pk_bf16(silu_(a[0]) * g[0], silu_(a[1]) * g[1]); w.y = cvt_pk_bf16(silu_(a[2]) * g[2], silu_(a[3]) * g[3]);
                    *(u32x2*)(rowp + col) = w; } }
    }
};
struct EpiRes {
    static constexpr bool PERM = false, AFTER_DRAIN = false;
    const float* base; float* out; bf16_t* hb; float* rsq;
    __device__ __forceinline__ void operator()(const f32x4 (&acc)[2][2][4][2], const Unit& u, int wr, int wc, int fr, int fq) const {
        const int row0 = u.pm * BM + wr * 64 + fr, col0 = u.pn * BM + wc * 32 + 4 * fq;
#pragma unroll
        for (int ai = 0; ai < 2; ++ai)
#pragma unroll
            for (int m = 0; m < 4; ++m) { const size_t off = (size_t)(row0 + ai * HALF + m * 16) * DM + col0; float ss = 0.f;
#pragma unroll
                for (int bj = 0; bj < 2; ++bj)
#pragma unroll
                    for (int n = 0; n < 2; ++n) { const f32x4 bs = *(const f32x4*)(base + off + bj * HALF + n * 16); const f32x4 o = bs + acc[ai][bj][m][n];
                        *(f32x4*)(out + off + bj * HALF + n * 16) = o;
                        u32x2 w; w.x = cvt_pk_bf16(o[0], o[1]); w.y = cvt_pk_bf16(o[2], o[3]); *(u32x2*)(hb + off + bj * HALF + n * 16) = w;
                        ss += (o[0] * o[0] + o[1] * o[1]) + (o[2] * o[2] + o[3] * o[3]); }
                ss += __shfl_xor(ss, 16); ss += __shfl_xor(ss, 32);
                if (fq == 0) unsafeAtomicAdd(rsq + row0 + ai * HALF + m * 16, ss); }
    }
};

}
namespace att {
constexpr int KVBLK = 64;
constexpr float SCALE = 0.07216878364870322f;
constexpr float THR = 8.f;
constexpr int SHM_V = KVBLK * 128 * 2, SHM_K = KVBLK * 192 * 2;
#ifndef ATT_SDEPTH
#define ATT_SDEPTH 1
#endif
constexpr int SDEPTH = ATT_SDEPTH;
#define KSWZ(row, colB) ((row) * 384 + ((colB) ^ (((row) & 7) << 4)))
#define SBAR() __builtin_amdgcn_sched_barrier(0)
__device__ __forceinline__ int crow(int r, int hi) { return (r & 3) + 8 * (r >> 2) + 4 * hi; }
__device__ __forceinline__ unsigned cvtpk(float lo, float hi) { return cvt_pk_bf16(lo, hi); }
__device__ __forceinline__ void partialSM(f32x16& p0, f32x16& p1, float& m_reg, float& mn, float& alpha) {
  constexpr float C = SCALE * 1.4426950408889634f;
  float pmax = p0[0];
#pragma unroll
  for (int r = 1; r < 16; ++r) pmax = fmaxf(pmax, p0[r]);
#pragma unroll
  for (int r = 0; r < 16; ++r) pmax = fmaxf(pmax, p1[r]);
  { auto rr = __builtin_amdgcn_permlane32_swap(__float_as_uint(pmax), __float_as_uint(pmax), false, false);
    pmax = fmaxf(__uint_as_float(rr[0]), __uint_as_float(rr[1])); }
  if (__builtin_expect(__all(pmax - m_reg <= THR / SCALE), 1)) { mn = m_reg; alpha = 1.f; }
  else { mn = fmaxf(m_reg, pmax); alpha = __builtin_amdgcn_exp2f((m_reg - mn) * C); m_reg = mn; }
  float mnC = -mn * C;
#pragma unroll
  for (int r = 0; r < 16; ++r) p0[r] = fmaf(p0[r], C, mnC);
#pragma unroll
  for (int r = 0; r < 16; ++r) p1[r] = fmaf(p1[r], C, mnC);
#pragma unroll
  for (int r = 0; r < 16; ++r) p0[r] = __builtin_amdgcn_exp2f(p0[r]);
}
__device__ __forceinline__ void finishSM(f32x16& p0, f32x16& p1, float alpha, float& l_reg, bf16x8& pa0, bf16x8& pa1, bf16x8& pa2, bf16x8& pa3) {
#pragma unroll
  for (int r = 0; r < 16; ++r) p1[r] = __builtin_amdgcn_exp2f(p1[r]);
  float ps = 0;
#pragma unroll
  for (int r = 0; r < 16; ++r) ps += p0[r];
#pragma unroll
  for (int r = 0; r < 16; ++r) ps += p1[r];
  { auto rr = __builtin_amdgcn_permlane32_swap(__float_as_uint(ps), __float_as_uint(ps), false, false);
    ps = __uint_as_float(rr[0]) + __uint_as_float(rr[1]); }
  l_reg = l_reg * alpha + ps;
#define PK4(P, BASE, OUT) do { unsigned a0 = cvtpk(P[BASE + 0], P[BASE + 1]), a1 = cvtpk(P[BASE + 2], P[BASE + 3]);   \
    unsigned b0 = cvtpk(P[BASE + 4], P[BASE + 5]), b1 = cvtpk(P[BASE + 6], P[BASE + 7]);                              \
    auto r0 = __builtin_amdgcn_permlane32_swap(a0, b0, false, false); auto r1 = __builtin_amdgcn_permlane32_swap(a1, b1, false, false); \
    u32x4 w = {r0[0], r1[0], r0[1], r1[1]}; OUT = __builtin_bit_cast(bf16x8, w); } while (0)
  PK4(p0, 0, pa0); PK4(p0, 8, pa1); PK4(p1, 0, pa2); PK4(p1, 8, pa3);
#undef PK4
}
__device__ __forceinline__ void qkt(f32x16& p0, f32x16& p1, const char* Ks, const bf16x8* qr, const char* qL, int r32, int hi) {
  p0 = f32x16{}; p1 = f32x16{};
#pragma unroll
  for (int d0 = 0; d0 < 12; ++d0) { int cb = (d0 * 16 + hi * 8) * 2;
    bf16x8 b0 = *reinterpret_cast<const bf16x8*>(Ks + KSWZ(r32, cb));
    bf16x8 b1 = *reinterpret_cast<const bf16x8*>(Ks + KSWZ(32 + r32, cb));
    const bf16x8 q = d0 < 8 ? qr[d0 < 8 ? d0 : 0] : *reinterpret_cast<const bf16x8*>(qL + (d0 - 8) * 1024);
    p0 = __builtin_amdgcn_mfma_f32_32x32x16_bf16(b0, q, p0, 0, 0, 0);
    p1 = __builtin_amdgcn_mfma_f32_32x32x16_bf16(b1, q, p1, 0, 0, 0); }
}
__device__ __forceinline__ int v_st(int k, int c) { const int kk = (k & ~0xC) | ((k & 4) << 1) | ((k & 8) >> 1); return ((kk >> 3) * 4 + (c >> 5)) * 512 + ((kk & 7) * 32 + (c & 31)) * 2; }
__device__ __forceinline__ int v_rd_base(int lane) { return ((lane & 3) << 3) | (((lane >> 2) & 3) << 6) | (((lane >> 4) & 1) << 5) | (((lane >> 5) & 1) << 8); }
constexpr int v_rd_off(int d0, int ks, int half) { return d0 * 512 + ks * 4096 + half * 2048; }
template <int OFF> __device__ __forceinline__ s16x4 tr_read(int vb) {
  s16x4 r; asm volatile("ds_read_b64_tr_b16 %0, %1 offset:%2" : "=&v"(r) : "v"(vb), "i"(OFF) : "memory"); return r;
}
template <int D0> __device__ __forceinline__ void pv_one(f32x16& od, int vb, bf16x8 pa0, bf16x8 pa1, bf16x8 pa2, bf16x8 pa3) {
  const s16x4 l0 = tr_read<v_rd_off(D0, 0, 0)>(vb), h0 = tr_read<v_rd_off(D0, 0, 1)>(vb), l1 = tr_read<v_rd_off(D0, 1, 0)>(vb), h1 = tr_read<v_rd_off(D0, 1, 1)>(vb);
  const s16x4 l2 = tr_read<v_rd_off(D0, 2, 0)>(vb), h2 = tr_read<v_rd_off(D0, 2, 1)>(vb), l3 = tr_read<v_rd_off(D0, 3, 0)>(vb), h3 = tr_read<v_rd_off(D0, 3, 1)>(vb);
  asm volatile("s_waitcnt lgkmcnt(0)" ::: "memory"); SBAR();
#define PK(L, H) (bf16x8){L[0], L[1], L[2], L[3], H[0], H[1], H[2], H[3]}
  od = __builtin_amdgcn_mfma_f32_32x32x16_bf16(pa0, PK(l0, h0), od, 0, 0, 0);
  od = __builtin_amdgcn_mfma_f32_32x32x16_bf16(pa1, PK(l1, h1), od, 0, 0, 0);
  od = __builtin_amdgcn_mfma_f32_32x32x16_bf16(pa2, PK(l2, h2), od, 0, 0, 0);
  od = __builtin_amdgcn_mfma_f32_32x32x16_bf16(pa3, PK(l3, h3), od, 0, 0, 0);
#undef PK
}
__device__ __forceinline__ void pv_d0(f32x16* o, int vb, bf16x8 pa0, bf16x8 pa1, bf16x8 pa2, bf16x8 pa3) {
  pv_one<0>(o[0], vb, pa0, pa1, pa2, pa3); pv_one<1>(o[1], vb, pa0, pa1, pa2, pa3); pv_one<2>(o[2], vb, pa0, pa1, pa2, pa3); pv_one<3>(o[3], vb, pa0, pa1, pa2, pa3);
}
__device__ __forceinline__ void attn_unit(const bf16_t* __restrict__ Qb, const bf16_t* __restrict__ Kn, const bf16_t* __restrict__ Kr, const bf16_t* __restrict__ Vh,
                                          bf16_t* __restrict__ Ob, char* lds) {
  const int tid = opaque_tid(), wid = tid >> 6, lane = tid & 63, r32 = lane & 31, hi = lane >> 5;
  char* V_lds = lds; char* K_lds = lds + 2 * SHM_V;
  float* ws = (float*)(lds + 2 * SHM_V + 2 * SHM_K) + wid * 64; float* li_l = ws; float* al_l = ws + 32;
  float m_reg = -1e30f, l_reg = 0; f32x16 o[4] = {}; bf16x8 qr[8];
  char* qL = lds + 2 * SHM_V + 2 * SHM_K + 2048 + wid * 4096 + lane * 16;
  const bf16_t* Qw = Qb + (long)(wid * 32 + r32) * 192 + hi * 8;
#pragma unroll
  for (int d0 = 0; d0 < 8; ++d0) qr[d0] = *reinterpret_cast<const bf16x8*>(Qw + d0 * 16);
#pragma unroll
  for (int d0 = 8; d0 < 12; ++d0) *reinterpret_cast<bf16x8*>(qL + (d0 - 8) * 1024) = *reinterpret_cast<const bf16x8*>(Qw + d0 * 16);
  const int sr = tid >> 4, sc = (tid & 15) * 8, vst0 = v_st(sr, sc), vst1 = v_st(32 + sr, sc);
  const int rr = tid >> 3, rc = (tid & 7) * 8;
  const int kst0 = KSWZ(sr, sc * 2), kst1 = KSWZ(32 + sr, sc * 2), kst2 = KSWZ(rr, 256 + rc * 2);
  const int vb0 = (int)(uintptr_t)V_lds + v_rd_base(lane);
  struct { bf16x8 vs0, vs1, ks0, ks1, ks2; } sr_[SDEPTH];
#define SLOAD(i, k0) do { sr_[i].vs0 = *(const bf16x8*)(&Vh[(long)((k0) + sr) * 128 + sc]); sr_[i].vs1 = *(const bf16x8*)(&Vh[(long)((k0) + 32 + sr) * 128 + sc]); \
    sr_[i].ks0 = *(const bf16x8*)(&Kn[(long)((k0) + sr) * 128 + sc]); sr_[i].ks1 = *(const bf16x8*)(&Kn[(long)((k0) + 32 + sr) * 128 + sc]); \
    sr_[i].ks2 = *(const bf16x8*)(&Kr[(long)((k0) + rr) * 64 + rc]); } while (0)
#define SWRITE(b, i) do { *(bf16x8*)(V_lds + (b) * SHM_V + vst0) = sr_[i].vs0; *(bf16x8*)(V_lds + (b) * SHM_V + vst1) = sr_[i].vs1; \
    *(bf16x8*)(K_lds + (b) * SHM_K + kst0) = sr_[i].ks0; *(bf16x8*)(K_lds + (b) * SHM_K + kst1) = sr_[i].ks1; *(bf16x8*)(K_lds + (b) * SHM_K + kst2) = sr_[i].ks2; } while (0)
#define SWAIT() do { if constexpr (SDEPTH == 2) asm volatile("s_waitcnt vmcnt(5)" ::: "memory"); else asm volatile("s_waitcnt vmcnt(0)" ::: "memory"); } while (0)
#define RESC(a) do { if (__any((a) < 1.f)) { if (hi == 0) al_l[r32] = (a); asm volatile("s_waitcnt lgkmcnt(0)" ::: "memory"); \
    _Pragma("unroll") for (int d = 0; d < 4; ++d) _Pragma("unroll") for (int r = 0; r < 16; ++r) o[d][r] *= al_l[crow(r, hi)]; } } while (0)
  f32x16 pA0, pA1, pB0, pB1; float mnA, mnB, alA, alB; bf16x8 pa0, pa1, pa2, pa3; const int NT = T / KVBLK;
  constexpr int SE = 0, SO = SDEPTH - 1;
  SLOAD(SE, 0); asm volatile("s_waitcnt vmcnt(0)" ::: "memory"); SWRITE(0, SE); __syncthreads();
  qkt(pA0, pA1, K_lds, qr, qL, r32, hi); partialSM(pA0, pA1, m_reg, mnA, alA);
  SLOAD(SO, KVBLK); if constexpr (SDEPTH == 2) { if (2 < NT) SLOAD(SE, 2 * KVBLK); }
  SWAIT(); SWRITE(1, SO); __syncthreads();
  for (int j = 1; j + 1 < NT; j += 2) {
    SBAR(); qkt(pB0, pB1, K_lds + SHM_K, qr, qL, r32, hi);
    finishSM(pA0, pA1, alA, l_reg, pa0, pa1, pa2, pa3); SBAR();
    SLOAD(SO, (j + SDEPTH) * KVBLK); SBAR();
    pv_d0(o, vb0, pa0, pa1, pa2, pa3); partialSM(pB0, pB1, m_reg, mnB, alB);
    __syncthreads(); SWAIT(); SWRITE(0, SE);
    RESC(alB); __syncthreads();
    SBAR(); qkt(pA0, pA1, K_lds, qr, qL, r32, hi);
    finishSM(pB0, pB1, alB, l_reg, pa0, pa1, pa2, pa3); SBAR();
    if (SDEPTH == 1 || j + 3 < NT) SLOAD(SE, (j + 1 + SDEPTH) * KVBLK); SBAR();
    pv_d0(o, vb0 + (int)SHM_V, pa0, pa1, pa2, pa3); partialSM(pA0, pA1, m_reg, mnA, alA);
    __syncthreads(); SWAIT(); SWRITE(1, SO);
    RESC(alA); __syncthreads();
  }
  SBAR(); qkt(pB0, pB1, K_lds + SHM_K, qr, qL, r32, hi);
  finishSM(pA0, pA1, alA, l_reg, pa0, pa1, pa2, pa3); SBAR();
  pv_d0(o, vb0, pa0, pa1, pa2, pa3); partialSM(pB0, pB1, m_reg, mnB, alB);
  __syncthreads(); RESC(alB);
  finishSM(pB0, pB1, alB, l_reg, pa0, pa1, pa2, pa3); SBAR();
  pv_d0(o, vb0 + (int)SHM_V, pa0, pa1, pa2, pa3);
  if (hi == 0) li_l[r32] = l_reg; asm volatile("s_waitcnt lgkmcnt(0)" ::: "memory");
  float rli[16];
#pragma unroll
  for (int r = 0; r < 16; ++r) rli[r] = __builtin_amdgcn_rcpf(li_l[crow(r, hi)]);
  bf16_t* Ow = Ob + (long)(wid * 32) * DM;
#pragma unroll
  for (int r = 0; r < 16; ++r) { int orow = crow(r, hi);
#pragma unroll
    for (int d0 = 0; d0 < 4; ++d0) Ow[(long)orow * DM + d0 * 32 + r32] = (bf16_t)f2bf(o[d0][r] * rli[r]); }
#undef SLOAD
#undef SWRITE
#undef SWAIT
#undef RESC
  __syncthreads();
}
}
namespace scan {
constexpr int LDT = 72;
constexpr int SC_G = 0, SC_K = 33792, SC_QT = SC_K + 17408, SC_QG = SC_QT + 17408, SC_VT = SC_QG + 17408, SC_P = SC_VT + 18432, SC_SEG = SC_P + 9216, SC_RSQ = SC_SEG + 4096,
              SC_END = SC_RSQ + 2048, SC_KDT = SC_QT;
static_assert(SC_END <= LDS_BYTES, "scan LDS");

template <int TYPE> struct Cfg { static constexpr int DK = TYPE ? 128 : 64, LDG = DK + 4, LDK_ = DK + 8, ND8 = DK / 8; };

struct LgRaw { bf16x8 a0, a1, k; };
template <int TYPE>
__device__ __forceinline__ LgRaw lg_issue(const bf16_t* u, int h, int dir, size_t tok0, int tid) {
    LgRaw r;
    if constexpr (TYPE == 1) {
        const int i0 = tid >> 4, d8 = tid & 15, col = (dir ? C_HFB : C_HFF) + h * 128 + d8 * 8;
        r.a0 = *(const bf16x8*)(u + (tok0 + i0) * DINP + col); r.a1 = *(const bf16x8*)(u + (tok0 + 32 + i0) * DINP + col); r.k = r.a0;
    } else {
        const int i = tid >> 3, d8 = tid & 7; const bf16_t* ur = u + (tok0 + i) * DINP;
        r.a0 = *(const bf16x8*)(ur + (dir ? C_GAB : C_GAF)); r.a1 = *(const bf16x8*)(ur + (dir ? C_GAB : C_GAF) + 8); r.k = *(const bf16x8*)(ur + C_GK + h * 64 + d8 * 8);
    }
    return r;
}
template <int TYPE>
__device__ __forceinline__ void lg_compute(const KArgs& a, unsigned char* wsb, int l, int h, int dir, const LgRaw& raw, LAS unsigned char* lds, int tid) {
    using C = Cfg<TYPE>;
    LAS float* G = (LAS float*)(lds + SC_G); LAS bf16_t* Kb = (LAS bf16_t*)(lds + SC_K);
    if constexpr (TYPE == 1) {
        const float* lbp = (const float*)(wsb + WS_LB) + (dir * DEPTH + l) * 512 + h * 128;
        const int d8 = tid & 15;
        const f32x4 lb0 = *(const f32x4*)(lbp + d8 * 8), lb1 = *(const f32x4*)(lbp + d8 * 8 + 4);
        const float lb[8] = {lb0[0], lb0[1], lb0[2], lb0[3], lb1[0], lb1[1], lb1[2], lb1[3]};
#pragma unroll
        for (int e2 = 0; e2 < 2; ++e2) { const int i = (tid >> 4) + 32 * e2;
            float z[8], lg[8], kk[8]; unpack8(e2 ? raw.a1 : raw.a0, z);
#pragma unroll
            for (int e = 0; e < 8; ++e) { const float sg = sigmoid_(fmaxf(z[e], -80.f)); lg[e] = __logf(lb[e] + (1.f - lb[e]) * sg); kk[e] = (1.f - lb[e]) * (1.f - sg); }
            *(LAS f32x4*)(G + i * C::LDG + d8 * 8) = (f32x4){lg[0], lg[1], lg[2], lg[3]}; *(LAS f32x4*)(G + i * C::LDG + d8 * 8 + 4) = (f32x4){lg[4], lg[5], lg[6], lg[7]};
            *(LAS bf16x8*)(Kb + i * C::LDK_ + d8 * 8) = pack8(kk); }
    } else {
        const int i = tid >> 3, d8 = tid & 7;
        float ua[16]; unpack8(raw.a0, ua); unpack8(raw.a1, ua + 8);
        const float* up = (const float*)a.in[3] + (size_t)((l * 2 + dir) * 16) * 256 + h * 64 + d8 * 8;
        const float* bs = (const float*)a.in[4] + (l * 2 + dir) * 256 + h * 64 + d8 * 8;
        f32x4 z0 = *(const f32x4*)bs, z1 = *(const f32x4*)(bs + 4);
#pragma unroll
        for (int r = 0; r < 16; ++r) { z0 += ua[r] * *(const f32x4*)(up + r * 256); z1 += ua[r] * *(const f32x4*)(up + r * 256 + 4); }
        f32x4 g0, g1;
#pragma unroll
        for (int e = 0; e < 4; ++e) { g0[e] = logsigmoid_(z0[e]) * (1.f / 16.f); g1[e] = logsigmoid_(z1[e]) * (1.f / 16.f); }
        *(LAS f32x4*)(G + i * C::LDG + d8 * 8) = g0; *(LAS f32x4*)(G + i * C::LDG + d8 * 8 + 4) = g1;
        *(LAS bf16x8*)(Kb + i * C::LDK_ + d8 * 8) = raw.k;
    }
}
template <int TYPE>
__device__ __forceinline__ void cumsum_g(int dir, LAS unsigned char* lds, int tid) {
    using C = Cfg<TYPE>; constexpr int NSEG = 512 / C::DK, SEGL = 64 / NSEG;
    LAS float* G = (LAS float*)(lds + SC_G); LAS float* SG = (LAS float*)(lds + SC_SEG);
    const int d = tid % C::DK, seg = tid / C::DK;
    __syncthreads();
    float run = 0.f;
#pragma unroll
    for (int ii = 0; ii < SEGL; ++ii) { const int i = seg * SEGL + (dir ? SEGL - 1 - ii : ii); run += G[i * C::LDG + d]; G[i * C::LDG + d] = run; }
    SG[seg * 128 + d] = run;
    __syncthreads();
    float off = 0.f;
#pragma unroll
    for (int s = 0; s < NSEG; ++s) { const bool before = dir ? (s > seg) : (s < seg); if (before) off += SG[s * 128 + d]; }
#pragma unroll
    for (int ii = 0; ii < SEGL; ++ii) { const int i = seg * SEGL + ii; G[i * C::LDG + d] += off; }
    __syncthreads();
}
struct VRaw { bf16x8 x0, x1; };
__device__ __forceinline__ VRaw vT_issue(const bf16_t* vsrc, int tid) {
    const int i0 = tid >> 4, v8 = tid & 15; VRaw r;
    r.x0 = *(const bf16x8*)(vsrc + (size_t)i0 * DINP + v8 * 8); r.x1 = *(const bf16x8*)(vsrc + (size_t)(32 + i0) * DINP + v8 * 8); return r;
}
__device__ __forceinline__ void vT_write(const VRaw& r, LAS unsigned char* lds, int tid) {
    LAS bf16_t* VT = (LAS bf16_t*)(lds + SC_VT);
    const int v8 = tid & 15;
#pragma unroll
    for (int e2 = 0; e2 < 2; ++e2) { const int i = (tid >> 4) + 32 * e2; const bf16x8 x = e2 ? r.x1 : r.x0; const int pc = ((((i >> 3) ^ (v8 & 7)) << 3) | (i & 7));
#pragma unroll
        for (int e = 0; e < 8; ++e) VT[(v8 * 8 + e) * LDT + pc] = (bf16_t)x[e]; }
}
__device__ __forceinline__ bf16x8 vt_frag(LAS bf16_t* VT, int v, int c8) {
    return *(LAS bf16x8*)(VT + v * LDT + ((c8 ^ ((v >> 3) & 7)) << 3));
}

template <int TYPE>
__device__ __forceinline__ void pass1_item(const KArgs& a, int l, int item, LAS unsigned char* lds) {
    unsigned char* const wsb = opq(a.ws);
    const int tid = opaque_tid();
    using C = Cfg<TYPE>; constexpr int DK = C::DK;
    const int c = item & (NCH - 1), dir = (item >> 8) & 1, h = (item >> 9) & 3, b = item >> 11;
    const size_t tok0 = (size_t)b * T + (size_t)c * 64;
    const bf16_t* u = (const bf16_t*)(wsb + WS_U);
    const int wid = tid >> 6, lane = tid & 63, fr = lane & 15, fq = lane >> 4;
    __syncthreads();
    { const LgRaw raw = lg_issue<TYPE>(u, h, dir, tok0, tid); const VRaw vr = vT_issue(u + tok0 * DINP + (TYPE ? C_HI : C_GV) + h * 128, tid);
      lg_compute<TYPE>(a, wsb, l, h, dir, raw, lds, tid); vT_write(vr, lds, tid); }
    cumsum_g<TYPE>(dir, lds, tid);
    LAS float* G = (LAS float*)(lds + SC_G); LAS bf16_t* Kb = (LAS bf16_t*)(lds + SC_K); LAS bf16_t* KDT = (LAS bf16_t*)(lds + SC_KDT); LAS bf16_t* VT = (LAS bf16_t*)(lds + SC_VT);
    const int last = dir ? 0 : 63;
    float* Dout = (float*)(wsb + (TYPE ? WS_DH : WS_DG)) + (size_t)item * DK;
#pragma unroll
    for (int e2 = 0; e2 < DK / 64; ++e2) { const int task = tid + 512 * e2, i = task & 63, d8 = task >> 6;
        const f32x4 g0 = *(LAS f32x4*)(G + i * C::LDG + d8 * 8), g1 = *(LAS f32x4*)(G + i * C::LDG + d8 * 8 + 4);
        const f32x4 t0 = *(LAS f32x4*)(G + last * C::LDG + d8 * 8), t1 = *(LAS f32x4*)(G + last * C::LDG + d8 * 8 + 4);
        float kk[8]; unpack8(*(LAS bf16x8*)(Kb + i * C::LDK_ + d8 * 8), kk);
#pragma unroll
        for (int e = 0; e < 8; ++e) { const float gg = e < 4 ? g0[e] : g1[e - 4], tt = e < 4 ? t0[e] : t1[e - 4];
            KDT[(d8 * 8 + e) * LDT + i] = (bf16_t)f2bf(kk[e] * __expf(tt - gg)); }
        if (i == 0) { *(f32x4*)(Dout + d8 * 8) = (f32x4){__expf(t0[0]), __expf(t0[1]), __expf(t0[2]), __expf(t0[3])};
                      *(f32x4*)(Dout + d8 * 8 + 4) = (f32x4){__expf(t1[0]), __expf(t1[1]), __expf(t1[2]), __expf(t1[3])}; } }
    __syncthreads();
    bf16_t* ST = (bf16_t*)(wsb + (TYPE ? WS_SH : WS_SG)) + (size_t)item * 128 * DK;
    const bf16x8 b0 = vt_frag(VT, wid * 16 + fr, fq), b1 = vt_frag(VT, wid * 16 + fr, 4 + fq);
#pragma unroll
    for (int dt = 0; dt < DK / 16; ++dt) {
        const bf16x8 a0 = *(LAS bf16x8*)(KDT + (dt * 16 + fr) * LDT + fq * 8), a1 = *(LAS bf16x8*)(KDT + (dt * 16 + fr) * LDT + 32 + fq * 8);
        f32x4 acc = {0.f, 0.f, 0.f, 0.f};
        acc = __builtin_amdgcn_mfma_f32_16x16x32_bf16(a0, b0, acc, 0, 0, 0);
        acc = __builtin_amdgcn_mfma_f32_16x16x32_bf16(a1, b1, acc, 0, 0, 0);
        u32x2 w; w.x = cvt_pk_bf16(acc[0], acc[1]); w.y = cvt_pk_bf16(acc[2], acc[3]);
        *(u32x2*)(ST + (size_t)(wid * 16 + fr) * DK + dt * 16 + fq * 4) = w;
    }
}

struct P2Chain { bf16_t* st; const float* dp; size_t sstride; int dstride; int dir; };
__device__ __forceinline__ P2Chain p2_chain(unsigned char* wsb, int type, int E) {
    const int DK = type ? 128 : 64, IPI = 128 * DK;
    const int chain = E / IPI, e = E % IPI;
    P2Chain c; c.st = (bf16_t*)(wsb + (type ? WS_SH : WS_SG)) + (size_t)chain * NCH * IPI + e;
    c.dp = (const float*)(wsb + (type ? WS_DH : WS_DG)) + (size_t)chain * NCH * DK + (e % DK);
    c.sstride = (size_t)IPI; c.dstride = DK; c.dir = chain & 1; return c;
}
__device__ __forceinline__ void pass2_triple(const KArgs& a, int t) {
    unsigned char* const wsb = opq(a.ws);
    const P2Chain c0 = p2_chain(wsb, 1, t), c1 = p2_chain(wsb, 1, t + 131072), c2 = p2_chain(wsb, 0, t);
    float s0 = 0.f, s1 = 0.f, s2 = 0.f;
    unsigned short uA[3][4], uB[3][4]; float dA[3][4], dB[3][4];
#define P2_CI(c, s) ((c).dir ? NCH - 1 - (s) : (s))
#define P2_LOAD(U, D, sb) do { _Pragma("unroll") for (int k = 0; k < 4; ++k) { \
        const int i0_ = P2_CI(c0, (sb) + k), i1_ = P2_CI(c1, (sb) + k), i2_ = P2_CI(c2, (sb) + k); \
        U[0][k] = c0.st[(size_t)i0_ * c0.sstride]; D[0][k] = c0.dp[(size_t)i0_ * c0.dstride]; \
        U[1][k] = c1.st[(size_t)i1_ * c1.sstride]; D[1][k] = c1.dp[(size_t)i1_ * c1.dstride]; \
        U[2][k] = c2.st[(size_t)i2_ * c2.sstride]; D[2][k] = c2.dp[(size_t)i2_ * c2.dstride]; } } while (0)
#define P2_STEP(U, D, sb) do { _Pragma("unroll") for (int k = 0; k < 4; ++k) { \
        const int i0_ = P2_CI(c0, (sb) + k), i1_ = P2_CI(c1, (sb) + k), i2_ = P2_CI(c2, (sb) + k); \
        c0.st[(size_t)i0_ * c0.sstride] = (bf16_t)f2bf(s0); s0 = D[0][k] * s0 + bf2f(U[0][k]); \
        c1.st[(size_t)i1_ * c1.sstride] = (bf16_t)f2bf(s1); s1 = D[1][k] * s1 + bf2f(U[1][k]); \
        c2.st[(size_t)i2_ * c2.sstride] = (bf16_t)f2bf(s2); s2 = D[2][k] * s2 + bf2f(U[2][k]); } } while (0)
    P2_LOAD(uA, dA, 0);
#pragma unroll 1
    for (int sb = 0; sb < NCH; sb += 8) {
        P2_LOAD(uB, dB, sb + 4);
        P2_STEP(uA, dA, sb);
        if (sb + 8 < NCH) P2_LOAD(uA, dA, sb + 8);
        P2_STEP(uB, dB, sb + 4);
    }
#undef P2_CI
#undef P2_LOAD
#undef P2_STEP
}

template <int TYPE>
__device__ __forceinline__ void pass3_item(const KArgs& a, int l, int item, LAS unsigned char* lds) {
    unsigned char* const wsb = opq(a.ws);
    const int tid = opaque_tid();
    using C = Cfg<TYPE>; constexpr int DK = C::DK;
    const int c = item & (NCH - 1), h = (item >> 8) & 3, b = item >> 10;
    const size_t tok0 = (size_t)b * T + (size_t)c * 64;
    const bf16_t* u = (const bf16_t*)(wsb + WS_U);
    const int wid = tid >> 6, lane = tid & 63, fr = lane & 15, fq = lane >> 4;
    LAS float* G = (LAS float*)(lds + SC_G); LAS bf16_t* Kb = (LAS bf16_t*)(lds + SC_K); LAS bf16_t* QT = (LAS bf16_t*)(lds + SC_QT); LAS bf16_t* QG = (LAS bf16_t*)(lds + SC_QG);
    LAS bf16_t* VT = (LAS bf16_t*)(lds + SC_VT); LAS bf16_t* P = (LAS bf16_t*)(lds + SC_P); LAS float* RSQ = (LAS float*)(lds + SC_RSQ);
    const VRaw vr = vT_issue(u + tok0 * DINP + (TYPE ? C_HI : C_GV) + h * 128, tid);
    bf16x8 qraw[DK / 64];
#pragma unroll
    for (int e2 = 0; e2 < DK / 64; ++e2) { const int task = tid + 512 * e2, i = task / C::ND8, d8 = task % C::ND8;
        qraw[e2] = *(const bf16x8*)(u + (tok0 + i) * DINP + (TYPE ? C_HQ + h * 128 : C_GQ + h * 64) + d8 * 8); }
    const LgRaw raw0 = lg_issue<TYPE>(u, h, 0, tok0, tid), raw1 = lg_issue<TYPE>(u, h, 1, tok0, tid);
    __syncthreads();
    vT_write(vr, lds, tid);
    float qf[DK / 64][8];
#pragma unroll
    for (int e2 = 0; e2 < DK / 64; ++e2) { unpack8(qraw[e2], qf[e2]);
#pragma unroll
        for (int e = 0; e < 8; ++e) qf[e2][e] = TYPE ? silu_(qf[e2][e]) : qf[e2][e] * 0.125f; }
    f32x4 o[4];
#pragma unroll
    for (int it = 0; it < 4; ++it) o[it] = (f32x4){0.f, 0.f, 0.f, 0.f};
#pragma unroll 1
    for (int dir = 0; dir < 2; ++dir) {
        const int sitem = ((b * 4 + h) * 2 + dir) * NCH + c;
        const bf16_t* ST = (const bf16_t*)(wsb + (TYPE ? WS_SH : WS_SG)) + (size_t)sitem * 128 * DK + (size_t)(wid * 16 + fr) * DK + fq * 8;
        bf16x8 sf[DK / 32];
#pragma unroll
        for (int ks = 0; ks < DK / 32; ++ks) sf[ks] = *(const bf16x8*)(ST + ks * 32);
        if (dir) __syncthreads();
        { LgRaw rw; rw.a0 = dir ? raw1.a0 : raw0.a0; rw.a1 = dir ? raw1.a1 : raw0.a1; rw.k = dir ? raw1.k : raw0.k; lg_compute<TYPE>(a, wsb, l, h, dir, rw, lds, tid); }
        cumsum_g<TYPE>(dir, lds, tid);
#pragma unroll
        for (int e2 = 0; e2 < DK / 64; ++e2) { const int task = tid + 512 * e2, i = task / C::ND8, d8 = task % C::ND8;
            const f32x4 g0 = *(LAS f32x4*)(G + i * C::LDG + d8 * 8), g1 = *(LAS f32x4*)(G + i * C::LDG + d8 * 8 + 4);
            const f32x4 m0 = *(LAS f32x4*)(G + 32 * C::LDG + d8 * 8), m1 = *(LAS f32x4*)(G + 32 * C::LDG + d8 * 8 + 4);
            float kk[8], qq[8], qt[8], qg[8]; unpack8(*(LAS bf16x8*)(Kb + i * C::LDK_ + d8 * 8), kk);
#pragma unroll
            for (int e = 0; e < 8; ++e) qq[e] = qf[e2][e];
#pragma unroll
            for (int e = 0; e < 8; ++e) { const float gg = e < 4 ? g0[e] : g1[e - 4], gm = e < 4 ? m0[e] : m1[e - 4];
                const float q = qq[e];
                qt[e] = q * __expf(gg - gm); qg[e] = q * __expf(gg); kk[e] = kk[e] * __expf(gm - gg); }
            *(LAS bf16x8*)(QT + i * C::LDK_ + d8 * 8) = pack8(qt); *(LAS bf16x8*)(QG + i * C::LDK_ + d8 * 8) = pack8(qg); *(LAS bf16x8*)(Kb + i * C::LDK_ + d8 * 8) = pack8(kk); }
        __syncthreads();
        { const int it = wid >> 1;
#pragma unroll
          for (int jj = 0; jj < 2; ++jj) { const int jt = 2 * (wid & 1) + jj;
            f32x4 acc = {0.f, 0.f, 0.f, 0.f};
#pragma unroll
            for (int ks = 0; ks < DK / 32; ++ks) {
                const bf16x8 af = *(LAS bf16x8*)(QT + (it * 16 + fr) * C::LDK_ + ks * 32 + fq * 8), bfr = *(LAS bf16x8*)(Kb + (jt * 16 + fr) * C::LDK_ + ks * 32 + fq * 8);
                acc = __builtin_amdgcn_mfma_f32_16x16x32_bf16(af, bfr, acc, 0, 0, 0); }
#pragma unroll
            for (int r = 0; r < 4; ++r) { const int i = it * 16 + fq * 4 + r, j = jt * 16 + fr; const bool keep = dir ? (j >= i) : (j <= i);
                P[i * LDT + j] = (bf16_t)f2bf(keep ? acc[r] : 0.f); } } }
        __syncthreads();
        const bf16x8 vb0 = vt_frag(VT, wid * 16 + fr, fq), vb1 = vt_frag(VT, wid * 16 + fr, 4 + fq);
#pragma unroll
        for (int it = 0; it < 4; ++it) {
            const bf16x8 p0 = *(LAS bf16x8*)(P + (it * 16 + fr) * LDT + fq * 8), p1 = *(LAS bf16x8*)(P + (it * 16 + fr) * LDT + 32 + fq * 8);
            o[it] = __builtin_amdgcn_mfma_f32_16x16x32_bf16(p0, vb0, o[it], 0, 0, 0);
            o[it] = __builtin_amdgcn_mfma_f32_16x16x32_bf16(p1, vb1, o[it], 0, 0, 0);
#pragma unroll
            for (int ks = 0; ks < DK / 32; ++ks) { const bf16x8 af = *(LAS bf16x8*)(QG + (it * 16 + fr) * C::LDK_ + ks * 32 + fq * 8);
                o[it] = __builtin_amdgcn_mfma_f32_16x16x32_bf16(af, sf[ks], o[it], 0, 0, 0); }
        }
    }
#pragma unroll
    for (int it = 0; it < 4; ++it)
#pragma unroll
        for (int r = 0; r < 4; ++r) { float s = o[it][r] * o[it][r]; s += __shfl_xor(s, 1); s += __shfl_xor(s, 2); s += __shfl_xor(s, 4); s += __shfl_xor(s, 8);
            if (fr == 0) RSQ[wid * 64 + it * 16 + fq * 4 + r] = s; }
    __syncthreads();
    const float gain = ((const float*)a.in[TYPE ? 7 : 5])[l * 128 + wid * 16 + fr];
    bf16_t* mix = (bf16_t*)(wsb + WS_XN);
#pragma unroll
    for (int it = 0; it < 4; ++it)
#pragma unroll
        for (int r = 0; r < 4; ++r) { const int i = it * 16 + fq * 4 + r; float s = 0.f;
#pragma unroll
            for (int w = 0; w < 8; ++w) s += RSQ[w * 64 + i];
            const float rstd = rsqrtf(s * (1.f / 128.f) + EPS);
            const float gt = bf2f(u[(tok0 + i) * DINP + (TYPE ? C_HG : C_GG) + h * 128 + wid * 16 + fr]);
            const float yv = o[it][r] * rstd * gain * silu_(gt);
            mix[(tok0 + i) * DM + (TYPE ? 512 : 0) + h * 128 + wid * 16 + fr] = (bf16_t)f2bf(yv); }
}
}
__device__ __forceinline__ void rmsnorm_rows_bf16(const float* src, const float* gain, bf16_t* dst) {
    const int tid = opaque_tid(), lane = tid & 63, gw = blockIdx.x * 8 + (tid >> 6), ngw = gridDim.x * 8;
    for (int m = gw; m < M; m += ngw) {
        const f32x4* xr = (const f32x4*)(src + (size_t)m * DM) + lane;
        f32x4 v[8]; float s = 0.f;
#pragma unroll
        for (int j = 0; j < 8; ++j) { v[j] = xr[64 * j]; s += (v[j][0] * v[j][0] + v[j][1] * v[j][1]) + (v[j][2] * v[j][2] + v[j][3] * v[j][3]); }
        const float rstd = rsqrtf(wave_sum(s) * (1.f / DM) + EPS);
        u32x2* o8 = (u32x2*)(dst + (size_t)m * DM) + lane;
#pragma unroll
        for (int j = 0; j < 8; ++j) { const f32x4 g = ((const f32x4*)gain)[lane + 64 * j];
            u32x2 w; w.x = cvt_pk_bf16(v[j][0] * rstd * g[0], v[j][1] * rstd * g[1]); w.y = cvt_pk_bf16(v[j][2] * rstd * g[2], v[j][3] * rstd * g[3]); o8[64 * j] = w; }
    }
}
__device__ __forceinline__ void cast_rows_bf16(const float* src, bf16_t* dst, float* rsq) {
    const int tid = opaque_tid(), lane = tid & 63, gw = blockIdx.x * 8 + (tid >> 6), ngw = gridDim.x * 8;
    for (int m = gw; m < M; m += ngw) {
        const f32x4* xr = (const f32x4*)(src + (size_t)m * DM) + lane;
        f32x4 v[8]; float s = 0.f;
#pragma unroll
        for (int j = 0; j < 8; ++j) { v[j] = xr[64 * j]; s += (v[j][0] * v[j][0] + v[j][1] * v[j][1]) + (v[j][2] * v[j][2] + v[j][3] * v[j][3]); }
        s = wave_sum(s);
        if (lane == 0) rsq[m] = s;
        u32x2* o8 = (u32x2*)(dst + (size_t)m * DM) + lane;
#pragma unroll
        for (int j = 0; j < 8; ++j) { u32x2 w; w.x = cvt_pk_bf16(v[j][0], v[j][1]); w.y = cvt_pk_bf16(v[j][2], v[j][3]); o8[64 * j] = w; }
    }
}
__device__ __forceinline__ void rmsnorm_rows_f32_inplace(float* buf, const float* gain) {
    const int tid = opaque_tid(), lane = tid & 63, gw = blockIdx.x * 8 + (tid >> 6), ngw = gridDim.x * 8;
    for (int m = gw; m < M; m += ngw) {
        f32x4* xr = (f32x4*)(buf + (size_t)m * DM) + lane;
        f32x4 v[8]; float s = 0.f;
#pragma unroll
        for (int j = 0; j < 8; ++j) { v[j] = xr[64 * j]; s += (v[j][0] * v[j][0] + v[j][1] * v[j][1]) + (v[j][2] * v[j][2] + v[j][3] * v[j][3]); }
        const float rstd = rsqrtf(wave_sum(s) * (1.f / DM) + EPS);
#pragma unroll
        for (int j = 0; j < 8; ++j) { const f32x4 g = ((const f32x4*)gain)[lane + 64 * j]; xr[64 * j] = v[j] * rstd * g; }
    }
}
__device__ __forceinline__ void convert_weights(const KArgs& a, int l, LAS unsigned char* lds) {
    unsigned char* const wsb = opq(a.ws);
    const int tid = opaque_tid();
    LAS float* tile = (LAS float*)lds;
    constexpr int I_IN = 32 * 84, I_QB = 8 * 24, I_KVB = 8 * 32, I_OUT = 32 * 32, I_13 = 32 * 176, I_2 = 88 * 32, NIT = I_IN + I_QB + I_KVB + I_OUT + I_13 + I_2;
    for (int it = blockIdx.x; it < NIT; it += gridDim.x) {
        int r = it, mode = 0, N, K, nkt; const float* w0; const float* w1 = nullptr; const float* gk = nullptr; bf16_t* WT;
        if (r < I_IN) { w0 = (const float*)a.in[2] + (size_t)l * DM * DIN; N = DIN; K = DM; nkt = 32; gk = (const float*)a.in[13] + l * DM; WT = (bf16_t*)(wsb + WS_WIN); }
        else if ((r -= I_IN) < I_QB) { w0 = (const float*)a.in[9] + (size_t)l * 512 * 1536; N = 1536; K = 512; nkt = 8; mode = 1; WT = (bf16_t*)(wsb + WS_WQB); }
        else if ((r -= I_QB) < I_KVB) { w0 = (const float*)a.in[11] + (size_t)l * 512 * 2048; N = 2048; K = 512; nkt = 8; WT = (bf16_t*)(wsb + WS_WKVB); }
        else if ((r -= I_KVB) < I_OUT) { w0 = (const float*)a.in[12] + (size_t)l * DM * DM; N = DM; K = DM; nkt = 32; WT = (bf16_t*)(wsb + WS_WOUT); }
        else if ((r -= I_OUT) < I_13) { w0 = (const float*)a.in[15] + (size_t)l * DM * DFF; w1 = (const float*)a.in[16] + (size_t)l * DM * DFF; N = DFF; K = DM; nkt = 32; mode = 2; gk = (const float*)a.in[14] + l * DM; WT = (bf16_t*)(wsb + WS_W13); }
        else { r -= I_13; w0 = (const float*)a.in[17] + (size_t)l * DFF * DM; N = DM; K = DFF; nkt = 88; WT = (bf16_t*)(wsb + WS_W2); }
        const int kt = r % nkt, rt = r / nkt, r0 = rt * 64, k0 = kt * 64;
        __syncthreads();
        if (mode == 1) {
#pragma unroll
            for (int e = 0; e < 8; ++e) { const int idx = tid + 512 * e, rl = idx & 63, kl = idx >> 6, rr = r0 + rl, k = k0 + kl;
                const int hh = rr / 192, ee = rr % 192; const int col = ee < 128 ? hh * 192 + ee : hh * 192 + 128 + ((ee - 128) & 1) * 32 + ((ee - 128) >> 1);
                tile[kl * 65 + rl] = w0[(size_t)k * N + col]; }
        } else {
#pragma unroll
            for (int e = 0; e < 2; ++e) { const int idx = tid + 512 * e, r4 = (idx & 15) * 4, kl = idx >> 4, rr = r0 + r4, k = k0 + kl;
                f32x4 v = {0.f, 0.f, 0.f, 0.f};
                if (mode == 0) { if (rr < N) v = *(const f32x4*)(w0 + (size_t)k * N + rr); }
                else { const int g = rr >> 5, n = (rr >> 4) & 1, i = rr & 15; v = *(const f32x4*)((n ? w1 : w0) + (size_t)k * N + 16 * g + i); }
                if (gk) v = v * gk[k];
                tile[kl * 65 + r4] = v[0]; tile[kl * 65 + r4 + 1] = v[1]; tile[kl * 65 + r4 + 2] = v[2]; tile[kl * 65 + r4 + 3] = v[3]; }
        }
        __syncthreads();
        { const int k8 = tid & 7, rl = tid >> 3;
          u32x4 w; w.x = pk2(tile[(8 * k8 + 0) * 65 + rl], tile[(8 * k8 + 1) * 65 + rl]); w.y = pk2(tile[(8 * k8 + 2) * 65 + rl], tile[(8 * k8 + 3) * 65 + rl]);
          w.z = pk2(tile[(8 * k8 + 4) * 65 + rl], tile[(8 * k8 + 5) * 65 + rl]); w.w = pk2(tile[(8 * k8 + 6) * 65 + rl], tile[(8 * k8 + 7) * 65 + rl]);
          *(u32x4*)(WT + (size_t)(r0 + rl) * K + k0 + 8 * k8) = w; }
    }
    __syncthreads();
}
__device__ __forceinline__ void tables_phase(const KArgs& a) {
    unsigned char* const wsb = opq(a.ws);
    const int tid = opaque_tid();
    const int* pos = (const int*)a.in[1];
    float* cs = (float*)(wsb + WS_COS); float* sn = (float*)(wsb + WS_SIN);
    const int gt = blockIdx.x * 512 + tid, ngt = gridDim.x * 512;
    for (int idx = gt; idx < M * 32; idx += ngt) { const int tok = idx >> 5, i = idx & 31;
        const float inv = 1.0f / exp2f((float)(2 * i) * (1.f / 64.f) * 13.287712379549449f);
        const float ang = (float)pos[tok] * inv;
        double rev = (double)ang * 0.15915494309189535; rev -= rint(rev);
        const float f = (float)rev;
        cs[idx] = __builtin_amdgcn_cosf(f); sn[idx] = __builtin_amdgcn_sinf(f); }
    if (blockIdx.x == 0) { const float* lg = (const float*)a.in[6]; float* lb = (float*)(wsb + WS_LB);
        for (int p = tid; p < 2 * 512; p += 512) { const int dir = p >> 9, c = p & 511;
            float mx = -1e30f;
#pragma unroll
            for (int l = 0; l < DEPTH; ++l) mx = fmaxf(mx, lg[(dir * DEPTH + l) * 512 + c]);
            float den = 0.f;
#pragma unroll
            for (int l = 0; l < DEPTH; ++l) den += __expf(lg[(dir * DEPTH + l) * 512 + c] - mx);
            float cum = 0.f;
#pragma unroll
            for (int l = 0; l < DEPTH; ++l) { if (l > 0) cum += __expf(lg[(dir * DEPTH + l) * 512 + c] - mx) / den; lb[(dir * DEPTH + l) * 512 + c] = cum; } } }
}
__device__ __forceinline__ void mla_prep(const KArgs& a, int l) {
    unsigned char* const wsb = opq(a.ws);
    const int tid = opaque_tid(), lane = tid & 63, gw = blockIdx.x * 8 + (tid >> 6), ngw = gridDim.x * 8;
    bf16_t* u = (bf16_t*)(wsb + WS_U); bf16_t* kr = (bf16_t*)(wsb + WS_KR);
    const float* cs = (const float*)(wsb + WS_COS); const float* sn = (const float*)(wsb + WS_SIN);
    const float* gq = (const float*)a.in[8] + l * 512 + lane * 8; const float* gkv = (const float*)a.in[10] + l * 512 + lane * 8;
    for (int tok = gw; tok < M; tok += ngw) {
        bf16_t* ur = u + (size_t)tok * DINP;
#pragma unroll
        for (int w = 0; w < 2; ++w) { bf16_t* p = ur + (w ? C_CKV : C_CQ) + lane * 8; const float* g = w ? gkv : gq;
            float f[8]; unpack8(*(const bf16x8*)p, f); float s = 0.f;
#pragma unroll
            for (int e = 0; e < 8; ++e) s += f[e] * f[e];
            const float rstd = rsqrtf(wave_sum(s) * (1.f / 512.f) + EPS);
#pragma unroll
            for (int e = 0; e < 8; ++e) f[e] = f[e] * rstd * g[e];
            *(bf16x8*)p = pack8(f); }
        if (lane < 32) { const float x1 = bf2f(ur[C_KR + lane]), x2 = bf2f(ur[C_KR + 32 + lane]), c = cs[(size_t)tok * 32 + lane], s = sn[(size_t)tok * 32 + lane];
            *(unsigned*)(kr + (size_t)tok * 64 + 2 * lane) = pk2(x1 * c - x2 * s, x2 * c + x1 * s); }
    }
}

__device__ __forceinline__ void grid_barrier(unsigned* bar, unsigned nblk, unsigned& epoch) {
    __builtin_amdgcn_fence(__ATOMIC_RELEASE, "agent");
    asm volatile("s_waitcnt vmcnt(0) lgkmcnt(0)" ::: "memory");
    __syncthreads();
    epoch += nblk;
    if (threadIdx.x == 0) {
        __hip_atomic_fetch_add(bar, 1u, __ATOMIC_RELEASE, __HIP_MEMORY_SCOPE_AGENT);
        while (__hip_atomic_load(bar, __ATOMIC_ACQUIRE, __HIP_MEMORY_SCOPE_AGENT) < epoch) __builtin_amdgcn_s_sleep(2);
    }
    __syncthreads();
    __builtin_amdgcn_fence(__ATOMIC_ACQUIRE, "agent");
}
__global__ void __launch_bounds__(512, 2) mega_fwd(KArgs a) {
    extern __shared__ __attribute__((aligned(16))) unsigned char smem[];
    cg::grid_group grid = cg::this_grid();
    LAS unsigned char* lds = (LAS unsigned char*)smem;
    const int G = gridDim.x, bx = blockIdx.x;
    const float* x = (const float*)a.in[0];
    unsigned epoch = 0; unsigned* const gbar = (unsigned*)(a.ws + WS_BAR);
#define GBAR() grid_barrier(gbar, (unsigned)G, epoch)

#if PH_MISC
    tables_phase(a);
    convert_weights(a, 0, lds);
#if PROBE_CVT_REP > 1
    convert_weights(a, 0, lds);
#endif
#endif
    { float* rz = (float*)(opq(a.ws) + WS_RSQ); for (int z_ = bx * 512 + opaque_tid(); z_ < 4 * M; z_ += G * 512) rz[z_] = 0.f; }
    cast_rows_bf16(x, (bf16_t*)(opq(a.ws) + WS_XN), (float*)(opq(a.ws) + WS_RSQ) + 4 * M);
    grid.sync();
    GBAR();
#pragma unroll 1
    for (int l = 0; l < DEPTH; ++l) {
        if (l > 0) {
#if PH_MISC
            convert_weights(a, l, lds);
#if PROBE_CVT_REP > 1
            convert_weights(a, l, lds);
#endif
#endif
            GBAR();
        }
        { pg8::Gemm g{(const bf16_t*)(opq(a.ws) + WS_XN), (const bf16_t*)(opq(a.ws) + WS_WIN), M, DINP, DM, DM, DM}; pg8::StaticOrder S; S.init(M, DINP, G, bx);
          pg8::EpiU E{(bf16_t*)(opq(a.ws) + WS_U), DINP, (const float*)(opq(a.ws) + WS_RSQ) + (size_t)(l == 0 ? 4 : 2 + (l - 1)) * M};
          __syncthreads(); if (PH_GEMM & 1) pg8::gemm_phase<pg8::EpiU, pg8::StaticOrder, true, true>(lds, g, S, E);
#if PROBE_GEMM_REP > 1
          __syncthreads(); if (PH_GEMM & 1) pg8::gemm_phase<pg8::EpiU, pg8::StaticOrder, true, true>(lds, g, S, E);
#endif
 }
        GBAR();
#if PH_MISC
        mla_prep(a, l);
#endif
#if PH_S1
        for (int it = bx; it < 4096; it += G) scan::pass1_item<1>(a, l, it, lds);
        for (int it = bx; it < 4096; it += G) scan::pass1_item<0>(a, l, it, lds);
#if PROBE_SCAN_REP > 1
        for (int it = bx; it < 4096; it += G) scan::pass1_item<1>(a, l, it, lds);
        for (int it = bx; it < 4096; it += G) scan::pass1_item<0>(a, l, it, lds);
#endif
#endif
        GBAR();
#if PH_S2
        for (int t = bx * 512 + opaque_tid(); t < 131072; t += G * 512) scan::pass2_triple(a, t);
#endif
        { pg8::Gemm g{(const bf16_t*)(opq(a.ws) + WS_U) + C_CQ, (const bf16_t*)(opq(a.ws) + WS_WQB), M, 1536, 512, DINP, 512}; pg8::StaticOrder S; S.init(M, 1536, G, bx);
          pg8::EpiQ E{(bf16_t*)(opq(a.ws) + WS_Q), (const float*)(opq(a.ws) + WS_COS), (const float*)(opq(a.ws) + WS_SIN)};
          __syncthreads(); if (PH_GEMM & 2) pg8::gemm_phase<pg8::EpiQ, pg8::StaticOrder, true, true>(lds, g, S, E);
#if PROBE_GEMM_REP > 1
          __syncthreads(); if (PH_GEMM & 2) pg8::gemm_phase<pg8::EpiQ, pg8::StaticOrder, true, true>(lds, g, S, E);
#endif
 }
        { pg8::Gemm g{(const bf16_t*)(opq(a.ws) + WS_U) + C_CKV, (const bf16_t*)(opq(a.ws) + WS_WKVB), M, 2048, 512, DINP, 512}; pg8::StaticOrder S; S.init(M, 2048, G, bx);
          pg8::EpiKV E{(bf16_t*)(opq(a.ws) + WS_KN), (bf16_t*)(opq(a.ws) + WS_V)};
          __syncthreads(); if (PH_GEMM & 4) pg8::gemm_phase<pg8::EpiKV, pg8::StaticOrder, true, true>(lds, g, S, E);
#if PROBE_GEMM_REP > 1
          __syncthreads(); if (PH_GEMM & 4) pg8::gemm_phase<pg8::EpiKV, pg8::StaticOrder, true, true>(lds, g, S, E);
#endif
 }
        GBAR();
        { const bool x8 = (G % 8) == 0; const int xcd = bx & 7, slot = bx >> 3, nslot = G >> 3;
          for (int pr = 0; pr < (x8 ? 2 : 16); ++pr) { const int p = x8 ? xcd + 8 * pr : pr, b = p >> 3, h = p & 7;
            for (int qb = x8 ? slot : bx; qb < 64; qb += x8 ? nslot : G) {
              const bf16_t* Qb = (const bf16_t*)(opq(a.ws) + WS_Q) + ((size_t)(b * 8 + h) * T + (size_t)qb * 256) * 192;
              const bf16_t* Kn = (const bf16_t*)(opq(a.ws) + WS_KN) + (size_t)(b * 8 + h) * T * 128;
              const bf16_t* Kr = (const bf16_t*)(opq(a.ws) + WS_KR) + (size_t)b * T * 64;
              const bf16_t* Vh = (const bf16_t*)(opq(a.ws) + WS_V) + (size_t)(b * 8 + h) * T * 128;
              bf16_t* Ob = (bf16_t*)(opq(a.ws) + WS_XN) + ((size_t)b * T + (size_t)qb * 256) * DM + 1024 + h * 128;
#if PH_ATT
              for (int rep_ = 0; rep_ < PROBE_ATT_REP; ++rep_) att::attn_unit(Qb, Kn, Kr, Vh, Ob, (char*)smem);
#else
              { const int t_ = opaque_tid(); bf16_t* zp = Ob + (size_t)(t_ >> 1) * DM + (t_ & 1) * 64; (void)Qb; (void)Kn; (void)Kr; (void)Vh;
                for (int z_ = 0; z_ < 8; ++z_) *(u32x4*)(zp + z_ * 8) = (u32x4){0u, 0u, 0u, 0u}; }
#endif
 } } }
#if PH_S3
        for (int it = bx; it < 2048; it += G) scan::pass3_item<1>(a, l, it, lds);
        for (int it = bx; it < 2048; it += G) scan::pass3_item<0>(a, l, it, lds);
#if PROBE_SCAN_REP > 1
        for (int it = bx; it < 2048; it += G) scan::pass3_item<1>(a, l, it, lds);
        for (int it = bx; it < 2048; it += G) scan::pass3_item<0>(a, l, it, lds);
#endif
#else
        { bf16_t* mz = (bf16_t*)(opq(a.ws) + WS_XN); for (size_t z_ = (size_t)bx * 512 + opaque_tid(); z_ < (size_t)M * 128; z_ += (size_t)G * 512) *(u32x4*)(mz + (z_ >> 7) * DM + (z_ & 127) * 8) = (u32x4){0u, 0u, 0u, 0u}; }
#endif
        GBAR();
        { pg8::Gemm g{(const bf16_t*)(opq(a.ws) + WS_XN), (const bf16_t*)(opq(a.ws) + WS_WOUT), M, DM, DM, DM, DM}; pg8::StaticOrder S; S.init(M, DM, G, bx);
          pg8::EpiRes E{l == 0 ? x : (const float*)a.out, a.out, (bf16_t*)(opq(a.ws) + WS_HB), (float*)(opq(a.ws) + WS_RSQ) + (size_t)l * M};
          __syncthreads(); if (PH_GEMM & 8) pg8::gemm_phase<pg8::EpiRes, pg8::StaticOrder, true, true>(lds, g, S, E); }
        GBAR();
        { pg8::Gemm g{(const bf16_t*)(opq(a.ws) + WS_HB), (const bf16_t*)(opq(a.ws) + WS_W13), M, 2 * DFF, DM, DM, DM}; pg8::StaticOrder S; S.init(M, 2 * DFF, G, bx);
          pg8::EpiSwi E{(bf16_t*)(opq(a.ws) + WS_HID), (const float*)(opq(a.ws) + WS_RSQ) + (size_t)l * M};
          __syncthreads(); if (PH_GEMM & 16) pg8::gemm_phase<pg8::EpiSwi, pg8::StaticOrder, true, true>(lds, g, S, E);
#if PROBE_GEMM_REP > 1
          __syncthreads(); if (PH_GEMM & 16) pg8::gemm_phase<pg8::EpiSwi, pg8::StaticOrder, true, true>(lds, g, S, E);
#endif
 }
        GBAR();
        { pg8::Gemm g{(const bf16_t*)(opq(a.ws) + WS_HID), (const bf16_t*)(opq(a.ws) + WS_W2), M, DM, DFF, DFF, DFF}; pg8::StaticOrder S; S.init(M, DM, G, bx);
          pg8::EpiRes E{(const float*)a.out, a.out, (bf16_t*)(opq(a.ws) + WS_XN), (float*)(opq(a.ws) + WS_RSQ) + (size_t)(2 + l) * M};
          __syncthreads(); if (PH_GEMM & 32) pg8::gemm_phase<pg8::EpiRes, pg8::StaticOrder, true, true>(lds, g, S, E); }
        GBAR();
    }
    rmsnorm_rows_f32_inplace(a.out, (const float*)a.in[18]);
}

extern "C" void kernel_launch(void* const* d_in, const int* in_sizes, int n_in, void* d_out, int out_size, void* d_ws, size_t ws_size, hipStream_t stream) {
    static int grid = 0;
    if (grid == 0) {
        if (n_in != 19 || out_size != M * DM || ws_size < WS_END) { fprintf(stderr, "kernel_launch: unexpected shapes (n_in %d out %d ws %zu)\n", n_in, out_size, ws_size); grid = -1; return; }
        int dev = 0, cus = 0, per_cu = 0;
        hipGetDevice(&dev); hipDeviceGetAttribute(&cus, hipDeviceAttributeMultiprocessorCount, dev);
        if (hipFuncSetAttribute((const void*)mega_fwd, hipFuncAttributeMaxDynamicSharedMemorySize, LDS_BYTES) != hipSuccess) { fprintf(stderr, "kernel_launch: hipFuncSetAttribute failed\n"); grid = -1; return; }
        if (hipOccupancyMaxActiveBlocksPerMultiprocessor(&per_cu, (const void*)mega_fwd, 512, LDS_BYTES) != hipSuccess || per_cu < 1) { fprintf(stderr, "kernel_launch: occupancy query says %d\n", per_cu); per_cu = 1; }
        (void)hipGetLastError();
        grid = cus * (per_cu > 1 ? 1 : per_cu);
    }
    if (grid < 0) return;
    KArgs a{};
    for (int i = 0; i < 19; ++i) a.in[i] = d_in[i];
    a.out = (float*)d_out; a.ws = (unsigned char*)d_ws;
    if (hipMemsetAsync((char*)d_ws + WS_BAR, 0, 256, stream) != hipSuccess) { fprintf(stderr, "kernel_launch: memset failed\n"); return; }
    void* args[] = {&a};
    hipError_t e = hipLaunchCooperativeKernel((const void*)mega_fwd, dim3(grid), dim3(512), args, LDS_BYTES, stream);
    if (e != hipSuccess) fprintf(stderr, "kernel_launch: cooperative launch failed: %s (grid %d)\n", hipGetErrorString(e), grid);
}
```

```cpp
#include <hip/hip_runtime.h>
#include <hip/hip_cooperative_groups.h>
#include <cstdint>
#include <cstdio>
namespace cg = cooperative_groups;
#ifndef PROBE_GEMM_REP
#define PROBE_GEMM_REP 1
#endif
#ifndef PROBE_SCAN_REP
#define PROBE_SCAN_REP 1
#endif
#ifndef PROBE_CVT_REP
#define PROBE_CVT_REP 1
#endif
#ifndef PROBE_ATT_REP
#define PROBE_ATT_REP 1
#endif
#ifndef PH_ATT
#define PH_ATT 1
#endif
#ifndef PH_S1
#define PH_S1 1
#endif
#ifndef PH_S2
#define PH_S2 1
#endif
#ifndef PH_S3
#define PH_S3 1
#endif
#ifndef PH_GEMM
#define PH_GEMM 63
#endif
#ifndef PH_MISC
#define PH_MISC 1
#endif

#define LAS __attribute__((address_space(3)))
typedef unsigned short bf16_t;
typedef short bf16x8 __attribute__((ext_vector_type(8)));
typedef short s16x4 __attribute__((ext_vector_type(4)));
typedef float f32x2 __attribute__((ext_vector_type(2)));
typedef float f32x4 __attribute__((ext_vector_type(4)));
typedef float f32x16 __attribute__((ext_vector_type(16)));
typedef unsigned u32x2 __attribute__((ext_vector_type(2)));
typedef unsigned u32x4 __attribute__((ext_vector_type(4)));

constexpr int NB = 2, T = 16384, M = NB * T, DM = 2048, DIN = 5216, DINP = 5376, DFF = 5632, DEPTH = 2;
constexpr int C_GQ = 0, C_GK = 256, C_GV = 512, C_GAF = 1024, C_GAB = 1040, C_GG = 1056, C_HQ = 1568, C_HFF = 2080, C_HFB = 2592, C_HI = 3104, C_HG = 3616,
              C_CQ = 4128, C_CKV = 4640, C_KR = 5152;
constexpr float EPS = 1e-6f;
constexpr int NCH = T / 64;
constexpr size_t MiB = 1048576;
constexpr size_t WS_WIN = 0, WS_WQB = 21 * MiB, WS_WKVB = WS_WQB + 3 * MiB / 2, WS_WOUT = WS_WKVB + 2 * MiB, WS_W13 = WS_WOUT + 8 * MiB, WS_W2 = WS_W13 + 44 * MiB;
constexpr size_t WS_XN = 99 * MiB, WS_U = 227 * MiB, WS_Q = 563 * MiB, WS_KN = 659 * MiB, WS_V = 723 * MiB, WS_KR = 787 * MiB, WS_SG = 791 * MiB, WS_SH = 855 * MiB,
                 WS_DG = 983 * MiB, WS_DH = 984 * MiB, WS_COS = 986 * MiB, WS_SIN = 990 * MiB, WS_LB = 994 * MiB, WS_BAR = 995 * MiB, WS_RSQ = WS_BAR + 4096, WS_END = 996 * MiB, WS_HB = WS_U, WS_HID = WS_U + 128 * MiB;
static_assert(WS_W2 + 22 * MiB <= WS_XN, "weights");
constexpr int LDS_BYTES = 131072;

struct KArgs { const void* in[19]; float* out; unsigned char* ws; };

__device__ __forceinline__ float bf2f(unsigned v) { return __uint_as_float(v << 16); }
__device__ __forceinline__ unsigned f2bf(float f) { unsigned u = __float_as_uint(f); return (u + 0x7fffu + ((u >> 16) & 1u)) >> 16; }
__device__ __forceinline__ unsigned pk2(float lo, float hi) { return f2bf(lo) | (f2bf(hi) << 16); }
typedef __bf16 bf16x2_t __attribute__((ext_vector_type(2)));
__device__ __forceinline__ unsigned cvt_pk_bf16(float lo, float hi) { f32x2 v = {lo, hi}; bf16x2_t b = __builtin_convertvector(v, bf16x2_t); return __builtin_bit_cast(unsigned, b); }
__device__ __forceinline__ float wave_sum(float v) {
#pragma unroll
    for (int o = 1; o < 64; o <<= 1) v += __shfl_xor(v, o);
    return v;
}
__device__ __forceinline__ unsigned char* opq(unsigned char* q) { asm volatile("" : "+s"(q)); return q; }
__device__ __forceinline__ int opaque_tid() { int t = threadIdx.x; asm volatile("" : "+v"(t)); return t; }
#define DBGF(ws_, cond_, bit_) do { if (cond_) atomicOr((unsigned*)((ws_) + WS_BAR) + 32, (unsigned)(bit_)); } while (0)
__device__ __forceinline__ bool badf(float v) { return !(fabsf(v) < 1e30f); }
__device__ __forceinline__ float sigmoid_(float z) { return __builtin_amdgcn_rcpf(1.f + __expf(-z)); }
__device__ __forceinline__ float silu_(float z) { return z * sigmoid_(z); }
__device__ __forceinline__ float logsigmoid_(float z) { return fminf(z, 0.f) - __logf(1.f + __expf(-fabsf(z))); }
__device__ __forceinline__ void unpack8(bf16x8 v, float* f) {
#pragma unroll
    for (int e = 0; e < 8; ++e) f[e] = bf2f((unsigned)(unsigned short)v[e]);
}
__device__ __forceinline__ bf16x8 pack8(const float* f) {
    u32x4 w = {cvt_pk_bf16(f[0], f[1]), cvt_pk_bf16(f[2], f[3]), cvt_pk_bf16(f[4], f[5]), cvt_pk_bf16(f[6], f[7])};
    return __builtin_bit_cast(bf16x8, w);
}

namespace pg8 {
#define PG8_LAS __attribute__((address_space(3)))
constexpr int BM = 256, BK = 64, HALF = 128, HTB = HALF * BK * 2, STAGE_BYTES = 8 * HTB, NXCD = 8, WGM = 8;
__host__ __device__ __forceinline__ int lds_byte(int r, int c) { const int st = (r >> 4) * 2 + (c >> 5), rr = r & 15, cc = c & 31, ob = rr * 64 + cc * 2; return st * 1024 + (ob ^ (((ob >> 9) & 1) << 5)); }
__host__ __device__ __forceinline__ void stage_rc(int b, int& R, int& C) { const int st = b / 1024, sb = b % 1024, swz = sb ^ (((sb >> 9) & 1) << 5); R = (st >> 1) * 16 + swz / 64; C = (st & 1) * 32 + (swz % 64) / 2; }
__host__ __device__ __forceinline__ int perm32(int rho) { const int n = rho >> 4, i = rho & 15; return 8 * (i >> 2) + 4 * n + (i & 3); }
struct Unit { int pm, pn; };
struct Gemm { const bf16_t* A; const bf16_t* Bt; int M, N, K, lda, ldb; };
struct StaticOrder {
    int nM, nN, nwg, G, c;
    __host__ __device__ void init(int M_, int N_, int G_, int c_) { nM = M_ / BM; nN = N_ / BM; nwg = nM * nN; G = G_; c = c_; }
    __host__ __device__ bool next(int i, Unit& u) const {
        const long L = (long)i * G + c; if (L >= nwg) return false;
        int wgid = (int)L; { const int q = nwg / NXCD, r = nwg % NXCD, xcd = wgid % NXCD, off = wgid / NXCD; wgid = (xcd < r ? xcd * (q + 1) : r * (q + 1) + (xcd - r) * q) + off; }
        const int nig = WGM * nN, gid = wgid / nig, fm = gid * WGM, gsz = (nM - fm) < WGM ? (nM - fm) : WGM;
        u.pm = fm + ((wgid % nig) % gsz); u.pn = (wgid % nig) / gsz; return true;
    }
    __device__ __forceinline__ void a_ready(const Unit&) const {}
    __device__ __forceinline__ void done(const Unit&) const {}
};
template <class Epi, class Sched, bool ALIGN_EPI = false, bool SP2 = false>
__device__ __forceinline__ void gemm_phase(PG8_LAS unsigned char* lds, const Gemm g, const Sched& S, const Epi& E) {
    const int tid = opaque_tid(), wid = __builtin_amdgcn_readfirstlane(tid >> 6), lane = tid & 63, wr = wid >> 2, wc = wid & 3, fr = lane & 15, fq = lane >> 4;
    const int K = g.K, nt = K / BK;
    unsigned voffA[2], voffB[2];
#pragma unroll
    for (int i = 0; i < 2; ++i) { int R, C; stage_rc(tid * 16 + i * 8192, R, C); const int Rb = Epi::PERM ? ((R & ~31) + perm32(R & 31)) : R;
        voffA[i] = (unsigned)(R * g.lda + C) * 2u; voffB[i] = (unsigned)(Rb * g.ldb + C) * 2u; }
    const size_t kstep = (size_t)(BK * 2);
    const size_t hstepA = (size_t)HALF * g.lda * 2, hstepB = (size_t)HALF * g.ldb * 2;
    const size_t tstepA = 2 * hstepA, tstepB = 2 * hstepB;
    const unsigned ldsw = (unsigned)wid * 1024u;
    const int aoff = lds_byte(wr * 64 + fr, fq * 8), boff = lds_byte(wc * 32 + fr, fq * 8);
#define PG8_SA(b, h) (((b) * 2 + (h)) * HTB)
#define PG8_SB(b, h) ((4 + (b) * 2 + (h)) * HTB)
#define PG8_STAGE(bufoff, gbase, voff) do { _Pragma("unroll") for (int _i = 0; _i < 2; ++_i) \
        __builtin_amdgcn_global_load_lds((const unsigned*)((const char*)(gbase) + (voff)[_i]), (PG8_LAS unsigned*)(lds + (bufoff) + ldsw + _i * 8192), 16, 0, 0); } while (0)
#define PG8_LDA(dst, b, h) do { _Pragma("unroll") for (int m = 0; m < 4; ++m) _Pragma("unroll") for (int k = 0; k < 2; ++k) dst[m][k] = *(const PG8_LAS bf16x8*)(lds + PG8_SA(b, h) + aoff + m * 2048 + k * 1024); } while (0)
#define PG8_LDB(dst, b, h) do { _Pragma("unroll") for (int n = 0; n < 2; ++n) _Pragma("unroll") for (int k = 0; k < 2; ++k) dst[n][k] = *(const PG8_LAS bf16x8*)(lds + PG8_SB(b, h) + boff + n * 2048 + k * 1024); } while (0)
#define PG8_MMA(ai, bj, At, Bt) do { __builtin_amdgcn_s_setprio(1); _Pragma("unroll") for (int m = 0; m < 4; ++m) _Pragma("unroll") for (int n = 0; n < 2; ++n) _Pragma("unroll") for (int k = 0; k < 2; ++k) \
        acc[ai][bj][m][n] = __builtin_amdgcn_mfma_f32_16x16x32_bf16(Bt[n][k], At[m][k], acc[ai][bj][m][n], 0, 0, 0); __builtin_amdgcn_s_setprio(0); } while (0)
#define PG8_WAIT_V(n) asm volatile("s_waitcnt vmcnt(" #n ")" ::: "memory")
#define PG8_WAIT_L(n) asm volatile("s_waitcnt lgkmcnt(" #n ")" ::: "memory")
#define PG8_BAR __builtin_amdgcn_s_barrier()
#define PG8_SCHED __builtin_amdgcn_sched_barrier(0)
    Unit cur, nxt; int ui = 0;
    if (!S.next(0, cur)) return;
    f32x4 acc[2][2][4][2];
#pragma unroll
    for (int a = 0; a < 2; ++a)
#pragma unroll
        for (int b = 0; b < 2; ++b)
#pragma unroll
            for (int m = 0; m < 4; ++m)
#pragma unroll
                for (int n = 0; n < 2; ++n) acc[a][b][m][n] = (f32x4){0.f, 0.f, 0.f, 0.f};
    bf16x8 At[4][2], B0[2][2], B1[2][2];
    const char* cA = (const char*)g.A + (size_t)cur.pm * tstepA; const char* cB = (const char*)g.Bt + (size_t)cur.pn * tstepB;
    S.a_ready(cur);
    if constexpr (SP2) {
        PG8_STAGE(PG8_SB(0, 0), cB, voffB); PG8_STAGE(PG8_SB(0, 1), cB + hstepB, voffB); PG8_STAGE(PG8_SA(0, 0), cA, voffA); PG8_STAGE(PG8_SA(0, 1), cA + hstepA, voffA);
        if (wr == 1) PG8_BAR;
        PG8_WAIT_V(2); PG8_BAR;
        PG8_STAGE(PG8_SB(1, 0), cB + kstep, voffB); PG8_STAGE(PG8_SA(1, 0), cA + kstep, voffA); PG8_STAGE(PG8_SB(1, 1), cB + hstepB + kstep, voffB);
        PG8_WAIT_V(6); PG8_BAR;
    } else {
        PG8_STAGE(PG8_SB(0, 0), cB, voffB); PG8_STAGE(PG8_SA(0, 0), cA, voffA); PG8_STAGE(PG8_SB(0, 1), cB + hstepB, voffB); PG8_STAGE(PG8_SA(0, 1), cA + hstepA, voffA);
        if (wr == 1) PG8_BAR;
        PG8_WAIT_V(4); PG8_BAR;
        PG8_STAGE(PG8_SB(1, 0), cB + kstep, voffB); PG8_STAGE(PG8_SA(1, 0), cA + kstep, voffA); PG8_STAGE(PG8_SB(1, 1), cB + hstepB + kstep, voffB);
        PG8_WAIT_V(6); PG8_BAR;
    }
    for (;;) {
        const bool has_next = S.next(ui + 1, nxt);
        const char* nA = has_next ? (const char*)g.A + (size_t)nxt.pm * tstepA : cA; const char* nB = has_next ? (const char*)g.Bt + (size_t)nxt.pn * tstepB : cB;
        for (int t = 0; t < nt; t += 2) {
            const bool last = (t == nt - 2);
            const char* a1 = cA + (size_t)(t + 1) * kstep;
            const char* a2 = last ? nA : cA + (size_t)(t + 2) * kstep; const char* b2 = last ? nB : cB + (size_t)(t + 2) * kstep;
            const char* a3 = a2 + kstep; const char* b3 = b2 + kstep;
            if (last && has_next) S.a_ready(nxt);
            if constexpr (SP2) {
            PG8_LDB(B0, 0, 0); PG8_LDB(B1, 0, 1); PG8_SCHED; PG8_LDA(At, 0, 0); PG8_STAGE(PG8_SA(1, 1), a1 + hstepA, voffA);
            PG8_WAIT_V(8); PG8_WAIT_L(0); PG8_BAR; PG8_MMA(0, 0, At, B0); PG8_MMA(0, 1, At, B1); PG8_BAR; PG8_SCHED;
            PG8_LDA(At, 0, 1); PG8_STAGE(PG8_SB(0, 0), b2, voffB); PG8_STAGE(PG8_SB(0, 1), b2 + hstepB, voffB); PG8_STAGE(PG8_SA(0, 0), a2, voffA);
            PG8_WAIT_V(8); PG8_WAIT_L(0); PG8_BAR; PG8_MMA(1, 0, At, B0); PG8_MMA(1, 1, At, B1); PG8_BAR; PG8_SCHED;
            PG8_LDB(B0, 1, 0); PG8_LDB(B1, 1, 1); PG8_SCHED; PG8_LDA(At, 1, 0); PG8_STAGE(PG8_SA(0, 1), a2 + hstepA, voffA);
            PG8_WAIT_V(8); PG8_WAIT_L(0); PG8_BAR; PG8_MMA(0, 0, At, B0); PG8_MMA(0, 1, At, B1); PG8_BAR; PG8_SCHED;
            PG8_LDA(At, 1, 1); PG8_STAGE(PG8_SB(1, 0), b3, voffB); PG8_STAGE(PG8_SB(1, 1), b3 + hstepB, voffB); PG8_STAGE(PG8_SA(1, 0), a3, voffA);
            PG8_WAIT_V(8); PG8_WAIT_L(0); PG8_BAR; PG8_MMA(1, 0, At, B0); PG8_MMA(1, 1, At, B1); PG8_BAR; PG8_SCHED;
            } else {
            PG8_LDB(B0, 0, 0); PG8_SCHED; PG8_LDA(At, 0, 0); PG8_STAGE(PG8_SA(1, 1), a1 + hstepA, voffA);
            PG8_WAIT_L(8); PG8_BAR; PG8_WAIT_L(0); PG8_MMA(0, 0, At, B0); PG8_BAR; PG8_SCHED;
            PG8_LDB(B1, 0, 1); PG8_STAGE(PG8_SB(0, 0), b2, voffB);
            PG8_BAR; PG8_WAIT_L(0); PG8_MMA(0, 1, At, B1); PG8_BAR;
            PG8_LDA(At, 0, 1); PG8_STAGE(PG8_SA(0, 0), a2, voffA);
            PG8_BAR; PG8_WAIT_L(0); PG8_MMA(1, 0, At, B0); PG8_BAR; PG8_SCHED;
            PG8_STAGE(PG8_SB(0, 1), b2 + hstepB, voffB);
            PG8_WAIT_V(6); PG8_BAR; PG8_MMA(1, 1, At, B1); PG8_BAR;
            PG8_LDB(B0, 1, 0); PG8_SCHED; PG8_LDA(At, 1, 0); PG8_STAGE(PG8_SA(0, 1), a2 + hstepA, voffA);
            PG8_WAIT_L(8); PG8_BAR; PG8_WAIT_L(0); PG8_MMA(0, 0, At, B0); PG8_BAR; PG8_SCHED;
            PG8_LDB(B1, 1, 1); PG8_STAGE(PG8_SB(1, 0), b3, voffB);
            PG8_BAR; PG8_WAIT_L(0); PG8_MMA(0, 1, At, B1); PG8_BAR;
            PG8_LDA(At, 1, 1); PG8_STAGE(PG8_SA(1, 0), a3, voffA);
            PG8_BAR; PG8_WAIT_L(0); PG8_MMA(1, 0, At, B0); PG8_BAR; PG8_SCHED;
            PG8_STAGE(PG8_SB(1, 1), b3 + hstepB, voffB);
            PG8_WAIT_V(6); PG8_BAR; PG8_MMA(1, 1, At, B1); PG8_BAR;
            }
        }
        if constexpr (ALIGN_EPI) { if (wr == 0) PG8_BAR; }
        if constexpr (!Epi::AFTER_DRAIN) { E(acc, cur, wr, wc, fr, fq); S.done(cur); }
        if (!has_next) break;
#pragma unroll
        for (int a = 0; a < 2; ++a)
#pragma unroll
            for (int b = 0; b < 2; ++b)
#pragma unroll
                for (int m = 0; m < 4; ++m)
#pragma unroll
                    for (int n = 0; n < 2; ++n) acc[a][b][m][n] = (f32x4){0.f, 0.f, 0.f, 0.f};
        cur = nxt; cA = nA; cB = nB; ++ui;
        if constexpr (ALIGN_EPI) { if (wr == 1) PG8_BAR; }
    }
    PG8_WAIT_V(0);
    if constexpr (!ALIGN_EPI) { if (wr == 0) PG8_BAR; }
    PG8_BAR;
    if constexpr (Epi::AFTER_DRAIN) { E.fused(acc, cur, wr, wc, fr, fq, lds, wid, lane); S.done(cur); }
#undef PG8_SA
#undef PG8_SB
#undef PG8_STAGE
#undef PG8_LDA
#undef PG8_LDB
#undef PG8_MMA
#undef PG8_WAIT_V
#undef PG8_WAIT_L
#undef PG8_BAR
#undef PG8_SCHED
}
struct EpiU {
    static constexpr bool PERM = true, AFTER_DRAIN = false;
    bf16_t* O; int ldc; const float* rsq;
    __device__ __forceinline__ void operator()(const f32x4 (&acc)[2][2][4][2], const Unit& u, int wr, int wc, int fr, int fq) const {
        const int row0 = u.pm * BM + wr * 64 + fr, col0 = u.pn * BM + wc * 32 + 8 * fq;
#pragma unroll
        for (int ai = 0; ai < 2; ++ai)
#pragma unroll
            for (int m = 0; m < 4; ++m) { bf16_t* rowp = O + (size_t)(row0 + ai * HALF + m * 16) * ldc + col0;
                const float rs = rsqrtf(rsq[row0 + ai * HALF + m * 16] * (1.f / DM) + EPS);
#pragma unroll
                for (int bj = 0; bj < 2; ++bj) { const f32x4 v0 = acc[ai][bj][m][0] * rs, v1 = acc[ai][bj][m][1] * rs;
                    u32x4 w; w.x = cvt_pk_bf16(v0[0], v0[1]); w.y = cvt_pk_bf16(v0[2], v0[3]); w.z = cvt_pk_bf16(v1[0], v1[1]); w.w = cvt_pk_bf16(v1[2], v1[3]);
                    *(u32x4*)(rowp + bj * HALF) = w; } }
    }
};
struct EpiQ {
    static constexpr bool PERM = true, AFTER_DRAIN = false;
    bf16_t* Q; const float* cs; const float* sn;
    __device__ __forceinline__ void operator()(const f32x4 (&acc)[2][2][4][2], const Unit& u, int wr, int wc, int fr, int fq) const {
        const int row0 = u.pm * BM + wr * 64 + fr;
#pragma unroll
        for (int ai = 0; ai < 2; ++ai)
#pragma unroll
            for (int m = 0; m < 4; ++m) { const int row = row0 + ai * HALF + m * 16, b = row / T, t = row % T;
#pragma unroll
                for (int bj = 0; bj < 2; ++bj) { const int c = u.pn * BM + bj * HALF + wc * 32 + 8 * fq, hh = c / 192, e = c % 192;
                    const f32x4 v0 = acc[ai][bj][m][0], v1 = acc[ai][bj][m][1];
                    float vals[8] = {v0[0], v0[1], v0[2], v0[3], v1[0], v1[1], v1[2], v1[3]};
                    if (e >= 128) { const int i0 = (e - 128) >> 1; const f32x4 cc = *(const f32x4*)(cs + (size_t)row * 32 + i0), ss = *(const f32x4*)(sn + (size_t)row * 32 + i0);
#pragma unroll
                        for (int p = 0; p < 4; ++p) { const float x1 = vals[2 * p], x2 = vals[2 * p + 1]; vals[2 * p] = x1 * cc[p] - x2 * ss[p]; vals[2 * p + 1] = x2 * cc[p] + x1 * ss[p]; } }
                    constexpr float QS = 0.07216878364870322f * 1.4426950408889634f;
#pragma unroll
                    for (int p_ = 0; p_ < 8; ++p_) vals[p_] *= QS;
                    u32x4 w; w.x = cvt_pk_bf16(vals[0], vals[1]); w.y = cvt_pk_bf16(vals[2], vals[3]); w.z = cvt_pk_bf16(vals[4], vals[5]); w.w = cvt_pk_bf16(vals[6], vals[7]);
                    *(u32x4*)(Q + ((size_t)(b * 8 + hh) * T + t) * 192 + e) = w; } }
    }
};
struct EpiKV {
    static constexpr bool PERM = true, AFTER_DRAIN = false;
    bf16_t* KN; bf16_t* V;
    __device__ __forceinline__ void operator()(const f32x4 (&acc)[2][2][4][2], const Unit& u, int wr, int wc, int fr, int fq) const {
        const int row0 = u.pm * BM + wr * 64 + fr, e = wc * 32 + 8 * fq;
#pragma unroll
        for (int ai = 0; ai < 2; ++ai)
#pragma unroll
            for (int m = 0; m < 4; ++m) { const int row = row0 + ai * HALF + m * 16, b = row / T, t = row % T;
                const size_t off = ((size_t)(b * 8 + u.pn) * T + t) * 128 + e;
#pragma unroll
                for (int bj = 0; bj < 2; ++bj) { const f32x4 v0 = acc[ai][bj][m][0], v1 = acc[ai][bj][m][1];
                    u32x4 w; w.x = cvt_pk_bf16(v0[0], v0[1]); w.y = cvt_pk_bf16(v0[2], v0[3]); w.z = cvt_pk_bf16(v1[0], v1[1]); w.w = cvt_pk_bf16(v1[2], v1[3]);
                    *(u32x4*)((bj ? V : KN) + off) = w; } }
    }
};
struct EpiSwi {
    static constexpr bool PERM = false, AFTER_DRAIN = false;
    bf16_t* H; const float* rsq;
    __device__ __forceinline__ void operator()(const f32x4 (&acc)[2][2][4][2], const Unit& u, int wr, int wc, int fr, int fq) const {
        const int row0 = u.pm * BM + wr * 64 + fr;
#pragma unroll
        for (int ai = 0; ai < 2; ++ai)
#pragma unroll
            for (int m = 0; m < 4; ++m) { bf16_t* rowp = H + (size_t)(row0 + ai * HALF + m * 16) * DFF;
                const float rs = rsqrtf(rsq[row0 + ai * HALF + m * 16] * (1.f / DM) + EPS);
#pragma unroll
                for (int bj = 0; bj < 2; ++bj) { const f32x4 a = acc[ai][bj][m][0] * rs, g = acc[ai][bj][m][1] * rs;
                    const int col = 16 * (8 * u.pn + 4 * bj + wc) + 4 * fq;
                    u32x2 w; w.x = cvt_pk_bf16(silu_(a[0]) * g[0], silu_(a[1]) * g[1]); w.y = cvt_pk_bf16(silu_(a[2]) * g[2], silu_(a[3]) * g[3]);
                    *(u32x2*)(rowp + col) = w; } }
    }
};
struct EpiRes {
    static constexpr bool PERM = false, AFTER_DRAIN = false;
    const float* base; float* out; bf16_t* hb; float* rsq;
    __device__ __forceinline__ void operator()(const f32x4 (&acc)[2][2][4][2], const Unit& u, int wr, int wc, int fr, int fq) const {
        const int row0 = u.pm * BM + wr * 64 + fr, col0 = u.pn * BM + wc * 32 + 4 * fq;
#pragma unroll
        for (int ai = 0; ai < 2; ++ai)
#pragma unroll
            for (int m = 0; m < 4; ++m) { const size_t off = (size_t)(row0 + ai * HALF + m * 16) * DM + col0; float ss = 0.f;
#pragma unroll
                for (int bj = 0; bj < 2; ++bj)
#pragma unroll
                    for (int n = 0; n < 2; ++n) { const f32x4 bs = *(const f32x4*)(base + off + bj * HALF + n * 16); const f32x4 o = bs + acc[ai][bj][m][n];
                        *(f32x4*)(out + off + bj * HALF + n * 16) = o;
                        u32x2 w; w.x = cvt_pk_bf16(o[0], o[1]); w.y = cvt_pk_bf16(o[2], o[3]); *(u32x2*)(hb + off + bj * HALF + n * 16) = w;
                        ss += (o[0] * o[0] + o[1] * o[1]) + (o[2] * o[2] + o[3] * o[3]); }
                ss += __shfl_xor(ss, 16); ss += __shfl_xor(ss, 32);
                if (fq == 0) unsafeAtomicAdd(rsq + row0 + ai * HALF + m * 16, ss); }
    }
};

}
namespace att {
constexpr int KVBLK = 64;
constexpr float SCALE = 0.07216878364870322f;
constexpr float THR = 8.f;
constexpr int SHM_V = KVBLK * 128 * 2, SHM_K = KVBLK * 192 * 2;
#ifndef ATT_SDEPTH
#define ATT_SDEPTH 1
#endif
constexpr int SDEPTH = ATT_SDEPTH;
#define KSWZ(row, colB) ((row) * 384 + ((colB) ^ (((row) & 7) << 4)))
#define SBAR() __builtin_amdgcn_sched_barrier(0)
__device__ __forceinline__ int crow(int r, int hi) { return (r & 3) + 8 * (r >> 2) + 4 * hi; }
__device__ __forceinline__ unsigned cvtpk(float lo, float hi) { return cvt_pk_bf16(lo, hi); }
template <bool FIRST>
__device__ __forceinline__ void partialSM(f32x16& p0, f32x16& p1, float& m_reg, float& alpha) {
  constexpr float THR2 = THR * 1.4426950408889634f;
  float pmax = p0[0];
#pragma unroll
  for (int r = 1; r < 16; ++r) pmax = fmaxf(pmax, p0[r]);
#pragma unroll
  for (int r = 0; r < 16; ++r) pmax = fmaxf(pmax, p1[r]);
  { auto rr = __builtin_amdgcn_permlane32_swap(__float_as_uint(pmax), __float_as_uint(pmax), false, false);
    pmax = fmaxf(__uint_as_float(rr[0]), __uint_as_float(rr[1])); }
  if (!FIRST && __builtin_expect(__all(pmax <= THR2), 1)) { alpha = 1.f; }
  else { const float d = FIRST ? pmax : fmaxf(pmax, 0.f); alpha = FIRST ? 1.f : __builtin_amdgcn_exp2f(-d); m_reg += d;
#pragma unroll
    for (int r = 0; r < 16; ++r) p0[r] -= d;
#pragma unroll
    for (int r = 0; r < 16; ++r) p1[r] -= d; }
#pragma unroll
  for (int r = 0; r < 16; ++r) p0[r] = __builtin_amdgcn_exp2f(p0[r]);
}
__device__ __forceinline__ void finishSM(f32x16& p0, f32x16& p1, float alpha, float& l_reg, bf16x8& pa0, bf16x8& pa1, bf16x8& pa2, bf16x8& pa3) {
#pragma unroll
  for (int r = 0; r < 16; ++r) p1[r] = __builtin_amdgcn_exp2f(p1[r]);
  float ps = 0;
#pragma unroll
  for (int r = 0; r < 16; ++r) ps += p0[r];
#pragma unroll
  for (int r = 0; r < 16; ++r) ps += p1[r];
  { auto rr = __builtin_amdgcn_permlane32_swap(__float_as_uint(ps), __float_as_uint(ps), false, false);
    ps = __uint_as_float(rr[0]) + __uint_as_float(rr[1]); }
  l_reg = l_reg * alpha + ps;
#define PK4(P, BASE, OUT) do { unsigned a0 = cvtpk(P[BASE + 0], P[BASE + 1]), a1 = cvtpk(P[BASE + 2], P[BASE + 3]);   \
    unsigned b0 = cvtpk(P[BASE + 4], P[BASE + 5]), b1 = cvtpk(P[BASE + 6], P[BASE + 7]);                              \
    auto r0 = __builtin_amdgcn_permlane32_swap(a0, b0, false, false); auto r1 = __builtin_amdgcn_permlane32_swap(a1, b1, false, false); \
    u32x4 w = {r0[0], r1[0], r0[1], r1[1]}; OUT = __builtin_bit_cast(bf16x8, w); } while (0)
  PK4(p0, 0, pa0); PK4(p0, 8, pa1); PK4(p1, 0, pa2); PK4(p1, 8, pa3);
#undef PK4
}
__device__ __forceinline__ void qkt(f32x16& p0, f32x16& p1, const char* Ks, const bf16x8* qr, const char* qL, int r32, int hi, float negm) {
#pragma unroll
  for (int r = 0; r < 16; ++r) { p0[r] = negm; p1[r] = negm; }
#pragma unroll
  for (int d0 = 0; d0 < 12; ++d0) { int cb = (d0 * 16 + hi * 8) * 2;
    bf16x8 b0 = *reinterpret_cast<const bf16x8*>(Ks + KSWZ(r32, cb));
    bf16x8 b1 = *reinterpret_cast<const bf16x8*>(Ks + KSWZ(32 + r32, cb));
    const bf16x8 q = d0 < 8 ? qr[d0 < 8 ? d0 : 0] : *reinterpret_cast<const bf16x8*>(qL + (d0 - 8) * 1024);
    p0 = __builtin_amdgcn_mfma_f32_32x32x16_bf16(b0, q, p0, 0, 0, 0);
    p1 = __builtin_amdgcn_mfma_f32_32x32x16_bf16(b1, q, p1, 0, 0, 0); }
}
__device__ __forceinline__ int v_st(int k, int c) { const int kk = (k & ~0xC) | ((k & 4) << 1) | ((k & 8) >> 1); return ((kk >> 3) * 4 + (c >> 5)) * 512 + ((kk & 7) * 32 + (c & 31)) * 2; }
__device__ __forceinline__ int v_rd_base(int lane) { return ((lane & 3) << 3) | (((lane >> 2) & 3) << 6) | (((lane >> 4) & 1) << 5) | (((lane >> 5) & 1) << 8); }
constexpr int v_rd_off(int d0, int ks, int half) { return d0 * 512 + ks * 4096 + half * 2048; }
template <int OFF> __device__ __forceinline__ s16x4 tr_read(int vb) {
  s16x4 r; asm volatile("ds_read_b64_tr_b16 %0, %1 offset:%2" : "=&v"(r) : "v"(vb), "i"(OFF) : "memory"); return r;
}
template <int D0> __device__ __forceinline__ void pv_one(f32x16& od, int vb, bf16x8 pa0, bf16x8 pa1, bf16x8 pa2, bf16x8 pa3) {
  const s16x4 l0 = tr_read<v_rd_off(D0, 0, 0)>(vb), h0 = tr_read<v_rd_off(D0, 0, 1)>(vb), l1 = tr_read<v_rd_off(D0, 1, 0)>(vb), h1 = tr_read<v_rd_off(D0, 1, 1)>(vb);
  const s16x4 l2 = tr_read<v_rd_off(D0, 2, 0)>(vb), h2 = tr_read<v_rd_off(D0, 2, 1)>(vb), l3 = tr_read<v_rd_off(D0, 3, 0)>(vb), h3 = tr_read<v_rd_off(D0, 3, 1)>(vb);
  asm volatile("s_waitcnt lgkmcnt(0)" ::: "memory"); SBAR();
#define PK(L, H) (bf16x8){L[0], L[1], L[2], L[3], H[0], H[1], H[2], H[3]}
  od = __builtin_amdgcn_mfma_f32_32x32x16_bf16(pa0, PK(l0, h0), od, 0, 0, 0);
  od = __builtin_amdgcn_mfma_f32_32x32x16_bf16(pa1, PK(l1, h1), od, 0, 0, 0);
  od = __builtin_amdgcn_mfma_f32_32x32x16_bf16(pa2, PK(l2, h2), od, 0, 0, 0);
  od = __builtin_amdgcn_mfma_f32_32x32x16_bf16(pa3, PK(l3, h3), od, 0, 0, 0);
#undef PK
}
__device__ __forceinline__ void pv_d0(f32x16* o, int vb, bf16x8 pa0, bf16x8 pa1, bf16x8 pa2, bf16x8 pa3) {
  pv_one<0>(o[0], vb, pa0, pa1, pa2, pa3); pv_one<1>(o[1], vb, pa0, pa1, pa2, pa3); pv_one<2>(o[2], vb, pa0, pa1, pa2, pa3); pv_one<3>(o[3], vb, pa0, pa1, pa2, pa3);
}
__device__ __forceinline__ void attn_unit(const bf16_t* __restrict__ Qb, const bf16_t* __restrict__ Kn, const bf16_t* __restrict__ Kr, const bf16_t* __restrict__ Vh,
                                          bf16_t* __restrict__ Ob, char* lds) {
  const int tid = opaque_tid(), wid = tid >> 6, lane = tid & 63, r32 = lane & 31, hi = lane >> 5;
  char* V_lds = lds; char* K_lds = lds + 2 * SHM_V;
  float* ws = (float*)(lds + 2 * SHM_V + 2 * SHM_K) + wid * 64; float* li_l = ws; float* al_l = ws + 32;
  float m_reg = 0.f, l_reg = 0; f32x16 o[4] = {}; bf16x8 qr[8];
  char* qL = lds + 2 * SHM_V + 2 * SHM_K + 2048 + wid * 4096 + lane * 16;
  const bf16_t* Qw = Qb + (long)(wid * 32 + r32) * 192 + hi * 8;
#pragma unroll
  for (int d0 = 0; d0 < 8; ++d0) qr[d0] = *reinterpret_cast<const bf16x8*>(Qw + d0 * 16);
#pragma unroll
  for (int d0 = 8; d0 < 12; ++d0) *reinterpret_cast<bf16x8*>(qL + (d0 - 8) * 1024) = *reinterpret_cast<const bf16x8*>(Qw + d0 * 16);
  const int sr = tid >> 4, sc = (tid & 15) * 8, vst0 = v_st(sr, sc), vst1 = v_st(32 + sr, sc);
  const int rr = tid >> 3, rc = (tid & 7) * 8;
  const int kst0 = KSWZ(sr, sc * 2), kst1 = KSWZ(32 + sr, sc * 2), kst2 = KSWZ(rr, 256 + rc * 2);
  const int vb0 = (int)(uintptr_t)V_lds + v_rd_base(lane);
  struct { bf16x8 vs0, vs1, ks0, ks1, ks2; } sr_[SDEPTH];
#define SLOAD(i, k0) do { sr_[i].vs0 = *(const bf16x8*)(&Vh[(long)((k0) + sr) * 128 + sc]); sr_[i].vs1 = *(const bf16x8*)(&Vh[(long)((k0) + 32 + sr) * 128 + sc]); \
    sr_[i].ks0 = *(const bf16x8*)(&Kn[(long)((k0) + sr) * 128 + sc]); sr_[i].ks1 = *(const bf16x8*)(&Kn[(long)((k0) + 32 + sr) * 128 + sc]); \
    sr_[i].ks2 = *(const bf16x8*)(&Kr[(long)((k0) + rr) * 64 + rc]); } while (0)
#define SWRITE(b, i) do { *(bf16x8*)(V_lds + (b) * SHM_V + vst0) = sr_[i].vs0; *(bf16x8*)(V_lds + (b) * SHM_V + vst1) = sr_[i].vs1; \
    *(bf16x8*)(K_lds + (b) * SHM_K + kst0) = sr_[i].ks0; *(bf16x8*)(K_lds + (b) * SHM_K + kst1) = sr_[i].ks1; *(bf16x8*)(K_lds + (b) * SHM_K + kst2) = sr_[i].ks2; } while (0)
#define SWAIT() do { if constexpr (SDEPTH == 2) asm volatile("s_waitcnt vmcnt(5)" ::: "memory"); else asm volatile("s_waitcnt vmcnt(0)" ::: "memory"); } while (0)
#define RESC(a) do { if (__any((a) < 1.f)) { if (hi == 0) al_l[r32] = (a); asm volatile("s_waitcnt lgkmcnt(0)" ::: "memory"); \
    _Pragma("unroll") for (int d = 0; d < 4; ++d) _Pragma("unroll") for (int r = 0; r < 16; ++r) o[d][r] *= al_l[crow(r, hi)]; } } while (0)
  f32x16 pA0, pA1, pB0, pB1; float alA, alB; bf16x8 pa0, pa1, pa2, pa3; const int NT = T / KVBLK;
  constexpr int SE = 0, SO = SDEPTH - 1;
  SLOAD(SE, 0); asm volatile("s_waitcnt vmcnt(0)" ::: "memory"); SWRITE(0, SE); __syncthreads();
  qkt(pA0, pA1, K_lds, qr, qL, r32, hi, 0.f); partialSM<true>(pA0, pA1, m_reg, alA);
  SLOAD(SO, KVBLK); if constexpr (SDEPTH == 2) { if (2 < NT) SLOAD(SE, 2 * KVBLK); }
  SWAIT(); SWRITE(1, SO); __syncthreads();
  for (int j = 1; j + 1 < NT; j += 2) {
    SBAR(); qkt(pB0, pB1, K_lds + SHM_K, qr, qL, r32, hi, -m_reg);
    finishSM(pA0, pA1, alA, l_reg, pa0, pa1, pa2, pa3); SBAR();
    SLOAD(SO, (j + SDEPTH) * KVBLK); SBAR();
    pv_d0(o, vb0, pa0, pa1, pa2, pa3); partialSM<false>(pB0, pB1, m_reg, alB);
    __syncthreads(); SWAIT(); SWRITE(0, SE);
    RESC(alB); __syncthreads();
    SBAR(); qkt(pA0, pA1, K_lds, qr, qL, r32, hi, -m_reg);
    finishSM(pB0, pB1, alB, l_reg, pa0, pa1, pa2, pa3); SBAR();
    if (SDEPTH == 1 || j + 3 < NT) SLOAD(SE, (j + 1 + SDEPTH) * KVBLK); SBAR();
    pv_d0(o, vb0 + (int)SHM_V, pa0, pa1, pa2, pa3); partialSM<false>(pA0, pA1, m_reg, alA);
    __syncthreads(); SWAIT(); SWRITE(1, SO);
    RESC(alA); __syncthreads();
  }
  SBAR(); qkt(pB0, pB1, K_lds + SHM_K, qr, qL, r32, hi, -m_reg);
  finishSM(pA0, pA1, alA, l_reg, pa0, pa1, pa2, pa3); SBAR();
  pv_d0(o, vb0, pa0, pa1, pa2, pa3); partialSM<false>(pB0, pB1, m_reg, alB);
  __syncthreads(); RESC(alB);
  finishSM(pB0, pB1, alB, l_reg, pa0, pa1, pa2, pa3); SBAR();
  pv_d0(o, vb0 + (int)SHM_V, pa0, pa1, pa2, pa3);
  if (hi == 0) li_l[r32] = l_reg; asm volatile("s_waitcnt lgkmcnt(0)" ::: "memory");
  float rli[16];
#pragma unroll
  for (int r = 0; r < 16; ++r) rli[r] = __builtin_amdgcn_rcpf(li_l[crow(r, hi)]);
  bf16_t* Ow = Ob + (long)(wid * 32) * DM;
#pragma unroll
  for (int r = 0; r < 16; ++r) { int orow = crow(r, hi);
#pragma unroll
    for (int d0 = 0; d0 < 4; ++d0) Ow[(long)orow * DM + d0 * 32 + r32] = (bf16_t)f2bf(o[d0][r] * rli[r]); }
#undef SLOAD
#undef SWRITE
#undef SWAIT
#undef RESC
  __syncthreads();
}
}
namespace scan {
constexpr int LDT = 72;
constexpr int SC_G = 0, SC_K = 33792, SC_QT = SC_K + 17408, SC_QG = SC_QT + 17408, SC_VT = SC_QG + 17408, SC_P = SC_VT + 18432, SC_SEG = SC_P + 9216, SC_RSQ = SC_SEG + 4096,
              SC_END = SC_RSQ + 2048, SC_KDT = SC_QT;
static_assert(SC_END <= LDS_BYTES, "scan LDS");

template <int TYPE> struct Cfg { static constexpr int DK = TYPE ? 128 : 64, LDG = DK + 4, LDK_ = DK + 8, ND8 = DK / 8; };

struct LgRaw { bf16x8 a0, a1, k; };
template <int TYPE>
__device__ __forceinline__ LgRaw lg_issue(const bf16_t* u, int h, int dir, size_t tok0, int tid) {
    LgRaw r;
    if constexpr (TYPE == 1) {
        const int i0 = tid >> 4, d8 = tid & 15, col = (dir ? C_HFB : C_HFF) + h * 128 + d8 * 8;
        r.a0 = *(const bf16x8*)(u + (tok0 + i0) * DINP + col); r.a1 = *(const bf16x8*)(u + (tok0 + 32 + i0) * DINP + col); r.k = r.a0;
    } else {
        const int i = tid >> 3, d8 = tid & 7; const bf16_t* ur = u + (tok0 + i) * DINP;
        r.a0 = *(const bf16x8*)(ur + (dir ? C_GAB : C_GAF)); r.a1 = *(const bf16x8*)(ur + (dir ? C_GAB : C_GAF) + 8); r.k = *(const bf16x8*)(ur + C_GK + h * 64 + d8 * 8);
    }
    return r;
}
template <int TYPE>
__device__ __forceinline__ void lg_compute(const KArgs& a, unsigned char* wsb, int l, int h, int dir, const LgRaw& raw, LAS unsigned char* lds, int tid) {
    using C = Cfg<TYPE>;
    LAS float* G = (LAS float*)(lds + SC_G); LAS bf16_t* Kb = (LAS bf16_t*)(lds + SC_K);
    if constexpr (TYPE == 1) {
        const float* lbp = (const float*)(wsb + WS_LB) + (dir * DEPTH + l) * 512 + h * 128;
        const int d8 = tid & 15;
        const f32x4 lb0 = *(const f32x4*)(lbp + d8 * 8), lb1 = *(const f32x4*)(lbp + d8 * 8 + 4);
        const float lb[8] = {lb0[0], lb0[1], lb0[2], lb0[3], lb1[0], lb1[1], lb1[2], lb1[3]};
#pragma unroll
        for (int e2 = 0; e2 < 2; ++e2) { const int i = (tid >> 4) + 32 * e2;
            float z[8], lg[8], kk[8]; unpack8(e2 ? raw.a1 : raw.a0, z);
#pragma unroll
            for (int e = 0; e < 8; ++e) { const float sg = sigmoid_(fmaxf(z[e], -80.f)); lg[e] = __logf(lb[e] + (1.f - lb[e]) * sg); kk[e] = (1.f - lb[e]) * (1.f - sg); }
            *(LAS f32x4*)(G + i * C::LDG + d8 * 8) = (f32x4){lg[0], lg[1], lg[2], lg[3]}; *(LAS f32x4*)(G + i * C::LDG + d8 * 8 + 4) = (f32x4){lg[4], lg[5], lg[6], lg[7]};
            *(LAS bf16x8*)(Kb + i * C::LDK_ + d8 * 8) = pack8(kk); }
    } else {
        const int i = tid >> 3, d8 = tid & 7;
        float ua[16]; unpack8(raw.a0, ua); unpack8(raw.a1, ua + 8);
        const float* up = (const float*)a.in[3] + (size_t)((l * 2 + dir) * 16) * 256 + h * 64 + d8 * 8;
        const float* bs = (const float*)a.in[4] + (l * 2 + dir) * 256 + h * 64 + d8 * 8;
        f32x4 z0 = *(const f32x4*)bs, z1 = *(const f32x4*)(bs + 4);
#pragma unroll
        for (int r = 0; r < 16; ++r) { z0 += ua[r] * *(const f32x4*)(up + r * 256); z1 += ua[r] * *(const f32x4*)(up + r * 256 + 4); }
        f32x4 g0, g1;
#pragma unroll
        for (int e = 0; e < 4; ++e) { g0[e] = logsigmoid_(z0[e]) * (1.f / 16.f); g1[e] = logsigmoid_(z1[e]) * (1.f / 16.f); }
        *(LAS f32x4*)(G + i * C::LDG + d8 * 8) = g0; *(LAS f32x4*)(G + i * C::LDG + d8 * 8 + 4) = g1;
        *(LAS bf16x8*)(Kb + i * C::LDK_ + d8 * 8) = raw.k;
    }
}
template <int TYPE>
__device__ __forceinline__ void cumsum_g(int dir, LAS unsigned char* lds, int tid) {
    using C = Cfg<TYPE>; constexpr int NSEG = 512 / C::DK, SEGL = 64 / NSEG;
    LAS float* G = (LAS float*)(lds + SC_G); LAS float* SG = (LAS float*)(lds + SC_SEG);
    const int d = tid % C::DK, seg = tid / C::DK;
    __syncthreads();
    float run = 0.f;
#pragma unroll
    for (int ii = 0; ii < SEGL; ++ii) { const int i = seg * SEGL + (dir ? SEGL - 1 - ii : ii); run += G[i * C::LDG + d]; G[i * C::LDG + d] = run; }
    SG[seg * 128 + d] = run;
    __syncthreads();
    float off = 0.f;
#pragma unroll
    for (int s = 0; s < NSEG; ++s) { const bool before = dir ? (s > seg) : (s < seg); if (before) off += SG[s * 128 + d]; }
#pragma unroll
    for (int ii = 0; ii < SEGL; ++ii) { const int i = seg * SEGL + ii; G[i * C::LDG + d] += off; }
    __syncthreads();
}
struct VRaw { bf16x8 x0, x1; };
__device__ __forceinline__ VRaw vT_issue(const bf16_t* vsrc, int tid) {
    const int i0 = tid >> 4, v8 = tid & 15; VRaw r;
    r.x0 = *(const bf16x8*)(vsrc + (size_t)i0 * DINP + v8 * 8); r.x1 = *(const bf16x8*)(vsrc + (size_t)(32 + i0) * DINP + v8 * 8); return r;
}
__device__ __forceinline__ void vT_write(const VRaw& r, LAS unsigned char* lds, int tid) {
    LAS bf16_t* VT = (LAS bf16_t*)(lds + SC_VT);
    const int v8 = tid & 15;
#pragma unroll
    for (int e2 = 0; e2 < 2; ++e2) { const int i = (tid >> 4) + 32 * e2; const bf16x8 x = e2 ? r.x1 : r.x0; const int pc = ((((i >> 3) ^ (v8 & 7)) << 3) | (i & 7));
#pragma unroll
        for (int e = 0; e < 8; ++e) VT[(v8 * 8 + e) * LDT + pc] = (bf16_t)x[e]; }
}
__device__ __forceinline__ bf16x8 vt_frag(LAS bf16_t* VT, int v, int c8) {
    return *(LAS bf16x8*)(VT + v * LDT + ((c8 ^ ((v >> 3) & 7)) << 3));
}

template <int TYPE>
__device__ __forceinline__ void pass1_item(const KArgs& a, int l, int item, LAS unsigned char* lds) {
    unsigned char* const wsb = opq(a.ws);
    const int tid = opaque_tid();
    using C = Cfg<TYPE>; constexpr int DK = C::DK;
    const int c = item & (NCH - 1), dir = (item >> 8) & 1, h = (item >> 9) & 3, b = item >> 11;
    const size_t tok0 = (size_t)b * T + (size_t)c * 64;
    const bf16_t* u = (const bf16_t*)(wsb + WS_U);
    const int wid = tid >> 6, lane = tid & 63, fr = lane & 15, fq = lane >> 4;
    __syncthreads();
    { const LgRaw raw = lg_issue<TYPE>(u, h, dir, tok0, tid); const VRaw vr = vT_issue(u + tok0 * DINP + (TYPE ? C_HI : C_GV) + h * 128, tid);
      lg_compute<TYPE>(a, wsb, l, h, dir, raw, lds, tid); vT_write(vr, lds, tid); }
    cumsum_g<TYPE>(dir, lds, tid);
    LAS float* G = (LAS float*)(lds + SC_G); LAS bf16_t* Kb = (LAS bf16_t*)(lds + SC_K); LAS bf16_t* KDT = (LAS bf16_t*)(lds + SC_KDT); LAS bf16_t* VT = (LAS bf16_t*)(lds + SC_VT);
    const int last = dir ? 0 : 63;
    float* Dout = (float*)(wsb + (TYPE ? WS_DH : WS_DG)) + (size_t)item * DK;
#pragma unroll
    for (int e2 = 0; e2 < DK / 64; ++e2) { const int task = tid + 512 * e2, i = task & 63, d8 = task >> 6;
        const f32x4 g0 = *(LAS f32x4*)(G + i * C::LDG + d8 * 8), g1 = *(LAS f32x4*)(G + i * C::LDG + d8 * 8 + 4);
        const f32x4 t0 = *(LAS f32x4*)(G + last * C::LDG + d8 * 8), t1 = *(LAS f32x4*)(G + last * C::LDG + d8 * 8 + 4);
        float kk[8]; unpack8(*(LAS bf16x8*)(Kb + i * C::LDK_ + d8 * 8), kk);
#pragma unroll
        for (int e = 0; e < 8; ++e) { const float gg = e < 4 ? g0[e] : g1[e - 4], tt = e < 4 ? t0[e] : t1[e - 4];
            KDT[(d8 * 8 + e) * LDT + i] = (bf16_t)f2bf(kk[e] * __expf(tt - gg)); }
        if (i == 0) { *(f32x4*)(Dout + d8 * 8) = (f32x4){__expf(t0[0]), __expf(t0[1]), __expf(t0[2]), __expf(t0[3])};
                      *(f32x4*)(Dout + d8 * 8 + 4) = (f32x4){__expf(t1[0]), __expf(t1[1]), __expf(t1[2]), __expf(t1[3])}; } }
    __syncthreads();
    bf16_t* ST = (bf16_t*)(wsb + (TYPE ? WS_SH : WS_SG)) + (size_t)item * 128 * DK;
    const bf16x8 b0 = vt_frag(VT, wid * 16 + fr, fq), b1 = vt_frag(VT, wid * 16 + fr, 4 + fq);
#pragma unroll
    for (int dt = 0; dt < DK / 16; ++dt) {
        const bf16x8 a0 = *(LAS bf16x8*)(KDT + (dt * 16 + fr) * LDT + fq * 8), a1 = *(LAS bf16x8*)(KDT + (dt * 16 + fr) * LDT + 32 + fq * 8);
        f32x4 acc = {0.f, 0.f, 0.f, 0.f};
        acc = __builtin_amdgcn_mfma_f32_16x16x32_bf16(a0, b0, acc, 0, 0, 0);
        acc = __builtin_amdgcn_mfma_f32_16x16x32_bf16(a1, b1, acc, 0, 0, 0);
        u32x2 w; w.x = cvt_pk_bf16(acc[0], acc[1]); w.y = cvt_pk_bf16(acc[2], acc[3]);
        *(u32x2*)(ST + (size_t)(wid * 16 + fr) * DK + dt * 16 + fq * 4) = w;
    }
}

struct P2Chain { bf16_t* st; const float* dp; size_t sstride; int dstride; int dir; };
__device__ __forceinline__ P2Chain p2_chain(unsigned char* wsb, int type, int E) {
    const int DK = type ? 128 : 64, IPI = 128 * DK;
    const int chain = E / IPI, e = E % IPI;
    P2Chain c; c.st = (bf16_t*)(wsb + (type ? WS_SH : WS_SG)) + (size_t)chain * NCH * IPI + e;
    c.dp = (const float*)(wsb + (type ? WS_DH : WS_DG)) + (size_t)chain * NCH * DK + (e % DK);
    c.sstride = (size_t)IPI; c.dstride = DK; c.dir = chain & 1; return c;
}
__device__ __forceinline__ void pass2_triple(const KArgs& a, int t) {
    unsigned char* const wsb = opq(a.ws);
    const P2Chain c0 = p2_chain(wsb, 1, t), c1 = p2_chain(wsb, 1, t + 131072), c2 = p2_chain(wsb, 0, t);
    float s0 = 0.f, s1 = 0.f, s2 = 0.f;
    unsigned short uA[3][4], uB[3][4]; float dA[3][4], dB[3][4];
#define P2_CI(c, s) ((c).dir ? NCH - 1 - (s) : (s))
#define P2_LOAD(U, D, sb) do { _Pragma("unroll") for (int k = 0; k < 4; ++k) { \
        const int i0_ = P2_CI(c0, (sb) + k), i1_ = P2_CI(c1, (sb) + k), i2_ = P2_CI(c2, (sb) + k); \
        U[0][k] = c0.st[(size_t)i0_ * c0.sstride]; D[0][k] = c0.dp[(size_t)i0_ * c0.dstride]; \
        U[1][k] = c1.st[(size_t)i1_ * c1.sstride]; D[1][k] = c1.dp[(size_t)i1_ * c1.dstride]; \
        U[2][k] = c2.st[(size_t)i2_ * c2.sstride]; D[2][k] = c2.dp[(size_t)i2_ * c2.dstride]; } } while (0)
#define P2_STEP(U, D, sb) do { _Pragma("unroll") for (int k = 0; k < 4; ++k) { \
        const int i0_ = P2_CI(c0, (sb) + k), i1_ = P2_CI(c1, (sb) + k), i2_ = P2_CI(c2, (sb) + k); \
        c0.st[(size_t)i0_ * c0.sstride] = (bf16_t)f2bf(s0); s0 = D[0][k] * s0 + bf2f(U[0][k]); \
        c1.st[(size_t)i1_ * c1.sstride] = (bf16_t)f2bf(s1); s1 = D[1][k] * s1 + bf2f(U[1][k]); \
        c2.st[(size_t)i2_ * c2.sstride] = (bf16_t)f2bf(s2); s2 = D[2][k] * s2 + bf2f(U[2][k]); } } while (0)
    P2_LOAD(uA, dA, 0);
#pragma unroll 1
    for (int sb = 0; sb < NCH; sb += 8) {
        P2_LOAD(uB, dB, sb + 4);
        P2_STEP(uA, dA, sb);
        if (sb + 8 < NCH) P2_LOAD(uA, dA, sb + 8);
        P2_STEP(uB, dB, sb + 4);
    }
#undef P2_CI
#undef P2_LOAD
#undef P2_STEP
}

template <int TYPE>
__device__ __forceinline__ void pass3_item(const KArgs& a, int l, int item, LAS unsigned char* lds) {
    unsigned char* const wsb = opq(a.ws);
    const int tid = opaque_tid();
    using C = Cfg<TYPE>; constexpr int DK = C::DK;
    const int c = item & (NCH - 1), h = (item >> 8) & 3, b = item >> 10;
    const size_t tok0 = (size_t)b * T + (size_t)c * 64;
    const bf16_t* u = (const bf16_t*)(wsb + WS_U);
    const int wid = tid >> 6, lane = tid & 63, fr = lane & 15, fq = lane >> 4;
    LAS float* G = (LAS float*)(lds + SC_G); LAS bf16_t* Kb = (LAS bf16_t*)(lds + SC_K); LAS bf16_t* QT = (LAS bf16_t*)(lds + SC_QT); LAS bf16_t* QG = (LAS bf16_t*)(lds + SC_QG);
    LAS bf16_t* VT = (LAS bf16_t*)(lds + SC_VT); LAS bf16_t* P = (LAS bf16_t*)(lds + SC_P); LAS float* RSQ = (LAS float*)(lds + SC_RSQ);
    const VRaw vr = vT_issue(u + tok0 * DINP + (TYPE ? C_HI : C_GV) + h * 128, tid);
    bf16x8 qraw[DK / 64];
#pragma unroll
    for (int e2 = 0; e2 < DK / 64; ++e2) { const int task = tid + 512 * e2, i = task / C::ND8, d8 = task % C::ND8;
        qraw[e2] = *(const bf16x8*)(u + (tok0 + i) * DINP + (TYPE ? C_HQ + h * 128 : C_GQ + h * 64) + d8 * 8); }
    const LgRaw raw0 = lg_issue<TYPE>(u, h, 0, tok0, tid), raw1 = lg_issue<TYPE>(u, h, 1, tok0, tid);
    __syncthreads();
    vT_write(vr, lds, tid);
    float qf[DK / 64][8];
#pragma unroll
    for (int e2 = 0; e2 < DK / 64; ++e2) { unpack8(qraw[e2], qf[e2]);
#pragma unroll
        for (int e = 0; e < 8; ++e) qf[e2][e] = TYPE ? silu_(qf[e2][e]) : qf[e2][e] * 0.125f; }
    f32x4 o[4];
#pragma unroll
    for (int it = 0; it < 4; ++it) o[it] = (f32x4){0.f, 0.f, 0.f, 0.f};
#pragma unroll 1
    for (int dir = 0; dir < 2; ++dir) {
        const int sitem = ((b * 4 + h) * 2 + dir) * NCH + c;
        const bf16_t* ST = (const bf16_t*)(wsb + (TYPE ? WS_SH : WS_SG)) + (size_t)sitem * 128 * DK + (size_t)(wid * 16 + fr) * DK + fq * 8;
        bf16x8 sf[DK / 32];
#pragma unroll
        for (int ks = 0; ks < DK / 32; ++ks) sf[ks] = *(const bf16x8*)(ST + ks * 32);
        if (dir) __syncthreads();
        { LgRaw rw; rw.a0 = dir ? raw1.a0 : raw0.a0; rw.a1 = dir ? raw1.a1 : raw0.a1; rw.k = dir ? raw1.k : raw0.k; lg_compute<TYPE>(a, wsb, l, h, dir, rw, lds, tid); }
        cumsum_g<TYPE>(dir, lds, tid);
#pragma unroll
        for (int e2 = 0; e2 < DK / 64; ++e2) { const int task = tid + 512 * e2, i = task / C::ND8, d8 = task % C::ND8;
            const f32x4 g0 = *(LAS f32x4*)(G + i * C::LDG + d8 * 8), g1 = *(LAS f32x4*)(G + i * C::LDG + d8 * 8 + 4);
            const f32x4 m0 = *(LAS f32x4*)(G + 32 * C::LDG + d8 * 8), m1 = *(LAS f32x4*)(G + 32 * C::LDG + d8 * 8 + 4);
            float kk[8], qq[8], qt[8], qg[8]; unpack8(*(LAS bf16x8*)(Kb + i * C::LDK_ + d8 * 8), kk);
#pragma unroll
            for (int e = 0; e < 8; ++e) qq[e] = qf[e2][e];
#pragma unroll
            for (int e = 0; e < 8; ++e) { const float gg = e < 4 ? g0[e] : g1[e - 4], gm = e < 4 ? m0[e] : m1[e - 4];
                const float q = qq[e];
                qt[e] = q * __expf(gg - gm); qg[e] = q * __expf(gg); kk[e] = kk[e] * __expf(gm - gg); }
            *(LAS bf16x8*)(QT + i * C::LDK_ + d8 * 8) = pack8(qt); *(LAS bf16x8*)(QG + i * C::LDK_ + d8 * 8) = pack8(qg); *(LAS bf16x8*)(Kb + i * C::LDK_ + d8 * 8) = pack8(kk); }
        __syncthreads();
        { const int it = wid >> 1;
#pragma unroll
          for (int jj = 0; jj < 2; ++jj) { const int jt = 2 * (wid & 1) + jj;
            f32x4 acc = {0.f, 0.f, 0.f, 0.f};
#pragma unroll
            for (int ks = 0; ks < DK / 32; ++ks) {
                const bf16x8 af = *(LAS bf16x8*)(QT + (it * 16 + fr) * C::LDK_ + ks * 32 + fq * 8), bfr = *(LAS bf16x8*)(Kb + (jt * 16 + fr) * C::LDK_ + ks * 32 + fq * 8);
                acc = __builtin_amdgcn_mfma_f32_16x16x32_bf16(af, bfr, acc, 0, 0, 0); }
#pragma unroll
            for (int r = 0; r < 4; ++r) { const int i = it * 16 + fq * 4 + r, j = jt * 16 + fr; const bool keep = dir ? (j >= i) : (j <= i);
                P[i * LDT + j] = (bf16_t)f2bf(keep ? acc[r] : 0.f); } } }
        __syncthreads();
        const bf16x8 vb0 = vt_frag(VT, wid * 16 + fr, fq), vb1 = vt_frag(VT, wid * 16 + fr, 4 + fq);
#pragma unroll
        for (int it = 0; it < 4; ++it) {
            const bf16x8 p0 = *(LAS bf16x8*)(P + (it * 16 + fr) * LDT + fq * 8), p1 = *(LAS bf16x8*)(P + (it * 16 + fr) * LDT + 32 + fq * 8);
            o[it] = __builtin_amdgcn_mfma_f32_16x16x32_bf16(p0, vb0, o[it], 0, 0, 0);
            o[it] = __builtin_amdgcn_mfma_f32_16x16x32_bf16(p1, vb1, o[it], 0, 0, 0);
#pragma unroll
            for (int ks = 0; ks < DK / 32; ++ks) { const bf16x8 af = *(LAS bf16x8*)(QG + (it * 16 + fr) * C::LDK_ + ks * 32 + fq * 8);
                o[it] = __builtin_amdgcn_mfma_f32_16x16x32_bf16(af, sf[ks], o[it], 0, 0, 0); }
        }
    }
#pragma unroll
    for (int it = 0; it < 4; ++it)
#pragma unroll
        for (int r = 0; r < 4; ++r) { float s = o[it][r] * o[it][r]; s += __shfl_xor(s, 1); s += __shfl_xor(s, 2); s += __shfl_xor(s, 4); s += __shfl_xor(s, 8);
            if (fr == 0) RSQ[wid * 64 + it * 16 + fq * 4 + r] = s; }
    __syncthreads();
    const float gain = ((const float*)a.in[TYPE ? 7 : 5])[l * 128 + wid * 16 + fr];
    bf16_t* mix = (bf16_t*)(wsb + WS_XN);
#pragma unroll
    for (int it = 0; it < 4; ++it)
#pragma unroll
        for (int r = 0; r < 4; ++r) { const int i = it * 16 + fq * 4 + r; float s = 0.f;
#pragma unroll
            for (int w = 0; w < 8; ++w) s += RSQ[w * 64 + i];
            const float rstd = rsqrtf(s * (1.f / 128.f) + EPS);
            const float gt = bf2f(u[(tok0 + i) * DINP + (TYPE ? C_HG : C_GG) + h * 128 + wid * 16 + fr]);
            const float yv = o[it][r] * rstd * gain * silu_(gt);
            mix[(tok0 + i) * DM + (TYPE ? 512 : 0) + h * 128 + wid * 16 + fr] = (bf16_t)f2bf(yv); }
}
}
__device__ __forceinline__ void rmsnorm_rows_bf16(const float* src, const float* gain, bf16_t* dst) {
    const int tid = opaque_tid(), lane = tid & 63, gw = blockIdx.x * 8 + (tid >> 6), ngw = gridDim.x * 8;
    for (int m = gw; m < M; m += ngw) {
        const f32x4* xr = (const f32x4*)(src + (size_t)m * DM) + lane;
        f32x4 v[8]; float s = 0.f;
#pragma unroll
        for (int j = 0; j < 8; ++j) { v[j] = xr[64 * j]; s += (v[j][0] * v[j][0] + v[j][1] * v[j][1]) + (v[j][2] * v[j][2] + v[j][3] * v[j][3]); }
        const float rstd = rsqrtf(wave_sum(s) * (1.f / DM) + EPS);
        u32x2* o8 = (u32x2*)(dst + (size_t)m * DM) + lane;
#pragma unroll
        for (int j = 0; j < 8; ++j) { const f32x4 g = ((const f32x4*)gain)[lane + 64 * j];
            u32x2 w; w.x = cvt_pk_bf16(v[j][0] * rstd * g[0], v[j][1] * rstd * g[1]); w.y = cvt_pk_bf16(v[j][2] * rstd * g[2], v[j][3] * rstd * g[3]); o8[64 * j] = w; }
    }
}
__device__ __forceinline__ void cast_rows_bf16(const float* src, bf16_t* dst, float* rsq) {
    const int tid = opaque_tid(), lane = tid & 63, gw = blockIdx.x * 8 + (tid >> 6), ngw = gridDim.x * 8;
    for (int m = gw; m < M; m += ngw) {
        const f32x4* xr = (const f32x4*)(src + (size_t)m * DM) + lane;
        f32x4 v[8]; float s = 0.f;
#pragma unroll
        for (int j = 0; j < 8; ++j) { v[j] = xr[64 * j]; s += (v[j][0] * v[j][0] + v[j][1] * v[j][1]) + (v[j][2] * v[j][2] + v[j][3] * v[j][3]); }
        s = wave_sum(s);
        if (lane == 0) rsq[m] = s;
        u32x2* o8 = (u32x2*)(dst + (size_t)m * DM) + lane;
#pragma unroll
        for (int j = 0; j < 8; ++j) { u32x2 w; w.x = cvt_pk_bf16(v[j][0], v[j][1]); w.y = cvt_pk_bf16(v[j][2], v[j][3]); o8[64 * j] = w; }
    }
}
__device__ __forceinline__ void rmsnorm_rows_f32_inplace(float* buf, const float* gain) {
    const int tid = opaque_tid(), lane = tid & 63, gw = blockIdx.x * 8 + (tid >> 6), ngw = gridDim.x * 8;
    for (int m = gw; m < M; m += ngw) {
        f32x4* xr = (f32x4*)(buf + (size_t)m * DM) + lane;
        f32x4 v[8]; float s = 0.f;
#pragma unroll
        for (int j = 0; j < 8; ++j) { v[j] = xr[64 * j]; s += (v[j][0] * v[j][0] + v[j][1] * v[j][1]) + (v[j][2] * v[j][2] + v[j][3] * v[j][3]); }
        const float rstd = rsqrtf(wave_sum(s) * (1.f / DM) + EPS);
#pragma unroll
        for (int j = 0; j < 8; ++j) { const f32x4 g = ((const f32x4*)gain)[lane + 64 * j]; xr[64 * j] = v[j] * rstd * g; }
    }
}
__device__ __forceinline__ void convert_weights(const KArgs& a, int l, LAS unsigned char* lds) {
    unsigned char* const wsb = opq(a.ws);
    const int tid = opaque_tid();
    LAS float* tile = (LAS float*)lds;
    constexpr int I_IN = 32 * 84, I_QB = 8 * 24, I_KVB = 8 * 32, I_OUT = 32 * 32, I_13 = 32 * 176, I_2 = 88 * 32, NIT = I_IN + I_QB + I_KVB + I_OUT + I_13 + I_2;
    for (int it = blockIdx.x; it < NIT; it += gridDim.x) {
        int r = it, mode = 0, N, K, nkt; const float* w0; const float* w1 = nullptr; const float* gk = nullptr; bf16_t* WT;
        if (r < I_IN) { w0 = (const float*)a.in[2] + (size_t)l * DM * DIN; N = DIN; K = DM; nkt = 32; gk = (const float*)a.in[13] + l * DM; WT = (bf16_t*)(wsb + WS_WIN); }
        else if ((r -= I_IN) < I_QB) { w0 = (const float*)a.in[9] + (size_t)l * 512 * 1536; N = 1536; K = 512; nkt = 8; mode = 1; WT = (bf16_t*)(wsb + WS_WQB); }
        else if ((r -= I_QB) < I_KVB) { w0 = (const float*)a.in[11] + (size_t)l * 512 * 2048; N = 2048; K = 512; nkt = 8; WT = (bf16_t*)(wsb + WS_WKVB); }
        else if ((r -= I_KVB) < I_OUT) { w0 = (const float*)a.in[12] + (size_t)l * DM * DM; N = DM; K = DM; nkt = 32; WT = (bf16_t*)(wsb + WS_WOUT); }
        else if ((r -= I_OUT) < I_13) { w0 = (const float*)a.in[15] + (size_t)l * DM * DFF; w1 = (const float*)a.in[16] + (size_t)l * DM * DFF; N = DFF; K = DM; nkt = 32; mode = 2; gk = (const float*)a.in[14] + l * DM; WT = (bf16_t*)(wsb + WS_W13); }
        else { r -= I_13; w0 = (const float*)a.in[17] + (size_t)l * DFF * DM; N = DM; K = DFF; nkt = 88; WT = (bf16_t*)(wsb + WS_W2); }
        const int kt = r % nkt, rt = r / nkt, r0 = rt * 64, k0 = kt * 64;
        __syncthreads();
        if (mode == 1) {
#pragma unroll
            for (int e = 0; e < 8; ++e) { const int idx = tid + 512 * e, rl = idx & 63, kl = idx >> 6, rr = r0 + rl, k = k0 + kl;
                const int hh = rr / 192, ee = rr % 192; const int col = ee < 128 ? hh * 192 + ee : hh * 192 + 128 + ((ee - 128) & 1) * 32 + ((ee - 128) >> 1);
                tile[kl * 65 + rl] = w0[(size_t)k * N + col]; }
        } else {
#pragma unroll
            for (int e = 0; e < 2; ++e) { const int idx = tid + 512 * e, r4 = (idx & 15) * 4, kl = idx >> 4, rr = r0 + r4, k = k0 + kl;
                f32x4 v = {0.f, 0.f, 0.f, 0.f};
                if (mode == 0) { if (rr < N) v = *(const f32x4*)(w0 + (size_t)k * N + rr); }
                else { const int g = rr >> 5, n = (rr >> 4) & 1, i = rr & 15; v = *(const f32x4*)((n ? w1 : w0) + (size_t)k * N + 16 * g + i); }
                if (gk) v = v * gk[k];
                tile[kl * 65 + r4] = v[0]; tile[kl * 65 + r4 + 1] = v[1]; tile[kl * 65 + r4 + 2] = v[2]; tile[kl * 65 + r4 + 3] = v[3]; }
        }
        __syncthreads();
        { const int k8 = tid & 7, rl = tid >> 3;
          u32x4 w; w.x = pk2(tile[(8 * k8 + 0) * 65 + rl], tile[(8 * k8 + 1) * 65 + rl]); w.y = pk2(tile[(8 * k8 + 2) * 65 + rl], tile[(8 * k8 + 3) * 65 + rl]);
          w.z = pk2(tile[(8 * k8 + 4) * 65 + rl], tile[(8 * k8 + 5) * 65 + rl]); w.w = pk2(tile[(8 * k8 + 6) * 65 + rl], tile[(8 * k8 + 7) * 65 + rl]);
          *(u32x4*)(WT + (size_t)(r0 + rl) * K + k0 + 8 * k8) = w; }
    }
    __syncthreads();
}
__device__ __forceinline__ void tables_phase(const KArgs& a) {
    unsigned char* const wsb = opq(a.ws);
    const int tid = opaque_tid();
    const int* pos = (const int*)a.in[1];
    float* cs = (float*)(wsb + WS_COS); float* sn = (float*)(wsb + WS_SIN);
    const int gt = blockIdx.x * 512 + tid, ngt = gridDim.x * 512;
    for (int idx = gt; idx < M * 32; idx += ngt) { const int tok = idx >> 5, i = idx & 31;
        const float inv = 1.0f / exp2f((float)(2 * i) * (1.f / 64.f) * 13.287712379549449f);
        const float ang = (float)pos[tok] * inv;
        double rev = (double)ang * 0.15915494309189535; rev -= rint(rev);
        const float f = (float)rev;
        cs[idx] = __builtin_amdgcn_cosf(f); sn[idx] = __builtin_amdgcn_sinf(f); }
    if (blockIdx.x == 0) { const float* lg = (const float*)a.in[6]; float* lb = (float*)(wsb + WS_LB);
        for (int p = tid; p < 2 * 512; p += 512) { const int dir = p >> 9, c = p & 511;
            float mx = -1e30f;
#pragma unroll
            for (int l = 0; l < DEPTH; ++l) mx = fmaxf(mx, lg[(dir * DEPTH + l) * 512 + c]);
            float den = 0.f;
#pragma unroll
            for (int l = 0; l < DEPTH; ++l) den += __expf(lg[(dir * DEPTH + l) * 512 + c] - mx);
            float cum = 0.f;
#pragma unroll
            for (int l = 0; l < DEPTH; ++l) { if (l > 0) cum += __expf(lg[(dir * DEPTH + l) * 512 + c] - mx) / den; lb[(dir * DEPTH + l) * 512 + c] = cum; } } }
}
__device__ __forceinline__ void mla_prep(const KArgs& a, int l) {
    unsigned char* const wsb = opq(a.ws);
    const int tid = opaque_tid(), lane = tid & 63, gw = blockIdx.x * 8 + (tid >> 6), ngw = gridDim.x * 8;
    bf16_t* u = (bf16_t*)(wsb + WS_U); bf16_t* kr = (bf16_t*)(wsb + WS_KR);
    const float* cs = (const float*)(wsb + WS_COS); const float* sn = (const float*)(wsb + WS_SIN);
    const float* gq = (const float*)a.in[8] + l * 512 + lane * 8; const float* gkv = (const float*)a.in[10] + l * 512 + lane * 8;
    for (int tok = gw; tok < M; tok += ngw) {
        bf16_t* ur = u + (size_t)tok * DINP;
#pragma unroll
        for (int w = 0; w < 2; ++w) { bf16_t* p = ur + (w ? C_CKV : C_CQ) + lane * 8; const float* g = w ? gkv : gq;
            float f[8]; unpack8(*(const bf16x8*)p, f); float s = 0.f;
#pragma unroll
            for (int e = 0; e < 8; ++e) s += f[e] * f[e];
            const float rstd = rsqrtf(wave_sum(s) * (1.f / 512.f) + EPS);
#pragma unroll
            for (int e = 0; e < 8; ++e) f[e] = f[e] * rstd * g[e];
            *(bf16x8*)p = pack8(f); }
        if (lane < 32) { const float x1 = bf2f(ur[C_KR + lane]), x2 = bf2f(ur[C_KR + 32 + lane]), c = cs[(size_t)tok * 32 + lane], s = sn[(size_t)tok * 32 + lane];
            *(unsigned*)(kr + (size_t)tok * 64 + 2 * lane) = pk2(x1 * c - x2 * s, x2 * c + x1 * s); }
    }
}

__device__ __forceinline__ void grid_barrier(unsigned* bar, unsigned nblk, unsigned& epoch) {
    __builtin_amdgcn_fence(__ATOMIC_RELEASE, "agent");
    asm volatile("s_waitcnt vmcnt(0) lgkmcnt(0)" ::: "memory");
    __syncthreads();
    epoch += nblk;
    if (threadIdx.x == 0) {
        __hip_atomic_fetch_add(bar, 1u, __ATOMIC_RELEASE, __HIP_MEMORY_SCOPE_AGENT);
        while (__hip_atomic_load(bar, __ATOMIC_ACQUIRE, __HIP_MEMORY_SCOPE_AGENT) < epoch) __builtin_amdgcn_s_sleep(2);
    }
    __syncthreads();
    __builtin_amdgcn_fence(__ATOMIC_ACQUIRE, "agent");
}
__global__ void __launch_bounds__(512, 2) mega_fwd(KArgs a) {
    extern __shared__ __attribute__((aligned(16))) unsigned char smem[];
    cg::grid_group grid = cg::this_grid();
    LAS unsigned char* lds = (LAS unsigned char*)smem;
    const int G = gridDim.x, bx = blockIdx.x;
    const float* x = (const float*)a.in[0];
    unsigned epoch = 0; unsigned* const gbar = (unsigned*)(a.ws + WS_BAR);
#define GBAR() grid_barrier(gbar, (unsigned)G, epoch)

#if PH_MISC
    tables_phase(a);
    convert_weights(a, 0, lds);
#if PROBE_CVT_REP > 1
    convert_weights(a, 0, lds);
#endif
#endif
    { float* rz = (float*)(opq(a.ws) + WS_RSQ); for (int z_ = bx * 512 + opaque_tid(); z_ < 4 * M; z_ += G * 512) rz[z_] = 0.f; }
    cast_rows_bf16(x, (bf16_t*)(opq(a.ws) + WS_XN), (float*)(opq(a.ws) + WS_RSQ) + 4 * M);
    grid.sync();
    GBAR();
#pragma unroll 1
    for (int l = 0; l < DEPTH; ++l) {
        if (l > 0) {
#if PH_MISC
            convert_weights(a, l, lds);
#if PROBE_CVT_REP > 1
            convert_weights(a, l, lds);
#endif
#endif
            GBAR();
        }
        { pg8::Gemm g{(const bf16_t*)(opq(a.ws) + WS_XN), (const bf16_t*)(opq(a.ws) + WS_WIN), M, DINP, DM, DM, DM}; pg8::StaticOrder S; S.init(M, DINP, G, bx);
          pg8::EpiU E{(bf16_t*)(opq(a.ws) + WS_U), DINP, (const float*)(opq(a.ws) + WS_RSQ) + (size_t)(l == 0 ? 4 : 2 + (l - 1)) * M};
          __syncthreads(); if (PH_GEMM & 1) pg8::gemm_phase<pg8::EpiU, pg8::StaticOrder, true, true>(lds, g, S, E);
#if PROBE_GEMM_REP > 1
          __syncthreads(); if (PH_GEMM & 1) pg8::gemm_phase<pg8::EpiU, pg8::StaticOrder, true, true>(lds, g, S, E);
#endif
 }
        GBAR();
#if PH_MISC
        mla_prep(a, l);
#endif
#if PH_S1
        for (int it = bx; it < 4096; it += G) scan::pass1_item<1>(a, l, it, lds);
        for (int it = bx; it < 4096; it += G) scan::pass1_item<0>(a, l, it, lds);
#if PROBE_SCAN_REP > 1
        for (int it = bx; it < 4096; it += G) scan::pass1_item<1>(a, l, it, lds);
        for (int it = bx; it < 4096; it += G) scan::pass1_item<0>(a, l, it, lds);
#endif
#endif
        GBAR();
#if PH_S2
        for (int t = bx * 512 + opaque_tid(); t < 131072; t += G * 512) scan::pass2_triple(a, t);
#endif
        { pg8::Gemm g{(const bf16_t*)(opq(a.ws) + WS_U) + C_CQ, (const bf16_t*)(opq(a.ws) + WS_WQB), M, 1536, 512, DINP, 512}; pg8::StaticOrder S; S.init(M, 1536, G, bx);
          pg8::EpiQ E{(bf16_t*)(opq(a.ws) + WS_Q), (const float*)(opq(a.ws) + WS_COS), (const float*)(opq(a.ws) + WS_SIN)};
          __syncthreads(); if (PH_GEMM & 2) pg8::gemm_phase<pg8::EpiQ, pg8::StaticOrder, true, true>(lds, g, S, E);
#if PROBE_GEMM_REP > 1
          __syncthreads(); if (PH_GEMM & 2) pg8::gemm_phase<pg8::EpiQ, pg8::StaticOrder, true, true>(lds, g, S, E);
#endif
 }
        { pg8::Gemm g{(const bf16_t*)(opq(a.ws) + WS_U) + C_CKV, (const bf16_t*)(opq(a.ws) + WS_WKVB), M, 2048, 512, DINP, 512}; pg8::StaticOrder S; S.init(M, 2048, G, bx);
          pg8::EpiKV E{(bf16_t*)(opq(a.ws) + WS_KN), (bf16_t*)(opq(a.ws) + WS_V)};
          __syncthreads(); if (PH_GEMM & 4) pg8::gemm_phase<pg8::EpiKV, pg8::StaticOrder, true, true>(lds, g, S, E);
#if PROBE_GEMM_REP > 1
          __syncthreads(); if (PH_GEMM & 4) pg8::gemm_phase<pg8::EpiKV, pg8::StaticOrder, true, true>(lds, g, S, E);
#endif
 }
        GBAR();
        { const bool x8 = (G % 8) == 0; const int xcd = bx & 7, slot = bx >> 3, nslot = G >> 3;
          for (int pr = 0; pr < (x8 ? 2 : 16); ++pr) { const int p = x8 ? xcd + 8 * pr : pr, b = p >> 3, h = p & 7;
            for (int qb = x8 ? slot : bx; qb < 64; qb += x8 ? nslot : G) {
              const bf16_t* Qb = (const bf16_t*)(opq(a.ws) + WS_Q) + ((size_t)(b * 8 + h) * T + (size_t)qb * 256) * 192;
              const bf16_t* Kn = (const bf16_t*)(opq(a.ws) + WS_KN) + (size_t)(b * 8 + h) * T * 128;
              const bf16_t* Kr = (const bf16_t*)(opq(a.ws) + WS_KR) + (size_t)b * T * 64;
              const bf16_t* Vh = (const bf16_t*)(opq(a.ws) + WS_V) + (size_t)(b * 8 + h) * T * 128;
              bf16_t* Ob = (bf16_t*)(opq(a.ws) + WS_XN) + ((size_t)b * T + (size_t)qb * 256) * DM + 1024 + h * 128;
#if PH_ATT
              for (int rep_ = 0; rep_ < PROBE_ATT_REP; ++rep_) att::attn_unit(Qb, Kn, Kr, Vh, Ob, (char*)smem);
#else
              { const int t_ = opaque_tid(); bf16_t* zp = Ob + (size_t)(t_ >> 1) * DM + (t_ & 1) * 64; (void)Qb; (void)Kn; (void)Kr; (void)Vh;
                for (int z_ = 0; z_ < 8; ++z_) *(u32x4*)(zp + z_ * 8) = (u32x4){0u, 0u, 0u, 0u}; }
#endif
 } } }
#if PH_S3
        for (int it = bx; it < 2048; it += G) scan::pass3_item<1>(a, l, it, lds);
        for (int it = bx; it < 2048; it += G) scan::pass3_item<0>(a, l, it, lds);
#if PROBE_SCAN_REP > 1
        for (int it = bx; it < 2048; it += G) scan::pass3_item<1>(a, l, it, lds);
        for (int it = bx; it < 2048; it += G) scan::pass3_item<0>(a, l, it, lds);
#endif
#else
        { bf16_t* mz = (bf16_t*)(opq(a.ws) + WS_XN); for (size_t z_ = (size_t)bx * 512 + opaque_tid(); z_ < (size_t)M * 128; z_ += (size_t)G * 512) *(u32x4*)(mz + (z_ >> 7) * DM + (z_ & 127) * 8) = (u32x4){0u, 0u, 0u, 0u}; }
#endif
        GBAR();
        { pg8::Gemm g{(const bf16_t*)(opq(a.ws) + WS_XN), (const bf16_t*)(opq(a.ws) + WS_WOUT), M, DM, DM, DM, DM}; pg8::StaticOrder S; S.init(M, DM, G, bx);
          pg8::EpiRes E{l == 0 ? x : (const float*)a.out, a.out, (bf16_t*)(opq(a.ws) + WS_HB), (float*)(opq(a.ws) + WS_RSQ) + (size_t)l * M};
          __syncthreads(); if (PH_GEMM & 8) pg8::gemm_phase<pg8::EpiRes, pg8::StaticOrder, true, true>(lds, g, S, E); }
        GBAR();
        { pg8::Gemm g{(const bf16_t*)(opq(a.ws) + WS_HB), (const bf16_t*)(opq(a.ws) + WS_W13), M, 2 * DFF, DM, DM, DM}; pg8::StaticOrder S; S.init(M, 2 * DFF, G, bx);
          pg8::EpiSwi E{(bf16_t*)(opq(a.ws) + WS_HID), (const float*)(opq(a.ws) + WS_RSQ) + (size_t)l * M};
          __syncthreads(); if (PH_GEMM & 16) pg8::gemm_phase<pg8::EpiSwi, pg8::StaticOrder, true, true>(lds, g, S, E);
#if PROBE_GEMM_REP > 1
          __syncthreads(); if (PH_GEMM & 16) pg8::gemm_phase<pg8::EpiSwi, pg8::StaticOrder, true, true>(lds, g, S, E);
#endif
 }
        GBAR();
        { pg8::Gemm g{(const bf16_t*)(opq(a.ws) + WS_HID), (const bf16_t*)(opq(a.ws) + WS_W2), M, DM, DFF, DFF, DFF}; pg8::StaticOrder S; S.init(M, DM, G, bx);
          pg8::EpiRes E{(const float*)a.out, a.out, (bf16_t*)(opq(a.ws) + WS_XN), (float*)(opq(a.ws) + WS_RSQ) + (size_t)(2 + l) * M};
          __syncthreads(); if (PH_GEMM & 32) pg8::gemm_phase<pg8::EpiRes, pg8::StaticOrder, true, true>(lds, g, S, E); }
        GBAR();
    }
    rmsnorm_rows_f32_inplace(a.out, (const float*)a.in[18]);
}

extern "C" void kernel_launch(void* const* d_in, const int* in_sizes, int n_in, void* d_out, int out_size, void* d_ws, size_t ws_size, hipStream_t stream) {
    static int grid = 0;
    if (grid == 0) {
        if (n_in != 19 || out_size != M * DM || ws_size < WS_END) { fprintf(stderr, "kernel_launch: unexpected shapes (n_in %d out %d ws %zu)\n", n_in, out_size, ws_size); grid = -1; return; }
        int dev = 0, cus = 0, per_cu = 0;
        hipGetDevice(&dev); hipDeviceGetAttribute(&cus, hipDeviceAttributeMultiprocessorCount, dev);
        if (hipFuncSetAttribute((const void*)mega_fwd, hipFuncAttributeMaxDynamicSharedMemorySize, LDS_BYTES) != hipSuccess) { fprintf(stderr, "kernel_launch: hipFuncSetAttribute failed\n"); grid = -1; return; }
        if (hipOccupancyMaxActiveBlocksPerMultiprocessor(&per_cu, (const void*)mega_fwd, 512, LDS_BYTES) != hipSuccess || per_cu < 1) { fprintf(stderr, "kernel_launch: occupancy query says %d\n", per_cu); per_cu = 1; }
        (void)hipGetLastError();
        grid = cus * (per_cu > 1 ? 1 : per_cu);
    }
    if (grid < 0) return;
    KArgs a{};
    for (int i = 0; i < 19; ++i) a.in[i] = d_in[i];
    a.out = (float*)d_out; a.ws = (unsigned char*)d_ws;
    if (hipMemsetAsync((char*)d_ws + WS_BAR, 0, 256, stream) != hipSuccess) { fprintf(stderr, "kernel_launch: memset failed\n"); return; }
    void* args[] = {&a};
    hipError_t e = hipLaunchCooperativeKernel((const void*)mega_fwd, dim3(grid), dim3(512), args, LDS_BYTES, stream);
    if (e != hipSuccess) fprintf(stderr, "kernel_launch: cooperative launch failed: %s (grid %d)\n", hipGetErrorString(e), grid);
}
```

```cpp
#include <hip/hip_runtime.h>
#include <hip/hip_cooperative_groups.h>
#include <cstdint>
#include <cstdio>
namespace cg = cooperative_groups;
#ifndef PROBE_GEMM_REP
#define PROBE_GEMM_REP 1
#endif
#ifndef PROBE_SCAN_REP
#define PROBE_SCAN_REP 1
#endif
#ifndef PROBE_CVT_REP
#define PROBE_CVT_REP 1
#endif
#ifndef PROBE_ATT_REP
#define PROBE_ATT_REP 1
#endif
#ifndef PH_ATT
#define PH_ATT 1
#endif
#ifndef PH_S1
#define PH_S1 1
#endif
#ifndef PH_S2
#define PH_S2 1
#endif
#ifndef PH_S3
#define PH_S3 1
#endif
#ifndef PH_GEMM
#define PH_GEMM 63
#endif
#ifndef PH_MISC
#define PH_MISC 1
#endif

#define LAS __attribute__((address_space(3)))
typedef unsigned short bf16_t;
typedef short bf16x8 __attribute__((ext_vector_type(8)));
typedef short s16x4 __attribute__((ext_vector_type(4)));
typedef float f32x2 __attribute__((ext_vector_type(2)));
typedef float f32x4 __attribute__((ext_vector_type(4)));
typedef float f32x16 __attribute__((ext_vector_type(16)));
typedef unsigned u32x2 __attribute__((ext_vector_type(2)));
typedef unsigned u32x4 __attribute__((ext_vector_type(4)));

constexpr int NB = 2, T = 16384, M = NB * T, DM = 2048, DIN = 5216, DINP = 5376, DFF = 5632, DEPTH = 2;
constexpr int C_GQ = 0, C_GK = 256, C_GV = 512, C_GAF = 1024, C_GAB = 1040, C_GG = 1056, C_HQ = 1568, C_HFF = 2080, C_HFB = 2592, C_HI = 3104, C_HG = 3616,
              C_CQ = 4128, C_CKV = 4640, C_KR = 5152;
constexpr float EPS = 1e-6f;
constexpr int NCH = T / 64;
constexpr size_t MiB = 1048576;
constexpr size_t WS_WIN = 0, WS_WQB = 21 * MiB, WS_WKVB = WS_WQB + 3 * MiB / 2, WS_WOUT = WS_WKVB + 2 * MiB, WS_W13 = WS_WOUT + 8 * MiB, WS_W2 = WS_W13 + 44 * MiB;
constexpr size_t WS_XN = 99 * MiB, WS_U = 227 * MiB, WS_Q = 563 * MiB, WS_KN = 659 * MiB, WS_V = 723 * MiB, WS_KR = 787 * MiB, WS_SG = 791 * MiB, WS_SH = 855 * MiB,
                 WS_DG = 983 * MiB, WS_DH = 984 * MiB, WS_COS = 986 * MiB, WS_SIN = 990 * MiB, WS_LB = 994 * MiB, WS_BAR = 995 * MiB, WS_RSQ = WS_BAR + 16384, WS_END = 996 * MiB, WS_HB = WS_U, WS_HID = WS_U + 128 * MiB;
static_assert(WS_W2 + 22 * MiB <= WS_XN, "weights");
constexpr int LDS_BYTES = 131072 + 64;

struct KArgs { const void* in[19]; float* out; unsigned char* ws; };

__device__ __forceinline__ float bf2f(unsigned v) { return __uint_as_float(v << 16); }
__device__ __forceinline__ unsigned f2bf(float f) { unsigned u = __float_as_uint(f); return (u + 0x7fffu + ((u >> 16) & 1u)) >> 16; }
__device__ __forceinline__ unsigned pk2(float lo, float hi) { return f2bf(lo) | (f2bf(hi) << 16); }
typedef __bf16 bf16x2_t __attribute__((ext_vector_type(2)));
__device__ __forceinline__ unsigned cvt_pk_bf16(float lo, float hi) { f32x2 v = {lo, hi}; bf16x2_t b = __builtin_convertvector(v, bf16x2_t); return __builtin_bit_cast(unsigned, b); }
__device__ __forceinline__ float wave_sum(float v) {
#pragma unroll
    for (int o = 1; o < 64; o <<= 1) v += __shfl_xor(v, o);
    return v;
}
__device__ __forceinline__ unsigned char* opq(unsigned char* q) { asm volatile("" : "+s"(q)); return q; }
__device__ __forceinline__ int opaque_tid() { int t = threadIdx.x; asm volatile("" : "+v"(t)); return t; }
#define DBGF(ws_, cond_, bit_) do { if (cond_) atomicOr((unsigned*)((ws_) + WS_BAR) + 32, (unsigned)(bit_)); } while (0)
__device__ __forceinline__ bool badf(float v) { return !(fabsf(v) < 1e30f); }
__device__ __forceinline__ float sigmoid_(float z) { return __builtin_amdgcn_rcpf(1.f + __expf(-z)); }
__device__ __forceinline__ float silu_(float z) { return z * sigmoid_(z); }
__device__ __forceinline__ float logsigmoid_(float z) { return fminf(z, 0.f) - __logf(1.f + __expf(-fabsf(z))); }
__device__ __forceinline__ void unpack8(bf16x8 v, float* f) {
#pragma unroll
    for (int e = 0; e < 8; ++e) f[e] = bf2f((unsigned)(unsigned short)v[e]);
}
__device__ __forceinline__ bf16x8 pack8(const float* f) {
    u32x4 w = {cvt_pk_bf16(f[0], f[1]), cvt_pk_bf16(f[2], f[3]), cvt_pk_bf16(f[4], f[5]), cvt_pk_bf16(f[6], f[7])};
    return __builtin_bit_cast(bf16x8, w);
}

namespace pg8 {
#define PG8_LAS __attribute__((address_space(3)))
constexpr int BM = 256, BK = 64, HALF = 128, HTB = HALF * BK * 2, STAGE_BYTES = 8 * HTB, NXCD = 8, WGM = 8;
__host__ __device__ __forceinline__ int lds_byte(int r, int c) { const int st = (r >> 4) * 2 + (c >> 5), rr = r & 15, cc = c & 31, ob = rr * 64 + cc * 2; return st * 1024 + (ob ^ (((ob >> 9) & 1) << 5)); }
__host__ __device__ __forceinline__ void stage_rc(int b, int& R, int& C) { const int st = b / 1024, sb = b % 1024, swz = sb ^ (((sb >> 9) & 1) << 5); R = (st >> 1) * 16 + swz / 64; C = (st & 1) * 32 + (swz % 64) / 2; }
__host__ __device__ __forceinline__ int perm32(int rho) { const int n = rho >> 4, i = rho & 15; return 8 * (i >> 2) + 4 * n + (i & 3); }
struct Unit { int pm, pn; };
struct Gemm { const bf16_t* A; const bf16_t* Bt; int M, N, K, lda, ldb; };
struct StaticOrder {
    int nM, nN, nwg, G, c;
    __host__ __device__ void init(int M_, int N_, int G_, int c_) { nM = M_ / BM; nN = N_ / BM; nwg = nM * nN; G = G_; c = c_; }
    __host__ __device__ bool next(int i, Unit& u) const {
        const long L = (long)i * G + c; if (L >= nwg) return false;
        int wgid = (int)L; { const int q = nwg / NXCD, r = nwg % NXCD, xcd = wgid % NXCD, off = wgid / NXCD; wgid = (xcd < r ? xcd * (q + 1) : r * (q + 1) + (xcd - r) * q) + off; }
        const int nig = WGM * nN, gid = wgid / nig, fm = gid * WGM, gsz = (nM - fm) < WGM ? (nM - fm) : WGM;
        u.pm = fm + ((wgid % nig) % gsz); u.pn = (wgid % nig) / gsz; return true;
    }
    __device__ __forceinline__ void a_ready(const Unit&) const {}
    __device__ __forceinline__ void done(const Unit&) const {}
};
template <class Epi, class Sched, bool ALIGN_EPI = false, bool SP2 = false>
__device__ __forceinline__ void gemm_phase(PG8_LAS unsigned char* lds, const Gemm g, const Sched& S, const Epi& E) {
    const int tid = opaque_tid(), wid = __builtin_amdgcn_readfirstlane(tid >> 6), lane = tid & 63, wr = wid >> 2, wc = wid & 3, fr = lane & 15, fq = lane >> 4;
    const int K = g.K, nt = K / BK;
    unsigned voffA[2], voffB[2];
#pragma unroll
    for (int i = 0; i < 2; ++i) { int R, C; stage_rc(tid * 16 + i * 8192, R, C); const int Rb = Epi::PERM ? ((R & ~31) + perm32(R & 31)) : R;
        voffA[i] = (unsigned)(R * g.lda + C) * 2u; voffB[i] = (unsigned)(Rb * g.ldb + C) * 2u; }
    const size_t kstep = (size_t)(BK * 2);
    const size_t hstepA = (size_t)HALF * g.lda * 2, hstepB = (size_t)HALF * g.ldb * 2;
    const size_t tstepA = 2 * hstepA, tstepB = 2 * hstepB;
    const unsigned ldsw = (unsigned)wid * 1024u;
    const int aoff = lds_byte(wr * 64 + fr, fq * 8), boff = lds_byte(wc * 32 + fr, fq * 8);
#define PG8_SA(b, h) (((b) * 2 + (h)) * HTB)
#define PG8_SB(b, h) ((4 + (b) * 2 + (h)) * HTB)
#define PG8_STAGE(bufoff, gbase, voff) do { _Pragma("unroll") for (int _i = 0; _i < 2; ++_i) \
        __builtin_amdgcn_global_load_lds((const unsigned*)((const char*)(gbase) + (voff)[_i]), (PG8_LAS unsigned*)(lds + (bufoff) + ldsw + _i * 8192), 16, 0, 0); } while (0)
#define PG8_LDA(dst, b, h) do { _Pragma("unroll") for (int m = 0; m < 4; ++m) _Pragma("unroll") for (int k = 0; k < 2; ++k) dst[m][k] = *(const PG8_LAS bf16x8*)(lds + PG8_SA(b, h) + aoff + m * 2048 + k * 1024); } while (0)
#define PG8_LDB(dst, b, h) do { _Pragma("unroll") for (int n = 0; n < 2; ++n) _Pragma("unroll") for (int k = 0; k < 2; ++k) dst[n][k] = *(const PG8_LAS bf16x8*)(lds + PG8_SB(b, h) + boff + n * 2048 + k * 1024); } while (0)
#define PG8_MMA(ai, bj, At, Bt) do { __builtin_amdgcn_s_setprio(1); _Pragma("unroll") for (int m = 0; m < 4; ++m) _Pragma("unroll") for (int n = 0; n < 2; ++n) _Pragma("unroll") for (int k = 0; k < 2; ++k) \
        acc[ai][bj][m][n] = __builtin_amdgcn_mfma_f32_16x16x32_bf16(Bt[n][k], At[m][k], acc[ai][bj][m][n], 0, 0, 0); __builtin_amdgcn_s_setprio(0); } while (0)
#define PG8_WAIT_V(n) asm volatile("s_waitcnt vmcnt(" #n ")" ::: "memory")
#define PG8_WAIT_L(n) asm volatile("s_waitcnt lgkmcnt(" #n ")" ::: "memory")
#define PG8_BAR __builtin_amdgcn_s_barrier()
#define PG8_SCHED __builtin_amdgcn_sched_barrier(0)
    Unit cur, nxt; int ui = 0;
    if (!S.next(0, cur)) return;
    f32x4 acc[2][2][4][2];
#pragma unroll
    for (int a = 0; a < 2; ++a)
#pragma unroll
        for (int b = 0; b < 2; ++b)
#pragma unroll
            for (int m = 0; m < 4; ++m)
#pragma unroll
                for (int n = 0; n < 2; ++n) acc[a][b][m][n] = (f32x4){0.f, 0.f, 0.f, 0.f};
    bf16x8 At[4][2], B0[2][2], B1[2][2];
    const char* cA = (const char*)g.A + (size_t)cur.pm * tstepA; const char* cB = (const char*)g.Bt + (size_t)cur.pn * tstepB;
    S.a_ready(cur);
    if constexpr (SP2) {
        PG8_STAGE(PG8_SB(0, 0), cB, voffB); PG8_STAGE(PG8_SB(0, 1), cB + hstepB, voffB); PG8_STAGE(PG8_SA(0, 0), cA, voffA); PG8_STAGE(PG8_SA(0, 1), cA + hstepA, voffA);
        if (wr == 1) PG8_BAR;
        PG8_WAIT_V(2); PG8_BAR;
        PG8_STAGE(PG8_SB(1, 0), cB + kstep, voffB); PG8_STAGE(PG8_SA(1, 0), cA + kstep, voffA); PG8_STAGE(PG8_SB(1, 1), cB + hstepB + kstep, voffB);
        PG8_WAIT_V(6); PG8_BAR;
    } else {
        PG8_STAGE(PG8_SB(0, 0), cB, voffB); PG8_STAGE(PG8_SA(0, 0), cA, voffA); PG8_STAGE(PG8_SB(0, 1), cB + hstepB, voffB); PG8_STAGE(PG8_SA(0, 1), cA + hstepA, voffA);
        if (wr == 1) PG8_BAR;
        PG8_WAIT_V(4); PG8_BAR;
        PG8_STAGE(PG8_SB(1, 0), cB + kstep, voffB); PG8_STAGE(PG8_SA(1, 0), cA + kstep, voffA); PG8_STAGE(PG8_SB(1, 1), cB + hstepB + kstep, voffB);
        PG8_WAIT_V(6); PG8_BAR;
    }
    for (;;) {
        const bool has_next = S.next(ui + 1, nxt);
        const char* nA = has_next ? (const char*)g.A + (size_t)nxt.pm * tstepA : cA; const char* nB = has_next ? (const char*)g.Bt + (size_t)nxt.pn * tstepB : cB;
        for (int t = 0; t < nt; t += 2) {
            const bool last = (t == nt - 2);
            const char* a1 = cA + (size_t)(t + 1) * kstep;
            const char* a2 = last ? nA : cA + (size_t)(t + 2) * kstep; const char* b2 = last ? nB : cB + (size_t)(t + 2) * kstep;
            const char* a3 = a2 + kstep; const char* b3 = b2 + kstep;
            if (last && has_next) S.a_ready(nxt);
            if constexpr (SP2) {
            PG8_LDB(B0, 0, 0); PG8_LDB(B1, 0, 1); PG8_SCHED; PG8_LDA(At, 0, 0); PG8_STAGE(PG8_SA(1, 1), a1 + hstepA, voffA);
            PG8_WAIT_V(8); PG8_WAIT_L(0); PG8_BAR; PG8_MMA(0, 0, At, B0); PG8_MMA(0, 1, At, B1); PG8_BAR; PG8_SCHED;
            PG8_LDA(At, 0, 1); PG8_STAGE(PG8_SB(0, 0), b2, voffB); PG8_STAGE(PG8_SB(0, 1), b2 + hstepB, voffB); PG8_STAGE(PG8_SA(0, 0), a2, voffA);
            PG8_WAIT_V(8); PG8_WAIT_L(0); PG8_BAR; PG8_MMA(1, 0, At, B0); PG8_MMA(1, 1, At, B1); PG8_BAR; PG8_SCHED;
            PG8_LDB(B0, 1, 0); PG8_LDB(B1, 1, 1); PG8_SCHED; PG8_LDA(At, 1, 0); PG8_STAGE(PG8_SA(0, 1), a2 + hstepA, voffA);
            PG8_WAIT_V(8); PG8_WAIT_L(0); PG8_BAR; PG8_MMA(0, 0, At, B0); PG8_MMA(0, 1, At, B1); PG8_BAR; PG8_SCHED;
            PG8_LDA(At, 1, 1); PG8_STAGE(PG8_SB(1, 0), b3, voffB); PG8_STAGE(PG8_SB(1, 1), b3 + hstepB, voffB); PG8_STAGE(PG8_SA(1, 0), a3, voffA);
            PG8_WAIT_V(8); PG8_WAIT_L(0); PG8_BAR; PG8_MMA(1, 0, At, B0); PG8_MMA(1, 1, At, B1); PG8_BAR; PG8_SCHED;
            } else {
            PG8_LDB(B0, 0, 0); PG8_SCHED; PG8_LDA(At, 0, 0); PG8_STAGE(PG8_SA(1, 1), a1 + hstepA, voffA);
            PG8_WAIT_L(8); PG8_BAR; PG8_WAIT_L(0); PG8_MMA(0, 0, At, B0); PG8_BAR; PG8_SCHED;
            PG8_LDB(B1, 0, 1); PG8_STAGE(PG8_SB(0, 0), b2, voffB);
            PG8_BAR; PG8_WAIT_L(0); PG8_MMA(0, 1, At, B1); PG8_BAR;
            PG8_LDA(At, 0, 1); PG8_STAGE(PG8_SA(0, 0), a2, voffA);
            PG8_BAR; PG8_WAIT_L(0); PG8_MMA(1, 0, At, B0); PG8_BAR; PG8_SCHED;
            PG8_STAGE(PG8_SB(0, 1), b2 + hstepB, voffB);
            PG8_WAIT_V(6); PG8_BAR; PG8_MMA(1, 1, At, B1); PG8_BAR;
            PG8_LDB(B0, 1, 0); PG8_SCHED; PG8_LDA(At, 1, 0); PG8_STAGE(PG8_SA(0, 1), a2 + hstepA, voffA);
            PG8_WAIT_L(8); PG8_BAR; PG8_WAIT_L(0); PG8_MMA(0, 0, At, B0); PG8_BAR; PG8_SCHED;
            PG8_LDB(B1, 1, 1); PG8_STAGE(PG8_SB(1, 0), b3, voffB);
            PG8_BAR; PG8_WAIT_L(0); PG8_MMA(0, 1, At, B1); PG8_BAR;
            PG8_LDA(At, 1, 1); PG8_STAGE(PG8_SA(1, 0), a3, voffA);
            PG8_BAR; PG8_WAIT_L(0); PG8_MMA(1, 0, At, B0); PG8_BAR; PG8_SCHED;
            PG8_STAGE(PG8_SB(1, 1), b3 + hstepB, voffB);
            PG8_WAIT_V(6); PG8_BAR; PG8_MMA(1, 1, At, B1); PG8_BAR;
            }
        }
        if constexpr (ALIGN_EPI) { if (wr == 0) PG8_BAR; }
        if constexpr (!Epi::AFTER_DRAIN) { E(acc, cur, wr, wc, fr, fq); S.done(cur); }
        if (!has_next) break;
#pragma unroll
        for (int a = 0; a < 2; ++a)
#pragma unroll
            for (int b = 0; b < 2; ++b)
#pragma unroll
                for (int m = 0; m < 4; ++m)
#pragma unroll
                    for (int n = 0; n < 2; ++n) acc[a][b][m][n] = (f32x4){0.f, 0.f, 0.f, 0.f};
        cur = nxt; cA = nA; cB = nB; ++ui;
        if constexpr (ALIGN_EPI) { if (wr == 1) PG8_BAR; }
    }
    PG8_WAIT_V(0);
    if constexpr (!ALIGN_EPI) { if (wr == 0) PG8_BAR; }
    PG8_BAR;
    if constexpr (Epi::AFTER_DRAIN) { E.fused(acc, cur, wr, wc, fr, fq, lds, wid, lane); S.done(cur); }
#undef PG8_SA
#undef PG8_SB
#undef PG8_STAGE
#undef PG8_LDA
#undef PG8_LDB
#undef PG8_MMA
#undef PG8_WAIT_V
#undef PG8_WAIT_L
#undef PG8_BAR
#undef PG8_SCHED
}
struct EpiU {
    static constexpr bool PERM = true, AFTER_DRAIN = false;
    bf16_t* O; int ldc; const float* rsq;
    __device__ __forceinline__ void operator()(const f32x4 (&acc)[2][2][4][2], const Unit& u, int wr, int wc, int fr, int fq) const {
        const int row0 = u.pm * BM + wr * 64 + fr, col0 = u.pn * BM + wc * 32 + 8 * fq;
#pragma unroll
        for (int ai = 0; ai < 2; ++ai)
#pragma unroll
            for (int m = 0; m < 4; ++m) { bf16_t* rowp = O + (size_t)(row0 + ai * HALF + m * 16) * ldc + col0;
                const float rs = rsqrtf(rsq[row0 + ai * HALF + m * 16] * (1.f / DM) + EPS);
#pragma unroll
                for (int bj = 0; bj < 2; ++bj) { const f32x4 v0 = acc[ai][bj][m][0] * rs, v1 = acc[ai][bj][m][1] * rs;
                    u32x4 w; w.x = cvt_pk_bf16(v0[0], v0[1]); w.y = cvt_pk_bf16(v0[2], v0[3]); w.z = cvt_pk_bf16(v1[0], v1[1]); w.w = cvt_pk_bf16(v1[2], v1[3]);
                    *(u32x4*)(rowp + bj * HALF) = w; } }
    }
};
struct EpiQ {
    static constexpr bool PERM = true, AFTER_DRAIN = false;
    bf16_t* Q; const float* cs; const float* sn;
    __device__ __forceinline__ void operator()(const f32x4 (&acc)[2][2][4][2], const Unit& u, int wr, int wc, int fr, int fq) const {
        const int row0 = u.pm * BM + wr * 64 + fr;
#pragma unroll
        for (int ai = 0; ai < 2; ++ai)
#pragma unroll
            for (int m = 0; m < 4; ++m) { const int row = row0 + ai * HALF + m * 16, b = row / T, t = row % T;
#pragma unroll
                for (int bj = 0; bj < 2; ++bj) { const int c = u.pn * BM + bj * HALF + wc * 32 + 8 * fq, hh = c / 192, e = c % 192;
                    const f32x4 v0 = acc[ai][bj][m][0], v1 = acc[ai][bj][m][1];
                    float vals[8] = {v0[0], v0[1], v0[2], v0[3], v1[0], v1[1], v1[2], v1[3]};
                    if (e >= 128) { const int i0 = (e - 128) >> 1; const f32x4 cc = *(const f32x4*)(cs + (size_t)row * 32 + i0), ss = *(const f32x4*)(sn + (size_t)row * 32 + i0);
#pragma unroll
                        for (int p = 0; p < 4; ++p) { const float x1 = vals[2 * p], x2 = vals[2 * p + 1]; vals[2 * p] = x1 * cc[p] - x2 * ss[p]; vals[2 * p + 1] = x2 * cc[p] + x1 * ss[p]; } }
                    constexpr float QS = 0.07216878364870322f * 1.4426950408889634f;
#pragma unroll
                    for (int p_ = 0; p_ < 8; ++p_) vals[p_] *= QS;
                    u32x4 w; w.x = cvt_pk_bf16(vals[0], vals[1]); w.y = cvt_pk_bf16(vals[2], vals[3]); w.z = cvt_pk_bf16(vals[4], vals[5]); w.w = cvt_pk_bf16(vals[6], vals[7]);
                    *(u32x4*)(Q + ((size_t)(b * 8 + hh) * T + t) * 192 + e) = w; } }
    }
};
struct EpiKV {
    static constexpr bool PERM = true, AFTER_DRAIN = false;
    bf16_t* KN; bf16_t* V;
    __device__ __forceinline__ void operator()(const f32x4 (&acc)[2][2][4][2], const Unit& u, int wr, int wc, int fr, int fq) const {
        const int row0 = u.pm * BM + wr * 64 + fr, e = wc * 32 + 8 * fq;
#pragma unroll
        for (int ai = 0; ai < 2; ++ai)
#pragma unroll
            for (int m = 0; m < 4; ++m) { const int row = row0 + ai * HALF + m * 16, b = row / T, t = row % T;
                const size_t off = ((size_t)(b * 8 + u.pn) * T + t) * 128 + e;
#pragma unroll
                for (int bj = 0; bj < 2; ++bj) { const f32x4 v0 = acc[ai][bj][m][0], v1 = acc[ai][bj][m][1];
                    u32x4 w; w.x = cvt_pk_bf16(v0[0], v0[1]); w.y = cvt_pk_bf16(v0[2], v0[3]); w.z = cvt_pk_bf16(v1[0], v1[1]); w.w = cvt_pk_bf16(v1[2], v1[3]);
                    *(u32x4*)((bj ? V : KN) + off) = w; } }
    }
};
struct EpiSwi {
    static constexpr bool PERM = false, AFTER_DRAIN = false;
    bf16_t* H; const float* rsq;
    __device__ __forceinline__ void operator()(const f32x4 (&acc)[2][2][4][2], const Unit& u, int wr, int wc, int fr, int fq) const {
        const int row0 = u.pm * BM + wr * 64 + fr;
#pragma unroll
        for (int ai = 0; ai < 2; ++ai)
#pragma unroll
            for (int m = 0; m < 4; ++m) { bf16_t* rowp = H + (size_t)(row0 + ai * HALF + m * 16) * DFF;
                const float rs = rsqrtf(rsq[row0 + ai * HALF + m * 16] * (1.f / DM) + EPS);
#pragma unroll
                for (int bj = 0; bj < 2; ++bj) { const f32x4 a = acc[ai][bj][m][0] * rs, g = acc[ai][bj][m][1] * rs;
                    const int col = 16 * (8 * u.pn + 4 * bj + wc) + 4 * fq;
                    u32x2 w; w.x = cvt_pk_bf16(silu_(a[0]) * g[0], silu_(a[1]) * g[1]); w.y = cvt_pk_bf16(silu_(a[2]) * g[2], silu_(a[3]) * g[3]);
                    *(u32x2*)(rowp + col) = w; } }
    }
};
struct EpiRes {
    static constexpr bool PERM = false, AFTER_DRAIN = false;
    const float* base; float* out; bf16_t* hb; float* rsq;
    __device__ __forceinline__ void operator()(const f32x4 (&acc)[2][2][4][2], const Unit& u, int wr, int wc, int fr, int fq) const {
        const int row0 = u.pm * BM + wr * 64 + fr, col0 = u.pn * BM + wc * 32 + 4 * fq;
#pragma unroll
        for (int ai = 0; ai < 2; ++ai)
#pragma unroll
            for (int m = 0; m < 4; ++m) { const size_t off = (size_t)(row0 + ai * HALF + m * 16) * DM + col0; float ss = 0.f;
#pragma unroll
                for (int bj = 0; bj < 2; ++bj)
#pragma unroll
                    for (int n = 0; n < 2; ++n) { const f32x4 bs = *(const f32x4*)(base + off + bj * HALF + n * 16); const f32x4 o = bs + acc[ai][bj][m][n];
                        *(f32x4*)(out + off + bj * HALF + n * 16) = o;
                        u32x2 w; w.x = cvt_pk_bf16(o[0], o[1]); w.y = cvt_pk_bf16(o[2], o[3]); *(u32x2*)(hb + off + bj * HALF + n * 16) = w;
                        ss += (o[0] * o[0] + o[1] * o[1]) + (o[2] * o[2] + o[3] * o[3]); }
                ss += __shfl_xor(ss, 16); ss += __shfl_xor(ss, 32);
                if (fq == 0) unsafeAtomicAdd(rsq + row0 + ai * HALF + m * 16, ss); }
    }
};

}
namespace att {
constexpr int KVBLK = 64;
constexpr float SCALE = 0.07216878364870322f;
constexpr float THR = 8.f;
constexpr int SHM_V = KVBLK * 128 * 2, SHM_K = KVBLK * 192 * 2;
#ifndef ATT_SDEPTH
#define ATT_SDEPTH 1
#endif
constexpr int SDEPTH = ATT_SDEPTH;
#define KSWZ(row, colB) ((row) * 384 + ((colB) ^ (((row) & 7) << 4)))
#define SBAR() __builtin_amdgcn_sched_barrier(0)
__device__ __forceinline__ int crow(int r, int hi) { return (r & 3) + 8 * (r >> 2) + 4 * hi; }
__device__ __forceinline__ unsigned cvtpk(float lo, float hi) { return cvt_pk_bf16(lo, hi); }
template <bool FIRST>
__device__ __forceinline__ void partialSM(f32x16& p0, f32x16& p1, float& m_reg, float& alpha) {
  constexpr float THR2 = THR * 1.4426950408889634f;
  float pmax = p0[0];
#pragma unroll
  for (int r = 1; r < 16; ++r) pmax = fmaxf(pmax, p0[r]);
#pragma unroll
  for (int r = 0; r < 16; ++r) pmax = fmaxf(pmax, p1[r]);
  { auto rr = __builtin_amdgcn_permlane32_swap(__float_as_uint(pmax), __float_as_uint(pmax), false, false);
    pmax = fmaxf(__uint_as_float(rr[0]), __uint_as_float(rr[1])); }
  if (!FIRST && __builtin_expect(__all(pmax <= THR2), 1)) { alpha = 1.f; }
  else { const float d = FIRST ? pmax : fmaxf(pmax, 0.f); alpha = FIRST ? 1.f : __builtin_amdgcn_exp2f(-d); m_reg += d;
#pragma unroll
    for (int r = 0; r < 16; ++r) p0[r] -= d;
#pragma unroll
    for (int r = 0; r < 16; ++r) p1[r] -= d; }
#pragma unroll
  for (int r = 0; r < 16; ++r) p0[r] = __builtin_amdgcn_exp2f(p0[r]);
}
__device__ __forceinline__ void finishSM(f32x16& p0, f32x16& p1, float alpha, float& l_reg, bf16x8& pa0, bf16x8& pa1, bf16x8& pa2, bf16x8& pa3) {
#pragma unroll
  for (int r = 0; r < 16; ++r) p1[r] = __builtin_amdgcn_exp2f(p1[r]);
  float ps = 0;
#pragma unroll
  for (int r = 0; r < 16; ++r) ps += p0[r];
#pragma unroll
  for (int r = 0; r < 16; ++r) ps += p1[r];
  { auto rr = __builtin_amdgcn_permlane32_swap(__float_as_uint(ps), __float_as_uint(ps), false, false);
    ps = __uint_as_float(rr[0]) + __uint_as_float(rr[1]); }
  l_reg = l_reg * alpha + ps;
#define PK4(P, BASE, OUT) do { unsigned a0 = cvtpk(P[BASE + 0], P[BASE + 1]), a1 = cvtpk(P[BASE + 2], P[BASE + 3]);   \
    unsigned b0 = cvtpk(P[BASE + 4], P[BASE + 5]), b1 = cvtpk(P[BASE + 6], P[BASE + 7]);                              \
    auto r0 = __builtin_amdgcn_permlane32_swap(a0, b0, false, false); auto r1 = __builtin_amdgcn_permlane32_swap(a1, b1, false, false); \
    u32x4 w = {r0[0], r1[0], r0[1], r1[1]}; OUT = __builtin_bit_cast(bf16x8, w); } while (0)
  PK4(p0, 0, pa0); PK4(p0, 8, pa1); PK4(p1, 0, pa2); PK4(p1, 8, pa3);
#undef PK4
}
__device__ __forceinline__ void qkt(f32x16& p0, f32x16& p1, const char* Ks, const bf16x8* qr, const char* qL, int r32, int hi, float negm) {
#pragma unroll
  for (int r = 0; r < 16; ++r) { p0[r] = negm; p1[r] = negm; }
#pragma unroll
  for (int d0 = 0; d0 < 12; ++d0) { int cb = (d0 * 16 + hi * 8) * 2;
    bf16x8 b0 = *reinterpret_cast<const bf16x8*>(Ks + KSWZ(r32, cb));
    bf16x8 b1 = *reinterpret_cast<const bf16x8*>(Ks + KSWZ(32 + r32, cb));
    const bf16x8 q = d0 < 8 ? qr[d0 < 8 ? d0 : 0] : *reinterpret_cast<const bf16x8*>(qL + (d0 - 8) * 1024);
    p0 = __builtin_amdgcn_mfma_f32_32x32x16_bf16(b0, q, p0, 0, 0, 0);
    p1 = __builtin_amdgcn_mfma_f32_32x32x16_bf16(b1, q, p1, 0, 0, 0); }
}
__device__ __forceinline__ int v_st(int k, int c) { const int kk = (k & ~0xC) | ((k & 4) << 1) | ((k & 8) >> 1); return ((kk >> 3) * 4 + (c >> 5)) * 512 + ((kk & 7) * 32 + (c & 31)) * 2; }
__device__ __forceinline__ int v_rd_base(int lane) { return ((lane & 3) << 3) | (((lane >> 2) & 3) << 6) | (((lane >> 4) & 1) << 5) | (((lane >> 5) & 1) << 8); }
constexpr int v_rd_off(int d0, int ks, int half) { return d0 * 512 + ks * 4096 + half * 2048; }
template <int OFF> __device__ __forceinline__ s16x4 tr_read(int vb) {
  s16x4 r; asm volatile("ds_read_b64_tr_b16 %0, %1 offset:%2" : "=&v"(r) : "v"(vb), "i"(OFF) : "memory"); return r;
}
template <int D0> __device__ __forceinline__ void pv_one(f32x16& od, int vb, bf16x8 pa0, bf16x8 pa1, bf16x8 pa2, bf16x8 pa3) {
  const s16x4 l0 = tr_read<v_rd_off(D0, 0, 0)>(vb), h0 = tr_read<v_rd_off(D0, 0, 1)>(vb), l1 = tr_read<v_rd_off(D0, 1, 0)>(vb), h1 = tr_read<v_rd_off(D0, 1, 1)>(vb);
  const s16x4 l2 = tr_read<v_rd_off(D0, 2, 0)>(vb), h2 = tr_read<v_rd_off(D0, 2, 1)>(vb), l3 = tr_read<v_rd_off(D0, 3, 0)>(vb), h3 = tr_read<v_rd_off(D0, 3, 1)>(vb);
  asm volatile("s_waitcnt lgkmcnt(0)" ::: "memory"); SBAR();
#define PK(L, H) (bf16x8){L[0], L[1], L[2], L[3], H[0], H[1], H[2], H[3]}
  od = __builtin_amdgcn_mfma_f32_32x32x16_bf16(pa0, PK(l0, h0), od, 0, 0, 0);
  od = __builtin_amdgcn_mfma_f32_32x32x16_bf16(pa1, PK(l1, h1), od, 0, 0, 0);
  od = __builtin_amdgcn_mfma_f32_32x32x16_bf16(pa2, PK(l2, h2), od, 0, 0, 0);
  od = __builtin_amdgcn_mfma_f32_32x32x16_bf16(pa3, PK(l3, h3), od, 0, 0, 0);
#undef PK
}
__device__ __forceinline__ void pv_d0(f32x16* o, int vb, bf16x8 pa0, bf16x8 pa1, bf16x8 pa2, bf16x8 pa3) {
  pv_one<0>(o[0], vb, pa0, pa1, pa2, pa3); pv_one<1>(o[1], vb, pa0, pa1, pa2, pa3); pv_one<2>(o[2], vb, pa0, pa1, pa2, pa3); pv_one<3>(o[3], vb, pa0, pa1, pa2, pa3);
}
__device__ __forceinline__ void attn_unit(const bf16_t* __restrict__ Qb, const bf16_t* __restrict__ Kn, const bf16_t* __restrict__ Kr, const bf16_t* __restrict__ Vh,
                                          bf16_t* __restrict__ Ob, char* lds) {
  const int tid = opaque_tid(), wid = tid >> 6, lane = tid & 63, r32 = lane & 31, hi = lane >> 5;
  char* V_lds = lds; char* K_lds = lds + 2 * SHM_V;
  float* ws = (float*)(lds + 2 * SHM_V + 2 * SHM_K) + wid * 64; float* li_l = ws; float* al_l = ws + 32;
  float m_reg = 0.f, l_reg = 0; f32x16 o[4] = {}; bf16x8 qr[8];
  char* qL = lds + 2 * SHM_V + 2 * SHM_K + 2048 + wid * 4096 + lane * 16;
  const bf16_t* Qw = Qb + (long)(wid * 32 + r32) * 192 + hi * 8;
#pragma unroll
  for (int d0 = 0; d0 < 8; ++d0) qr[d0] = *reinterpret_cast<const bf16x8*>(Qw + d0 * 16);
#pragma unroll
  for (int d0 = 8; d0 < 12; ++d0) *reinterpret_cast<bf16x8*>(qL + (d0 - 8) * 1024) = *reinterpret_cast<const bf16x8*>(Qw + d0 * 16);
  const int sr = tid >> 4, sc = (tid & 15) * 8, vst0 = v_st(sr, sc), vst1 = v_st(32 + sr, sc);
  const int rr = tid >> 3, rc = (tid & 7) * 8;
  const int kst0 = KSWZ(sr, sc * 2), kst1 = KSWZ(32 + sr, sc * 2), kst2 = KSWZ(rr, 256 + rc * 2);
  const int vb0 = (int)(uintptr_t)V_lds + v_rd_base(lane);
  struct { bf16x8 vs0, vs1, ks0, ks1, ks2; } sr_[SDEPTH];
#define SLOAD(i, k0) do { sr_[i].vs0 = *(const bf16x8*)(&Vh[(long)((k0) + sr) * 128 + sc]); sr_[i].vs1 = *(const bf16x8*)(&Vh[(long)((k0) + 32 + sr) * 128 + sc]); \
    sr_[i].ks0 = *(const bf16x8*)(&Kn[(long)((k0) + sr) * 128 + sc]); sr_[i].ks1 = *(const bf16x8*)(&Kn[(long)((k0) + 32 + sr) * 128 + sc]); \
    sr_[i].ks2 = *(const bf16x8*)(&Kr[(long)((k0) + rr) * 64 + rc]); } while (0)
#define SWRITE(b, i) do { *(bf16x8*)(V_lds + (b) * SHM_V + vst0) = sr_[i].vs0; *(bf16x8*)(V_lds + (b) * SHM_V + vst1) = sr_[i].vs1; \
    *(bf16x8*)(K_lds + (b) * SHM_K + kst0) = sr_[i].ks0; *(bf16x8*)(K_lds + (b) * SHM_K + kst1) = sr_[i].ks1; *(bf16x8*)(K_lds + (b) * SHM_K + kst2) = sr_[i].ks2; } while (0)
#define SWAIT() do { if constexpr (SDEPTH == 2) asm volatile("s_waitcnt vmcnt(5)" ::: "memory"); else asm volatile("s_waitcnt vmcnt(0)" ::: "memory"); } while (0)
#define RESC(a) do { if (__any((a) < 1.f)) { if (hi == 0) al_l[r32] = (a); asm volatile("s_waitcnt lgkmcnt(0)" ::: "memory"); \
    _Pragma("unroll") for (int d = 0; d < 4; ++d) _Pragma("unroll") for (int r = 0; r < 16; ++r) o[d][r] *= al_l[crow(r, hi)]; } } while (0)
  f32x16 pA0, pA1, pB0, pB1; float alA, alB; bf16x8 pa0, pa1, pa2, pa3; const int NT = T / KVBLK;
  constexpr int SE = 0, SO = SDEPTH - 1;
  SLOAD(SE, 0); asm volatile("s_waitcnt vmcnt(0)" ::: "memory"); SWRITE(0, SE); __syncthreads();
  qkt(pA0, pA1, K_lds, qr, qL, r32, hi, 0.f); partialSM<true>(pA0, pA1, m_reg, alA);
  SLOAD(SO, KVBLK); if constexpr (SDEPTH == 2) { if (2 < NT) SLOAD(SE, 2 * KVBLK); }
  SWAIT(); SWRITE(1, SO); __syncthreads();
  for (int j = 1; j + 1 < NT; j += 2) {
    SBAR(); qkt(pB0, pB1, K_lds + SHM_K, qr, qL, r32, hi, -m_reg);
    finishSM(pA0, pA1, alA, l_reg, pa0, pa1, pa2, pa3); SBAR();
    SLOAD(SO, (j + SDEPTH) * KVBLK); SBAR();
    pv_d0(o, vb0, pa0, pa1, pa2, pa3); partialSM<false>(pB0, pB1, m_reg, alB);
    __syncthreads(); SWAIT(); SWRITE(0, SE);
    RESC(alB); __syncthreads();
    SBAR(); qkt(pA0, pA1, K_lds, qr, qL, r32, hi, -m_reg);
    finishSM(pB0, pB1, alB, l_reg, pa0, pa1, pa2, pa3); SBAR();
    if (SDEPTH == 1 || j + 3 < NT) SLOAD(SE, (j + 1 + SDEPTH) * KVBLK); SBAR();
    pv_d0(o, vb0 + (int)SHM_V, pa0, pa1, pa2, pa3); partialSM<false>(pA0, pA1, m_reg, alA);
    __syncthreads(); SWAIT(); SWRITE(1, SO);
    RESC(alA); __syncthreads();
  }
  SBAR(); qkt(pB0, pB1, K_lds + SHM_K, qr, qL, r32, hi, -m_reg);
  finishSM(pA0, pA1, alA, l_reg, pa0, pa1, pa2, pa3); SBAR();
  pv_d0(o, vb0, pa0, pa1, pa2, pa3); partialSM<false>(pB0, pB1, m_reg, alB);
  __syncthreads(); RESC(alB);
  finishSM(pB0, pB1, alB, l_reg, pa0, pa1, pa2, pa3); SBAR();
  pv_d0(o, vb0 + (int)SHM_V, pa0, pa1, pa2, pa3);
  if (hi == 0) li_l[r32] = l_reg; asm volatile("s_waitcnt lgkmcnt(0)" ::: "memory");
  float rli[16];
#pragma unroll
  for (int r = 0; r < 16; ++r) rli[r] = __builtin_amdgcn_rcpf(li_l[crow(r, hi)]);
  bf16_t* Ow = Ob + (long)(wid * 32) * DM;
#pragma unroll
  for (int r = 0; r < 16; ++r) { int orow = crow(r, hi);
#pragma unroll
    for (int d0 = 0; d0 < 4; ++d0) Ow[(long)orow * DM + d0 * 32 + r32] = (bf16_t)f2bf(o[d0][r] * rli[r]); }
#undef SLOAD
#undef SWRITE
#undef SWAIT
#undef RESC
  __syncthreads();
}
}
namespace scan {
constexpr int LDT = 72;
constexpr int SC_G = 0, SC_K = 33792, SC_QT = SC_K + 17408, SC_QG = SC_QT + 17408, SC_VT = SC_QG + 17408, SC_P = SC_VT + 18432, SC_SEG = SC_P + 9216, SC_RSQ = SC_SEG + 4096,
              SC_END = SC_RSQ + 2048, SC_KDT = SC_QT;
static_assert(SC_END <= LDS_BYTES, "scan LDS");

template <int TYPE> struct Cfg { static constexpr int DK = TYPE ? 128 : 64, LDG = DK + 4, LDK_ = DK + 8, ND8 = DK / 8; };

struct LgRaw { bf16x8 a0, a1, k; };
template <int TYPE>
__device__ __forceinline__ LgRaw lg_issue(const bf16_t* u, int h, int dir, size_t tok0, int tid) {
    LgRaw r;
    if constexpr (TYPE == 1) {
        const int i0 = tid >> 4, d8 = tid & 15, col = (dir ? C_HFB : C_HFF) + h * 128 + d8 * 8;
        r.a0 = *(const bf16x8*)(u + (tok0 + i0) * DINP + col); r.a1 = *(const bf16x8*)(u + (tok0 + 32 + i0) * DINP + col); r.k = r.a0;
    } else {
        const int i = tid >> 3, d8 = tid & 7; const bf16_t* ur = u + (tok0 + i) * DINP;
        r.a0 = *(const bf16x8*)(ur + (dir ? C_GAB : C_GAF)); r.a1 = *(const bf16x8*)(ur + (dir ? C_GAB : C_GAF) + 8); r.k = *(const bf16x8*)(ur + C_GK + h * 64 + d8 * 8);
    }
    return r;
}
template <int TYPE>
__device__ __forceinline__ void lg_compute(const KArgs& a, unsigned char* wsb, int l, int h, int dir, const LgRaw& raw, LAS unsigned char* lds, int tid) {
    using C = Cfg<TYPE>;
    LAS float* G = (LAS float*)(lds + SC_G); LAS bf16_t* Kb = (LAS bf16_t*)(lds + SC_K);
    if constexpr (TYPE == 1) {
        const float* lbp = (const float*)(wsb + WS_LB) + (dir * DEPTH + l) * 512 + h * 128;
        const int d8 = tid & 15;
        const f32x4 lb0 = *(const f32x4*)(lbp + d8 * 8), lb1 = *(const f32x4*)(lbp + d8 * 8 + 4);
        const float lb[8] = {lb0[0], lb0[1], lb0[2], lb0[3], lb1[0], lb1[1], lb1[2], lb1[3]};
#pragma unroll
        for (int e2 = 0; e2 < 2; ++e2) { const int i = (tid >> 4) + 32 * e2;
            float z[8], lg[8], kk[8]; unpack8(e2 ? raw.a1 : raw.a0, z);
#pragma unroll
            for (int e = 0; e < 8; ++e) { const float sg = sigmoid_(fmaxf(z[e], -80.f)); lg[e] = __logf(lb[e] + (1.f - lb[e]) * sg); kk[e] = (1.f - lb[e]) * (1.f - sg); }
            *(LAS f32x4*)(G + i * C::LDG + d8 * 8) = (f32x4){lg[0], lg[1], lg[2], lg[3]}; *(LAS f32x4*)(G + i * C::LDG + d8 * 8 + 4) = (f32x4){lg[4], lg[5], lg[6], lg[7]};
            *(LAS bf16x8*)(Kb + i * C::LDK_ + d8 * 8) = pack8(kk); }
    } else {
        const int i = tid >> 3, d8 = tid & 7;
        float ua[16]; unpack8(raw.a0, ua); unpack8(raw.a1, ua + 8);
        const float* up = (const float*)a.in[3] + (size_t)((l * 2 + dir) * 16) * 256 + h * 64 + d8 * 8;
        const float* bs = (const float*)a.in[4] + (l * 2 + dir) * 256 + h * 64 + d8 * 8;
        f32x4 z0 = *(const f32x4*)bs, z1 = *(const f32x4*)(bs + 4);
#pragma unroll
        for (int r = 0; r < 16; ++r) { z0 += ua[r] * *(const f32x4*)(up + r * 256); z1 += ua[r] * *(const f32x4*)(up + r * 256 + 4); }
        f32x4 g0, g1;
#pragma unroll
        for (int e = 0; e < 4; ++e) { g0[e] = logsigmoid_(z0[e]) * (1.f / 16.f); g1[e] = logsigmoid_(z1[e]) * (1.f / 16.f); }
        *(LAS f32x4*)(G + i * C::LDG + d8 * 8) = g0; *(LAS f32x4*)(G + i * C::LDG + d8 * 8 + 4) = g1;
        *(LAS bf16x8*)(Kb + i * C::LDK_ + d8 * 8) = raw.k;
    }
}
template <int TYPE>
__device__ __forceinline__ void cumsum_g(int dir, LAS unsigned char* lds, int tid) {
    using C = Cfg<TYPE>; constexpr int NSEG = 512 / C::DK, SEGL = 64 / NSEG;
    LAS float* G = (LAS float*)(lds + SC_G); LAS float* SG = (LAS float*)(lds + SC_SEG);
    const int d = tid % C::DK, seg = tid / C::DK;
    __syncthreads();
    float run = 0.f;
#pragma unroll
    for (int ii = 0; ii < SEGL; ++ii) { const int i = seg * SEGL + (dir ? SEGL - 1 - ii : ii); run += G[i * C::LDG + d]; G[i * C::LDG + d] = run; }
    SG[seg * 128 + d] = run;
    __syncthreads();
    float off = 0.f;
#pragma unroll
    for (int s = 0; s < NSEG; ++s) { const bool before = dir ? (s > seg) : (s < seg); if (before) off += SG[s * 128 + d]; }
#pragma unroll
    for (int ii = 0; ii < SEGL; ++ii) { const int i = seg * SEGL + ii; G[i * C::LDG + d] += off; }
    __syncthreads();
}
struct VRaw { bf16x8 x0, x1; };
__device__ __forceinline__ VRaw vT_issue(const bf16_t* vsrc, int tid) {
    const int i0 = tid >> 4, v8 = tid & 15; VRaw r;
    r.x0 = *(const bf16x8*)(vsrc + (size_t)i0 * DINP + v8 * 8); r.x1 = *(const bf16x8*)(vsrc + (size_t)(32 + i0) * DINP + v8 * 8); return r;
}
__device__ __forceinline__ void vT_write(const VRaw& r, LAS unsigned char* lds, int tid) {
    LAS bf16_t* VT = (LAS bf16_t*)(lds + SC_VT);
    const int v8 = tid & 15;
#pragma unroll
    for (int e2 = 0; e2 < 2; ++e2) { const int i = (tid >> 4) + 32 * e2; const bf16x8 x = e2 ? r.x1 : r.x0; const int pc = ((((i >> 3) ^ (v8 & 7)) << 3) | (i & 7));
#pragma unroll
        for (int e = 0; e < 8; ++e) VT[(v8 * 8 + e) * LDT + pc] = (bf16_t)x[e]; }
}
__device__ __forceinline__ bf16x8 vt_frag(LAS bf16_t* VT, int v, int c8) {
    return *(LAS bf16x8*)(VT + v * LDT + ((c8 ^ ((v >> 3) & 7)) << 3));
}

template <int TYPE>
__device__ __forceinline__ void pass1_item(const KArgs& a, int l, int item, LAS unsigned char* lds) {
    unsigned char* const wsb = opq(a.ws);
    const int tid = opaque_tid();
    using C = Cfg<TYPE>; constexpr int DK = C::DK;
    const int c = item & (NCH - 1), dir = (item >> 8) & 1, h = (item >> 9) & 3, b = item >> 11;
    const size_t tok0 = (size_t)b * T + (size_t)c * 64;
    const bf16_t* u = (const bf16_t*)(wsb + WS_U);
    const int wid = tid >> 6, lane = tid & 63, fr = lane & 15, fq = lane >> 4;
    __syncthreads();
    { const LgRaw raw = lg_issue<TYPE>(u, h, dir, tok0, tid); const VRaw vr = vT_issue(u + tok0 * DINP + (TYPE ? C_HI : C_GV) + h * 128, tid);
      lg_compute<TYPE>(a, wsb, l, h, dir, raw, lds, tid); vT_write(vr, lds, tid); }
    cumsum_g<TYPE>(dir, lds, tid);
    LAS float* G = (LAS float*)(lds + SC_G); LAS bf16_t* Kb = (LAS bf16_t*)(lds + SC_K); LAS bf16_t* KDT = (LAS bf16_t*)(lds + SC_KDT); LAS bf16_t* VT = (LAS bf16_t*)(lds + SC_VT);
    const int last = dir ? 0 : 63;
    float* Dout = (float*)(wsb + (TYPE ? WS_DH : WS_DG)) + (size_t)item * DK;
#pragma unroll
    for (int e2 = 0; e2 < DK / 64; ++e2) { const int task = tid + 512 * e2, i = task & 63, d8 = task >> 6;
        const f32x4 g0 = *(LAS f32x4*)(G + i * C::LDG + d8 * 8), g1 = *(LAS f32x4*)(G + i * C::LDG + d8 * 8 + 4);
        const f32x4 t0 = *(LAS f32x4*)(G + last * C::LDG + d8 * 8), t1 = *(LAS f32x4*)(G + last * C::LDG + d8 * 8 + 4);
        float kk[8]; unpack8(*(LAS bf16x8*)(Kb + i * C::LDK_ + d8 * 8), kk);
#pragma unroll
        for (int e = 0; e < 8; ++e) { const float gg = e < 4 ? g0[e] : g1[e - 4], tt = e < 4 ? t0[e] : t1[e - 4];
            KDT[(d8 * 8 + e) * LDT + i] = (bf16_t)f2bf(kk[e] * __expf(tt - gg)); }
        if (i == 0) { *(f32x4*)(Dout + d8 * 8) = (f32x4){__expf(t0[0]), __expf(t0[1]), __expf(t0[2]), __expf(t0[3])};
                      *(f32x4*)(Dout + d8 * 8 + 4) = (f32x4){__expf(t1[0]), __expf(t1[1]), __expf(t1[2]), __expf(t1[3])}; } }
    __syncthreads();
    bf16_t* ST = (bf16_t*)(wsb + (TYPE ? WS_SH : WS_SG)) + (size_t)item * 128 * DK;
    const bf16x8 b0 = vt_frag(VT, wid * 16 + fr, fq), b1 = vt_frag(VT, wid * 16 + fr, 4 + fq);
#pragma unroll
    for (int dt = 0; dt < DK / 16; ++dt) {
        const bf16x8 a0 = *(LAS bf16x8*)(KDT + (dt * 16 + fr) * LDT + fq * 8), a1 = *(LAS bf16x8*)(KDT + (dt * 16 + fr) * LDT + 32 + fq * 8);
        f32x4 acc = {0.f, 0.f, 0.f, 0.f};
        acc = __builtin_amdgcn_mfma_f32_16x16x32_bf16(a0, b0, acc, 0, 0, 0);
        acc = __builtin_amdgcn_mfma_f32_16x16x32_bf16(a1, b1, acc, 0, 0, 0);
        u32x2 w; w.x = cvt_pk_bf16(acc[0], acc[1]); w.y = cvt_pk_bf16(acc[2], acc[3]);
        *(u32x2*)(ST + (size_t)(wid * 16 + fr) * DK + dt * 16 + fq * 4) = w;
    }
}

struct P2Chain { bf16_t* st; const float* dp; size_t sstride; int dstride; int dir; };
__device__ __forceinline__ P2Chain p2_chain(unsigned char* wsb, int type, int E) {
    const int DK = type ? 128 : 64, IPI = 128 * DK;
    const int chain = E / IPI, e = E % IPI;
    P2Chain c; c.st = (bf16_t*)(wsb + (type ? WS_SH : WS_SG)) + (size_t)chain * NCH * IPI + e;
    c.dp = (const float*)(wsb + (type ? WS_DH : WS_DG)) + (size_t)chain * NCH * DK + (e % DK);
    c.sstride = (size_t)IPI; c.dstride = DK; c.dir = chain & 1; return c;
}
__device__ __forceinline__ void pass2_triple(const KArgs& a, int t) {
    unsigned char* const wsb = opq(a.ws);
    const P2Chain c0 = p2_chain(wsb, 1, t), c1 = p2_chain(wsb, 1, t + 131072), c2 = p2_chain(wsb, 0, t);
    float s0 = 0.f, s1 = 0.f, s2 = 0.f;
    unsigned short uA[3][4], uB[3][4]; float dA[3][4], dB[3][4];
#define P2_CI(c, s) ((c).dir ? NCH - 1 - (s) : (s))
#define P2_LOAD(U, D, sb) do { _Pragma("unroll") for (int k = 0; k < 4; ++k) { \
        const int i0_ = P2_CI(c0, (sb) + k), i1_ = P2_CI(c1, (sb) + k), i2_ = P2_CI(c2, (sb) + k); \
        U[0][k] = c0.st[(size_t)i0_ * c0.sstride]; D[0][k] = c0.dp[(size_t)i0_ * c0.dstride]; \
        U[1][k] = c1.st[(size_t)i1_ * c1.sstride]; D[1][k] = c1.dp[(size_t)i1_ * c1.dstride]; \
        U[2][k] = c2.st[(size_t)i2_ * c2.sstride]; D[2][k] = c2.dp[(size_t)i2_ * c2.dstride]; } } while (0)
#define P2_STEP(U, D, sb) do { _Pragma("unroll") for (int k = 0; k < 4; ++k) { \
        const int i0_ = P2_CI(c0, (sb) + k), i1_ = P2_CI(c1, (sb) + k), i2_ = P2_CI(c2, (sb) + k); \
        c0.st[(size_t)i0_ * c0.sstride] = (bf16_t)f2bf(s0); s0 = D[0][k] * s0 + bf2f(U[0][k]); \
        c1.st[(size_t)i1_ * c1.sstride] = (bf16_t)f2bf(s1); s1 = D[1][k] * s1 + bf2f(U[1][k]); \
        c2.st[(size_t)i2_ * c2.sstride] = (bf16_t)f2bf(s2); s2 = D[2][k] * s2 + bf2f(U[2][k]); } } while (0)
    P2_LOAD(uA, dA, 0);
#pragma unroll 1
    for (int sb = 0; sb < NCH; sb += 8) {
        P2_LOAD(uB, dB, sb + 4);
        P2_STEP(uA, dA, sb);
        if (sb + 8 < NCH) P2_LOAD(uA, dA, sb + 8);
        P2_STEP(uB, dB, sb + 4);
    }
#undef P2_CI
#undef P2_LOAD
#undef P2_STEP
}

template <int TYPE>
__device__ __forceinline__ void pass3_item(const KArgs& a, int l, int item, LAS unsigned char* lds) {
    unsigned char* const wsb = opq(a.ws);
    const int tid = opaque_tid();
    using C = Cfg<TYPE>; constexpr int DK = C::DK;
    const int c = item & (NCH - 1), h = (item >> 8) & 3, b = item >> 10;
    const size_t tok0 = (size_t)b * T + (size_t)c * 64;
    const bf16_t* u = (const bf16_t*)(wsb + WS_U);
    const int wid = tid >> 6, lane = tid & 63, fr = lane & 15, fq = lane >> 4;
    LAS float* G = (LAS float*)(lds + SC_G); LAS bf16_t* Kb = (LAS bf16_t*)(lds + SC_K); LAS bf16_t* QT = (LAS bf16_t*)(lds + SC_QT); LAS bf16_t* QG = (LAS bf16_t*)(lds + SC_QG);
    LAS bf16_t* VT = (LAS bf16_t*)(lds + SC_VT); LAS bf16_t* P = (LAS bf16_t*)(lds + SC_P); LAS float* RSQ = (LAS float*)(lds + SC_RSQ);
    const VRaw vr = vT_issue(u + tok0 * DINP + (TYPE ? C_HI : C_GV) + h * 128, tid);
    bf16x8 qraw[DK / 64];
#pragma unroll
    for (int e2 = 0; e2 < DK / 64; ++e2) { const int task = tid + 512 * e2, i = task / C::ND8, d8 = task % C::ND8;
        qraw[e2] = *(const bf16x8*)(u + (tok0 + i) * DINP + (TYPE ? C_HQ + h * 128 : C_GQ + h * 64) + d8 * 8); }
    const LgRaw raw0 = lg_issue<TYPE>(u, h, 0, tok0, tid), raw1 = lg_issue<TYPE>(u, h, 1, tok0, tid);
    __syncthreads();
    vT_write(vr, lds, tid);
    float qf[DK / 64][8];
#pragma unroll
    for (int e2 = 0; e2 < DK / 64; ++e2) { unpack8(qraw[e2], qf[e2]);
#pragma unroll
        for (int e = 0; e < 8; ++e) qf[e2][e] = TYPE ? silu_(qf[e2][e]) : qf[e2][e] * 0.125f; }
    f32x4 o[4];
#pragma unroll
    for (int it = 0; it < 4; ++it) o[it] = (f32x4){0.f, 0.f, 0.f, 0.f};
#pragma unroll 1
    for (int dir = 0; dir < 2; ++dir) {
        const int sitem = ((b * 4 + h) * 2 + dir) * NCH + c;
        const bf16_t* ST = (const bf16_t*)(wsb + (TYPE ? WS_SH : WS_SG)) + (size_t)sitem * 128 * DK + (size_t)(wid * 16 + fr) * DK + fq * 8;
        bf16x8 sf[DK / 32];
#pragma unroll
        for (int ks = 0; ks < DK / 32; ++ks) sf[ks] = *(const bf16x8*)(ST + ks * 32);
        if (dir) __syncthreads();
        { LgRaw rw; rw.a0 = dir ? raw1.a0 : raw0.a0; rw.a1 = dir ? raw1.a1 : raw0.a1; rw.k = dir ? raw1.k : raw0.k; lg_compute<TYPE>(a, wsb, l, h, dir, rw, lds, tid); }
        cumsum_g<TYPE>(dir, lds, tid);
#pragma unroll
        for (int e2 = 0; e2 < DK / 64; ++e2) { const int task = tid + 512 * e2, i = task / C::ND8, d8 = task % C::ND8;
            const f32x4 g0 = *(LAS f32x4*)(G + i * C::LDG + d8 * 8), g1 = *(LAS f32x4*)(G + i * C::LDG + d8 * 8 + 4);
            const f32x4 m0 = *(LAS f32x4*)(G + 32 * C::LDG + d8 * 8), m1 = *(LAS f32x4*)(G + 32 * C::LDG + d8 * 8 + 4);
            float kk[8], qq[8], qt[8], qg[8]; unpack8(*(LAS bf16x8*)(Kb + i * C::LDK_ + d8 * 8), kk);
#pragma unroll
            for (int e = 0; e < 8; ++e) qq[e] = qf[e2][e];
#pragma unroll
            for (int e = 0; e < 8; ++e) { const float gg = e < 4 ? g0[e] : g1[e - 4], gm = e < 4 ? m0[e] : m1[e - 4];
                const float q = qq[e];
                qt[e] = q * __expf(gg - gm); qg[e] = q * __expf(gg); kk[e] = kk[e] * __expf(gm - gg); }
            *(LAS bf16x8*)(QT + i * C::LDK_ + d8 * 8) = pack8(qt); *(LAS bf16x8*)(QG + i * C::LDK_ + d8 * 8) = pack8(qg); *(LAS bf16x8*)(Kb + i * C::LDK_ + d8 * 8) = pack8(kk); }
        __syncthreads();
        { const int it = wid >> 1;
#pragma unroll
          for (int jj = 0; jj < 2; ++jj) { const int jt = 2 * (wid & 1) + jj;
            f32x4 acc = {0.f, 0.f, 0.f, 0.f};
#pragma unroll
            for (int ks = 0; ks < DK / 32; ++ks) {
                const bf16x8 af = *(LAS bf16x8*)(QT + (it * 16 + fr) * C::LDK_ + ks * 32 + fq * 8), bfr = *(LAS bf16x8*)(Kb + (jt * 16 + fr) * C::LDK_ + ks * 32 + fq * 8);
                acc = __builtin_amdgcn_mfma_f32_16x16x32_bf16(af, bfr, acc, 0, 0, 0); }
#pragma unroll
            for (int r = 0; r < 4; ++r) { const int i = it * 16 + fq * 4 + r, j = jt * 16 + fr; const bool keep = dir ? (j >= i) : (j <= i);
                P[i * LDT + j] = (bf16_t)f2bf(keep ? acc[r] : 0.f); } } }
        __syncthreads();
        const bf16x8 vb0 = vt_frag(VT, wid * 16 + fr, fq), vb1 = vt_frag(VT, wid * 16 + fr, 4 + fq);
#pragma unroll
        for (int it = 0; it < 4; ++it) {
            const bf16x8 p0 = *(LAS bf16x8*)(P + (it * 16 + fr) * LDT + fq * 8), p1 = *(LAS bf16x8*)(P + (it * 16 + fr) * LDT + 32 + fq * 8);
            o[it] = __builtin_amdgcn_mfma_f32_16x16x32_bf16(p0, vb0, o[it], 0, 0, 0);
            o[it] = __builtin_amdgcn_mfma_f32_16x16x32_bf16(p1, vb1, o[it], 0, 0, 0);
#pragma unroll
            for (int ks = 0; ks < DK / 32; ++ks) { const bf16x8 af = *(LAS bf16x8*)(QG + (it * 16 + fr) * C::LDK_ + ks * 32 + fq * 8);
                o[it] = __builtin_amdgcn_mfma_f32_16x16x32_bf16(af, sf[ks], o[it], 0, 0, 0); }
        }
    }
#pragma unroll
    for (int it = 0; it < 4; ++it)
#pragma unroll
        for (int r = 0; r < 4; ++r) { float s = o[it][r] * o[it][r]; s += __shfl_xor(s, 1); s += __shfl_xor(s, 2); s += __shfl_xor(s, 4); s += __shfl_xor(s, 8);
            if (fr == 0) RSQ[wid * 64 + it * 16 + fq * 4 + r] = s; }
    __syncthreads();
    const float gain = ((const float*)a.in[TYPE ? 7 : 5])[l * 128 + wid * 16 + fr];
    bf16_t* mix = (bf16_t*)(wsb + WS_XN);
#pragma unroll
    for (int it = 0; it < 4; ++it)
#pragma unroll
        for (int r = 0; r < 4; ++r) { const int i = it * 16 + fq * 4 + r; float s = 0.f;
#pragma unroll
            for (int w = 0; w < 8; ++w) s += RSQ[w * 64 + i];
            const float rstd = rsqrtf(s * (1.f / 128.f) + EPS);
            const float gt = bf2f(u[(tok0 + i) * DINP + (TYPE ? C_HG : C_GG) + h * 128 + wid * 16 + fr]);
            const float yv = o[it][r] * rstd * gain * silu_(gt);
            mix[(tok0 + i) * DM + (TYPE ? 512 : 0) + h * 128 + wid * 16 + fr] = (bf16_t)f2bf(yv); }
}
}
__device__ __forceinline__ void rmsnorm_rows_bf16(const float* src, const float* gain, bf16_t* dst) {
    const int tid = opaque_tid(), lane = tid & 63, gw = blockIdx.x * 8 + (tid >> 6), ngw = gridDim.x * 8;
    for (int m = gw; m < M; m += ngw) {
        const f32x4* xr = (const f32x4*)(src + (size_t)m * DM) + lane;
        f32x4 v[8]; float s = 0.f;
#pragma unroll
        for (int j = 0; j < 8; ++j) { v[j] = xr[64 * j]; s += (v[j][0] * v[j][0] + v[j][1] * v[j][1]) + (v[j][2] * v[j][2] + v[j][3] * v[j][3]); }
        const float rstd = rsqrtf(wave_sum(s) * (1.f / DM) + EPS);
        u32x2* o8 = (u32x2*)(dst + (size_t)m * DM) + lane;
#pragma unroll
        for (int j = 0; j < 8; ++j) { const f32x4 g = ((const f32x4*)gain)[lane + 64 * j];
            u32x2 w; w.x = cvt_pk_bf16(v[j][0] * rstd * g[0], v[j][1] * rstd * g[1]); w.y = cvt_pk_bf16(v[j][2] * rstd * g[2], v[j][3] * rstd * g[3]); o8[64 * j] = w; }
    }
}
__device__ __forceinline__ void cast_rows_bf16(const float* src, bf16_t* dst, float* rsq) {
    const int tid = opaque_tid(), lane = tid & 63, gw = blockIdx.x * 8 + (tid >> 6), ngw = gridDim.x * 8;
    for (int m = gw; m < M; m += ngw) {
        const f32x4* xr = (const f32x4*)(src + (size_t)m * DM) + lane;
        f32x4 v[8]; float s = 0.f;
#pragma unroll
        for (int j = 0; j < 8; ++j) { v[j] = xr[64 * j]; s += (v[j][0] * v[j][0] + v[j][1] * v[j][1]) + (v[j][2] * v[j][2] + v[j][3] * v[j][3]); }
        s = wave_sum(s);
        if (lane == 0) rsq[m] = s;
        u32x2* o8 = (u32x2*)(dst + (size_t)m * DM) + lane;
#pragma unroll
        for (int j = 0; j < 8; ++j) { u32x2 w; w.x = cvt_pk_bf16(v[j][0], v[j][1]); w.y = cvt_pk_bf16(v[j][2], v[j][3]); o8[64 * j] = w; }
    }
}
__device__ __forceinline__ void rmsnorm_rows_f32_inplace(float* buf, const float* gain) {
    const int tid = opaque_tid(), lane = tid & 63, gw = blockIdx.x * 8 + (tid >> 6), ngw = gridDim.x * 8;
    for (int m = gw; m < M; m += ngw) {
        f32x4* xr = (f32x4*)(buf + (size_t)m * DM) + lane;
        f32x4 v[8]; float s = 0.f;
#pragma unroll
        for (int j = 0; j < 8; ++j) { v[j] = xr[64 * j]; s += (v[j][0] * v[j][0] + v[j][1] * v[j][1]) + (v[j][2] * v[j][2] + v[j][3] * v[j][3]); }
        const float rstd = rsqrtf(wave_sum(s) * (1.f / DM) + EPS);
#pragma unroll
        for (int j = 0; j < 8; ++j) { const f32x4 g = ((const f32x4*)gain)[lane + 64 * j]; xr[64 * j] = v[j] * rstd * g; }
    }
}
__device__ __forceinline__ void convert_weights(const KArgs& a, int l, LAS unsigned char* lds) {
    unsigned char* const wsb = opq(a.ws);
    const int tid = opaque_tid();
    LAS float* tile = (LAS float*)lds;
    constexpr int I_IN = 32 * 84, I_QB = 8 * 24, I_KVB = 8 * 32, I_OUT = 32 * 32, I_13 = 32 * 176, I_2 = 88 * 32, NIT = I_IN + I_QB + I_KVB + I_OUT + I_13 + I_2;
    for (int it = blockIdx.x; it < NIT; it += gridDim.x) {
        int r = it, mode = 0, N, K, nkt; const float* w0; const float* w1 = nullptr; const float* gk = nullptr; bf16_t* WT;
        if (r < I_IN) { w0 = (const float*)a.in[2] + (size_t)l * DM * DIN; N = DIN; K = DM; nkt = 32; gk = (const float*)a.in[13] + l * DM; WT = (bf16_t*)(wsb + WS_WIN); }
        else if ((r -= I_IN) < I_QB) { w0 = (const float*)a.in[9] + (size_t)l * 512 * 1536; N = 1536; K = 512; nkt = 8; mode = 1; WT = (bf16_t*)(wsb + WS_WQB); }
        else if ((r -= I_QB) < I_KVB) { w0 = (const float*)a.in[11] + (size_t)l * 512 * 2048; N = 2048; K = 512; nkt = 8; WT = (bf16_t*)(wsb + WS_WKVB); }
        else if ((r -= I_KVB) < I_OUT) { w0 = (const float*)a.in[12] + (size_t)l * DM * DM; N = DM; K = DM; nkt = 32; WT = (bf16_t*)(wsb + WS_WOUT); }
        else if ((r -= I_OUT) < I_13) { w0 = (const float*)a.in[15] + (size_t)l * DM * DFF; w1 = (const float*)a.in[16] + (size_t)l * DM * DFF; N = DFF; K = DM; nkt = 32; mode = 2; gk = (const float*)a.in[14] + l * DM; WT = (bf16_t*)(wsb + WS_W13); }
        else { r -= I_13; w0 = (const float*)a.in[17] + (size_t)l * DFF * DM; N = DM; K = DFF; nkt = 88; WT = (bf16_t*)(wsb + WS_W2); }
        const int kt = r % nkt, rt = r / nkt, r0 = rt * 64, k0 = kt * 64;
        __syncthreads();
        if (mode == 1) {
#pragma unroll
            for (int e = 0; e < 8; ++e) { const int idx = tid + 512 * e, rl = idx & 63, kl = idx >> 6, rr = r0 + rl, k = k0 + kl;
                const int hh = rr / 192, ee = rr % 192; const int col = ee < 128 ? hh * 192 + ee : hh * 192 + 128 + ((ee - 128) & 1) * 32 + ((ee - 128) >> 1);
                tile[kl * 65 + rl] = w0[(size_t)k * N + col]; }
        } else {
#pragma unroll
            for (int e = 0; e < 2; ++e) { const int idx = tid + 512 * e, r4 = (idx & 15) * 4, kl = idx >> 4, rr = r0 + r4, k = k0 + kl;
                f32x4 v = {0.f, 0.f, 0.f, 0.f};
                if (mode == 0) { if (rr < N) v = *(const f32x4*)(w0 + (size_t)k * N + rr); }
                else { const int g = rr >> 5, n = (rr >> 4) & 1, i = rr & 15; v = *(const f32x4*)((n ? w1 : w0) + (size_t)k * N + 16 * g + i); }
                if (gk) v = v * gk[k];
                tile[kl * 65 + r4] = v[0]; tile[kl * 65 + r4 + 1] = v[1]; tile[kl * 65 + r4 + 2] = v[2]; tile[kl * 65 + r4 + 3] = v[3]; }
        }
        __syncthreads();
        { const int k8 = tid & 7, rl = tid >> 3;
          u32x4 w; w.x = pk2(tile[(8 * k8 + 0) * 65 + rl], tile[(8 * k8 + 1) * 65 + rl]); w.y = pk2(tile[(8 * k8 + 2) * 65 + rl], tile[(8 * k8 + 3) * 65 + rl]);
          w.z = pk2(tile[(8 * k8 + 4) * 65 + rl], tile[(8 * k8 + 5) * 65 + rl]); w.w = pk2(tile[(8 * k8 + 6) * 65 + rl], tile[(8 * k8 + 7) * 65 + rl]);
          *(u32x4*)(WT + (size_t)(r0 + rl) * K + k0 + 8 * k8) = w; }
    }
    __syncthreads();
}
__device__ __forceinline__ void tables_phase(const KArgs& a) {
    unsigned char* const wsb = opq(a.ws);
    const int tid = opaque_tid();
    const int* pos = (const int*)a.in[1];
    float* cs = (float*)(wsb + WS_COS); float* sn = (float*)(wsb + WS_SIN);
    const int gt = blockIdx.x * 512 + tid, ngt = gridDim.x * 512;
    for (int idx = gt; idx < M * 32; idx += ngt) { const int tok = idx >> 5, i = idx & 31;
        const float inv = 1.0f / exp2f((float)(2 * i) * (1.f / 64.f) * 13.287712379549449f);
        const float ang = (float)pos[tok] * inv;
        double rev = (double)ang * 0.15915494309189535; rev -= rint(rev);
        const float f = (float)rev;
        cs[idx] = __builtin_amdgcn_cosf(f); sn[idx] = __builtin_amdgcn_sinf(f); }
    if (blockIdx.x == 0) { const float* lg = (const float*)a.in[6]; float* lb = (float*)(wsb + WS_LB);
        for (int p = tid; p < 2 * 512; p += 512) { const int dir = p >> 9, c = p & 511;
            float mx = -1e30f;
#pragma unroll
            for (int l = 0; l < DEPTH; ++l) mx = fmaxf(mx, lg[(dir * DEPTH + l) * 512 + c]);
            float den = 0.f;
#pragma unroll
            for (int l = 0; l < DEPTH; ++l) den += __expf(lg[(dir * DEPTH + l) * 512 + c] - mx);
            float cum = 0.f;
#pragma unroll
            for (int l = 0; l < DEPTH; ++l) { if (l > 0) cum += __expf(lg[(dir * DEPTH + l) * 512 + c] - mx) / den; lb[(dir * DEPTH + l) * 512 + c] = cum; } } }
}
__device__ __forceinline__ void mla_prep(const KArgs& a, int l) {
    unsigned char* const wsb = opq(a.ws);
    const int tid = opaque_tid(), lane = tid & 63, gw = blockIdx.x * 8 + (tid >> 6), ngw = gridDim.x * 8;
    bf16_t* u = (bf16_t*)(wsb + WS_U); bf16_t* kr = (bf16_t*)(wsb + WS_KR);
    const float* cs = (const float*)(wsb + WS_COS); const float* sn = (const float*)(wsb + WS_SIN);
    const float* gq = (const float*)a.in[8] + l * 512 + lane * 8; const float* gkv = (const float*)a.in[10] + l * 512 + lane * 8;
    for (int tok = gw; tok < M; tok += ngw) {
        bf16_t* ur = u + (size_t)tok * DINP;
#pragma unroll
        for (int w = 0; w < 2; ++w) { bf16_t* p = ur + (w ? C_CKV : C_CQ) + lane * 8; const float* g = w ? gkv : gq;
            float f[8]; unpack8(*(const bf16x8*)p, f); float s = 0.f;
#pragma unroll
            for (int e = 0; e < 8; ++e) s += f[e] * f[e];
            const float rstd = rsqrtf(wave_sum(s) * (1.f / 512.f) + EPS);
#pragma unroll
            for (int e = 0; e < 8; ++e) f[e] = f[e] * rstd * g[e];
            *(bf16x8*)p = pack8(f); }
        if (lane < 32) { const float x1 = bf2f(ur[C_KR + lane]), x2 = bf2f(ur[C_KR + 32 + lane]), c = cs[(size_t)tok * 32 + lane], s = sn[(size_t)tok * 32 + lane];
            *(unsigned*)(kr + (size_t)tok * 64 + 2 * lane) = pk2(x1 * c - x2 * s, x2 * c + x1 * s); }
    }
}

#define XB_TMO      128
#define XB_XCNT(j)  (256  + 64 * (j))
#define XB_XSUB(j)  (1280 + 64 * (j))
#define XB_XGEN(j)  (2304 + 64 * (j))
#define XB_TOP      3328
#define XB_TOPGEN   3392
#define XCD_BAR_WORDS 3456
#define XB_SPIN_CAP (1u << 18)

__device__ __forceinline__ unsigned xb_ld(unsigned* p)              { return __hip_atomic_load(p, __ATOMIC_RELAXED, __HIP_MEMORY_SCOPE_AGENT); }
__device__ __forceinline__ unsigned xb_add(unsigned* p, unsigned v) { return __hip_atomic_fetch_add(p, v, __ATOMIC_RELAXED, __HIP_MEMORY_SCOPE_AGENT); }
__device__ __forceinline__ unsigned xb_xcc_id() { return (unsigned)__builtin_amdgcn_s_getreg((3 << 11) | 20) & 0xFu; }
#define XB_SPIN(cond, bar) do { unsigned _sp = 0; while (cond) { __builtin_amdgcn_s_sleep(1); \
    if ((++_sp & 255u) == 0u) { if (xb_ld(&(bar)[XB_TMO])) break; if (_sp > XB_SPIN_CAP) { atomicAdd(&(bar)[XB_TMO], 1u); break; } } } } while (0)

struct XcdBarrier {
    unsigned* bar; unsigned x;
    volatile LAS unsigned* st;
};

__device__ __forceinline__ XcdBarrier xcd_barrier_post(unsigned* bar, volatile LAS unsigned* st) {
    XcdBarrier b; b.bar = bar; b.x = xb_xcc_id(); b.st = st;
    if (threadIdx.x == 0) (void)xb_add(&bar[XB_XCNT(b.x)], 1u);
    return b;
}
__device__ __forceinline__ void xcd_barrier_complete(unsigned* bar, unsigned x, unsigned& nloc, unsigned& nx) {
    const unsigned G = gridDim.x * gridDim.y * gridDim.z;
    unsigned sum, cnt, mine, sp = 0u;
    for (;;) {
        sum = 0u; cnt = 0u; mine = 0u;
#pragma unroll
        for (unsigned j = 0; j < 16; ++j) { const unsigned c = xb_ld(&bar[XB_XCNT(j)]); sum += c; cnt += (c > 0u) ? 1u : 0u; mine = (j == x) ? c : mine; }
        if (sum == G) break;
        __builtin_amdgcn_s_sleep(1);
        if ((++sp & 255u) == 0u) { if (xb_ld(&bar[XB_TMO])) break; if (sp > XB_SPIN_CAP) { atomicAdd(&bar[XB_TMO], 1u); break; } }
    }
    nloc = mine > 0u ? mine : 1u; nx = cnt > 0u ? cnt : 1u;
}

__device__ __forceinline__ void xcd_barrier(const XcdBarrier& b) {
    asm volatile("s_waitcnt vmcnt(0)" ::: "memory");
    __syncthreads();
    if (threadIdx.x == 0) {
        unsigned* bar = b.bar;
        __builtin_amdgcn_s_waitcnt(0);
        unsigned nloc = b.st[0], nx = b.st[1];
        if (nloc == 0u) { xcd_barrier_complete(bar, b.x, nloc, nx); b.st[0] = nloc; b.st[1] = nx; }
        const unsigned old = xb_add(&bar[XB_XSUB(b.x)], 1u);
        const unsigned gen = old / nloc;
        if (old + 1u == (gen + 1u) * nloc) {
            __builtin_amdgcn_fence(__ATOMIC_RELEASE, "agent");
            asm volatile("s_waitcnt vmcnt(0)" ::: "memory");
            const unsigned og = xb_add(&bar[XB_TOP], 1u);
            const unsigned tg = og / nx;
            if (og + 1u == (tg + 1u) * nx) xb_add(&bar[XB_TOPGEN], 1u);
            else XB_SPIN(xb_ld(&bar[XB_TOPGEN]) == tg, bar);
            __builtin_amdgcn_fence(__ATOMIC_ACQUIRE, "agent");
            xb_add(&bar[XB_XGEN(b.x)], 1u);
            asm volatile("s_waitcnt vmcnt(0)" ::: "memory");
        } else {
            XB_SPIN(xb_ld(&bar[XB_XGEN(b.x)]) == gen, bar);
            __builtin_amdgcn_fence(__ATOMIC_ACQUIRE, "agent");
            asm volatile("s_waitcnt vmcnt(0)" ::: "memory");
        }
    }
    __syncthreads();
}
__global__ void __launch_bounds__(512, 2) mega_fwd(KArgs a) {
    extern __shared__ __attribute__((aligned(16))) unsigned char smem[];
    cg::grid_group grid = cg::this_grid();
    LAS unsigned char* lds = (LAS unsigned char*)smem;
    const int G = gridDim.x, bx = blockIdx.x;
    const float* x = (const float*)a.in[0];
    if (threadIdx.x < 16) ((LAS unsigned*)(lds + 131072))[threadIdx.x] = 0u;
    __syncthreads();
    (void)xcd_barrier_post((unsigned*)(a.ws + WS_BAR), (volatile LAS unsigned*)(lds + 131072));
#define GBAR() do { XcdBarrier xb_; xb_.bar = (unsigned*)(opq(a.ws) + WS_BAR); xb_.x = xb_xcc_id(); xb_.st = (volatile LAS unsigned*)(lds + 131072); xcd_barrier(xb_); } while (0)

#if PH_MISC
    tables_phase(a);
    convert_weights(a, 0, lds);
#if PROBE_CVT_REP > 1
    convert_weights(a, 0, lds);
#endif
#endif
    { float* rz = (float*)(opq(a.ws) + WS_RSQ); for (int z_ = bx * 512 + opaque_tid(); z_ < 4 * M; z_ += G * 512) rz[z_] = 0.f; }
    cast_rows_bf16(x, (bf16_t*)(opq(a.ws) + WS_XN), (float*)(opq(a.ws) + WS_RSQ) + 4 * M);
    grid.sync();
    GBAR();
#pragma unroll 1
    for (int l = 0; l < DEPTH; ++l) {
        if (l > 0) {
#if PH_MISC
            convert_weights(a, l, lds);
#if PROBE_CVT_REP > 1
            convert_weights(a, l, lds);
#endif
#endif
            GBAR();
        }
        { pg8::Gemm g{(const bf16_t*)(opq(a.ws) + WS_XN), (const bf16_t*)(opq(a.ws) + WS_WIN), M, DINP, DM, DM, DM}; pg8::StaticOrder S; S.init(M, DINP, G, bx);
          pg8::EpiU E{(bf16_t*)(opq(a.ws) + WS_U), DINP, (const float*)(opq(a.ws) + WS_RSQ) + (size_t)(l == 0 ? 4 : 2 + (l - 1)) * M};
          __syncthreads(); if (PH_GEMM & 1) pg8::gemm_phase<pg8::EpiU, pg8::StaticOrder, true, true>(lds, g, S, E);
#if PROBE_GEMM_REP > 1
          __syncthreads(); if (PH_GEMM & 1) pg8::gemm_phase<pg8::EpiU, pg8::StaticOrder, true, true>(lds, g, S, E);
#endif
 }
        GBAR();
#if PH_MISC
        mla_prep(a, l);
#endif
#if PH_S1
        for (int it = bx; it < 4096; it += G) scan::pass1_item<1>(a, l, it, lds);
        for (int it = bx; it < 4096; it += G) scan::pass1_item<0>(a, l, it, lds);
#if PROBE_SCAN_REP > 1
        for (int it = bx; it < 4096; it += G) scan::pass1_item<1>(a, l, it, lds);
        for (int it = bx; it < 4096; it += G) scan::pass1_item<0>(a, l, it, lds);
#endif
#endif
        GBAR();
#if PH_S2
        for (int t = bx * 512 + opaque_tid(); t < 131072; t += G * 512) scan::pass2_triple(a, t);
#endif
        { pg8::Gemm g{(const bf16_t*)(opq(a.ws) + WS_U) + C_CQ, (const bf16_t*)(opq(a.ws) + WS_WQB), M, 1536, 512, DINP, 512}; pg8::StaticOrder S; S.init(M, 1536, G, bx);
          pg8::EpiQ E{(bf16_t*)(opq(a.ws) + WS_Q), (const float*)(opq(a.ws) + WS_COS), (const float*)(opq(a.ws) + WS_SIN)};
          __syncthreads(); if (PH_GEMM & 2) pg8::gemm_phase<pg8::EpiQ, pg8::StaticOrder, true, true>(lds, g, S, E);
#if PROBE_GEMM_REP > 1
          __syncthreads(); if (PH_GEMM & 2) pg8::gemm_phase<pg8::EpiQ, pg8::StaticOrder, true, true>(lds, g, S, E);
#endif
 }
        { pg8::Gemm g{(const bf16_t*)(opq(a.ws) + WS_U) + C_CKV, (const bf16_t*)(opq(a.ws) + WS_WKVB), M, 2048, 512, DINP, 512}; pg8::StaticOrder S; S.init(M, 2048, G, bx);
          pg8::EpiKV E{(bf16_t*)(opq(a.ws) + WS_KN), (bf16_t*)(opq(a.ws) + WS_V)};
          __syncthreads(); if (PH_GEMM & 4) pg8::gemm_phase<pg8::EpiKV, pg8::StaticOrder, true, true>(lds, g, S, E);
#if PROBE_GEMM_REP > 1
          __syncthreads(); if (PH_GEMM & 4) pg8::gemm_phase<pg8::EpiKV, pg8::StaticOrder, true, true>(lds, g, S, E);
#endif
 }
        GBAR();
        { const bool x8 = (G % 8) == 0; const int xcd = bx & 7, slot = bx >> 3, nslot = G >> 3;
          for (int pr = 0; pr < (x8 ? 2 : 16); ++pr) { const int p = x8 ? xcd + 8 * pr : pr, b = p >> 3, h = p & 7;
            for (int qb = x8 ? slot : bx; qb < 64; qb += x8 ? nslot : G) {
              const bf16_t* Qb = (const bf16_t*)(opq(a.ws) + WS_Q) + ((size_t)(b * 8 + h) * T + (size_t)qb * 256) * 192;
              const bf16_t* Kn = (const bf16_t*)(opq(a.ws) + WS_KN) + (size_t)(b * 8 + h) * T * 128;
              const bf16_t* Kr = (const bf16_t*)(opq(a.ws) + WS_KR) + (size_t)b * T * 64;
              const bf16_t* Vh = (const bf16_t*)(opq(a.ws) + WS_V) + (size_t)(b * 8 + h) * T * 128;
              bf16_t* Ob = (bf16_t*)(opq(a.ws) + WS_XN) + ((size_t)b * T + (size_t)qb * 256) * DM + 1024 + h * 128;
#if PH_ATT
              for (int rep_ = 0; rep_ < PROBE_ATT_REP; ++rep_) att::attn_unit(Qb, Kn, Kr, Vh, Ob, (char*)smem);
#else
              { const int t_ = opaque_tid(); bf16_t* zp = Ob + (size_t)(t_ >> 1) * DM + (t_ & 1) * 64; (void)Qb; (void)Kn; (void)Kr; (void)Vh;
                for (int z_ = 0; z_ < 8; ++z_) *(u32x4*)(zp + z_ * 8) = (u32x4){0u, 0u, 0u, 0u}; }
#endif
 } } }
#if PH_S3
        for (int it = bx; it < 2048; it += G) scan::pass3_item<1>(a, l, it, lds);
        for (int it = bx; it < 2048; it += G) scan::pass3_item<0>(a, l, it, lds);
#if PROBE_SCAN_REP > 1
        for (int it = bx; it < 2048; it += G) scan::pass3_item<1>(a, l, it, lds);
        for (int it = bx; it < 2048; it += G) scan::pass3_item<0>(a, l, it, lds);
#endif
#else
        { bf16_t* mz = (bf16_t*)(opq(a.ws) + WS_XN); for (size_t z_ = (size_t)bx * 512 + opaque_tid(); z_ < (size_t)M * 128; z_ += (size_t)G * 512) *(u32x4*)(mz + (z_ >> 7) * DM + (z_ & 127) * 8) = (u32x4){0u, 0u, 0u, 0u}; }
#endif
        GBAR();
        { pg8::Gemm g{(const bf16_t*)(opq(a.ws) + WS_XN), (const bf16_t*)(opq(a.ws) + WS_WOUT), M, DM, DM, DM, DM}; pg8::StaticOrder S; S.init(M, DM, G, bx);
          pg8::EpiRes E{l == 0 ? x : (const float*)a.out, a.out, (bf16_t*)(opq(a.ws) + WS_HB), (float*)(opq(a.ws) + WS_RSQ) + (size_t)l * M};
          __syncthreads(); if (PH_GEMM & 8) pg8::gemm_phase<pg8::EpiRes, pg8::StaticOrder, true, true>(lds, g, S, E); }
        GBAR();
        { pg8::Gemm g{(const bf16_t*)(opq(a.ws) + WS_HB), (const bf16_t*)(opq(a.ws) + WS_W13), M, 2 * DFF, DM, DM, DM}; pg8::StaticOrder S; S.init(M, 2 * DFF, G, bx);
          pg8::EpiSwi E{(bf16_t*)(opq(a.ws) + WS_HID), (const float*)(opq(a.ws) + WS_RSQ) + (size_t)l * M};
          __syncthreads(); if (PH_GEMM & 16) pg8::gemm_phase<pg8::EpiSwi, pg8::StaticOrder, true, true>(lds, g, S, E);
#if PROBE_GEMM_REP > 1
          __syncthreads(); if (PH_GEMM & 16) pg8::gemm_phase<pg8::EpiSwi, pg8::StaticOrder, true, true>(lds, g, S, E);
#endif
 }
        GBAR();
        { pg8::Gemm g{(const bf16_t*)(opq(a.ws) + WS_HID), (const bf16_t*)(opq(a.ws) + WS_W2), M, DM, DFF, DFF, DFF}; pg8::StaticOrder S; S.init(M, DM, G, bx);
          pg8::EpiRes E{(const float*)a.out, a.out, (bf16_t*)(opq(a.ws) + WS_XN), (float*)(opq(a.ws) + WS_RSQ) + (size_t)(2 + l) * M};
          __syncthreads(); if (PH_GEMM & 32) pg8::gemm_phase<pg8::EpiRes, pg8::StaticOrder, true, true>(lds, g, S, E); }
        GBAR();
    }
    rmsnorm_rows_f32_inplace(a.out, (const float*)a.in[18]);
}

extern "C" void kernel_launch(void* const* d_in, const int* in_sizes, int n_in, void* d_out, int out_size, void* d_ws, size_t ws_size, hipStream_t stream) {
    static int grid = 0;
    if (grid == 0) {
        if (n_in != 19 || out_size != M * DM || ws_size < WS_END) { fprintf(stderr, "kernel_launch: unexpected shapes (n_in %d out %d ws %zu)\n", n_in, out_size, ws_size); grid = -1; return; }
        int dev = 0, cus = 0, per_cu = 0;
        hipGetDevice(&dev); hipDeviceGetAttribute(&cus, hipDeviceAttributeMultiprocessorCount, dev);
        if (hipFuncSetAttribute((const void*)mega_fwd, hipFuncAttributeMaxDynamicSharedMemorySize, LDS_BYTES) != hipSuccess) { fprintf(stderr, "kernel_launch: hipFuncSetAttribute failed\n"); grid = -1; return; }
        if (hipOccupancyMaxActiveBlocksPerMultiprocessor(&per_cu, (const void*)mega_fwd, 512, LDS_BYTES) != hipSuccess || per_cu < 1) { fprintf(stderr, "kernel_launch: occupancy query says %d\n", per_cu); per_cu = 1; }
        (void)hipGetLastError();
        grid = cus * (per_cu > 1 ? 1 : per_cu);
    }
    if (grid < 0) return;
    KArgs a{};
    for (int i = 0; i < 19; ++i) a.in[i] = d_in[i];
    a.out = (float*)d_out; a.ws = (unsigned char*)d_ws;
    if (hipMemsetAsync((char*)d_ws + WS_BAR, 0, 16384, stream) != hipSuccess) { fprintf(stderr, "kernel_launch: memset failed\n"); return; }
    void* args[] = {&a};
    hipError_t e = hipLaunchCooperativeKernel((const void*)mega_fwd, dim3(grid), dim3(512), args, LDS_BYTES, stream);
    if (e != hipSuccess) fprintf(stderr, "kernel_launch: cooperative launch failed: %s (grid %d)\n", hipGetErrorString(e), grid);
}
```

```cpp
#include <hip/hip_runtime.h>
#include <hip/hip_cooperative_groups.h>
#include <cstdint>
#include <cstdio>
namespace cg = cooperative_groups;
#ifndef PROBE_GEMM_REP
#define PROBE_GEMM_REP 1
#endif
#ifndef PROBE_SCAN_REP
#define PROBE_SCAN_REP 1
#endif
#ifndef PROBE_CVT_REP
#define PROBE_CVT_REP 1
#endif
#ifndef PROBE_ATT_REP
#define PROBE_ATT_REP 1
#endif
#ifndef PH_ATT
#define PH_ATT 1
#endif
#ifndef PH_S1
#define PH_S1 1
#endif
#ifndef PH_S2
#define PH_S2 1
#endif
#ifndef PH_S3
#define PH_S3 1
#endif
#ifndef PH_GEMM
#define PH_GEMM 63
#endif
#ifndef PH_MISC
#define PH_MISC 1
#endif

#define LAS __attribute__((address_space(3)))
typedef unsigned short bf16_t;
typedef short bf16x8 __attribute__((ext_vector_type(8)));
typedef short s16x4 __attribute__((ext_vector_type(4)));
typedef float f32x2 __attribute__((ext_vector_type(2)));
typedef float f32x4 __attribute__((ext_vector_type(4)));
typedef float f32x16 __attribute__((ext_vector_type(16)));
typedef unsigned u32x2 __attribute__((ext_vector_type(2)));
typedef unsigned u32x4 __attribute__((ext_vector_type(4)));

constexpr int NB = 2, T = 16384, M = NB * T, DM = 2048, DIN = 5216, DINP = 5376, DFF = 5632, DEPTH = 2;
constexpr int C_GQ = 0, C_GK = 256, C_GV = 512, C_GAF = 1024, C_GAB = 1040, C_GG = 1056, C_HQ = 1568, C_HFF = 2080, C_HFB = 2592, C_HI = 3104, C_HG = 3616,
              C_CQ = 4128, C_CKV = 4640, C_KR = 5152;
constexpr float EPS = 1e-6f;
constexpr int NCH = T / 64;
constexpr size_t MiB = 1048576;
constexpr size_t WS_WIN = 0, WS_WQB = 21 * MiB, WS_WKVB = WS_WQB + 3 * MiB / 2, WS_WOUT = WS_WKVB + 2 * MiB, WS_W13 = WS_WOUT + 8 * MiB, WS_W2 = WS_W13 + 44 * MiB;
constexpr size_t WS_XN = 99 * MiB, WS_U = 227 * MiB, WS_Q = 563 * MiB, WS_KN = 659 * MiB, WS_V = 723 * MiB, WS_KR = 787 * MiB, WS_SG = 791 * MiB, WS_SH = 855 * MiB,
                 WS_DG = 983 * MiB, WS_DH = 984 * MiB, WS_COS = 986 * MiB, WS_SIN = 990 * MiB, WS_LB = 994 * MiB, WS_BAR = 995 * MiB, WS_RSQ = WS_BAR + 16384, WS_END = 996 * MiB, WS_HB = WS_U, WS_HID = WS_U + 128 * MiB;
static_assert(WS_W2 + 22 * MiB <= WS_XN, "weights");
constexpr int LDS_BYTES = 131072 + 64;

struct KArgs { const void* in[19]; float* out; unsigned char* ws; };

__device__ __forceinline__ float bf2f(unsigned v) { return __uint_as_float(v << 16); }
__device__ __forceinline__ unsigned f2bf(float f) { unsigned u = __float_as_uint(f); return (u + 0x7fffu + ((u >> 16) & 1u)) >> 16; }
__device__ __forceinline__ unsigned pk2(float lo, float hi) { return f2bf(lo) | (f2bf(hi) << 16); }
typedef __bf16 bf16x2_t __attribute__((ext_vector_type(2)));
__device__ __forceinline__ unsigned cvt_pk_bf16(float lo, float hi) { f32x2 v = {lo, hi}; bf16x2_t b = __builtin_convertvector(v, bf16x2_t); return __builtin_bit_cast(unsigned, b); }
__device__ __forceinline__ float wave_sum(float v) {
#pragma unroll
    for (int o = 1; o < 64; o <<= 1) v += __shfl_xor(v, o);
    return v;
}
__device__ __forceinline__ unsigned char* opq(unsigned char* q) { asm volatile("" : "+s"(q)); return q; }
__device__ __forceinline__ int opaque_tid() { int t = threadIdx.x; asm volatile("" : "+v"(t)); return t; }
#define DBGF(ws_, cond_, bit_) do { if (cond_) atomicOr((unsigned*)((ws_) + WS_BAR) + 32, (unsigned)(bit_)); } while (0)
__device__ __forceinline__ bool badf(float v) { return !(fabsf(v) < 1e30f); }
__device__ __forceinline__ float sigmoid_(float z) { return __builtin_amdgcn_rcpf(1.f + __expf(-z)); }
__device__ __forceinline__ float silu_(float z) { return z * sigmoid_(z); }
__device__ __forceinline__ float logsigmoid_(float z) { return fminf(z, 0.f) - __logf(1.f + __expf(-fabsf(z))); }
__device__ __forceinline__ void unpack8(bf16x8 v, float* f) {
#pragma unroll
    for (int e = 0; e < 8; ++e) f[e] = bf2f((unsigned)(unsigned short)v[e]);
}
__device__ __forceinline__ bf16x8 pack8(const float* f) {
    u32x4 w = {cvt_pk_bf16(f[0], f[1]), cvt_pk_bf16(f[2], f[3]), cvt_pk_bf16(f[4], f[5]), cvt_pk_bf16(f[6], f[7])};
    return __builtin_bit_cast(bf16x8, w);
}

namespace pg8 {
#define PG8_LAS __attribute__((address_space(3)))
constexpr int BM = 256, BK = 64, HALF = 128, HTB = HALF * BK * 2, STAGE_BYTES = 8 * HTB, NXCD = 8, WGM = 8;
__host__ __device__ __forceinline__ int lds_byte(int r, int c) { const int st = (r >> 4) * 2 + (c >> 5), rr = r & 15, cc = c & 31, ob = rr * 64 + cc * 2; return st * 1024 + (ob ^ (((ob >> 9) & 1) << 5)); }
__host__ __device__ __forceinline__ void stage_rc(int b, int& R, int& C) { const int st = b / 1024, sb = b % 1024, swz = sb ^ (((sb >> 9) & 1) << 5); R = (st >> 1) * 16 + swz / 64; C = (st & 1) * 32 + (swz % 64) / 2; }
__host__ __device__ __forceinline__ int perm32(int rho) { const int n = rho >> 4, i = rho & 15; return 8 * (i >> 2) + 4 * n + (i & 3); }
struct Unit { int pm, pn; };
struct Gemm { const bf16_t* A; const bf16_t* Bt; int M, N, K, lda, ldb; };
struct StaticOrder {
    int nM, nN, nwg, G, c;
    __host__ __device__ void init(int M_, int N_, int G_, int c_) { nM = M_ / BM; nN = N_ / BM; nwg = nM * nN; G = G_; c = c_; }
    __host__ __device__ bool next(int i, Unit& u) const {
        const long L = (long)i * G + c; if (L >= nwg) return false;
        int wgid = (int)L; { const int q = nwg / NXCD, r = nwg % NXCD, xcd = wgid % NXCD, off = wgid / NXCD; wgid = (xcd < r ? xcd * (q + 1) : r * (q + 1) + (xcd - r) * q) + off; }
        const int nig = WGM * nN, gid = wgid / nig, fm = gid * WGM, gsz = (nM - fm) < WGM ? (nM - fm) : WGM;
        u.pm = fm + ((wgid % nig) % gsz); u.pn = (wgid % nig) / gsz; return true;
    }
    __device__ __forceinline__ void a_ready(const Unit&) const {}
    __device__ __forceinline__ void done(const Unit&) const {}
};
template <class Epi, class Sched, bool ALIGN_EPI = false, bool SP2 = false>
__device__ __forceinline__ void gemm_phase(PG8_LAS unsigned char* lds, const Gemm g, const Sched& S, const Epi& E) {
    const int tid = opaque_tid(), wid = __builtin_amdgcn_readfirstlane(tid >> 6), lane = tid & 63, wr = wid >> 2, wc = wid & 3, fr = lane & 15, fq = lane >> 4;
    const int K = g.K, nt = K / BK;
    unsigned voffA[2], voffB[2];
#pragma unroll
    for (int i = 0; i < 2; ++i) { int R, C; stage_rc(tid * 16 + i * 8192, R, C); const int Rb = Epi::PERM ? ((R & ~31) + perm32(R & 31)) : R;
        voffA[i] = (unsigned)(R * g.lda + C) * 2u; voffB[i] = (unsigned)(Rb * g.ldb + C) * 2u; }
    const size_t kstep = (size_t)(BK * 2);
    const size_t hstepA = (size_t)HALF * g.lda * 2, hstepB = (size_t)HALF * g.ldb * 2;
    const size_t tstepA = 2 * hstepA, tstepB = 2 * hstepB;
    const unsigned ldsw = (unsigned)wid * 1024u;
    const int aoff = lds_byte(wr * 64 + fr, fq * 8), boff = lds_byte(wc * 32 + fr, fq * 8);
#define PG8_SA(b, h) (((b) * 2 + (h)) * HTB)
#define PG8_SB(b, h) ((4 + (b) * 2 + (h)) * HTB)
#define PG8_STAGE(bufoff, gbase, voff) do { _Pragma("unroll") for (int _i = 0; _i < 2; ++_i) \
        __builtin_amdgcn_global_load_lds((const unsigned*)((const char*)(gbase) + (voff)[_i]), (PG8_LAS unsigned*)(lds + (bufoff) + ldsw + _i * 8192), 16, 0, 0); } while (0)
#define PG8_LDA(dst, b, h) do { _Pragma("unroll") for (int m = 0; m < 4; ++m) _Pragma("unroll") for (int k = 0; k < 2; ++k) dst[m][k] = *(const PG8_LAS bf16x8*)(lds + PG8_SA(b, h) + aoff + m * 2048 + k * 1024); } while (0)
#define PG8_LDB(dst, b, h) do { _Pragma("unroll") for (int n = 0; n < 2; ++n) _Pragma("unroll") for (int k = 0; k < 2; ++k) dst[n][k] = *(const PG8_LAS bf16x8*)(lds + PG8_SB(b, h) + boff + n * 2048 + k * 1024); } while (0)
#define PG8_MMA(ai, bj, At, Bt) do { __builtin_amdgcn_s_setprio(1); _Pragma("unroll") for (int m = 0; m < 4; ++m) _Pragma("unroll") for (int n = 0; n < 2; ++n) _Pragma("unroll") for (int k = 0; k < 2; ++k) \
        acc[ai][bj][m][n] = __builtin_amdgcn_mfma_f32_16x16x32_bf16(Bt[n][k], At[m][k], acc[ai][bj][m][n], 0, 0, 0); __builtin_amdgcn_s_setprio(0); } while (0)
#define PG8_WAIT_V(n) asm volatile("s_waitcnt vmcnt(" #n ")" ::: "memory")
#define PG8_WAIT_L(n) asm volatile("s_waitcnt lgkmcnt(" #n ")" ::: "memory")
#define PG8_BAR __builtin_amdgcn_s_barrier()
#define PG8_SCHED __builtin_amdgcn_sched_barrier(0)
    Unit cur, nxt; int ui = 0;
    if (!S.next(0, cur)) return;
    f32x4 acc[2][2][4][2];
#pragma unroll
    for (int a = 0; a < 2; ++a)
#pragma unroll
        for (int b = 0; b < 2; ++b)
#pragma unroll
            for (int m = 0; m < 4; ++m)
#pragma unroll
                for (int n = 0; n < 2; ++n) acc[a][b][m][n] = (f32x4){0.f, 0.f, 0.f, 0.f};
    bf16x8 At[4][2], B0[2][2], B1[2][2];
    const char* cA = (const char*)g.A + (size_t)cur.pm * tstepA; const char* cB = (const char*)g.Bt + (size_t)cur.pn * tstepB;
    S.a_ready(cur);
    if constexpr (SP2) {
        PG8_STAGE(PG8_SB(0, 0), cB, voffB); PG8_STAGE(PG8_SB(0, 1), cB + hstepB, voffB); PG8_STAGE(PG8_SA(0, 0), cA, voffA); PG8_STAGE(PG8_SA(0, 1), cA + hstepA, voffA);
        if (wr == 1) PG8_BAR;
        PG8_WAIT_V(2); PG8_BAR;
        PG8_STAGE(PG8_SB(1, 0), cB + kstep, voffB); PG8_STAGE(PG8_SA(1, 0), cA + kstep, voffA); PG8_STAGE(PG8_SB(1, 1), cB + hstepB + kstep, voffB);
        PG8_WAIT_V(6); PG8_BAR;
    } else {
        PG8_STAGE(PG8_SB(0, 0), cB, voffB); PG8_STAGE(PG8_SA(0, 0), cA, voffA); PG8_STAGE(PG8_SB(0, 1), cB + hstepB, voffB); PG8_STAGE(PG8_SA(0, 1), cA + hstepA, voffA);
        if (wr == 1) PG8_BAR;
        PG8_WAIT_V(4); PG8_BAR;
        PG8_STAGE(PG8_SB(1, 0), cB + kstep, voffB); PG8_STAGE(PG8_SA(1, 0), cA + kstep, voffA); PG8_STAGE(PG8_SB(1, 1), cB + hstepB + kstep, voffB);
        PG8_WAIT_V(6); PG8_BAR;
    }
    for (;;) {
        const bool has_next = S.next(ui + 1, nxt);
        const char* nA = has_next ? (const char*)g.A + (size_t)nxt.pm * tstepA : cA; const char* nB = has_next ? (const char*)g.Bt + (size_t)nxt.pn * tstepB : cB;
        for (int t = 0; t < nt; t += 2) {
            const bool last = (t == nt - 2);
            const char* a1 = cA + (size_t)(t + 1) * kstep;
            const char* a2 = last ? nA : cA + (size_t)(t + 2) * kstep; const char* b2 = last ? nB : cB + (size_t)(t + 2) * kstep;
            const char* a3 = a2 + kstep; const char* b3 = b2 + kstep;
            if (last && has_next) S.a_ready(nxt);
            if constexpr (SP2) {
            PG8_LDB(B0, 0, 0); PG8_LDB(B1, 0, 1); PG8_SCHED; PG8_LDA(At, 0, 0); PG8_STAGE(PG8_SA(1, 1), a1 + hstepA, voffA);
            PG8_WAIT_V(8); PG8_WAIT_L(0); PG8_BAR; PG8_MMA(0, 0, At, B0); PG8_MMA(0, 1, At, B1); PG8_BAR; PG8_SCHED;
            PG8_LDA(At, 0, 1); PG8_STAGE(PG8_SB(0, 0), b2, voffB); PG8_STAGE(PG8_SB(0, 1), b2 + hstepB, voffB); PG8_STAGE(PG8_SA(0, 0), a2, voffA);
            PG8_WAIT_V(8); PG8_WAIT_L(0); PG8_BAR; PG8_MMA(1, 0, At, B0); PG8_MMA(1, 1, At, B1); PG8_BAR; PG8_SCHED;
            PG8_LDB(B0, 1, 0); PG8_LDB(B1, 1, 1); PG8_SCHED; PG8_LDA(At, 1, 0); PG8_STAGE(PG8_SA(0, 1), a2 + hstepA, voffA);
            PG8_WAIT_V(8); PG8_WAIT_L(0); PG8_BAR; PG8_MMA(0, 0, At, B0); PG8_MMA(0, 1, At, B1); PG8_BAR; PG8_SCHED;
            PG8_LDA(At, 1, 1); PG8_STAGE(PG8_SB(1, 0), b3, voffB); PG8_STAGE(PG8_SB(1, 1), b3 + hstepB, voffB); PG8_STAGE(PG8_SA(1, 0), a3, voffA);
            PG8_WAIT_V(8); PG8_WAIT_L(0); PG8_BAR; PG8_MMA(1, 0, At, B0); PG8_MMA(1, 1, At, B1); PG8_BAR; PG8_SCHED;
            } else {
            PG8_LDB(B0, 0, 0); PG8_SCHED; PG8_LDA(At, 0, 0); PG8_STAGE(PG8_SA(1, 1), a1 + hstepA, voffA);
            PG8_WAIT_L(8); PG8_BAR; PG8_WAIT_L(0); PG8_MMA(0, 0, At, B0); PG8_BAR; PG8_SCHED;
            PG8_LDB(B1, 0, 1); PG8_STAGE(PG8_SB(0, 0), b2, voffB);
            PG8_BAR; PG8_WAIT_L(0); PG8_MMA(0, 1, At, B1); PG8_BAR;
            PG8_LDA(At, 0, 1); PG8_STAGE(PG8_SA(0, 0), a2, voffA);
            PG8_BAR; PG8_WAIT_L(0); PG8_MMA(1, 0, At, B0); PG8_BAR; PG8_SCHED;
            PG8_STAGE(PG8_SB(0, 1), b2 + hstepB, voffB);
            PG8_WAIT_V(6); PG8_BAR; PG8_MMA(1, 1, At, B1); PG8_BAR;
            PG8_LDB(B0, 1, 0); PG8_SCHED; PG8_LDA(At, 1, 0); PG8_STAGE(PG8_SA(0, 1), a2 + hstepA, voffA);
            PG8_WAIT_L(8); PG8_BAR; PG8_WAIT_L(0); PG8_MMA(0, 0, At, B0); PG8_BAR; PG8_SCHED;
            PG8_LDB(B1, 1, 1); PG8_STAGE(PG8_SB(1, 0), b3, voffB);
            PG8_BAR; PG8_WAIT_L(0); PG8_MMA(0, 1, At, B1); PG8_BAR;
            PG8_LDA(At, 1, 1); PG8_STAGE(PG8_SA(1, 0), a3, voffA);
            PG8_BAR; PG8_WAIT_L(0); PG8_MMA(1, 0, At, B0); PG8_BAR; PG8_SCHED;
            PG8_STAGE(PG8_SB(1, 1), b3 + hstepB, voffB);
            PG8_WAIT_V(6); PG8_BAR; PG8_MMA(1, 1, At, B1); PG8_BAR;
            }
        }
        if constexpr (ALIGN_EPI) { if (wr == 0) PG8_BAR; }
        if constexpr (!Epi::AFTER_DRAIN) { E(acc, cur, wr, wc, fr, fq); S.done(cur); }
        if (!has_next) break;
#pragma unroll
        for (int a = 0; a < 2; ++a)
#pragma unroll
            for (int b = 0; b < 2; ++b)
#pragma unroll
                for (int m = 0; m < 4; ++m)
#pragma unroll
                    for (int n = 0; n < 2; ++n) acc[a][b][m][n] = (f32x4){0.f, 0.f, 0.f, 0.f};
        cur = nxt; cA = nA; cB = nB; ++ui;
        if constexpr (ALIGN_EPI) { if (wr == 1) PG8_BAR; }
    }
    PG8_WAIT_V(0);
    if constexpr (!ALIGN_EPI) { if (wr == 0) PG8_BAR; }
    PG8_BAR;
    if constexpr (Epi::AFTER_DRAIN) { E.fused(acc, cur, wr, wc, fr, fq, lds, wid, lane); S.done(cur); }
#undef PG8_SA
#undef PG8_SB
#undef PG8_STAGE
#undef PG8_LDA
#undef PG8_LDB
#undef PG8_MMA
#undef PG8_WAIT_V
#undef PG8_WAIT_L
#undef PG8_BAR
#undef PG8_SCHED
}
struct EpiU {
    static constexpr bool PERM = true, AFTER_DRAIN = false;
    bf16_t* O; int ldc; const float* rsq;
    __device__ __forceinline__ void operator()(const f32x4 (&acc)[2][2][4][2], const Unit& u, int wr, int wc, int fr, int fq) const {
        const int row0 = u.pm * BM + wr * 64 + fr, col0 = u.pn * BM + wc * 32 + 8 * fq;
#pragma unroll
        for (int ai = 0; ai < 2; ++ai)
#pragma unroll
            for (int m = 0; m < 4; ++m) { bf16_t* rowp = O + (size_t)(row0 + ai * HALF + m * 16) * ldc + col0;
                const float rs = rsqrtf(rsq[row0 + ai * HALF + m * 16] * (1.f / DM) + EPS);
#pragma unroll
                for (int bj = 0; bj < 2; ++bj) { const f32x4 v0 = acc[ai][bj][m][0] * rs, v1 = acc[ai][bj][m][1] * rs;
                    u32x4 w; w.x = cvt_pk_bf16(v0[0], v0[1]); w.y = cvt_pk_bf16(v0[2], v0[3]); w.z = cvt_pk_bf16(v1[0], v1[1]); w.w = cvt_pk_bf16(v1[2], v1[3]);
                    *(u32x4*)(rowp + bj * HALF) = w; } }
    }
};
struct EpiQ {
    static constexpr bool PERM = true, AFTER_DRAIN = false;
    bf16_t* Q; const float* cs; const float* sn;
    __device__ __forceinline__ void operator()(const f32x4 (&acc)[2][2][4][2], const Unit& u, int wr, int wc, int fr, int fq) const {
        const int row0 = u.pm * BM + wr * 64 + fr;
#pragma unroll
        for (int ai = 0; ai < 2; ++ai)
#pragma unroll
            for (int m = 0; m < 4; ++m) { const int row = row0 + ai * HALF + m * 16, b = row / T, t = row % T;
#pragma unroll
                for (int bj = 0; bj < 2; ++bj) { const int c = u.pn * BM + bj * HALF + wc * 32 + 8 * fq, hh = c / 192, e = c % 192;
                    const f32x4 v0 = acc[ai][bj][m][0], v1 = acc[ai][bj][m][1];
                    float vals[8] = {v0[0], v0[1], v0[2], v0[3], v1[0], v1[1], v1[2], v1[3]};
                    if (e >= 128) { const int i0 = (e - 128) >> 1; const f32x4 cc = *(const f32x4*)(cs + (size_t)row * 32 + i0), ss = *(const f32x4*)(sn + (size_t)row * 32 + i0);
#pragma unroll
                        for (int p = 0; p < 4; ++p) { const float x1 = vals[2 * p], x2 = vals[2 * p + 1]; vals[2 * p] = x1 * cc[p] - x2 * ss[p]; vals[2 * p + 1] = x2 * cc[p] + x1 * ss[p]; } }
                    constexpr float QS = 0.07216878364870322f * 1.4426950408889634f;
#pragma unroll
                    for (int p_ = 0; p_ < 8; ++p_) vals[p_] *= QS;
                    u32x4 w; w.x = cvt_pk_bf16(vals[0], vals[1]); w.y = cvt_pk_bf16(vals[2], vals[3]); w.z = cvt_pk_bf16(vals[4], vals[5]); w.w = cvt_pk_bf16(vals[6], vals[7]);
                    *(u32x4*)(Q + ((size_t)(b * 8 + hh) * T + t) * 192 + e) = w; } }
    }
};
struct EpiKV {
    static constexpr bool PERM = true, AFTER_DRAIN = false;
    bf16_t* KN; bf16_t* V;
    __device__ __forceinline__ void operator()(const f32x4 (&acc)[2][2][4][2], const Unit& u, int wr, int wc, int fr, int fq) const {
        const int row0 = u.pm * BM + wr * 64 + fr, e = wc * 32 + 8 * fq;
#pragma unroll
        for (int ai = 0; ai < 2; ++ai)
#pragma unroll
            for (int m = 0; m < 4; ++m) { const int row = row0 + ai * HALF + m * 16, b = row / T, t = row % T;
                const size_t off = ((size_t)(b * 8 + u.pn) * T + t) * 128 + e;
#pragma unroll
                for (int bj = 0; bj < 2; ++bj) { const f32x4 v0 = acc[ai][bj][m][0], v1 = acc[ai][bj][m][1];
                    u32x4 w; w.x = cvt_pk_bf16(v0[0], v0[1]); w.y = cvt_pk_bf16(v0[2], v0[3]); w.z = cvt_pk_bf16(v1[0], v1[1]); w.w = cvt_pk_bf16(v1[2], v1[3]);
                    *(u32x4*)((bj ? V : KN) + off) = w; } }
    }
};
struct EpiSwi {
    static constexpr bool PERM = false, AFTER_DRAIN = false;
    bf16_t* H; const float* rsq;
    __device__ __forceinline__ void operator()(const f32x4 (&acc)[2][2][4][2], const Unit& u, int wr, int wc, int fr, int fq) const {
        const int row0 = u.pm * BM + wr * 64 + fr;
#pragma unroll
        for (int ai = 0; ai < 2; ++ai)
#pragma unroll
            for (int m = 0; m < 4; ++m) { bf16_t* rowp = H + (size_t)(row0 + ai * HALF + m * 16) * DFF;
                const float rs = rsqrtf(rsq[row0 + ai * HALF + m * 16] * (1.f / DM) + EPS);
#pragma unroll
                for (int bj = 0; bj < 2; ++bj) { const f32x4 a = acc[ai][bj][m][0] * rs, g = acc[ai][bj][m][1] * rs;
                    const int col = 16 * (8 * u.pn + 4 * bj + wc) + 4 * fq;
                    u32x2 w; w.x = cvt_pk_bf16(silu_(a[0]) * g[0], silu_(a[1]) * g[1]); w.y = cvt_pk_bf16(silu_(a[2]) * g[2], silu_(a[3]) * g[3]);
                    *(u32x2*)(rowp + col) = w; } }
    }
};
struct EpiRes {
    static constexpr bool PERM = false, AFTER_DRAIN = false;
    const float* base; float* out; bf16_t* hb; float* rsq;
    __device__ __forceinline__ void operator()(const f32x4 (&acc)[2][2][4][2], const Unit& u, int wr, int wc, int fr, int fq) const {
        const int row0 = u.pm * BM + wr * 64 + fr, col0 = u.pn * BM + wc * 32 + 4 * fq;
#pragma unroll
        for (int ai = 0; ai < 2; ++ai)
#pragma unroll
            for (int m = 0; m < 4; ++m) { const size_t off = (size_t)(row0 + ai * HALF + m * 16) * DM + col0; float ss = 0.f;
#pragma unroll
                for (int bj = 0; bj < 2; ++bj)
#pragma unroll
                    for (int n = 0; n < 2; ++n) { const f32x4 bs = *(const f32x4*)(base + off + bj * HALF + n * 16); const f32x4 o = bs + acc[ai][bj][m][n];
                        *(f32x4*)(out + off + bj * HALF + n * 16) = o;
                        u32x2 w; w.x = cvt_pk_bf16(o[0], o[1]); w.y = cvt_pk_bf16(o[2], o[3]); *(u32x2*)(hb + off + bj * HALF + n * 16) = w;
                        ss += (o[0] * o[0] + o[1] * o[1]) + (o[2] * o[2] + o[3] * o[3]); }
                ss += __shfl_xor(ss, 16); ss += __shfl_xor(ss, 32);
                if (fq == 0) unsafeAtomicAdd(rsq + row0 + ai * HALF + m * 16, ss); }
    }
};

}
namespace att {
constexpr int KVBLK = 64;
constexpr float SCALE = 0.07216878364870322f;
constexpr float THR = 8.f;
constexpr int SHM_V = KVBLK * 128 * 2, SHM_K = KVBLK * 192 * 2;
#ifndef ATT_SDEPTH
#define ATT_SDEPTH 1
#endif
constexpr int SDEPTH = ATT_SDEPTH;
#define KSWZ(row, colB) ((row) * 384 + ((colB) ^ (((row) & 7) << 4)))
#define SBAR() __builtin_amdgcn_sched_barrier(0)
__device__ __forceinline__ int crow(int r, int hi) { return (r & 3) + 8 * (r >> 2) + 4 * hi; }
__device__ __forceinline__ unsigned cvtpk(float lo, float hi) { return cvt_pk_bf16(lo, hi); }
template <bool FIRST>
__device__ __forceinline__ void partialSM(f32x16& p0, f32x16& p1, float& m_reg, float& alpha) {
  constexpr float THR2 = THR * 1.4426950408889634f;
  float pmax = p0[0];
#pragma unroll
  for (int r = 1; r < 16; ++r) pmax = fmaxf(pmax, p0[r]);
#pragma unroll
  for (int r = 0; r < 16; ++r) pmax = fmaxf(pmax, p1[r]);
  { auto rr = __builtin_amdgcn_permlane32_swap(__float_as_uint(pmax), __float_as_uint(pmax), false, false);
    pmax = fmaxf(__uint_as_float(rr[0]), __uint_as_float(rr[1])); }
  if (!FIRST && __builtin_expect(__all(pmax <= THR2), 1)) { alpha = 1.f; }
  else { const float d = FIRST ? pmax : fmaxf(pmax, 0.f); alpha = FIRST ? 1.f : __builtin_amdgcn_exp2f(-d); m_reg += d;
#pragma unroll
    for (int r = 0; r < 16; ++r) p0[r] -= d;
#pragma unroll
    for (int r = 0; r < 16; ++r) p1[r] -= d; }
#pragma unroll
  for (int r = 0; r < 16; ++r) p0[r] = __builtin_amdgcn_exp2f(p0[r]);
}
__device__ __forceinline__ void finishSM(f32x16& p0, f32x16& p1, float alpha, float& l_reg, bf16x8& pa0, bf16x8& pa1, bf16x8& pa2, bf16x8& pa3) {
#pragma unroll
  for (int r = 0; r < 16; ++r) p1[r] = __builtin_amdgcn_exp2f(p1[r]);
  float ps = 0;
#pragma unroll
  for (int r = 0; r < 16; ++r) ps += p0[r];
#pragma unroll
  for (int r = 0; r < 16; ++r) ps += p1[r];
  { auto rr = __builtin_amdgcn_permlane32_swap(__float_as_uint(ps), __float_as_uint(ps), false, false);
    ps = __uint_as_float(rr[0]) + __uint_as_float(rr[1]); }
  l_reg = l_reg * alpha + ps;
#define PK4(P, BASE, OUT) do { unsigned a0 = cvtpk(P[BASE + 0], P[BASE + 1]), a1 = cvtpk(P[BASE + 2], P[BASE + 3]);   \
    unsigned b0 = cvtpk(P[BASE + 4], P[BASE + 5]), b1 = cvtpk(P[BASE + 6], P[BASE + 7]);                              \
    auto r0 = __builtin_amdgcn_permlane32_swap(a0, b0, false, false); auto r1 = __builtin_amdgcn_permlane32_swap(a1, b1, false, false); \
    u32x4 w = {r0[0], r1[0], r0[1], r1[1]}; OUT = __builtin_bit_cast(bf16x8, w); } while (0)
  PK4(p0, 0, pa0); PK4(p0, 8, pa1); PK4(p1, 0, pa2); PK4(p1, 8, pa3);
#undef PK4
}
__device__ __forceinline__ void qkt(f32x16& p0, f32x16& p1, const char* Ks, const bf16x8* qr, const char* qL, int r32, int hi, float negm) {
#pragma unroll
  for (int r = 0; r < 16; ++r) { p0[r] = negm; p1[r] = negm; }
#pragma unroll
  for (int d0 = 0; d0 < 12; ++d0) { int cb = (d0 * 16 + hi * 8) * 2;
    bf16x8 b0 = *reinterpret_cast<const bf16x8*>(Ks + KSWZ(r32, cb));
    bf16x8 b1 = *reinterpret_cast<const bf16x8*>(Ks + KSWZ(32 + r32, cb));
    const bf16x8 q = d0 < 8 ? qr[d0 < 8 ? d0 : 0] : *reinterpret_cast<const bf16x8*>(qL + (d0 - 8) * 1024);
    p0 = __builtin_amdgcn_mfma_f32_32x32x16_bf16(b0, q, p0, 0, 0, 0);
    p1 = __builtin_amdgcn_mfma_f32_32x32x16_bf16(b1, q, p1, 0, 0, 0); }
}
__device__ __forceinline__ int v_st(int k, int c) { const int kk = (k & ~0xC) | ((k & 4) << 1) | ((k & 8) >> 1); return ((kk >> 3) * 4 + (c >> 5)) * 512 + ((kk & 7) * 32 + (c & 31)) * 2; }
__device__ __forceinline__ int v_rd_base(int lane) { return ((lane & 3) << 3) | (((lane >> 2) & 3) << 6) | (((lane >> 4) & 1) << 5) | (((lane >> 5) & 1) << 8); }
constexpr int v_rd_off(int d0, int ks, int half) { return d0 * 512 + ks * 4096 + half * 2048; }
template <int OFF> __device__ __forceinline__ s16x4 tr_read(int vb) {
  s16x4 r; asm volatile("ds_read_b64_tr_b16 %0, %1 offset:%2" : "=&v"(r) : "v"(vb), "i"(OFF) : "memory"); return r;
}
template <int D0> __device__ __forceinline__ void pv_one(f32x16& od, int vb, bf16x8 pa0, bf16x8 pa1, bf16x8 pa2, bf16x8 pa3) {
  const s16x4 l0 = tr_read<v_rd_off(D0, 0, 0)>(vb), h0 = tr_read<v_rd_off(D0, 0, 1)>(vb), l1 = tr_read<v_rd_off(D0, 1, 0)>(vb), h1 = tr_read<v_rd_off(D0, 1, 1)>(vb);
  const s16x4 l2 = tr_read<v_rd_off(D0, 2, 0)>(vb), h2 = tr_read<v_rd_off(D0, 2, 1)>(vb), l3 = tr_read<v_rd_off(D0, 3, 0)>(vb), h3 = tr_read<v_rd_off(D0, 3, 1)>(vb);
  asm volatile("s_waitcnt lgkmcnt(0)" ::: "memory"); SBAR();
#define PK(L, H) (bf16x8){L[0], L[1], L[2], L[3], H[0], H[1], H[2], H[3]}
  od = __builtin_amdgcn_mfma_f32_32x32x16_bf16(pa0, PK(l0, h0), od, 0, 0, 0);
  od = __builtin_amdgcn_mfma_f32_32x32x16_bf16(pa1, PK(l1, h1), od, 0, 0, 0);
  od = __builtin_amdgcn_mfma_f32_32x32x16_bf16(pa2, PK(l2, h2), od, 0, 0, 0);
  od = __builtin_amdgcn_mfma_f32_32x32x16_bf16(pa3, PK(l3, h3), od, 0, 0, 0);
#undef PK
}
__device__ __forceinline__ void pv_d0(f32x16* o, int vb, bf16x8 pa0, bf16x8 pa1, bf16x8 pa2, bf16x8 pa3) {
  pv_one<0>(o[0], vb, pa0, pa1, pa2, pa3); pv_one<1>(o[1], vb, pa0, pa1, pa2, pa3); pv_one<2>(o[2], vb, pa0, pa1, pa2, pa3); pv_one<3>(o[3], vb, pa0, pa1, pa2, pa3);
}
__device__ __forceinline__ void attn_unit(const bf16_t* __restrict__ Qb, const bf16_t* __restrict__ Kn, const bf16_t* __restrict__ Kr, const bf16_t* __restrict__ Vh,
                                          bf16_t* __restrict__ Ob, char* lds) {
  const int tid = opaque_tid(), wid = tid >> 6, lane = tid & 63, r32 = lane & 31, hi = lane >> 5;
  char* V_lds = lds; char* K_lds = lds + 2 * SHM_V;
  float* ws = (float*)(lds + 2 * SHM_V + 2 * SHM_K) + wid * 64; float* li_l = ws; float* al_l = ws + 32;
  float m_reg = 0.f, l_reg = 0; f32x16 o[4] = {}; bf16x8 qr[8];
  char* qL = lds + 2 * SHM_V + 2 * SHM_K + 2048 + wid * 4096 + lane * 16;
  const bf16_t* Qw = Qb + (long)(wid * 32 + r32) * 192 + hi * 8;
#pragma unroll
  for (int d0 = 0; d0 < 8; ++d0) qr[d0] = *reinterpret_cast<const bf16x8*>(Qw + d0 * 16);
#pragma unroll
  for (int d0 = 8; d0 < 12; ++d0) *reinterpret_cast<bf16x8*>(qL + (d0 - 8) * 1024) = *reinterpret_cast<const bf16x8*>(Qw + d0 * 16);
  const int sr = tid >> 4, sc = (tid & 15) * 8, vst0 = v_st(sr, sc), vst1 = v_st(32 + sr, sc);
  const int rr = tid >> 3, rc = (tid & 7) * 8;
  const int kst0 = KSWZ(sr, sc * 2), kst1 = KSWZ(32 + sr, sc * 2), kst2 = KSWZ(rr, 256 + rc * 2);
  const int vb0 = (int)(uintptr_t)V_lds + v_rd_base(lane);
  struct { bf16x8 vs0, vs1, ks0, ks1, ks2; } sr_[SDEPTH];
#define SLOAD(i, k0) do { sr_[i].vs0 = *(const bf16x8*)(&Vh[(long)((k0) + sr) * 128 + sc]); sr_[i].vs1 = *(const bf16x8*)(&Vh[(long)((k0) + 32 + sr) * 128 + sc]); \
    sr_[i].ks0 = *(const bf16x8*)(&Kn[(long)((k0) + sr) * 128 + sc]); sr_[i].ks1 = *(const bf16x8*)(&Kn[(long)((k0) + 32 + sr) * 128 + sc]); \
    sr_[i].ks2 = *(const bf16x8*)(&Kr[(long)((k0) + rr) * 64 + rc]); } while (0)
#define SWRITE(b, i) do { *(bf16x8*)(V_lds + (b) * SHM_V + vst0) = sr_[i].vs0; *(bf16x8*)(V_lds + (b) * SHM_V + vst1) = sr_[i].vs1; \
    *(bf16x8*)(K_lds + (b) * SHM_K + kst0) = sr_[i].ks0; *(bf16x8*)(K_lds + (b) * SHM_K + kst1) = sr_[i].ks1; *(bf16x8*)(K_lds + (b) * SHM_K + kst2) = sr_[i].ks2; } while (0)
#define SWAIT() do { if constexpr (SDEPTH == 2) asm volatile("s_waitcnt vmcnt(5)" ::: "memory"); else asm volatile("s_waitcnt vmcnt(0)" ::: "memory"); } while (0)
#define RESC(a) do { if (__any((a) < 1.f)) { if (hi == 0) al_l[r32] = (a); asm volatile("s_waitcnt lgkmcnt(0)" ::: "memory"); \
    _Pragma("unroll") for (int d = 0; d < 4; ++d) _Pragma("unroll") for (int r = 0; r < 16; ++r) o[d][r] *= al_l[crow(r, hi)]; } } while (0)
  f32x16 pA0, pA1, pB0, pB1; float alA, alB; bf16x8 pa0, pa1, pa2, pa3; const int NT = T / KVBLK;
  constexpr int SE = 0, SO = SDEPTH - 1;
  SLOAD(SE, 0); asm volatile("s_waitcnt vmcnt(0)" ::: "memory"); SWRITE(0, SE); __syncthreads();
  qkt(pA0, pA1, K_lds, qr, qL, r32, hi, 0.f); partialSM<true>(pA0, pA1, m_reg, alA);
  SLOAD(SO, KVBLK); if constexpr (SDEPTH == 2) { if (2 < NT) SLOAD(SE, 2 * KVBLK); }
  SWAIT(); SWRITE(1, SO); __syncthreads();
  for (int j = 1; j + 1 < NT; j += 2) {
    SBAR(); qkt(pB0, pB1, K_lds + SHM_K, qr, qL, r32, hi, -m_reg);
    finishSM(pA0, pA1, alA, l_reg, pa0, pa1, pa2, pa3); SBAR();
    SLOAD(SO, (j + SDEPTH) * KVBLK); SBAR();
    pv_d0(o, vb0, pa0, pa1, pa2, pa3); partialSM<false>(pB0, pB1, m_reg, alB);
    __syncthreads(); SWAIT(); SWRITE(0, SE);
    RESC(alB); __syncthreads();
    SBAR(); qkt(pA0, pA1, K_lds, qr, qL, r32, hi, -m_reg);
    finishSM(pB0, pB1, alB, l_reg, pa0, pa1, pa2, pa3); SBAR();
    if (SDEPTH == 1 || j + 3 < NT) SLOAD(SE, (j + 1 + SDEPTH) * KVBLK); SBAR();
    pv_d0(o, vb0 + (int)SHM_V, pa0, pa1, pa2, pa3); partialSM<false>(pA0, pA1, m_reg, alA);
    __syncthreads(); SWAIT(); SWRITE(1, SO);
    RESC(alA); __syncthreads();
  }
  SBAR(); qkt(pB0, pB1, K_lds + SHM_K, qr, qL, r32, hi, -m_reg);
  finishSM(pA0, pA1, alA, l_reg, pa0, pa1, pa2, pa3); SBAR();
  pv_d0(o, vb0, pa0, pa1, pa2, pa3); partialSM<false>(pB0, pB1, m_reg, alB);
  __syncthreads(); RESC(alB);
  finishSM(pB0, pB1, alB, l_reg, pa0, pa1, pa2, pa3); SBAR();
  pv_d0(o, vb0 + (int)SHM_V, pa0, pa1, pa2, pa3);
  if (hi == 0) li_l[r32] = l_reg; asm volatile("s_waitcnt lgkmcnt(0)" ::: "memory");
  float rli[16];
#pragma unroll
  for (int r = 0; r < 16; ++r) rli[r] = __builtin_amdgcn_rcpf(li_l[crow(r, hi)]);
  bf16_t* Ow = Ob + (long)(wid * 32) * DM;
#pragma unroll
  for (int r = 0; r < 16; ++r) { int orow = crow(r, hi);
#pragma unroll
    for (int d0 = 0; d0 < 4; ++d0) Ow[(long)orow * DM + d0 * 32 + r32] = (bf16_t)f2bf(o[d0][r] * rli[r]); }
#undef SLOAD
#undef SWRITE
#undef SWAIT
#undef RESC
  __syncthreads();
}
}
namespace scan {
constexpr int LDT = 72;
constexpr int SC_G = 0, SC_K = 33792, SC_QT = SC_K + 17408, SC_QG = SC_QT + 17408, SC_VT = SC_QG + 17408, SC_P = SC_VT + 18432, SC_SEG = SC_P + 9216, SC_RSQ = SC_SEG + 4096,
              SC_END = SC_RSQ + 2048, SC_KDT = SC_QT;
static_assert(SC_END <= LDS_BYTES, "scan LDS");

template <int TYPE> struct Cfg { static constexpr int DK = TYPE ? 128 : 64, LDG = DK + 4, LDK_ = DK + 8, ND8 = DK / 8; };

struct LgRaw { bf16x8 a0, a1, k; };
template <int TYPE>
__device__ __forceinline__ LgRaw lg_issue(const bf16_t* u, int h, int dir, size_t tok0, int tid) {
    LgRaw r;
    if constexpr (TYPE == 1) {
        const int i0 = tid >> 4, d8 = tid & 15, col = (dir ? C_HFB : C_HFF) + h * 128 + d8 * 8;
        r.a0 = *(const bf16x8*)(u + (tok0 + i0) * DINP + col); r.a1 = *(const bf16x8*)(u + (tok0 + 32 + i0) * DINP + col); r.k = r.a0;
    } else {
        const int i = tid >> 3, d8 = tid & 7; const bf16_t* ur = u + (tok0 + i) * DINP;
        r.a0 = *(const bf16x8*)(ur + (dir ? C_GAB : C_GAF)); r.a1 = *(const bf16x8*)(ur + (dir ? C_GAB : C_GAF) + 8); r.k = *(const bf16x8*)(ur + C_GK + h * 64 + d8 * 8);
    }
    return r;
}
template <int TYPE>
__device__ __forceinline__ void lg_compute(const KArgs& a, unsigned char* wsb, int l, int h, int dir, const LgRaw& raw, LAS unsigned char* lds, int tid) {
    using C = Cfg<TYPE>;
    LAS float* G = (LAS float*)(lds + SC_G); LAS bf16_t* Kb = (LAS bf16_t*)(lds + SC_K);
    if constexpr (TYPE == 1) {
        const float* lbp = (const float*)(wsb + WS_LB) + (dir * DEPTH + l) * 512 + h * 128;
        const int d8 = tid & 15;
        const f32x4 lb0 = *(const f32x4*)(lbp + d8 * 8), lb1 = *(const f32x4*)(lbp + d8 * 8 + 4);
        const float lb[8] = {lb0[0], lb0[1], lb0[2], lb0[3], lb1[0], lb1[1], lb1[2], lb1[3]};
#pragma unroll
        for (int e2 = 0; e2 < 2; ++e2) { const int i = (tid >> 4) + 32 * e2;
            float z[8], lg[8], kk[8]; unpack8(e2 ? raw.a1 : raw.a0, z);
#pragma unroll
            for (int e = 0; e < 8; ++e) { const float sg = sigmoid_(fmaxf(z[e], -80.f)); lg[e] = __logf(lb[e] + (1.f - lb[e]) * sg); kk[e] = (1.f - lb[e]) * (1.f - sg); }
            *(LAS f32x4*)(G + i * C::LDG + d8 * 8) = (f32x4){lg[0], lg[1], lg[2], lg[3]}; *(LAS f32x4*)(G + i * C::LDG + d8 * 8 + 4) = (f32x4){lg[4], lg[5], lg[6], lg[7]};
            *(LAS bf16x8*)(Kb + i * C::LDK_ + d8 * 8) = pack8(kk); }
    } else {
        const int i = tid >> 3, d8 = tid & 7;
        float ua[16]; unpack8(raw.a0, ua); unpack8(raw.a1, ua + 8);
        const float* up = (const float*)a.in[3] + (size_t)((l * 2 + dir) * 16) * 256 + h * 64 + d8 * 8;
        const float* bs = (const float*)a.in[4] + (l * 2 + dir) * 256 + h * 64 + d8 * 8;
        f32x4 z0 = *(const f32x4*)bs, z1 = *(const f32x4*)(bs + 4);
#pragma unroll
        for (int r = 0; r < 16; ++r) { z0 += ua[r] * *(const f32x4*)(up + r * 256); z1 += ua[r] * *(const f32x4*)(up + r * 256 + 4); }
        f32x4 g0, g1;
#pragma unroll
        for (int e = 0; e < 4; ++e) { g0[e] = logsigmoid_(z0[e]) * (1.f / 16.f); g1[e] = logsigmoid_(z1[e]) * (1.f / 16.f); }
        *(LAS f32x4*)(G + i * C::LDG + d8 * 8) = g0; *(LAS f32x4*)(G + i * C::LDG + d8 * 8 + 4) = g1;
        *(LAS bf16x8*)(Kb + i * C::LDK_ + d8 * 8) = raw.k;
    }
}
template <int TYPE>
__device__ __forceinline__ void cumsum_g(int dir, LAS unsigned char* lds, int tid) {
    using C = Cfg<TYPE>; constexpr int NSEG = 512 / C::DK, SEGL = 64 / NSEG;
    LAS float* G = (LAS float*)(lds + SC_G); LAS float* SG = (LAS float*)(lds + SC_SEG);
    const int d = tid % C::DK, seg = tid / C::DK;
    __syncthreads();
    float run = 0.f;
#pragma unroll
    for (int ii = 0; ii < SEGL; ++ii) { const int i = seg * SEGL + (dir ? SEGL - 1 - ii : ii); run += G[i * C::LDG + d]; G[i * C::LDG + d] = run; }
    SG[seg * 128 + d] = run;
    __syncthreads();
    float off = 0.f;
#pragma unroll
    for (int s = 0; s < NSEG; ++s) { const bool before = dir ? (s > seg) : (s < seg); if (before) off += SG[s * 128 + d]; }
#pragma unroll
    for (int ii = 0; ii < SEGL; ++ii) { const int i = seg * SEGL + ii; G[i * C::LDG + d] += off; }
    __syncthreads();
}
struct VRaw { bf16x8 x0, x1; };
__device__ __forceinline__ VRaw vT_issue(const bf16_t* vsrc, int tid) {
    const int i0 = tid >> 4, v8 = tid & 15; VRaw r;
    r.x0 = *(const bf16x8*)(vsrc + (size_t)i0 * DINP + v8 * 8); r.x1 = *(const bf16x8*)(vsrc + (size_t)(32 + i0) * DINP + v8 * 8); return r;
}
__device__ __forceinline__ void vT_write(const VRaw& r, LAS unsigned char* lds, int tid) {
    LAS bf16_t* VT = (LAS bf16_t*)(lds + SC_VT);
    const int v8 = tid & 15;
#pragma unroll
    for (int e2 = 0; e2 < 2; ++e2) { const int i = (tid >> 4) + 32 * e2; const bf16x8 x = e2 ? r.x1 : r.x0; const int pc = ((((i >> 3) ^ (v8 & 7)) << 3) | (i & 7));
#pragma unroll
        for (int e = 0; e < 8; ++e) VT[(v8 * 8 + e) * LDT + pc] = (bf16_t)x[e]; }
}
__device__ __forceinline__ bf16x8 vt_frag(LAS bf16_t* VT, int v, int c8) {
    return *(LAS bf16x8*)(VT + v * LDT + ((c8 ^ ((v >> 3) & 7)) << 3));
}

template <int TYPE>
__device__ __forceinline__ void pass1_item(const KArgs& a, int l, int item, LAS unsigned char* lds) {
    unsigned char* const wsb = opq(a.ws);
    const int tid = opaque_tid();
    using C = Cfg<TYPE>; constexpr int DK = C::DK;
    const int c = item & (NCH - 1), dir = (item >> 8) & 1, h = (item >> 9) & 3, b = item >> 11;
    const size_t tok0 = (size_t)b * T + (size_t)c * 64;
    const bf16_t* u = (const bf16_t*)(wsb + WS_U);
    const int wid = tid >> 6, lane = tid & 63, fr = lane & 15, fq = lane >> 4;
    __syncthreads();
    { const LgRaw raw = lg_issue<TYPE>(u, h, dir, tok0, tid); const VRaw vr = vT_issue(u + tok0 * DINP + (TYPE ? C_HI : C_GV) + h * 128, tid);
      lg_compute<TYPE>(a, wsb, l, h, dir, raw, lds, tid); vT_write(vr, lds, tid); }
    cumsum_g<TYPE>(dir, lds, tid);
    LAS float* G = (LAS float*)(lds + SC_G); LAS bf16_t* Kb = (LAS bf16_t*)(lds + SC_K); LAS bf16_t* KDT = (LAS bf16_t*)(lds + SC_KDT); LAS bf16_t* VT = (LAS bf16_t*)(lds + SC_VT);
    const int last = dir ? 0 : 63;
    float* Dout = (float*)(wsb + (TYPE ? WS_DH : WS_DG)) + (size_t)item * DK;
#pragma unroll
    for (int e2 = 0; e2 < DK / 64; ++e2) { const int task = tid + 512 * e2, i = task & 63, d8 = task >> 6;
        const f32x4 g0 = *(LAS f32x4*)(G + i * C::LDG + d8 * 8), g1 = *(LAS f32x4*)(G + i * C::LDG + d8 * 8 + 4);
        const f32x4 t0 = *(LAS f32x4*)(G + last * C::LDG + d8 * 8), t1 = *(LAS f32x4*)(G + last * C::LDG + d8 * 8 + 4);
        float kk[8]; unpack8(*(LAS bf16x8*)(Kb + i * C::LDK_ + d8 * 8), kk);
#pragma unroll
        for (int e = 0; e < 8; ++e) { const float gg = e < 4 ? g0[e] : g1[e - 4], tt = e < 4 ? t0[e] : t1[e - 4];
            KDT[(d8 * 8 + e) * LDT + i] = (bf16_t)f2bf(kk[e] * __expf(tt - gg)); }
        if (i == 0) { *(f32x4*)(Dout + d8 * 8) = (f32x4){__expf(t0[0]), __expf(t0[1]), __expf(t0[2]), __expf(t0[3])};
                      *(f32x4*)(Dout + d8 * 8 + 4) = (f32x4){__expf(t1[0]), __expf(t1[1]), __expf(t1[2]), __expf(t1[3])}; } }
    __syncthreads();
    bf16_t* ST = (bf16_t*)(wsb + (TYPE ? WS_SH : WS_SG)) + (size_t)item * 128 * DK;
    const bf16x8 b0 = vt_frag(VT, wid * 16 + fr, fq), b1 = vt_frag(VT, wid * 16 + fr, 4 + fq);
#pragma unroll
    for (int dt = 0; dt < DK / 16; ++dt) {
        const bf16x8 a0 = *(LAS bf16x8*)(KDT + (dt * 16 + fr) * LDT + fq * 8), a1 = *(LAS bf16x8*)(KDT + (dt * 16 + fr) * LDT + 32 + fq * 8);
        f32x4 acc = {0.f, 0.f, 0.f, 0.f};
        acc = __builtin_amdgcn_mfma_f32_16x16x32_bf16(a0, b0, acc, 0, 0, 0);
        acc = __builtin_amdgcn_mfma_f32_16x16x32_bf16(a1, b1, acc, 0, 0, 0);
        u32x2 w; w.x = cvt_pk_bf16(acc[0], acc[1]); w.y = cvt_pk_bf16(acc[2], acc[3]);
        *(u32x2*)(ST + (size_t)(wid * 16 + fr) * DK + dt * 16 + fq * 4) = w;
    }
}

struct P2Chain { bf16_t* st; const float* dp; size_t sstride; int dstride; int dir; };
__device__ __forceinline__ P2Chain p2_chain(unsigned char* wsb, int type, int E) {
    const int DK = type ? 128 : 64, IPI = 128 * DK;
    const int chain = E / IPI, e = E % IPI;
    P2Chain c; c.st = (bf16_t*)(wsb + (type ? WS_SH : WS_SG)) + (size_t)chain * NCH * IPI + e;
    c.dp = (const float*)(wsb + (type ? WS_DH : WS_DG)) + (size_t)chain * NCH * DK + (e % DK);
    c.sstride = (size_t)IPI; c.dstride = DK; c.dir = chain & 1; return c;
}
__device__ __forceinline__ void pass2_triple(const KArgs& a, int t) {
    unsigned char* const wsb = opq(a.ws);
    const P2Chain c0 = p2_chain(wsb, 1, t), c1 = p2_chain(wsb, 1, t + 131072), c2 = p2_chain(wsb, 0, t);
    float s0 = 0.f, s1 = 0.f, s2 = 0.f;
    unsigned short uA[3][4], uB[3][4]; float dA[3][4], dB[3][4];
#define P2_CI(c, s) ((c).dir ? NCH - 1 - (s) : (s))
#define P2_LOAD(U, D, sb) do { _Pragma("unroll") for (int k = 0; k < 4; ++k) { \
        const int i0_ = P2_CI(c0, (sb) + k), i1_ = P2_CI(c1, (sb) + k), i2_ = P2_CI(c2, (sb) + k); \
        U[0][k] = c0.st[(size_t)i0_ * c0.sstride]; D[0][k] = c0.dp[(size_t)i0_ * c0.dstride]; \
        U[1][k] = c1.st[(size_t)i1_ * c1.sstride]; D[1][k] = c1.dp[(size_t)i1_ * c1.dstride]; \
        U[2][k] = c2.st[(size_t)i2_ * c2.sstride]; D[2][k] = c2.dp[(size_t)i2_ * c2.dstride]; } } while (0)
#define P2_STEP(U, D, sb) do { _Pragma("unroll") for (int k = 0; k < 4; ++k) { \
        const int i0_ = P2_CI(c0, (sb) + k), i1_ = P2_CI(c1, (sb) + k), i2_ = P2_CI(c2, (sb) + k); \
        c0.st[(size_t)i0_ * c0.sstride] = (bf16_t)f2bf(s0); s0 = D[0][k] * s0 + bf2f(U[0][k]); \
        c1.st[(size_t)i1_ * c1.sstride] = (bf16_t)f2bf(s1); s1 = D[1][k] * s1 + bf2f(U[1][k]); \
        c2.st[(size_t)i2_ * c2.sstride] = (bf16_t)f2bf(s2); s2 = D[2][k] * s2 + bf2f(U[2][k]); } } while (0)
    P2_LOAD(uA, dA, 0);
#pragma unroll 1
    for (int sb = 0; sb < NCH; sb += 8) {
        P2_LOAD(uB, dB, sb + 4);
        P2_STEP(uA, dA, sb);
        if (sb + 8 < NCH) P2_LOAD(uA, dA, sb + 8);
        P2_STEP(uB, dB, sb + 4);
    }
#undef P2_CI
#undef P2_LOAD
#undef P2_STEP
}

template <int TYPE>
__device__ __forceinline__ void pass3_item(const KArgs& a, int l, int item, LAS unsigned char* lds) {
    unsigned char* const wsb = opq(a.ws);
    const int tid = opaque_tid();
    using C = Cfg<TYPE>; constexpr int DK = C::DK;
    const int c = item & (NCH - 1), h = (item >> 8) & 3, b = item >> 10;
    const size_t tok0 = (size_t)b * T + (size_t)c * 64;
    const bf16_t* u = (const bf16_t*)(wsb + WS_U);
    const int wid = tid >> 6, lane = tid & 63, fr = lane & 15, fq = lane >> 4;
    LAS float* G = (LAS float*)(lds + SC_G); LAS bf16_t* Kb = (LAS bf16_t*)(lds + SC_K); LAS bf16_t* QT = (LAS bf16_t*)(lds + SC_QT); LAS bf16_t* QG = (LAS bf16_t*)(lds + SC_QG);
    LAS bf16_t* VT = (LAS bf16_t*)(lds + SC_VT); LAS bf16_t* P = (LAS bf16_t*)(lds + SC_P); LAS float* RSQ = (LAS float*)(lds + SC_RSQ);
    const VRaw vr = vT_issue(u + tok0 * DINP + (TYPE ? C_HI : C_GV) + h * 128, tid);
    bf16x8 qraw[DK / 64];
#pragma unroll
    for (int e2 = 0; e2 < DK / 64; ++e2) { const int task = tid + 512 * e2, i = task / C::ND8, d8 = task % C::ND8;
        qraw[e2] = *(const bf16x8*)(u + (tok0 + i) * DINP + (TYPE ? C_HQ + h * 128 : C_GQ + h * 64) + d8 * 8); }
    const LgRaw raw0 = lg_issue<TYPE>(u, h, 0, tok0, tid), raw1 = lg_issue<TYPE>(u, h, 1, tok0, tid);
    __syncthreads();
    vT_write(vr, lds, tid);
    float qf[DK / 64][8];
#pragma unroll
    for (int e2 = 0; e2 < DK / 64; ++e2) { unpack8(qraw[e2], qf[e2]);
#pragma unroll
        for (int e = 0; e < 8; ++e) qf[e2][e] = TYPE ? silu_(qf[e2][e]) : qf[e2][e] * 0.125f; }
    f32x4 o[4];
#pragma unroll
    for (int it = 0; it < 4; ++it) o[it] = (f32x4){0.f, 0.f, 0.f, 0.f};
#pragma unroll 1
    for (int dir = 0; dir < 2; ++dir) {
        const int sitem = ((b * 4 + h) * 2 + dir) * NCH + c;
        const bf16_t* ST = (const bf16_t*)(wsb + (TYPE ? WS_SH : WS_SG)) + (size_t)sitem * 128 * DK + (size_t)(wid * 16 + fr) * DK + fq * 8;
        bf16x8 sf[DK / 32];
#pragma unroll
        for (int ks = 0; ks < DK / 32; ++ks) sf[ks] = *(const bf16x8*)(ST + ks * 32);
        if (dir) __syncthreads();
        { LgRaw rw; rw.a0 = dir ? raw1.a0 : raw0.a0; rw.a1 = dir ? raw1.a1 : raw0.a1; rw.k = dir ? raw1.k : raw0.k; lg_compute<TYPE>(a, wsb, l, h, dir, rw, lds, tid); }
        cumsum_g<TYPE>(dir, lds, tid);
#pragma unroll
        for (int e2 = 0; e2 < DK / 64; ++e2) { const int task = tid + 512 * e2, i = task / C::ND8, d8 = task % C::ND8;
            const f32x4 g0 = *(LAS f32x4*)(G + i * C::LDG + d8 * 8), g1 = *(LAS f32x4*)(G + i * C::LDG + d8 * 8 + 4);
            const f32x4 m0 = *(LAS f32x4*)(G + 32 * C::LDG + d8 * 8), m1 = *(LAS f32x4*)(G + 32 * C::LDG + d8 * 8 + 4);
            float kk[8], qq[8], qt[8], qg[8]; unpack8(*(LAS bf16x8*)(Kb + i * C::LDK_ + d8 * 8), kk);
#pragma unroll
            for (int e = 0; e < 8; ++e) qq[e] = qf[e2][e];
#pragma unroll
            for (int e = 0; e < 8; ++e) { const float gg = e < 4 ? g0[e] : g1[e - 4], gm = e < 4 ? m0[e] : m1[e - 4];
                const float q = qq[e];
                qt[e] = q * __expf(gg - gm); qg[e] = q * __expf(gg); kk[e] = kk[e] * __expf(gm - gg); }
            *(LAS bf16x8*)(QT + i * C::LDK_ + d8 * 8) = pack8(qt); *(LAS bf16x8*)(QG + i * C::LDK_ + d8 * 8) = pack8(qg); *(LAS bf16x8*)(Kb + i * C::LDK_ + d8 * 8) = pack8(kk); }
        __syncthreads();
        { const int it = wid >> 1;
#pragma unroll
          for (int jj = 0; jj < 2; ++jj) { const int jt = 2 * (wid & 1) + jj;
            f32x4 acc = {0.f, 0.f, 0.f, 0.f};
#pragma unroll
            for (int ks = 0; ks < DK / 32; ++ks) {
                const bf16x8 af = *(LAS bf16x8*)(QT + (it * 16 + fr) * C::LDK_ + ks * 32 + fq * 8), bfr = *(LAS bf16x8*)(Kb + (jt * 16 + fr) * C::LDK_ + ks * 32 + fq * 8);
                acc = __builtin_amdgcn_mfma_f32_16x16x32_bf16(af, bfr, acc, 0, 0, 0); }
#pragma unroll
            for (int r = 0; r < 4; ++r) { const int i = it * 16 + fq * 4 + r, j = jt * 16 + fr; const bool keep = dir ? (j >= i) : (j <= i);
                P[i * LDT + j] = (bf16_t)f2bf(keep ? acc[r] : 0.f); } } }
        __syncthreads();
        const bf16x8 vb0 = vt_frag(VT, wid * 16 + fr, fq), vb1 = vt_frag(VT, wid * 16 + fr, 4 + fq);
#pragma unroll
        for (int it = 0; it < 4; ++it) {
            const bf16x8 p0 = *(LAS bf16x8*)(P + (it * 16 + fr) * LDT + fq * 8), p1 = *(LAS bf16x8*)(P + (it * 16 + fr) * LDT + 32 + fq * 8);
            o[it] = __builtin_amdgcn_mfma_f32_16x16x32_bf16(p0, vb0, o[it], 0, 0, 0);
            o[it] = __builtin_amdgcn_mfma_f32_16x16x32_bf16(p1, vb1, o[it], 0, 0, 0);
#pragma unroll
            for (int ks = 0; ks < DK / 32; ++ks) { const bf16x8 af = *(LAS bf16x8*)(QG + (it * 16 + fr) * C::LDK_ + ks * 32 + fq * 8);
                o[it] = __builtin_amdgcn_mfma_f32_16x16x32_bf16(af, sf[ks], o[it], 0, 0, 0); }
        }
    }
#pragma unroll
    for (int it = 0; it < 4; ++it)
#pragma unroll
        for (int r = 0; r < 4; ++r) { float s = o[it][r] * o[it][r];
            s += __builtin_bit_cast(float, __builtin_amdgcn_update_dpp(0, __builtin_bit_cast(int, s), 0xB1, 0xF, 0xF, true));
            s += __builtin_bit_cast(float, __builtin_amdgcn_update_dpp(0, __builtin_bit_cast(int, s), 0x4E, 0xF, 0xF, true));
            s += __builtin_bit_cast(float, __builtin_amdgcn_update_dpp(0, __builtin_bit_cast(int, s), 0x141, 0xF, 0xF, true));
            s += __builtin_bit_cast(float, __builtin_amdgcn_update_dpp(0, __builtin_bit_cast(int, s), 0x140, 0xF, 0xF, true));
            RSQ[wid * 64 + it * 16 + fq * 4 + r] = s; }
    __syncthreads();
    LAS float* RSTD = (LAS float*)(lds + SC_SEG);
    if (tid < 64) { float s = 0.f;
#pragma unroll
        for (int w = 0; w < 8; ++w) s += RSQ[w * 64 + tid];
        RSTD[tid] = rsqrtf(s * (1.f / 128.f) + EPS); }
    __syncthreads();
    const float gain = ((const float*)a.in[TYPE ? 7 : 5])[l * 128 + wid * 16 + fr];
    bf16_t* mix = (bf16_t*)(wsb + WS_XN);
#pragma unroll
    for (int it = 0; it < 4; ++it)
#pragma unroll
        for (int r = 0; r < 4; ++r) { const int i = it * 16 + fq * 4 + r;
            const float rstd = RSTD[i];
            const float gt = bf2f(u[(tok0 + i) * DINP + (TYPE ? C_HG : C_GG) + h * 128 + wid * 16 + fr]);
            const float yv = o[it][r] * rstd * gain * silu_(gt);
            mix[(tok0 + i) * DM + (TYPE ? 512 : 0) + h * 128 + wid * 16 + fr] = (bf16_t)f2bf(yv); }
}
}
__device__ __forceinline__ void rmsnorm_rows_bf16(const float* src, const float* gain, bf16_t* dst) {
    const int tid = opaque_tid(), lane = tid & 63, gw = blockIdx.x * 8 + (tid >> 6), ngw = gridDim.x * 8;
    for (int m = gw; m < M; m += ngw) {
        const f32x4* xr = (const f32x4*)(src + (size_t)m * DM) + lane;
        f32x4 v[8]; float s = 0.f;
#pragma unroll
        for (int j = 0; j < 8; ++j) { v[j] = xr[64 * j]; s += (v[j][0] * v[j][0] + v[j][1] * v[j][1]) + (v[j][2] * v[j][2] + v[j][3] * v[j][3]); }
        const float rstd = rsqrtf(wave_sum(s) * (1.f / DM) + EPS);
        u32x2* o8 = (u32x2*)(dst + (size_t)m * DM) + lane;
#pragma unroll
        for (int j = 0; j < 8; ++j) { const f32x4 g = ((const f32x4*)gain)[lane + 64 * j];
            u32x2 w; w.x = cvt_pk_bf16(v[j][0] * rstd * g[0], v[j][1] * rstd * g[1]); w.y = cvt_pk_bf16(v[j][2] * rstd * g[2], v[j][3] * rstd * g[3]); o8[64 * j] = w; }
    }
}
__device__ __forceinline__ void cast_rows_bf16(const float* src, bf16_t* dst, float* rsq) {
    const int tid = opaque_tid(), lane = tid & 63, gw = blockIdx.x * 8 + (tid >> 6), ngw = gridDim.x * 8;
    for (int m = gw; m < M; m += ngw) {
        const f32x4* xr = (const f32x4*)(src + (size_t)m * DM) + lane;
        f32x4 v[8]; float s = 0.f;
#pragma unroll
        for (int j = 0; j < 8; ++j) { v[j] = xr[64 * j]; s += (v[j][0] * v[j][0] + v[j][1] * v[j][1]) + (v[j][2] * v[j][2] + v[j][3] * v[j][3]); }
        s = wave_sum(s);
        if (lane == 0) rsq[m] = s;
        u32x2* o8 = (u32x2*)(dst + (size_t)m * DM) + lane;
#pragma unroll
        for (int j = 0; j < 8; ++j) { u32x2 w; w.x = cvt_pk_bf16(v[j][0], v[j][1]); w.y = cvt_pk_bf16(v[j][2], v[j][3]); o8[64 * j] = w; }
    }
}
__device__ __forceinline__ void rmsnorm_rows_f32_inplace(float* buf, const float* gain) {
    const int tid = opaque_tid(), lane = tid & 63, gw = blockIdx.x * 8 + (tid >> 6), ngw = gridDim.x * 8;
    for (int m = gw; m < M; m += ngw) {
        f32x4* xr = (f32x4*)(buf + (size_t)m * DM) + lane;
        f32x4 v[8]; float s = 0.f;
#pragma unroll
        for (int j = 0; j < 8; ++j) { v[j] = xr[64 * j]; s += (v[j][0] * v[j][0] + v[j][1] * v[j][1]) + (v[j][2] * v[j][2] + v[j][3] * v[j][3]); }
        const float rstd = rsqrtf(wave_sum(s) * (1.f / DM) + EPS);
#pragma unroll
        for (int j = 0; j < 8; ++j) { const f32x4 g = ((const f32x4*)gain)[lane + 64 * j]; xr[64 * j] = v[j] * rstd * g; }
    }
}
__device__ __forceinline__ void convert_weights(const KArgs& a, int l, LAS unsigned char* lds) {
    unsigned char* const wsb = opq(a.ws);
    const int tid = opaque_tid();
    LAS float* tile = (LAS float*)lds;
    constexpr int I_IN = 32 * 84, I_QB = 8 * 24, I_KVB = 8 * 32, I_OUT = 32 * 32, I_13 = 32 * 176, I_2 = 88 * 32, NIT = I_IN + I_QB + I_KVB + I_OUT + I_13 + I_2;
    for (int it = blockIdx.x; it < NIT; it += gridDim.x) {
        int r = it, mode = 0, N, K, nkt; const float* w0; const float* w1 = nullptr; const float* gk = nullptr; bf16_t* WT;
        if (r < I_IN) { w0 = (const float*)a.in[2] + (size_t)l * DM * DIN; N = DIN; K = DM; nkt = 32; gk = (const float*)a.in[13] + l * DM; WT = (bf16_t*)(wsb + WS_WIN); }
        else if ((r -= I_IN) < I_QB) { w0 = (const float*)a.in[9] + (size_t)l * 512 * 1536; N = 1536; K = 512; nkt = 8; mode = 1; WT = (bf16_t*)(wsb + WS_WQB); }
        else if ((r -= I_QB) < I_KVB) { w0 = (const float*)a.in[11] + (size_t)l * 512 * 2048; N = 2048; K = 512; nkt = 8; WT = (bf16_t*)(wsb + WS_WKVB); }
        else if ((r -= I_KVB) < I_OUT) { w0 = (const float*)a.in[12] + (size_t)l * DM * DM; N = DM; K = DM; nkt = 32; WT = (bf16_t*)(wsb + WS_WOUT); }
        else if ((r -= I_OUT) < I_13) { w0 = (const float*)a.in[15] + (size_t)l * DM * DFF; w1 = (const float*)a.in[16] + (size_t)l * DM * DFF; N = DFF; K = DM; nkt = 32; mode = 2; gk = (const float*)a.in[14] + l * DM; WT = (bf16_t*)(wsb + WS_W13); }
        else { r -= I_13; w0 = (const float*)a.in[17] + (size_t)l * DFF * DM; N = DM; K = DFF; nkt = 88; WT = (bf16_t*)(wsb + WS_W2); }
        const int kt = r % nkt, rt = r / nkt, r0 = rt * 64, k0 = kt * 64;
        __syncthreads();
        if (mode == 1) {
#pragma unroll
            for (int e = 0; e < 8; ++e) { const int idx = tid + 512 * e, rl = idx & 63, kl = idx >> 6, rr = r0 + rl, k = k0 + kl;
                const int hh = rr / 192, ee = rr % 192; const int col = ee < 128 ? hh * 192 + ee : hh * 192 + 128 + ((ee - 128) & 1) * 32 + ((ee - 128) >> 1);
                tile[kl * 65 + rl] = w0[(size_t)k * N + col]; }
        } else {
#pragma unroll
            for (int e = 0; e < 2; ++e) { const int idx = tid + 512 * e, r4 = (idx & 15) * 4, kl = idx >> 4, rr = r0 + r4, k = k0 + kl;
                f32x4 v = {0.f, 0.f, 0.f, 0.f};
                if (mode == 0) { if (rr < N) v = *(const f32x4*)(w0 + (size_t)k * N + rr); }
                else { const int g = rr >> 5, n = (rr >> 4) & 1, i = rr & 15; v = *(const f32x4*)((n ? w1 : w0) + (size_t)k * N + 16 * g + i); }
                if (gk) v = v * gk[k];
                tile[kl * 65 + r4] = v[0]; tile[kl * 65 + r4 + 1] = v[1]; tile[kl * 65 + r4 + 2] = v[2]; tile[kl * 65 + r4 + 3] = v[3]; }
        }
        __syncthreads();
        { const int k8 = tid & 7, rl = tid >> 3;
          u32x4 w; w.x = pk2(tile[(8 * k8 + 0) * 65 + rl], tile[(8 * k8 + 1) * 65 + rl]); w.y = pk2(tile[(8 * k8 + 2) * 65 + rl], tile[(8 * k8 + 3) * 65 + rl]);
          w.z = pk2(tile[(8 * k8 + 4) * 65 + rl], tile[(8 * k8 + 5) * 65 + rl]); w.w = pk2(tile[(8 * k8 + 6) * 65 + rl], tile[(8 * k8 + 7) * 65 + rl]);
          *(u32x4*)(WT + (size_t)(r0 + rl) * K + k0 + 8 * k8) = w; }
    }
    __syncthreads();
}
__device__ __forceinline__ void tables_phase(const KArgs& a) {
    unsigned char* const wsb = opq(a.ws);
    const int tid = opaque_tid();
    const int* pos = (const int*)a.in[1];
    float* cs = (float*)(wsb + WS_COS); float* sn = (float*)(wsb + WS_SIN);
    const int gt = blockIdx.x * 512 + tid, ngt = gridDim.x * 512;
    for (int idx = gt; idx < M * 32; idx += ngt) { const int tok = idx >> 5, i = idx & 31;
        const float inv = 1.0f / exp2f((float)(2 * i) * (1.f / 64.f) * 13.287712379549449f);
        const float ang = (float)pos[tok] * inv;
        double rev = (double)ang * 0.15915494309189535; rev -= rint(rev);
        const float f = (float)rev;
        cs[idx] = __builtin_amdgcn_cosf(f); sn[idx] = __builtin_amdgcn_sinf(f); }
    if (blockIdx.x == 0) { const float* lg = (const float*)a.in[6]; float* lb = (float*)(wsb + WS_LB);
        for (int p = tid; p < 2 * 512; p += 512) { const int dir = p >> 9, c = p & 511;
            float mx = -1e30f;
#pragma unroll
            for (int l = 0; l < DEPTH; ++l) mx = fmaxf(mx, lg[(dir * DEPTH + l) * 512 + c]);
            float den = 0.f;
#pragma unroll
            for (int l = 0; l < DEPTH; ++l) den += __expf(lg[(dir * DEPTH + l) * 512 + c] - mx);
            float cum = 0.f;
#pragma unroll
            for (int l = 0; l < DEPTH; ++l) { if (l > 0) cum += __expf(lg[(dir * DEPTH + l) * 512 + c] - mx) / den; lb[(dir * DEPTH + l) * 512 + c] = cum; } } }
}
__device__ __forceinline__ void mla_prep(const KArgs& a, int l) {
    unsigned char* const wsb = opq(a.ws);
    const int tid = opaque_tid(), lane = tid & 63, gw = blockIdx.x * 8 + (tid >> 6), ngw = gridDim.x * 8;
    bf16_t* u = (bf16_t*)(wsb + WS_U); bf16_t* kr = (bf16_t*)(wsb + WS_KR);
    const float* cs = (const float*)(wsb + WS_COS); const float* sn = (const float*)(wsb + WS_SIN);
    const float* gq = (const float*)a.in[8] + l * 512 + lane * 8; const float* gkv = (const float*)a.in[10] + l * 512 + lane * 8;
    for (int tok = gw; tok < M; tok += ngw) {
        bf16_t* ur = u + (size_t)tok * DINP;
#pragma unroll
        for (int w = 0; w < 2; ++w) { bf16_t* p = ur + (w ? C_CKV : C_CQ) + lane * 8; const float* g = w ? gkv : gq;
            float f[8]; unpack8(*(const bf16x8*)p, f); float s = 0.f;
#pragma unroll
            for (int e = 0; e < 8; ++e) s += f[e] * f[e];
            const float rstd = rsqrtf(wave_sum(s) * (1.f / 512.f) + EPS);
#pragma unroll
            for (int e = 0; e < 8; ++e) f[e] = f[e] * rstd * g[e];
            *(bf16x8*)p = pack8(f); }
        if (lane < 32) { const float x1 = bf2f(ur[C_KR + lane]), x2 = bf2f(ur[C_KR + 32 + lane]), c = cs[(size_t)tok * 32 + lane], s = sn[(size_t)tok * 32 + lane];
            *(unsigned*)(kr + (size_t)tok * 64 + 2 * lane) = pk2(x1 * c - x2 * s, x2 * c + x1 * s); }
    }
}

#define XB_TMO      128
#define XB_XCNT(j)  (256  + 64 * (j))
#define XB_XSUB(j)  (1280 + 64 * (j))
#define XB_XGEN(j)  (2304 + 64 * (j))
#define XB_TOP      3328
#define XB_TOPGEN   3392
#define XCD_BAR_WORDS 3456
#define XB_SPIN_CAP (1u << 18)

__device__ __forceinline__ unsigned xb_ld(unsigned* p)              { return __hip_atomic_load(p, __ATOMIC_RELAXED, __HIP_MEMORY_SCOPE_AGENT); }
__device__ __forceinline__ unsigned xb_add(unsigned* p, unsigned v) { return __hip_atomic_fetch_add(p, v, __ATOMIC_RELAXED, __HIP_MEMORY_SCOPE_AGENT); }
__device__ __forceinline__ unsigned xb_xcc_id() { return (unsigned)__builtin_amdgcn_s_getreg((3 << 11) | 20) & 0xFu; }
#define XB_SPIN(cond, bar) do { unsigned _sp = 0; while (cond) { __builtin_amdgcn_s_sleep(1); \
    if ((++_sp & 255u) == 0u) { if (xb_ld(&(bar)[XB_TMO])) break; if (_sp > XB_SPIN_CAP) { atomicAdd(&(bar)[XB_TMO], 1u); break; } } } } while (0)

struct XcdBarrier {
    unsigned* bar; unsigned x;
    volatile LAS unsigned* st;
};

__device__ __forceinline__ XcdBarrier xcd_barrier_post(unsigned* bar, volatile LAS unsigned* st) {
    XcdBarrier b; b.bar = bar; b.x = xb_xcc_id(); b.st = st;
    if (threadIdx.x == 0) (void)xb_add(&bar[XB_XCNT(b.x)], 1u);
    return b;
}
__device__ __forceinline__ void xcd_barrier_complete(unsigned* bar, unsigned x, unsigned& nloc, unsigned& nx) {
    const unsigned G = gridDim.x * gridDim.y * gridDim.z;
    unsigned sum, cnt, mine, sp = 0u;
    for (;;) {
        sum = 0u; cnt = 0u; mine = 0u;
#pragma unroll
        for (unsigned j = 0; j < 16; ++j) { const unsigned c = xb_ld(&bar[XB_XCNT(j)]); sum += c; cnt += (c > 0u) ? 1u : 0u; mine = (j == x) ? c : mine; }
        if (sum == G) break;
        __builtin_amdgcn_s_sleep(1);
        if ((++sp & 255u) == 0u) { if (xb_ld(&bar[XB_TMO])) break; if (sp > XB_SPIN_CAP) { atomicAdd(&bar[XB_TMO], 1u); break; } }
    }
    nloc = mine > 0u ? mine : 1u; nx = cnt > 0u ? cnt : 1u;
}

__device__ __forceinline__ void xcd_barrier(const XcdBarrier& b) {
    asm volatile("s_waitcnt vmcnt(0)" ::: "memory");
    __syncthreads();
    if (threadIdx.x == 0) {
        unsigned* bar = b.bar;
        __builtin_amdgcn_s_waitcnt(0);
        unsigned nloc = b.st[0], nx = b.st[1];
        if (nloc == 0u) { xcd_barrier_complete(bar, b.x, nloc, nx); b.st[0] = nloc; b.st[1] = nx; }
        const unsigned old = xb_add(&bar[XB_XSUB(b.x)], 1u);
        const unsigned gen = old / nloc;
        if (old + 1u == (gen + 1u) * nloc) {
            __builtin_amdgcn_fence(__ATOMIC_RELEASE, "agent");
            asm volatile("s_waitcnt vmcnt(0)" ::: "memory");
            const unsigned og = xb_add(&bar[XB_TOP], 1u);
            const unsigned tg = og / nx;
            if (og + 1u == (tg + 1u) * nx) xb_add(&bar[XB_TOPGEN], 1u);
            else XB_SPIN(xb_ld(&bar[XB_TOPGEN]) == tg, bar);
            __builtin_amdgcn_fence(__ATOMIC_ACQUIRE, "agent");
            xb_add(&bar[XB_XGEN(b.x)], 1u);
            asm volatile("s_waitcnt vmcnt(0)" ::: "memory");
        } else {
            XB_SPIN(xb_ld(&bar[XB_XGEN(b.x)]) == gen, bar);
            __builtin_amdgcn_fence(__ATOMIC_ACQUIRE, "agent");
            asm volatile("s_waitcnt vmcnt(0)" ::: "memory");
        }
    }
    __syncthreads();
}
__global__ void __launch_bounds__(512, 2) mega_fwd(KArgs a) {
    extern __shared__ __attribute__((aligned(16))) unsigned char smem[];
    cg::grid_group grid = cg::this_grid();
    LAS unsigned char* lds = (LAS unsigned char*)smem;
    const int G = gridDim.x, bx = blockIdx.x;
    const float* x = (const float*)a.in[0];
    grid.sync();
    if (threadIdx.x < 16) ((LAS unsigned*)(lds + 131072))[threadIdx.x] = 0u;
    __syncthreads();
    (void)xcd_barrier_post((unsigned*)(a.ws + WS_BAR), (volatile LAS unsigned*)(lds + 131072));
#define GBAR() do { XcdBarrier xb_; xb_.bar = (unsigned*)(opq(a.ws) + WS_BAR); xb_.x = xb_xcc_id(); xb_.st = (volatile LAS unsigned*)(lds + 131072); xcd_barrier(xb_); } while (0)

#if PH_MISC
    tables_phase(a);
    convert_weights(a, 0, lds);
#if PROBE_CVT_REP > 1
    convert_weights(a, 0, lds);
#endif
#endif
    { float* rz = (float*)(opq(a.ws) + WS_RSQ); for (int z_ = bx * 512 + opaque_tid(); z_ < 4 * M; z_ += G * 512) rz[z_] = 0.f; }
    cast_rows_bf16(x, (bf16_t*)(opq(a.ws) + WS_XN), (float*)(opq(a.ws) + WS_RSQ) + 4 * M);
    GBAR();
#pragma unroll 1
    for (int l = 0; l < DEPTH; ++l) {
        if (l > 0) {
#if PH_MISC
            convert_weights(a, l, lds);
#if PROBE_CVT_REP > 1
            convert_weights(a, l, lds);
#endif
#endif
            GBAR();
        }
        { pg8::Gemm g{(const bf16_t*)(opq(a.ws) + WS_XN), (const bf16_t*)(opq(a.ws) + WS_WIN), M, DINP, DM, DM, DM}; pg8::StaticOrder S; S.init(M, DINP, G, bx);
          pg8::EpiU E{(bf16_t*)(opq(a.ws) + WS_U), DINP, (const float*)(opq(a.ws) + WS_RSQ) + (size_t)(l == 0 ? 4 : 2 + (l - 1)) * M};
          __syncthreads(); if (PH_GEMM & 1) pg8::gemm_phase<pg8::EpiU, pg8::StaticOrder, true, true>(lds, g, S, E);
#if PROBE_GEMM_REP > 1
          __syncthreads(); if (PH_GEMM & 1) pg8::gemm_phase<pg8::EpiU, pg8::StaticOrder, true, true>(lds, g, S, E);
#endif
 }
        GBAR();
#if PH_MISC
        mla_prep(a, l);
#endif
#if PH_S1
        for (int it = bx; it < 4096; it += G) scan::pass1_item<1>(a, l, it, lds);
        for (int it = bx; it < 4096; it += G) scan::pass1_item<0>(a, l, it, lds);
#if PROBE_SCAN_REP > 1
        for (int it = bx; it < 4096; it += G) scan::pass1_item<1>(a, l, it, lds);
        for (int it = bx; it < 4096; it += G) scan::pass1_item<0>(a, l, it, lds);
#endif
#endif
        GBAR();
#if PH_S2
        for (int t = bx * 512 + opaque_tid(); t < 131072; t += G * 512) scan::pass2_triple(a, t);
#endif
        { pg8::Gemm g{(const bf16_t*)(opq(a.ws) + WS_U) + C_CQ, (const bf16_t*)(opq(a.ws) + WS_WQB), M, 1536, 512, DINP, 512}; pg8::StaticOrder S; S.init(M, 1536, G, bx);
          pg8::EpiQ E{(bf16_t*)(opq(a.ws) + WS_Q), (const float*)(opq(a.ws) + WS_COS), (const float*)(opq(a.ws) + WS_SIN)};
          __syncthreads(); if (PH_GEMM & 2) pg8::gemm_phase<pg8::EpiQ, pg8::StaticOrder, true, true>(lds, g, S, E);
#if PROBE_GEMM_REP > 1
          __syncthreads(); if (PH_GEMM & 2) pg8::gemm_phase<pg8::EpiQ, pg8::StaticOrder, true, true>(lds, g, S, E);
#endif
 }
        { pg8::Gemm g{(const bf16_t*)(opq(a.ws) + WS_U) + C_CKV, (const bf16_t*)(opq(a.ws) + WS_WKVB), M, 2048, 512, DINP, 512}; pg8::StaticOrder S; S.init(M, 2048, G, bx);
          pg8::EpiKV E{(bf16_t*)(opq(a.ws) + WS_KN), (bf16_t*)(opq(a.ws) + WS_V)};
          __syncthreads(); if (PH_GEMM & 4) pg8::gemm_phase<pg8::EpiKV, pg8::StaticOrder, true, true>(lds, g, S, E);
#if PROBE_GEMM_REP > 1
          __syncthreads(); if (PH_GEMM & 4) pg8::gemm_phase<pg8::EpiKV, pg8::StaticOrder, true, true>(lds, g, S, E);
#endif
 }
        GBAR();
        { const bool x8 = (G % 8) == 0; const int xcd = bx & 7, slot = bx >> 3, nslot = G >> 3;
          for (int pr = 0; pr < (x8 ? 2 : 16); ++pr) { const int p = x8 ? xcd + 8 * pr : pr, b = p >> 3, h = p & 7;
            for (int qb = x8 ? slot : bx; qb < 64; qb += x8 ? nslot : G) {
              const bf16_t* Qb = (const bf16_t*)(opq(a.ws) + WS_Q) + ((size_t)(b * 8 + h) * T + (size_t)qb * 256) * 192;
              const bf16_t* Kn = (const bf16_t*)(opq(a.ws) + WS_KN) + (size_t)(b * 8 + h) * T * 128;
              const bf16_t* Kr = (const bf16_t*)(opq(a.ws) + WS_KR) + (size_t)b * T * 64;
              const bf16_t* Vh = (const bf16_t*)(opq(a.ws) + WS_V) + (size_t)(b * 8 + h) * T * 128;
              bf16_t* Ob = (bf16_t*)(opq(a.ws) + WS_XN) + ((size_t)b * T + (size_t)qb * 256) * DM + 1024 + h * 128;
#if PH_ATT
              for (int rep_ = 0; rep_ < PROBE_ATT_REP; ++rep_) att::attn_unit(Qb, Kn, Kr, Vh, Ob, (char*)smem);
#else
              { const int t_ = opaque_tid(); bf16_t* zp = Ob + (size_t)(t_ >> 1) * DM + (t_ & 1) * 64; (void)Qb; (void)Kn; (void)Kr; (void)Vh;
                for (int z_ = 0; z_ < 8; ++z_) *(u32x4*)(zp + z_ * 8) = (u32x4){0u, 0u, 0u, 0u}; }
#endif
 } } }
#if PH_S3
        for (int it = bx; it < 2048; it += G) scan::pass3_item<1>(a, l, it, lds);
        for (int it = bx; it < 2048; it += G) scan::pass3_item<0>(a, l, it, lds);
#if PROBE_SCAN_REP > 1
        for (int it = bx; it < 2048; it += G) scan::pass3_item<1>(a, l, it, lds);
        for (int it = bx; it < 2048; it += G) scan::pass3_item<0>(a, l, it, lds);
#endif
#else
        { bf16_t* mz = (bf16_t*)(opq(a.ws) + WS_XN); for (size_t z_ = (size_t)bx * 512 + opaque_tid(); z_ < (size_t)M * 128; z_ += (size_t)G * 512) *(u32x4*)(mz + (z_ >> 7) * DM + (z_ & 127) * 8) = (u32x4){0u, 0u, 0u, 0u}; }
#endif
        GBAR();
        { pg8::Gemm g{(const bf16_t*)(opq(a.ws) + WS_XN), (const bf16_t*)(opq(a.ws) + WS_WOUT), M, DM, DM, DM, DM}; pg8::StaticOrder S; S.init(M, DM, G, bx);
          pg8::EpiRes E{l == 0 ? x : (const float*)a.out, a.out, (bf16_t*)(opq(a.ws) + WS_HB), (float*)(opq(a.ws) + WS_RSQ) + (size_t)l * M};
          __syncthreads(); if (PH_GEMM & 8) pg8::gemm_phase<pg8::EpiRes, pg8::StaticOrder, true, true>(lds, g, S, E); }
        GBAR();
        { pg8::Gemm g{(const bf16_t*)(opq(a.ws) + WS_HB), (const bf16_t*)(opq(a.ws) + WS_W13), M, 2 * DFF, DM, DM, DM}; pg8::StaticOrder S; S.init(M, 2 * DFF, G, bx);
          pg8::EpiSwi E{(bf16_t*)(opq(a.ws) + WS_HID), (const float*)(opq(a.ws) + WS_RSQ) + (size_t)l * M};
          __syncthreads(); if (PH_GEMM & 16) pg8::gemm_phase<pg8::EpiSwi, pg8::StaticOrder, true, true>(lds, g, S, E);
#if PROBE_GEMM_REP > 1
          __syncthreads(); if (PH_GEMM & 16) pg8::gemm_phase<pg8::EpiSwi, pg8::StaticOrder, true, true>(lds, g, S, E);
#endif
 }
        GBAR();
        { pg8::Gemm g{(const bf16_t*)(opq(a.ws) + WS_HID), (const bf16_t*)(opq(a.ws) + WS_W2), M, DM, DFF, DFF, DFF}; pg8::StaticOrder S; S.init(M, DM, G, bx);
          pg8::EpiRes E{(const float*)a.out, a.out, (bf16_t*)(opq(a.ws) + WS_XN), (float*)(opq(a.ws) + WS_RSQ) + (size_t)(2 + l) * M};
          __syncthreads(); if (PH_GEMM & 32) pg8::gemm_phase<pg8::EpiRes, pg8::StaticOrder, true, true>(lds, g, S, E); }
        GBAR();
    }
    rmsnorm_rows_f32_inplace(a.out, (const float*)a.in[18]);
}

extern "C" void kernel_launch(void* const* d_in, const int* in_sizes, int n_in, void* d_out, int out_size, void* d_ws, size_t ws_size, hipStream_t stream) {
    static int grid = 0;
    if (grid == 0) {
        if (n_in != 19 || out_size != M * DM || ws_size < WS_END) { fprintf(stderr, "kernel_launch: unexpected shapes (n_in %d out %d ws %zu)\n", n_in, out_size, ws_size); grid = -1; return; }
        int dev = 0, cus = 0, per_cu = 0;
        hipGetDevice(&dev); hipDeviceGetAttribute(&cus, hipDeviceAttributeMultiprocessorCount, dev);
        if (hipFuncSetAttribute((const void*)mega_fwd, hipFuncAttributeMaxDynamicSharedMemorySize, LDS_BYTES) != hipSuccess) { fprintf(stderr, "kernel_launch: hipFuncSetAttribute failed\n"); grid = -1; return; }
        if (hipOccupancyMaxActiveBlocksPerMultiprocessor(&per_cu, (const void*)mega_fwd, 512, LDS_BYTES) != hipSuccess || per_cu < 1) { fprintf(stderr, "kernel_launch: occupancy query says %d\n", per_cu); per_cu = 1; }
        (void)hipGetLastError();
        grid = cus * (per_cu > 1 ? 1 : per_cu);
    }
    if (grid < 0) return;
    KArgs a{};
    for (int i = 0; i < 19; ++i) a.in[i] = d_in[i];
    a.out = (float*)d_out; a.ws = (unsigned char*)d_ws;
    if (hipMemsetAsync((char*)d_ws + WS_BAR, 0, 16384, stream) != hipSuccess) { fprintf(stderr, "kernel_launch: memset failed\n"); return; }
    void* args[] = {&a};
    hipError_t e = hipLaunchCooperativeKernel((const void*)mega_fwd, dim3(grid), dim3(512), args, LDS_BYTES, stream);
    if (e != hipSuccess) fprintf(stderr, "kernel_launch: cooperative launch failed: %s (grid %d)\n", hipGetErrorString(e), grid);
}
```

```cpp
#include <hip/hip_runtime.h>
#include <hip/hip_cooperative_groups.h>
#include <cstdint>
#include <cstdio>
namespace cg = cooperative_groups;
#ifndef PROBE_GEMM_REP
#define PROBE_GEMM_REP 1
#endif
#ifndef PROBE_SCAN_REP
#define PROBE_SCAN_REP 1
#endif
#ifndef PROBE_CVT_REP
#define PROBE_CVT_REP 1
#endif
#ifndef PROBE_ATT_REP
#define PROBE_ATT_REP 1
#endif
#ifndef PH_ATT
#define PH_ATT 1
#endif
#ifndef PH_S1
#define PH_S1 1
#endif
#ifndef PH_S2
#define PH_S2 1
#endif
#ifndef PH_S3
#define PH_S3 1
#endif
#ifndef PH_GEMM
#define PH_GEMM 63
#endif
#ifndef PH_MISC
#define PH_MISC 1
#endif

#define LAS __attribute__((address_space(3)))
typedef unsigned short bf16_t;
typedef short bf16x8 __attribute__((ext_vector_type(8)));
typedef short s16x4 __attribute__((ext_vector_type(4)));
typedef float f32x2 __attribute__((ext_vector_type(2)));
typedef float f32x4 __attribute__((ext_vector_type(4)));
typedef float f32x16 __attribute__((ext_vector_type(16)));
typedef unsigned u32x2 __attribute__((ext_vector_type(2)));
typedef unsigned u32x4 __attribute__((ext_vector_type(4)));

constexpr int NB = 2, T = 16384, M = NB * T, DM = 2048, DIN = 5216, DINP = 5376, DFF = 5632, DEPTH = 2;
constexpr int C_GQ = 0, C_GK = 256, C_GV = 512, C_GAF = 1024, C_GAB = 1040, C_GG = 1056, C_HQ = 1568, C_HFF = 2080, C_HFB = 2592, C_HI = 3104, C_HG = 3616,
              C_CQ = 4128, C_CKV = 4640, C_KR = 5152;
constexpr float EPS = 1e-6f;
constexpr int NCH = T / 64;
constexpr size_t MiB = 1048576;
constexpr size_t WS_WIN = 0, WS_WQB = 21 * MiB, WS_WKVB = WS_WQB + 3 * MiB / 2, WS_WOUT = WS_WKVB + 2 * MiB, WS_W13 = WS_WOUT + 8 * MiB, WS_W2 = WS_W13 + 44 * MiB;
constexpr size_t WS_XN = 99 * MiB, WS_U = 227 * MiB, WS_Q = 563 * MiB, WS_KN = 659 * MiB, WS_V = 723 * MiB, WS_KR = 787 * MiB, WS_SG = 791 * MiB, WS_SH = 855 * MiB,
                 WS_DG = 983 * MiB, WS_DH = 984 * MiB, WS_COS = 986 * MiB, WS_SIN = 990 * MiB, WS_LB = 994 * MiB, WS_BAR = 995 * MiB, WS_RSQ = WS_BAR + 16384, WS_END = 996 * MiB, WS_HB = WS_U, WS_HID = WS_U + 128 * MiB;
static_assert(WS_W2 + 22 * MiB <= WS_XN, "weights");
constexpr int LDS_BYTES = 131072 + 64;

struct KArgs { const void* in[19]; float* out; unsigned char* ws; };

__device__ __forceinline__ float bf2f(unsigned v) { return __uint_as_float(v << 16); }
__device__ __forceinline__ unsigned f2bf(float f) { unsigned u = __float_as_uint(f); return (u + 0x7fffu + ((u >> 16) & 1u)) >> 16; }
__device__ __forceinline__ unsigned pk2(float lo, float hi) { return f2bf(lo) | (f2bf(hi) << 16); }
typedef __bf16 bf16x2_t __attribute__((ext_vector_type(2)));
__device__ __forceinline__ unsigned cvt_pk_bf16(float lo, float hi) { f32x2 v = {lo, hi}; bf16x2_t b = __builtin_convertvector(v, bf16x2_t); return __builtin_bit_cast(unsigned, b); }
__device__ __forceinline__ float wave_sum(float v) {
#pragma unroll
    for (int o = 1; o < 64; o <<= 1) v += __shfl_xor(v, o);
    return v;
}
__device__ __forceinline__ unsigned char* opq(unsigned char* q) { asm volatile("" : "+s"(q)); return q; }
__device__ __forceinline__ int opaque_tid() { int t = threadIdx.x; asm volatile("" : "+v"(t)); return t; }
#define DBGF(ws_, cond_, bit_) do { if (cond_) atomicOr((unsigned*)((ws_) + WS_BAR) + 32, (unsigned)(bit_)); } while (0)
__device__ __forceinline__ bool badf(float v) { return !(fabsf(v) < 1e30f); }
__device__ __forceinline__ float sigmoid_(float z) { return __builtin_amdgcn_rcpf(1.f + __expf(-z)); }
__device__ __forceinline__ float silu_(float z) { return z * sigmoid_(z); }
__device__ __forceinline__ float logsigmoid_(float z) { return fminf(z, 0.f) - __logf(1.f + __expf(-fabsf(z))); }
__device__ __forceinline__ void unpack8(bf16x8 v, float* f) {
#pragma unroll
    for (int e = 0; e < 8; ++e) f[e] = bf2f((unsigned)(unsigned short)v[e]);
}
__device__ __forceinline__ bf16x8 pack8(const float* f) {
    u32x4 w = {cvt_pk_bf16(f[0], f[1]), cvt_pk_bf16(f[2], f[3]), cvt_pk_bf16(f[4], f[5]), cvt_pk_bf16(f[6], f[7])};
    return __builtin_bit_cast(bf16x8, w);
}

namespace pg8 {
#define PG8_LAS __attribute__((address_space(3)))
constexpr int BM = 256, BK = 64, HALF = 128, HTB = HALF * BK * 2, STAGE_BYTES = 8 * HTB, NXCD = 8, WGM = 8;
__host__ __device__ __forceinline__ int lds_byte(int r, int c) { const int st = (r >> 4) * 2 + (c >> 5), rr = r & 15, cc = c & 31, ob = rr * 64 + cc * 2; return st * 1024 + (ob ^ (((ob >> 9) & 1) << 5)); }
__host__ __device__ __forceinline__ void stage_rc(int b, int& R, int& C) { const int st = b / 1024, sb = b % 1024, swz = sb ^ (((sb >> 9) & 1) << 5); R = (st >> 1) * 16 + swz / 64; C = (st & 1) * 32 + (swz % 64) / 2; }
__host__ __device__ __forceinline__ int perm32(int rho) { const int n = rho >> 4, i = rho & 15; return 8 * (i >> 2) + 4 * n + (i & 3); }
struct Unit { int pm, pn; };
struct Gemm { const bf16_t* A; const bf16_t* Bt; int M, N, K, lda, ldb; };
struct StaticOrder {
    int nM, nN, nwg, G, c;
    __host__ __device__ void init(int M_, int N_, int G_, int c_) { nM = M_ / BM; nN = N_ / BM; nwg = nM * nN; G = G_; c = c_; }
    __host__ __device__ bool next(int i, Unit& u) const {
        const long L = (long)i * G + c; if (L >= nwg) return false;
        int wgid = (int)L; { const int q = nwg / NXCD, r = nwg % NXCD, xcd = wgid % NXCD, off = wgid / NXCD; wgid = (xcd < r ? xcd * (q + 1) : r * (q + 1) + (xcd - r) * q) + off; }
        const int nig = WGM * nN, gid = wgid / nig, fm = gid * WGM, gsz = (nM - fm) < WGM ? (nM - fm) : WGM;
        u.pm = fm + ((wgid % nig) % gsz); u.pn = (wgid % nig) / gsz; return true;
    }
    __device__ __forceinline__ void a_ready(const Unit&) const {}
    __device__ __forceinline__ void done(const Unit&) const {}
};
template <class Epi, class Sched, bool ALIGN_EPI = false, bool SP2 = false>
__device__ __forceinline__ void gemm_phase(PG8_LAS unsigned char* lds, const Gemm g, const Sched& S, const Epi& E) {
    const int tid = opaque_tid(), wid = __builtin_amdgcn_readfirstlane(tid >> 6), lane = tid & 63, wr = wid >> 2, wc = wid & 3, fr = lane & 15, fq = lane >> 4;
    const int K = g.K, nt = K / BK;
    unsigned voffA[2], voffB[2];
#pragma unroll
    for (int i = 0; i < 2; ++i) { int R, C; stage_rc(tid * 16 + i * 8192, R, C); const int Rb = Epi::PERM ? ((R & ~31) + perm32(R & 31)) : R;
        voffA[i] = (unsigned)(R * g.lda + C) * 2u; voffB[i] = (unsigned)(Rb * g.ldb + C) * 2u; }
    const size_t kstep = (size_t)(BK * 2);
    const size_t hstepA = (size_t)HALF * g.lda * 2, hstepB = (size_t)HALF * g.ldb * 2;
    const size_t tstepA = 2 * hstepA, tstepB = 2 * hstepB;
    const unsigned ldsw = (unsigned)wid * 1024u;
    const int aoff = lds_byte(wr * 64 + fr, fq * 8), boff = lds_byte(wc * 32 + fr, fq * 8);
#define PG8_SA(b, h) (((b) * 2 + (h)) * HTB)
#define PG8_SB(b, h) ((4 + (b) * 2 + (h)) * HTB)
#define PG8_STAGE(bufoff, gbase, voff) do { _Pragma("unroll") for (int _i = 0; _i < 2; ++_i) \
        __builtin_amdgcn_global_load_lds((const unsigned*)((const char*)(gbase) + (voff)[_i]), (PG8_LAS unsigned*)(lds + (bufoff) + ldsw + _i * 8192), 16, 0, 0); } while (0)
#define PG8_LDA(dst, b, h) do { _Pragma("unroll") for (int m = 0; m < 4; ++m) _Pragma("unroll") for (int k = 0; k < 2; ++k) dst[m][k] = *(const PG8_LAS bf16x8*)(lds + PG8_SA(b, h) + aoff + m * 2048 + k * 1024); } while (0)
#define PG8_LDB(dst, b, h) do { _Pragma("unroll") for (int n = 0; n < 2; ++n) _Pragma("unroll") for (int k = 0; k < 2; ++k) dst[n][k] = *(const PG8_LAS bf16x8*)(lds + PG8_SB(b, h) + boff + n * 2048 + k * 1024); } while (0)
#define PG8_MMA(ai, bj, At, Bt) do { __builtin_amdgcn_s_setprio(1); _Pragma("unroll") for (int m = 0; m < 4; ++m) _Pragma("unroll") for (int n = 0; n < 2; ++n) _Pragma("unroll") for (int k = 0; k < 2; ++k) \
        acc[ai][bj][m][n] = __builtin_amdgcn_mfma_f32_16x16x32_bf16(Bt[n][k], At[m][k], acc[ai][bj][m][n], 0, 0, 0); __builtin_amdgcn_s_setprio(0); } while (0)
#define PG8_WAIT_V(n) asm volatile("s_waitcnt vmcnt(" #n ")" ::: "memory")
#define PG8_WAIT_L(n) asm volatile("s_waitcnt lgkmcnt(" #n ")" ::: "memory")
#define PG8_BAR __builtin_amdgcn_s_barrier()
#define PG8_SCHED __builtin_amdgcn_sched_barrier(0)
    Unit cur, nxt; int ui = 0;
    if (!S.next(0, cur)) return;
    f32x4 acc[2][2][4][2];
#pragma unroll
    for (int a = 0; a < 2; ++a)
#pragma unroll
        for (int b = 0; b < 2; ++b)
#pragma unroll
            for (int m = 0; m < 4; ++m)
#pragma unroll
                for (int n = 0; n < 2; ++n) acc[a][b][m][n] = (f32x4){0.f, 0.f, 0.f, 0.f};
    bf16x8 At[4][2], B0[2][2], B1[2][2];
    const char* cA = (const char*)g.A + (size_t)cur.pm * tstepA; const char* cB = (const char*)g.Bt + (size_t)cur.pn * tstepB;
    S.a_ready(cur);
    if constexpr (SP2) {
        PG8_STAGE(PG8_SB(0, 0), cB, voffB); PG8_STAGE(PG8_SB(0, 1), cB + hstepB, voffB); PG8_STAGE(PG8_SA(0, 0), cA, voffA); PG8_STAGE(PG8_SA(0, 1), cA + hstepA, voffA);
        if (wr == 1) PG8_BAR;
        PG8_WAIT_V(2); PG8_BAR;
        PG8_STAGE(PG8_SB(1, 0), cB + kstep, voffB); PG8_STAGE(PG8_SA(1, 0), cA + kstep, voffA); PG8_STAGE(PG8_SB(1, 1), cB + hstepB + kstep, voffB);
        PG8_WAIT_V(6); PG8_BAR;
    } else {
        PG8_STAGE(PG8_SB(0, 0), cB, voffB); PG8_STAGE(PG8_SA(0, 0), cA, voffA); PG8_STAGE(PG8_SB(0, 1), cB + hstepB, voffB); PG8_STAGE(PG8_SA(0, 1), cA + hstepA, voffA);
        if (wr == 1) PG8_BAR;
        PG8_WAIT_V(4); PG8_BAR;
        PG8_STAGE(PG8_SB(1, 0), cB + kstep, voffB); PG8_STAGE(PG8_SA(1, 0), cA + kstep, voffA); PG8_STAGE(PG8_SB(1, 1), cB + hstepB + kstep, voffB);
        PG8_WAIT_V(6); PG8_BAR;
    }
    for (;;) {
        const bool has_next = S.next(ui + 1, nxt);
        const char* nA = has_next ? (const char*)g.A + (size_t)nxt.pm * tstepA : cA; const char* nB = has_next ? (const char*)g.Bt + (size_t)nxt.pn * tstepB : cB;
        for (int t = 0; t < nt; t += 2) {
            const bool last = (t == nt - 2);
            const char* a1 = cA + (size_t)(t + 1) * kstep;
            const char* a2 = last ? nA : cA + (size_t)(t + 2) * kstep; const char* b2 = last ? nB : cB + (size_t)(t + 2) * kstep;
            const char* a3 = a2 + kstep; const char* b3 = b2 + kstep;
            if (last && has_next) S.a_ready(nxt);
            if constexpr (SP2) {
            PG8_LDB(B0, 0, 0); PG8_LDB(B1, 0, 1); PG8_SCHED; PG8_LDA(At, 0, 0); PG8_STAGE(PG8_SA(1, 1), a1 + hstepA, voffA);
            PG8_WAIT_V(8); PG8_WAIT_L(0); PG8_BAR; PG8_MMA(0, 0, At, B0); PG8_MMA(0, 1, At, B1); PG8_BAR; PG8_SCHED;
            PG8_LDA(At, 0, 1); PG8_STAGE(PG8_SB(0, 0), b2, voffB); PG8_STAGE(PG8_SB(0, 1), b2 + hstepB, voffB); PG8_STAGE(PG8_SA(0, 0), a2, voffA);
            PG8_WAIT_V(8); PG8_WAIT_L(0); PG8_BAR; PG8_MMA(1, 0, At, B0); PG8_MMA(1, 1, At, B1); PG8_BAR; PG8_SCHED;
            PG8_LDB(B0, 1, 0); PG8_LDB(B1, 1, 1); PG8_SCHED; PG8_LDA(At, 1, 0); PG8_STAGE(PG8_SA(0, 1), a2 + hstepA, voffA);
            PG8_WAIT_V(8); PG8_WAIT_L(0); PG8_BAR; PG8_MMA(0, 0, At, B0); PG8_MMA(0, 1, At, B1); PG8_BAR; PG8_SCHED;
            PG8_LDA(At, 1, 1); PG8_STAGE(PG8_SB(1, 0), b3, voffB); PG8_STAGE(PG8_SB(1, 1), b3 + hstepB, voffB); PG8_STAGE(PG8_SA(1, 0), a3, voffA);
            PG8_WAIT_V(8); PG8_WAIT_L(0); PG8_BAR; PG8_MMA(1, 0, At, B0); PG8_MMA(1, 1, At, B1); PG8_BAR; PG8_SCHED;
            } else {
            PG8_LDB(B0, 0, 0); PG8_SCHED; PG8_LDA(At, 0, 0); PG8_STAGE(PG8_SA(1, 1), a1 + hstepA, voffA);
            PG8_WAIT_L(8); PG8_BAR; PG8_WAIT_L(0); PG8_MMA(0, 0, At, B0); PG8_BAR; PG8_SCHED;
            PG8_LDB(B1, 0, 1); PG8_STAGE(PG8_SB(0, 0), b2, voffB);
            PG8_BAR; PG8_WAIT_L(0); PG8_MMA(0, 1, At, B1); PG8_BAR;
            PG8_LDA(At, 0, 1); PG8_STAGE(PG8_SA(0, 0), a2, voffA);
            PG8_BAR; PG8_WAIT_L(0); PG8_MMA(1, 0, At, B0); PG8_BAR; PG8_SCHED;
            PG8_STAGE(PG8_SB(0, 1), b2 + hstepB, voffB);
            PG8_WAIT_V(6); PG8_BAR; PG8_MMA(1, 1, At, B1); PG8_BAR;
            PG8_LDB(B0, 1, 0); PG8_SCHED; PG8_LDA(At, 1, 0); PG8_STAGE(PG8_SA(0, 1), a2 + hstepA, voffA);
            PG8_WAIT_L(8); PG8_BAR; PG8_WAIT_L(0); PG8_MMA(0, 0, At, B0); PG8_BAR; PG8_SCHED;
            PG8_LDB(B1, 1, 1); PG8_STAGE(PG8_SB(1, 0), b3, voffB);
            PG8_BAR; PG8_WAIT_L(0); PG8_MMA(0, 1, At, B1); PG8_BAR;
            PG8_LDA(At, 1, 1); PG8_STAGE(PG8_SA(1, 0), a3, voffA);
            PG8_BAR; PG8_WAIT_L(0); PG8_MMA(1, 0, At, B0); PG8_BAR; PG8_SCHED;
            PG8_STAGE(PG8_SB(1, 1), b3 + hstepB, voffB);
            PG8_WAIT_V(6); PG8_BAR; PG8_MMA(1, 1, At, B1); PG8_BAR;
            }
        }
        if constexpr (ALIGN_EPI) { if (wr == 0) PG8_BAR; }
        if constexpr (!Epi::AFTER_DRAIN) { E(acc, cur, wr, wc, fr, fq); S.done(cur); }
        if (!has_next) break;
#pragma unroll
        for (int a = 0; a < 2; ++a)
#pragma unroll
            for (int b = 0; b < 2; ++b)
#pragma unroll
                for (int m = 0; m < 4; ++m)
#pragma unroll
                    for (int n = 0; n < 2; ++n) acc[a][b][m][n] = (f32x4){0.f, 0.f, 0.f, 0.f};
        cur = nxt; cA = nA; cB = nB; ++ui;
        if constexpr (ALIGN_EPI) { if (wr == 1) PG8_BAR; }
    }
    PG8_WAIT_V(0);
    if constexpr (!ALIGN_EPI) { if (wr == 0) PG8_BAR; }
    PG8_BAR;
    if constexpr (Epi::AFTER_DRAIN) { E.fused(acc, cur, wr, wc, fr, fq, lds, wid, lane); S.done(cur); }
#undef PG8_SA
#undef PG8_SB
#undef PG8_STAGE
#undef PG8_LDA
#undef PG8_LDB
#undef PG8_MMA
#undef PG8_WAIT_V
#undef PG8_WAIT_L
#undef PG8_BAR
#undef PG8_SCHED
}
struct EpiU {
    static constexpr bool PERM = true, AFTER_DRAIN = false;
    bf16_t* O; int ldc; const float* rsq;
    __device__ __forceinline__ void operator()(const f32x4 (&acc)[2][2][4][2], const Unit& u, int wr, int wc, int fr, int fq) const {
        const int row0 = u.pm * BM + wr * 64 + fr, col0 = u.pn * BM + wc * 32 + 8 * fq;
        float rsv[2][4];
#pragma unroll
        for (int ai = 0; ai < 2; ++ai)
#pragma unroll
            for (int m = 0; m < 4; ++m) rsv[ai][m] = rsq[row0 + ai * HALF + m * 16];
#pragma unroll
        for (int ai = 0; ai < 2; ++ai)
#pragma unroll
            for (int m = 0; m < 4; ++m) { bf16_t* rowp = O + (size_t)(row0 + ai * HALF + m * 16) * ldc + col0;
                const float rs = rsqrtf(rsv[ai][m] * (1.f / DM) + EPS);
#pragma unroll
                for (int bj = 0; bj < 2; ++bj) { const f32x4 v0 = acc[ai][bj][m][0] * rs, v1 = acc[ai][bj][m][1] * rs;
                    u32x4 w; w.x = cvt_pk_bf16(v0[0], v0[1]); w.y = cvt_pk_bf16(v0[2], v0[3]); w.z = cvt_pk_bf16(v1[0], v1[1]); w.w = cvt_pk_bf16(v1[2], v1[3]);
                    *(u32x4*)(rowp + bj * HALF) = w; } }
    }
};
struct EpiQ {
    static constexpr bool PERM = true, AFTER_DRAIN = false;
    bf16_t* Q; const float* cs; const float* sn;
    __device__ __forceinline__ void operator()(const f32x4 (&acc)[2][2][4][2], const Unit& u, int wr, int wc, int fr, int fq) const {
        const int row0 = u.pm * BM + wr * 64 + fr;
#pragma unroll
        for (int ai = 0; ai < 2; ++ai) {
            f32x4 ccv[4][2], ssv[4][2];
#pragma unroll
            for (int m = 0; m < 4; ++m)
#pragma unroll
                for (int bj = 0; bj < 2; ++bj) { const int row = row0 + ai * HALF + m * 16, e = (u.pn * BM + bj * HALF + wc * 32 + 8 * fq) % 192, i0 = e >= 128 ? (e - 128) >> 1 : 0;
                    ccv[m][bj] = *(const f32x4*)(cs + (size_t)row * 32 + i0); ssv[m][bj] = *(const f32x4*)(sn + (size_t)row * 32 + i0); }
#pragma unroll
            for (int m = 0; m < 4; ++m) { const int row = row0 + ai * HALF + m * 16, b = row / T, t = row % T;
#pragma unroll
                for (int bj = 0; bj < 2; ++bj) { const int c = u.pn * BM + bj * HALF + wc * 32 + 8 * fq, hh = c / 192, e = c % 192;
                    const f32x4 v0 = acc[ai][bj][m][0], v1 = acc[ai][bj][m][1];
                    float vals[8] = {v0[0], v0[1], v0[2], v0[3], v1[0], v1[1], v1[2], v1[3]};
                    if (e >= 128) { const f32x4 cc = ccv[m][bj], ss = ssv[m][bj];
#pragma unroll
                        for (int p = 0; p < 4; ++p) { const float x1 = vals[2 * p], x2 = vals[2 * p + 1]; vals[2 * p] = x1 * cc[p] - x2 * ss[p]; vals[2 * p + 1] = x2 * cc[p] + x1 * ss[p]; } }
                    constexpr float QS = 0.07216878364870322f * 1.4426950408889634f;
#pragma unroll
                    for (int p_ = 0; p_ < 8; ++p_) vals[p_] *= QS;
                    u32x4 w; w.x = cvt_pk_bf16(vals[0], vals[1]); w.y = cvt_pk_bf16(vals[2], vals[3]); w.z = cvt_pk_bf16(vals[4], vals[5]); w.w = cvt_pk_bf16(vals[6], vals[7]);
                    *(u32x4*)(Q + ((size_t)(b * 8 + hh) * T + t) * 192 + e) = w; } } }
    }
};
struct EpiKV {
    static constexpr bool PERM = true, AFTER_DRAIN = false;
    bf16_t* KN; bf16_t* V;
    __device__ __forceinline__ void operator()(const f32x4 (&acc)[2][2][4][2], const Unit& u, int wr, int wc, int fr, int fq) const {
        const int row0 = u.pm * BM + wr * 64 + fr, e = wc * 32 + 8 * fq;
#pragma unroll
        for (int ai = 0; ai < 2; ++ai)
#pragma unroll
            for (int m = 0; m < 4; ++m) { const int row = row0 + ai * HALF + m * 16, b = row / T, t = row % T;
                const size_t off = ((size_t)(b * 8 + u.pn) * T + t) * 128 + e;
#pragma unroll
                for (int bj = 0; bj < 2; ++bj) { const f32x4 v0 = acc[ai][bj][m][0], v1 = acc[ai][bj][m][1];
                    u32x4 w; w.x = cvt_pk_bf16(v0[0], v0[1]); w.y = cvt_pk_bf16(v0[2], v0[3]); w.z = cvt_pk_bf16(v1[0], v1[1]); w.w = cvt_pk_bf16(v1[2], v1[3]);
                    *(u32x4*)((bj ? V : KN) + off) = w; } }
    }
};
struct EpiSwi {
    static constexpr bool PERM = false, AFTER_DRAIN = false;
    bf16_t* H; const float* rsq;
    __device__ __forceinline__ void operator()(const f32x4 (&acc)[2][2][4][2], const Unit& u, int wr, int wc, int fr, int fq) const {
        const int row0 = u.pm * BM + wr * 64 + fr;
        float rsv[2][4];
#pragma unroll
        for (int ai = 0; ai < 2; ++ai)
#pragma unroll
            for (int m = 0; m < 4; ++m) rsv[ai][m] = rsq[row0 + ai * HALF + m * 16];
#pragma unroll
        for (int ai = 0; ai < 2; ++ai)
#pragma unroll
            for (int m = 0; m < 4; ++m) { bf16_t* rowp = H + (size_t)(row0 + ai * HALF + m * 16) * DFF;
                const float rs = rsqrtf(rsv[ai][m] * (1.f / DM) + EPS);
#pragma unroll
                for (int bj = 0; bj < 2; ++bj) { const f32x4 a = acc[ai][bj][m][0] * rs, g = acc[ai][bj][m][1] * rs;
                    const int col = 16 * (8 * u.pn + 4 * bj + wc) + 4 * fq;
                    u32x2 w; w.x = cvt_pk_bf16(silu_(a[0]) * g[0], silu_(a[1]) * g[1]); w.y = cvt_pk_bf16(silu_(a[2]) * g[2], silu_(a[3]) * g[3]);
                    *(u32x2*)(rowp + col) = w; } }
    }
};
struct EpiRes {
    static constexpr bool PERM = false, AFTER_DRAIN = false;
    const float* base; float* out; bf16_t* hb; float* rsq;
    __device__ __forceinline__ void operator()(const f32x4 (&acc)[2][2][4][2], const Unit& u, int wr, int wc, int fr, int fq) const {
        const int row0 = u.pm * BM + wr * 64 + fr, col0 = u.pn * BM + wc * 32 + 4 * fq;
#pragma unroll
        for (int ai = 0; ai < 2; ++ai) {
            f32x4 bs[4][2][2];
#pragma unroll
            for (int m = 0; m < 4; ++m) { const size_t off = (size_t)(row0 + ai * HALF + m * 16) * DM + col0;
#pragma unroll
                for (int bj = 0; bj < 2; ++bj)
#pragma unroll
                    for (int n = 0; n < 2; ++n) bs[m][bj][n] = *(const f32x4*)(base + off + bj * HALF + n * 16); }
#pragma unroll
            for (int m = 0; m < 4; ++m) { const size_t off = (size_t)(row0 + ai * HALF + m * 16) * DM + col0; float ss = 0.f;
#pragma unroll
                for (int bj = 0; bj < 2; ++bj)
#pragma unroll
                    for (int n = 0; n < 2; ++n) { const f32x4 o = bs[m][bj][n] + acc[ai][bj][m][n];
                        *(f32x4*)(out + off + bj * HALF + n * 16) = o;
                        u32x2 w; w.x = cvt_pk_bf16(o[0], o[1]); w.y = cvt_pk_bf16(o[2], o[3]); *(u32x2*)(hb + off + bj * HALF + n * 16) = w;
                        ss += (o[0] * o[0] + o[1] * o[1]) + (o[2] * o[2] + o[3] * o[3]); }
                ss += __shfl_xor(ss, 16); ss += __shfl_xor(ss, 32);
                if (fq == 0) unsafeAtomicAdd(rsq + row0 + ai * HALF + m * 16, ss); } }
    }
};

}
namespace att {
constexpr int KVBLK = 64;
constexpr float SCALE = 0.07216878364870322f;
constexpr float THR = 8.f;
constexpr int SHM_V = KVBLK * 128 * 2, SHM_K = KVBLK * 192 * 2;
#ifndef ATT_SDEPTH
#define ATT_SDEPTH 1
#endif
constexpr int SDEPTH = ATT_SDEPTH;
#define KSWZ(row, colB) ((row) * 384 + ((colB) ^ (((row) & 7) << 4)))
#define SBAR() __builtin_amdgcn_sched_barrier(0)
__device__ __forceinline__ int crow(int r, int hi) { return (r & 3) + 8 * (r >> 2) + 4 * hi; }
__device__ __forceinline__ unsigned cvtpk(float lo, float hi) { return cvt_pk_bf16(lo, hi); }
template <bool FIRST>
__device__ __forceinline__ void partialSM(f32x16& p0, f32x16& p1, float& m_reg, float& alpha) {
  constexpr float THR2 = THR * 1.4426950408889634f;
  float pmax = p0[0];
#pragma unroll
  for (int r = 1; r < 16; ++r) pmax = fmaxf(pmax, p0[r]);
#pragma unroll
  for (int r = 0; r < 16; ++r) pmax = fmaxf(pmax, p1[r]);
  { auto rr = __builtin_amdgcn_permlane32_swap(__float_as_uint(pmax), __float_as_uint(pmax), false, false);
    pmax = fmaxf(__uint_as_float(rr[0]), __uint_as_float(rr[1])); }
  if (!FIRST && __builtin_expect(__all(pmax <= THR2), 1)) { alpha = 1.f; }
  else { const float d = FIRST ? pmax : fmaxf(pmax, 0.f); alpha = FIRST ? 1.f : __builtin_amdgcn_exp2f(-d); m_reg += d;
#pragma unroll
    for (int r = 0; r < 16; ++r) p0[r] -= d;
#pragma unroll
    for (int r = 0; r < 16; ++r) p1[r] -= d; }
#pragma unroll
  for (int r = 0; r < 16; ++r) p0[r] = __builtin_amdgcn_exp2f(p0[r]);
}
__device__ __forceinline__ void finishSM(f32x16& p0, f32x16& p1, float alpha, float& l_reg, bf16x8& pa0, bf16x8& pa1, bf16x8& pa2, bf16x8& pa3) {
#pragma unroll
  for (int r = 0; r < 16; ++r) p1[r] = __builtin_amdgcn_exp2f(p1[r]);
  float ps = 0;
#pragma unroll
  for (int r = 0; r < 16; ++r) ps += p0[r];
#pragma unroll
  for (int r = 0; r < 16; ++r) ps += p1[r];
  { auto rr = __builtin_amdgcn_permlane32_swap(__float_as_uint(ps), __float_as_uint(ps), false, false);
    ps = __uint_as_float(rr[0]) + __uint_as_float(rr[1]); }
  l_reg = l_reg * alpha + ps;
#define PK4(P, BASE, OUT) do { unsigned a0 = cvtpk(P[BASE + 0], P[BASE + 1]), a1 = cvtpk(P[BASE + 2], P[BASE + 3]);   \
    unsigned b0 = cvtpk(P[BASE + 4], P[BASE + 5]), b1 = cvtpk(P[BASE + 6], P[BASE + 7]);                              \
    auto r0 = __builtin_amdgcn_permlane32_swap(a0, b0, false, false); auto r1 = __builtin_amdgcn_permlane32_swap(a1, b1, false, false); \
    u32x4 w = {r0[0], r1[0], r0[1], r1[1]}; OUT = __builtin_bit_cast(bf16x8, w); } while (0)
  PK4(p0, 0, pa0); PK4(p0, 8, pa1); PK4(p1, 0, pa2); PK4(p1, 8, pa3);
#undef PK4
}
__device__ __forceinline__ void qkt(f32x16& p0, f32x16& p1, const char* Ks, const bf16x8* qr, const char* qL, int r32, int hi, float negm) {
#pragma unroll
  for (int r = 0; r < 16; ++r) { p0[r] = negm; p1[r] = negm; }
#pragma unroll
  for (int d0 = 0; d0 < 12; ++d0) { int cb = (d0 * 16 + hi * 8) * 2;
    bf16x8 b0 = *reinterpret_cast<const bf16x8*>(Ks + KSWZ(r32, cb));
    bf16x8 b1 = *reinterpret_cast<const bf16x8*>(Ks + KSWZ(32 + r32, cb));
    const bf16x8 q = d0 < 8 ? qr[d0 < 8 ? d0 : 0] : *reinterpret_cast<const bf16x8*>(qL + (d0 - 8) * 1024);
    p0 = __builtin_amdgcn_mfma_f32_32x32x16_bf16(b0, q, p0, 0, 0, 0);
    p1 = __builtin_amdgcn_mfma_f32_32x32x16_bf16(b1, q, p1, 0, 0, 0); }
}
__device__ __forceinline__ int v_st(int k, int c) { const int kk = (k & ~0xC) | ((k & 4) << 1) | ((k & 8) >> 1); return ((kk >> 3) * 4 + (c >> 5)) * 512 + ((kk & 7) * 32 + (c & 31)) * 2; }
__device__ __forceinline__ int v_rd_base(int lane) { return ((lane & 3) << 3) | (((lane >> 2) & 3) << 6) | (((lane >> 4) & 1) << 5) | (((lane >> 5) & 1) << 8); }
constexpr int v_rd_off(int d0, int ks, int half) { return d0 * 512 + ks * 4096 + half * 2048; }
template <int OFF> __device__ __forceinline__ s16x4 tr_read(int vb) {
  s16x4 r; asm volatile("ds_read_b64_tr_b16 %0, %1 offset:%2" : "=&v"(r) : "v"(vb), "i"(OFF) : "memory"); return r;
}
template <int D0> __device__ __forceinline__ void pv_one(f32x16& od, int vb, bf16x8 pa0, bf16x8 pa1, bf16x8 pa2, bf16x8 pa3) {
  const s16x4 l0 = tr_read<v_rd_off(D0, 0, 0)>(vb), h0 = tr_read<v_rd_off(D0, 0, 1)>(vb), l1 = tr_read<v_rd_off(D0, 1, 0)>(vb), h1 = tr_read<v_rd_off(D0, 1, 1)>(vb);
  const s16x4 l2 = tr_read<v_rd_off(D0, 2, 0)>(vb), h2 = tr_read<v_rd_off(D0, 2, 1)>(vb), l3 = tr_read<v_rd_off(D0, 3, 0)>(vb), h3 = tr_read<v_rd_off(D0, 3, 1)>(vb);
  asm volatile("s_waitcnt lgkmcnt(0)" ::: "memory"); SBAR();
#define PK(L, H) (bf16x8){L[0], L[1], L[2], L[3], H[0], H[1], H[2], H[3]}
  od = __builtin_amdgcn_mfma_f32_32x32x16_bf16(pa0, PK(l0, h0), od, 0, 0, 0);
  od = __builtin_amdgcn_mfma_f32_32x32x16_bf16(pa1, PK(l1, h1), od, 0, 0, 0);
  od = __builtin_amdgcn_mfma_f32_32x32x16_bf16(pa2, PK(l2, h2), od, 0, 0, 0);
  od = __builtin_amdgcn_mfma_f32_32x32x16_bf16(pa3, PK(l3, h3), od, 0, 0, 0);
#undef PK
}
__device__ __forceinline__ void pv_d0(f32x16* o, int vb, bf16x8 pa0, bf16x8 pa1, bf16x8 pa2, bf16x8 pa3) {
  pv_one<0>(o[0], vb, pa0, pa1, pa2, pa3); pv_one<1>(o[1], vb, pa0, pa1, pa2, pa3); pv_one<2>(o[2], vb, pa0, pa1, pa2, pa3); pv_one<3>(o[3], vb, pa0, pa1, pa2, pa3);
}
__device__ __forceinline__ void attn_unit(const bf16_t* __restrict__ Qb, const bf16_t* __restrict__ Kn, const bf16_t* __restrict__ Kr, const bf16_t* __restrict__ Vh,
                                          bf16_t* __restrict__ Ob, char* lds) {
  const int tid = opaque_tid(), wid = tid >> 6, lane = tid & 63, r32 = lane & 31, hi = lane >> 5;
  char* V_lds = lds; char* K_lds = lds + 2 * SHM_V;
  float* ws = (float*)(lds + 2 * SHM_V + 2 * SHM_K) + wid * 64; float* li_l = ws; float* al_l = ws + 32;
  float m_reg = 0.f, l_reg = 0; f32x16 o[4] = {}; bf16x8 qr[8];
  char* qL = lds + 2 * SHM_V + 2 * SHM_K + 2048 + wid * 4096 + lane * 16;
  const bf16_t* Qw = Qb + (long)(wid * 32 + r32) * 192 + hi * 8;
#pragma unroll
  for (int d0 = 0; d0 < 8; ++d0) qr[d0] = *reinterpret_cast<const bf16x8*>(Qw + d0 * 16);
#pragma unroll
  for (int d0 = 8; d0 < 12; ++d0) *reinterpret_cast<bf16x8*>(qL + (d0 - 8) * 1024) = *reinterpret_cast<const bf16x8*>(Qw + d0 * 16);
  const int sr = tid >> 4, sc = (tid & 15) * 8, vst0 = v_st(sr, sc), vst1 = v_st(32 + sr, sc);
  const int rr = tid >> 3, rc = (tid & 7) * 8;
  const int kst0 = KSWZ(sr, sc * 2), kst1 = KSWZ(32 + sr, sc * 2), kst2 = KSWZ(rr, 256 + rc * 2);
  const int vb0 = (int)(uintptr_t)V_lds + v_rd_base(lane);
  struct { bf16x8 vs0, vs1, ks0, ks1, ks2; } sr_[SDEPTH];
#define SLOAD(i, k0) do { sr_[i].vs0 = *(const bf16x8*)(&Vh[(long)((k0) + sr) * 128 + sc]); sr_[i].vs1 = *(const bf16x8*)(&Vh[(long)((k0) + 32 + sr) * 128 + sc]); \
    sr_[i].ks0 = *(const bf16x8*)(&Kn[(long)((k0) + sr) * 128 + sc]); sr_[i].ks1 = *(const bf16x8*)(&Kn[(long)((k0) + 32 + sr) * 128 + sc]); \
    sr_[i].ks2 = *(const bf16x8*)(&Kr[(long)((k0) + rr) * 64 + rc]); } while (0)
#define SWRITE(b, i) do { *(bf16x8*)(V_lds + (b) * SHM_V + vst0) = sr_[i].vs0; *(bf16x8*)(V_lds + (b) * SHM_V + vst1) = sr_[i].vs1; \
    *(bf16x8*)(K_lds + (b) * SHM_K + kst0) = sr_[i].ks0; *(bf16x8*)(K_lds + (b) * SHM_K + kst1) = sr_[i].ks1; *(bf16x8*)(K_lds + (b) * SHM_K + kst2) = sr_[i].ks2; } while (0)
#define SWAIT() do { if constexpr (SDEPTH == 2) asm volatile("s_waitcnt vmcnt(5)" ::: "memory"); else asm volatile("s_waitcnt vmcnt(0)" ::: "memory"); } while (0)
#define RESC(a) do { if (__any((a) < 1.f)) { if (hi == 0) al_l[r32] = (a); asm volatile("s_waitcnt lgkmcnt(0)" ::: "memory"); \
    _Pragma("unroll") for (int d = 0; d < 4; ++d) _Pragma("unroll") for (int r = 0; r < 16; ++r) o[d][r] *= al_l[crow(r, hi)]; } } while (0)
  f32x16 pA0, pA1, pB0, pB1; float alA, alB; bf16x8 pa0, pa1, pa2, pa3; const int NT = T / KVBLK;
  constexpr int SE = 0, SO = SDEPTH - 1;
  SLOAD(SE, 0); asm volatile("s_waitcnt vmcnt(0)" ::: "memory"); SWRITE(0, SE); __syncthreads();
  qkt(pA0, pA1, K_lds, qr, qL, r32, hi, 0.f); partialSM<true>(pA0, pA1, m_reg, alA);
  SLOAD(SO, KVBLK); if constexpr (SDEPTH == 2) { if (2 < NT) SLOAD(SE, 2 * KVBLK); }
  SWAIT(); SWRITE(1, SO); __syncthreads();
  for (int j = 1; j + 1 < NT; j += 2) {
    SBAR(); qkt(pB0, pB1, K_lds + SHM_K, qr, qL, r32, hi, -m_reg);
    finishSM(pA0, pA1, alA, l_reg, pa0, pa1, pa2, pa3); SBAR();
    SLOAD(SO, (j + SDEPTH) * KVBLK); SBAR();
    pv_d0(o, vb0, pa0, pa1, pa2, pa3); partialSM<false>(pB0, pB1, m_reg, alB);
    __syncthreads(); SWAIT(); SWRITE(0, SE);
    RESC(alB); __syncthreads();
    SBAR(); qkt(pA0, pA1, K_lds, qr, qL, r32, hi, -m_reg);
    finishSM(pB0, pB1, alB, l_reg, pa0, pa1, pa2, pa3); SBAR();
    if (SDEPTH == 1 || j + 3 < NT) SLOAD(SE, (j + 1 + SDEPTH) * KVBLK); SBAR();
    pv_d0(o, vb0 + (int)SHM_V, pa0, pa1, pa2, pa3); partialSM<false>(pA0, pA1, m_reg, alA);
    __syncthreads(); SWAIT(); SWRITE(1, SO);
    RESC(alA); __syncthreads();
  }
  SBAR(); qkt(pB0, pB1, K_lds + SHM_K, qr, qL, r32, hi, -m_reg);
  finishSM(pA0, pA1, alA, l_reg, pa0, pa1, pa2, pa3); SBAR();
  pv_d0(o, vb0, pa0, pa1, pa2, pa3); partialSM<false>(pB0, pB1, m_reg, alB);
  __syncthreads(); RESC(alB);
  finishSM(pB0, pB1, alB, l_reg, pa0, pa1, pa2, pa3); SBAR();
  pv_d0(o, vb0 + (int)SHM_V, pa0, pa1, pa2, pa3);
  if (hi == 0) li_l[r32] = l_reg; asm volatile("s_waitcnt lgkmcnt(0)" ::: "memory");
  float rli[16];
#pragma unroll
  for (int r = 0; r < 16; ++r) rli[r] = __builtin_amdgcn_rcpf(li_l[crow(r, hi)]);
  bf16_t* Ow = Ob + (long)(wid * 32) * DM;
#pragma unroll
  for (int r = 0; r < 16; ++r) { int orow = crow(r, hi);
#pragma unroll
    for (int d0 = 0; d0 < 4; ++d0) Ow[(long)orow * DM + d0 * 32 + r32] = (bf16_t)f2bf(o[d0][r] * rli[r]); }
#undef SLOAD
#undef SWRITE
#undef SWAIT
#undef RESC
  __syncthreads();
}
}
namespace scan {
constexpr int LDT = 72;
constexpr int SC_G = 0, SC_K = 33792, SC_QT = SC_K + 17408, SC_QG = SC_QT + 17408, SC_VT = SC_QG + 17408, SC_P = SC_VT + 18432, SC_SEG = SC_P + 9216, SC_RSQ = SC_SEG + 4096,
              SC_END = SC_RSQ + 2048, SC_KDT = SC_QT;
static_assert(SC_END <= LDS_BYTES, "scan LDS");

template <int TYPE> struct Cfg { static constexpr int DK = TYPE ? 128 : 64, LDG = DK + 4, LDK_ = DK + 8, ND8 = DK / 8; };

struct LgRaw { bf16x8 a0, a1, k; };
template <int TYPE>
__device__ __forceinline__ LgRaw lg_issue(const bf16_t* u, int h, int dir, size_t tok0, int tid) {
    LgRaw r;
    if constexpr (TYPE == 1) {
        const int i0 = tid >> 4, d8 = tid & 15, col = (dir ? C_HFB : C_HFF) + h * 128 + d8 * 8;
        r.a0 = *(const bf16x8*)(u + (tok0 + i0) * DINP + col); r.a1 = *(const bf16x8*)(u + (tok0 + 32 + i0) * DINP + col); r.k = r.a0;
    } else {
        const int i = tid >> 3, d8 = tid & 7; const bf16_t* ur = u + (tok0 + i) * DINP;
        r.a0 = *(const bf16x8*)(ur + (dir ? C_GAB : C_GAF)); r.a1 = *(const bf16x8*)(ur + (dir ? C_GAB : C_GAF) + 8); r.k = *(const bf16x8*)(ur + C_GK + h * 64 + d8 * 8);
    }
    return r;
}
template <int TYPE>
__device__ __forceinline__ void lg_compute(const KArgs& a, unsigned char* wsb, int l, int h, int dir, const LgRaw& raw, LAS unsigned char* lds, int tid) {
    using C = Cfg<TYPE>;
    LAS float* G = (LAS float*)(lds + SC_G); LAS bf16_t* Kb = (LAS bf16_t*)(lds + SC_K);
    if constexpr (TYPE == 1) {
        const float* lbp = (const float*)(wsb + WS_LB) + (dir * DEPTH + l) * 512 + h * 128;
        const int d8 = tid & 15;
        const f32x4 lb0 = *(const f32x4*)(lbp + d8 * 8), lb1 = *(const f32x4*)(lbp + d8 * 8 + 4);
        const float lb[8] = {lb0[0], lb0[1], lb0[2], lb0[3], lb1[0], lb1[1], lb1[2], lb1[3]};
#pragma unroll
        for (int e2 = 0; e2 < 2; ++e2) { const int i = (tid >> 4) + 32 * e2;
            float z[8], lg[8], kk[8]; unpack8(e2 ? raw.a1 : raw.a0, z);
#pragma unroll
            for (int e = 0; e < 8; ++e) { const float sg = sigmoid_(fmaxf(z[e], -80.f)); lg[e] = __logf(lb[e] + (1.f - lb[e]) * sg); kk[e] = (1.f - lb[e]) * (1.f - sg); }
            *(LAS f32x4*)(G + i * C::LDG + d8 * 8) = (f32x4){lg[0], lg[1], lg[2], lg[3]}; *(LAS f32x4*)(G + i * C::LDG + d8 * 8 + 4) = (f32x4){lg[4], lg[5], lg[6], lg[7]};
            *(LAS bf16x8*)(Kb + i * C::LDK_ + d8 * 8) = pack8(kk); }
    } else {
        const int i = tid >> 3, d8 = tid & 7;
        float ua[16]; unpack8(raw.a0, ua); unpack8(raw.a1, ua + 8);
        const float* up = (const float*)a.in[3] + (size_t)((l * 2 + dir) * 16) * 256 + h * 64 + d8 * 8;
        const float* bs = (const float*)a.in[4] + (l * 2 + dir) * 256 + h * 64 + d8 * 8;
        f32x4 z0 = *(const f32x4*)bs, z1 = *(const f32x4*)(bs + 4);
#pragma unroll
        for (int r = 0; r < 16; ++r) { z0 += ua[r] * *(const f32x4*)(up + r * 256); z1 += ua[r] * *(const f32x4*)(up + r * 256 + 4); }
        f32x4 g0, g1;
#pragma unroll
        for (int e = 0; e < 4; ++e) { g0[e] = logsigmoid_(z0[e]) * (1.f / 16.f); g1[e] = logsigmoid_(z1[e]) * (1.f / 16.f); }
        *(LAS f32x4*)(G + i * C::LDG + d8 * 8) = g0; *(LAS f32x4*)(G + i * C::LDG + d8 * 8 + 4) = g1;
        *(LAS bf16x8*)(Kb + i * C::LDK_ + d8 * 8) = raw.k;
    }
}
template <int TYPE>
__device__ __forceinline__ void cumsum_g(int dir, LAS unsigned char* lds, int tid) {
    using C = Cfg<TYPE>; constexpr int NSEG = 512 / C::DK, SEGL = 64 / NSEG;
    LAS float* G = (LAS float*)(lds + SC_G); LAS float* SG = (LAS float*)(lds + SC_SEG);
    const int d = tid % C::DK, seg = tid / C::DK;
    __syncthreads();
    float run = 0.f;
#pragma unroll
    for (int ii = 0; ii < SEGL; ++ii) { const int i = seg * SEGL + (dir ? SEGL - 1 - ii : ii); run += G[i * C::LDG + d]; G[i * C::LDG + d] = run; }
    SG[seg * 128 + d] = run;
    __syncthreads();
    float off = 0.f;
#pragma unroll
    for (int s = 0; s < NSEG; ++s) { const bool before = dir ? (s > seg) : (s < seg); if (before) off += SG[s * 128 + d]; }
#pragma unroll
    for (int ii = 0; ii < SEGL; ++ii) { const int i = seg * SEGL + ii; G[i * C::LDG + d] += off; }
    __syncthreads();
}
struct VRaw { bf16x8 x0, x1; };
__device__ __forceinline__ VRaw vT_issue(const bf16_t* vsrc, int tid) {
    const int i0 = tid >> 4, v8 = tid & 15; VRaw r;
    r.x0 = *(const bf16x8*)(vsrc + (size_t)i0 * DINP + v8 * 8); r.x1 = *(const bf16x8*)(vsrc + (size_t)(32 + i0) * DINP + v8 * 8); return r;
}
__device__ __forceinline__ void vT_write(const VRaw& r, LAS unsigned char* lds, int tid) {
    LAS bf16_t* VT = (LAS bf16_t*)(lds + SC_VT);
    const int v8 = tid & 15;
#pragma unroll
    for (int e2 = 0; e2 < 2; ++e2) { const int i = (tid >> 4) + 32 * e2; const bf16x8 x = e2 ? r.x1 : r.x0; const int pc = ((((i >> 3) ^ (v8 & 7)) << 3) | (i & 7));
#pragma unroll
        for (int e = 0; e < 8; ++e) VT[(v8 * 8 + e) * LDT + pc] = (bf16_t)x[e]; }
}
__device__ __forceinline__ bf16x8 vt_frag(LAS bf16_t* VT, int v, int c8) {
    return *(LAS bf16x8*)(VT + v * LDT + ((c8 ^ ((v >> 3) & 7)) << 3));
}

template <int TYPE>
__device__ __forceinline__ void pass1_item(const KArgs& a, int l, int item, LAS unsigned char* lds) {
    unsigned char* const wsb = opq(a.ws);
    const int tid = opaque_tid();
    using C = Cfg<TYPE>; constexpr int DK = C::DK;
    const int c = item & (NCH - 1), dir = (item >> 8) & 1, h = (item >> 9) & 3, b = item >> 11;
    const size_t tok0 = (size_t)b * T + (size_t)c * 64;
    const bf16_t* u = (const bf16_t*)(wsb + WS_U);
    const int wid = tid >> 6, lane = tid & 63, fr = lane & 15, fq = lane >> 4;
    __syncthreads();
    { const LgRaw raw = lg_issue<TYPE>(u, h, dir, tok0, tid); const VRaw vr = vT_issue(u + tok0 * DINP + (TYPE ? C_HI : C_GV) + h * 128, tid);
      lg_compute<TYPE>(a, wsb, l, h, dir, raw, lds, tid); vT_write(vr, lds, tid); }
    cumsum_g<TYPE>(dir, lds, tid);
    LAS float* G = (LAS float*)(lds + SC_G); LAS bf16_t* Kb = (LAS bf16_t*)(lds + SC_K); LAS bf16_t* KDT = (LAS bf16_t*)(lds + SC_KDT); LAS bf16_t* VT = (LAS bf16_t*)(lds + SC_VT);
    const int last = dir ? 0 : 63;
    float* Dout = (float*)(wsb + (TYPE ? WS_DH : WS_DG)) + (size_t)item * DK;
#pragma unroll
    for (int e2 = 0; e2 < DK / 64; ++e2) { const int task = tid + 512 * e2, i = task & 63, d8 = task >> 6;
        const f32x4 g0 = *(LAS f32x4*)(G + i * C::LDG + d8 * 8), g1 = *(LAS f32x4*)(G + i * C::LDG + d8 * 8 + 4);
        const f32x4 t0 = *(LAS f32x4*)(G + last * C::LDG + d8 * 8), t1 = *(LAS f32x4*)(G + last * C::LDG + d8 * 8 + 4);
        float kk[8]; unpack8(*(LAS bf16x8*)(Kb + i * C::LDK_ + d8 * 8), kk);
#pragma unroll
        for (int e = 0; e < 8; ++e) { const float gg = e < 4 ? g0[e] : g1[e - 4], tt = e < 4 ? t0[e] : t1[e - 4];
            KDT[(d8 * 8 + e) * LDT + i] = (bf16_t)f2bf(kk[e] * __expf(tt - gg)); }
        if (i == 0) { *(f32x4*)(Dout + d8 * 8) = (f32x4){__expf(t0[0]), __expf(t0[1]), __expf(t0[2]), __expf(t0[3])};
                      *(f32x4*)(Dout + d8 * 8 + 4) = (f32x4){__expf(t1[0]), __expf(t1[1]), __expf(t1[2]), __expf(t1[3])}; } }
    __syncthreads();
    bf16_t* ST = (bf16_t*)(wsb + (TYPE ? WS_SH : WS_SG)) + (size_t)item * 128 * DK;
    const bf16x8 b0 = vt_frag(VT, wid * 16 + fr, fq), b1 = vt_frag(VT, wid * 16 + fr, 4 + fq);
#pragma unroll
    for (int dt = 0; dt < DK / 16; ++dt) {
        const bf16x8 a0 = *(LAS bf16x8*)(KDT + (dt * 16 + fr) * LDT + fq * 8), a1 = *(LAS bf16x8*)(KDT + (dt * 16 + fr) * LDT + 32 + fq * 8);
        f32x4 acc = {0.f, 0.f, 0.f, 0.f};
        acc = __builtin_amdgcn_mfma_f32_16x16x32_bf16(a0, b0, acc, 0, 0, 0);
        acc = __builtin_amdgcn_mfma_f32_16x16x32_bf16(a1, b1, acc, 0, 0, 0);
        u32x2 w; w.x = cvt_pk_bf16(acc[0], acc[1]); w.y = cvt_pk_bf16(acc[2], acc[3]);
        *(u32x2*)(ST + (size_t)(wid * 16 + fr) * DK + dt * 16 + fq * 4) = w;
    }
}

struct P2Chain { bf16_t* st; const float* dp; size_t sstride; int dstride; int dir; };
__device__ __forceinline__ P2Chain p2_chain(unsigned char* wsb, int type, int E) {
    const int DK = type ? 128 : 64, IPI = 128 * DK;
    const int chain = E / IPI, e = E % IPI;
    P2Chain c; c.st = (bf16_t*)(wsb + (type ? WS_SH : WS_SG)) + (size_t)chain * NCH * IPI + e;
    c.dp = (const float*)(wsb + (type ? WS_DH : WS_DG)) + (size_t)chain * NCH * DK + (e % DK);
    c.sstride = (size_t)IPI; c.dstride = DK; c.dir = chain & 1; return c;
}
__device__ __forceinline__ void pass2_triple(const KArgs& a, int t) {
    unsigned char* const wsb = opq(a.ws);
    const P2Chain c0 = p2_chain(wsb, 1, t), c1 = p2_chain(wsb, 1, t + 131072), c2 = p2_chain(wsb, 0, t);
    float s0 = 0.f, s1 = 0.f, s2 = 0.f;
    unsigned short uA[3][4], uB[3][4]; float dA[3][4], dB[3][4];
#define P2_CI(c, s) ((c).dir ? NCH - 1 - (s) : (s))
#define P2_LOAD(U, D, sb) do { _Pragma("unroll") for (int k = 0; k < 4; ++k) { \
        const int i0_ = P2_CI(c0, (sb) + k), i1_ = P2_CI(c1, (sb) + k), i2_ = P2_CI(c2, (sb) + k); \
        U[0][k] = c0.st[(size_t)i0_ * c0.sstride]; D[0][k] = c0.dp[(size_t)i0_ * c0.dstride]; \
        U[1][k] = c1.st[(size_t)i1_ * c1.sstride]; D[1][k] = c1.dp[(size_t)i1_ * c1.dstride]; \
        U[2][k] = c2.st[(size_t)i2_ * c2.sstride]; D[2][k] = c2.dp[(size_t)i2_ * c2.dstride]; } } while (0)
#define P2_STEP(U, D, sb) do { _Pragma("unroll") for (int k = 0; k < 4; ++k) { \
        const int i0_ = P2_CI(c0, (sb) + k), i1_ = P2_CI(c1, (sb) + k), i2_ = P2_CI(c2, (sb) + k); \
        c0.st[(size_t)i0_ * c0.sstride] = (bf16_t)f2bf(s0); s0 = D[0][k] * s0 + bf2f(U[0][k]); \
        c1.st[(size_t)i1_ * c1.sstride] = (bf16_t)f2bf(s1); s1 = D[1][k] * s1 + bf2f(U[1][k]); \
        c2.st[(size_t)i2_ * c2.sstride] = (bf16_t)f2bf(s2); s2 = D[2][k] * s2 + bf2f(U[2][k]); } } while (0)
    P2_LOAD(uA, dA, 0);
#pragma unroll 1
    for (int sb = 0; sb < NCH; sb += 8) {
        P2_LOAD(uB, dB, sb + 4);
        P2_STEP(uA, dA, sb);
        if (sb + 8 < NCH) P2_LOAD(uA, dA, sb + 8);
        P2_STEP(uB, dB, sb + 4);
    }
#undef P2_CI
#undef P2_LOAD
#undef P2_STEP
}

template <int TYPE>
__device__ __forceinline__ void pass3_item(const KArgs& a, int l, int item, LAS unsigned char* lds) {
    unsigned char* const wsb = opq(a.ws);
    const int tid = opaque_tid();
    using C = Cfg<TYPE>; constexpr int DK = C::DK;
    const int c = item & (NCH - 1), h = (item >> 8) & 3, b = item >> 10;
    const size_t tok0 = (size_t)b * T + (size_t)c * 64;
    const bf16_t* u = (const bf16_t*)(wsb + WS_U);
    const int wid = tid >> 6, lane = tid & 63, fr = lane & 15, fq = lane >> 4;
    LAS float* G = (LAS float*)(lds + SC_G); LAS bf16_t* Kb = (LAS bf16_t*)(lds + SC_K); LAS bf16_t* QT = (LAS bf16_t*)(lds + SC_QT); LAS bf16_t* QG = (LAS bf16_t*)(lds + SC_QG);
    LAS bf16_t* VT = (LAS bf16_t*)(lds + SC_VT); LAS bf16_t* P = (LAS bf16_t*)(lds + SC_P); LAS float* RSQ = (LAS float*)(lds + SC_RSQ);
    const VRaw vr = vT_issue(u + tok0 * DINP + (TYPE ? C_HI : C_GV) + h * 128, tid);
    bf16x8 qraw[DK / 64];
#pragma unroll
    for (int e2 = 0; e2 < DK / 64; ++e2) { const int task = tid + 512 * e2, i = task / C::ND8, d8 = task % C::ND8;
        qraw[e2] = *(const bf16x8*)(u + (tok0 + i) * DINP + (TYPE ? C_HQ + h * 128 : C_GQ + h * 64) + d8 * 8); }
    const LgRaw raw0 = lg_issue<TYPE>(u, h, 0, tok0, tid), raw1 = lg_issue<TYPE>(u, h, 1, tok0, tid);
    __syncthreads();
    vT_write(vr, lds, tid);
    float qf[DK / 64][8];
#pragma unroll
    for (int e2 = 0; e2 < DK / 64; ++e2) { unpack8(qraw[e2], qf[e2]);
#pragma unroll
        for (int e = 0; e < 8; ++e) qf[e2][e] = TYPE ? silu_(qf[e2][e]) : qf[e2][e] * 0.125f; }
    f32x4 o[4];
#pragma unroll
    for (int it = 0; it < 4; ++it) o[it] = (f32x4){0.f, 0.f, 0.f, 0.f};
#pragma unroll 1
    for (int dir = 0; dir < 2; ++dir) {
        const int sitem = ((b * 4 + h) * 2 + dir) * NCH + c;
        const bf16_t* ST = (const bf16_t*)(wsb + (TYPE ? WS_SH : WS_SG)) + (size_t)sitem * 128 * DK + (size_t)(wid * 16 + fr) * DK + fq * 8;
        bf16x8 sf[DK / 32];
#pragma unroll
        for (int ks = 0; ks < DK / 32; ++ks) sf[ks] = *(const bf16x8*)(ST + ks * 32);
        if (dir) __syncthreads();
        { LgRaw rw; rw.a0 = dir ? raw1.a0 : raw0.a0; rw.a1 = dir ? raw1.a1 : raw0.a1; rw.k = dir ? raw1.k : raw0.k; lg_compute<TYPE>(a, wsb, l, h, dir, rw, lds, tid); }
        cumsum_g<TYPE>(dir, lds, tid);
#pragma unroll
        for (int e2 = 0; e2 < DK / 64; ++e2) { const int task = tid + 512 * e2, i = task / C::ND8, d8 = task % C::ND8;
            const f32x4 g0 = *(LAS f32x4*)(G + i * C::LDG + d8 * 8), g1 = *(LAS f32x4*)(G + i * C::LDG + d8 * 8 + 4);
            const f32x4 m0 = *(LAS f32x4*)(G + 32 * C::LDG + d8 * 8), m1 = *(LAS f32x4*)(G + 32 * C::LDG + d8 * 8 + 4);
            float kk[8], qq[8], qt[8], qg[8]; unpack8(*(LAS bf16x8*)(Kb + i * C::LDK_ + d8 * 8), kk);
#pragma unroll
            for (int e = 0; e < 8; ++e) qq[e] = qf[e2][e];
#pragma unroll
            for (int e = 0; e < 8; ++e) { const float gg = e < 4 ? g0[e] : g1[e - 4], gm = e < 4 ? m0[e] : m1[e - 4];
                const float q = qq[e];
                qt[e] = q * __expf(gg - gm); qg[e] = q * __expf(gg); kk[e] = kk[e] * __expf(gm - gg); }
            *(LAS bf16x8*)(QT + i * C::LDK_ + d8 * 8) = pack8(qt); *(LAS bf16x8*)(QG + i * C::LDK_ + d8 * 8) = pack8(qg); *(LAS bf16x8*)(Kb + i * C::LDK_ + d8 * 8) = pack8(kk); }
        __syncthreads();
        { const int it = wid >> 1;
#pragma unroll
          for (int jj = 0; jj < 2; ++jj) { const int jt = 2 * (wid & 1) + jj;
            f32x4 acc = {0.f, 0.f, 0.f, 0.f};
#pragma unroll
            for (int ks = 0; ks < DK / 32; ++ks) {
                const bf16x8 af = *(LAS bf16x8*)(QT + (it * 16 + fr) * C::LDK_ + ks * 32 + fq * 8), bfr = *(LAS bf16x8*)(Kb + (jt * 16 + fr) * C::LDK_ + ks * 32 + fq * 8);
                acc = __builtin_amdgcn_mfma_f32_16x16x32_bf16(af, bfr, acc, 0, 0, 0); }
#pragma unroll
            for (int r = 0; r < 4; ++r) { const int i = it * 16 + fq * 4 + r, j = jt * 16 + fr; const bool keep = dir ? (j >= i) : (j <= i);
                P[i * LDT + j] = (bf16_t)f2bf(keep ? acc[r] : 0.f); } } }
        __syncthreads();
        const bf16x8 vb0 = vt_frag(VT, wid * 16 + fr, fq), vb1 = vt_frag(VT, wid * 16 + fr, 4 + fq);
#pragma unroll
        for (int it = 0; it < 4; ++it) {
            const bf16x8 p0 = *(LAS bf16x8*)(P + (it * 16 + fr) * LDT + fq * 8), p1 = *(LAS bf16x8*)(P + (it * 16 + fr) * LDT + 32 + fq * 8);
            o[it] = __builtin_amdgcn_mfma_f32_16x16x32_bf16(p0, vb0, o[it], 0, 0, 0);
            o[it] = __builtin_amdgcn_mfma_f32_16x16x32_bf16(p1, vb1, o[it], 0, 0, 0);
#pragma unroll
            for (int ks = 0; ks < DK / 32; ++ks) { const bf16x8 af = *(LAS bf16x8*)(QG + (it * 16 + fr) * C::LDK_ + ks * 32 + fq * 8);
                o[it] = __builtin_amdgcn_mfma_f32_16x16x32_bf16(af, sf[ks], o[it], 0, 0, 0); }
        }
    }
#pragma unroll
    for (int it = 0; it < 4; ++it)
#pragma unroll
        for (int r = 0; r < 4; ++r) { float s = o[it][r] * o[it][r];
            s += __builtin_bit_cast(float, __builtin_amdgcn_update_dpp(0, __builtin_bit_cast(int, s), 0xB1, 0xF, 0xF, true));
            s += __builtin_bit_cast(float, __builtin_amdgcn_update_dpp(0, __builtin_bit_cast(int, s), 0x4E, 0xF, 0xF, true));
            s += __builtin_bit_cast(float, __builtin_amdgcn_update_dpp(0, __builtin_bit_cast(int, s), 0x141, 0xF, 0xF, true));
            s += __builtin_bit_cast(float, __builtin_amdgcn_update_dpp(0, __builtin_bit_cast(int, s), 0x140, 0xF, 0xF, true));
            RSQ[wid * 64 + it * 16 + fq * 4 + r] = s; }
    __syncthreads();
    LAS float* RSTD = (LAS float*)(lds + SC_SEG);
    if (tid < 64) { float s = 0.f;
#pragma unroll
        for (int w = 0; w < 8; ++w) s += RSQ[w * 64 + tid];
        RSTD[tid] = rsqrtf(s * (1.f / 128.f) + EPS); }
    __syncthreads();
    const float gain = ((const float*)a.in[TYPE ? 7 : 5])[l * 128 + wid * 16 + fr];
    bf16_t* mix = (bf16_t*)(wsb + WS_XN);
    float gtv[4][4];
#pragma unroll
    for (int it = 0; it < 4; ++it)
#pragma unroll
        for (int r = 0; r < 4; ++r) gtv[it][r] = bf2f(u[(tok0 + it * 16 + fq * 4 + r) * DINP + (TYPE ? C_HG : C_GG) + h * 128 + wid * 16 + fr]);
#pragma unroll
    for (int it = 0; it < 4; ++it)
#pragma unroll
        for (int r = 0; r < 4; ++r) { const int i = it * 16 + fq * 4 + r;
            const float rstd = RSTD[i];
            const float gt = gtv[it][r];
            const float yv = o[it][r] * rstd * gain * silu_(gt);
            mix[(tok0 + i) * DM + (TYPE ? 512 : 0) + h * 128 + wid * 16 + fr] = (bf16_t)f2bf(yv); }
}
}
__device__ __forceinline__ void rmsnorm_rows_bf16(const float* src, const float* gain, bf16_t* dst) {
    const int tid = opaque_tid(), lane = tid & 63, gw = blockIdx.x * 8 + (tid >> 6), ngw = gridDim.x * 8;
    for (int m = gw; m < M; m += ngw) {
        const f32x4* xr = (const f32x4*)(src + (size_t)m * DM) + lane;
        f32x4 v[8]; float s = 0.f;
#pragma unroll
        for (int j = 0; j < 8; ++j) { v[j] = xr[64 * j]; s += (v[j][0] * v[j][0] + v[j][1] * v[j][1]) + (v[j][2] * v[j][2] + v[j][3] * v[j][3]); }
        const float rstd = rsqrtf(wave_sum(s) * (1.f / DM) + EPS);
        u32x2* o8 = (u32x2*)(dst + (size_t)m * DM) + lane;
#pragma unroll
        for (int j = 0; j < 8; ++j) { const f32x4 g = ((const f32x4*)gain)[lane + 64 * j];
            u32x2 w; w.x = cvt_pk_bf16(v[j][0] * rstd * g[0], v[j][1] * rstd * g[1]); w.y = cvt_pk_bf16(v[j][2] * rstd * g[2], v[j][3] * rstd * g[3]); o8[64 * j] = w; }
    }
}
__device__ __forceinline__ void cast_rows_bf16(const float* src, bf16_t* dst, float* rsq) {
    const int tid = opaque_tid(), lane = tid & 63, gw = blockIdx.x * 8 + (tid >> 6), ngw = gridDim.x * 8;
    for (int m = gw; m < M; m += ngw) {
        const f32x4* xr = (const f32x4*)(src + (size_t)m * DM) + lane;
        f32x4 v[8]; float s = 0.f;
#pragma unroll
        for (int j = 0; j < 8; ++j) { v[j] = xr[64 * j]; s += (v[j][0] * v[j][0] + v[j][1] * v[j][1]) + (v[j][2] * v[j][2] + v[j][3] * v[j][3]); }
        s = wave_sum(s);
        if (lane == 0) rsq[m] = s;
        u32x2* o8 = (u32x2*)(dst + (size_t)m * DM) + lane;
#pragma unroll
        for (int j = 0; j < 8; ++j) { u32x2 w; w.x = cvt_pk_bf16(v[j][0], v[j][1]); w.y = cvt_pk_bf16(v[j][2], v[j][3]); o8[64 * j] = w; }
    }
}
__device__ __forceinline__ void rmsnorm_rows_f32_inplace(float* buf, const float* gain) {
    const int tid = opaque_tid(), lane = tid & 63, gw = blockIdx.x * 8 + (tid >> 6), ngw = gridDim.x * 8;
    for (int m = gw; m < M; m += ngw) {
        f32x4* xr = (f32x4*)(buf + (size_t)m * DM) + lane;
        f32x4 v[8]; float s = 0.f;
#pragma unroll
        for (int j = 0; j < 8; ++j) { v[j] = xr[64 * j]; s += (v[j][0] * v[j][0] + v[j][1] * v[j][1]) + (v[j][2] * v[j][2] + v[j][3] * v[j][3]); }
        const float rstd = rsqrtf(wave_sum(s) * (1.f / DM) + EPS);
#pragma unroll
        for (int j = 0; j < 8; ++j) { const f32x4 g = ((const f32x4*)gain)[lane + 64 * j]; xr[64 * j] = v[j] * rstd * g; }
    }
}
__device__ __forceinline__ void convert_weights(const KArgs& a, int l, LAS unsigned char* lds) {
    unsigned char* const wsb = opq(a.ws);
    const int tid = opaque_tid();
    LAS float* tile = (LAS float*)lds;
    constexpr int I_IN = 32 * 84, I_QB = 8 * 24, I_KVB = 8 * 32, I_OUT = 32 * 32, I_13 = 32 * 176, I_2 = 88 * 32, NIT = I_IN + I_QB + I_KVB + I_OUT + I_13 + I_2;
    for (int it = blockIdx.x; it < NIT; it += gridDim.x) {
        int r = it, mode = 0, N, K, nkt; const float* w0; const float* w1 = nullptr; const float* gk = nullptr; bf16_t* WT;
        if (r < I_IN) { w0 = (const float*)a.in[2] + (size_t)l * DM * DIN; N = DIN; K = DM; nkt = 32; gk = (const float*)a.in[13] + l * DM; WT = (bf16_t*)(wsb + WS_WIN); }
        else if ((r -= I_IN) < I_QB) { w0 = (const float*)a.in[9] + (size_t)l * 512 * 1536; N = 1536; K = 512; nkt = 8; mode = 1; WT = (bf16_t*)(wsb + WS_WQB); }
        else if ((r -= I_QB) < I_KVB) { w0 = (const float*)a.in[11] + (size_t)l * 512 * 2048; N = 2048; K = 512; nkt = 8; WT = (bf16_t*)(wsb + WS_WKVB); }
        else if ((r -= I_KVB) < I_OUT) { w0 = (const float*)a.in[12] + (size_t)l * DM * DM; N = DM; K = DM; nkt = 32; WT = (bf16_t*)(wsb + WS_WOUT); }
        else if ((r -= I_OUT) < I_13) { w0 = (const float*)a.in[15] + (size_t)l * DM * DFF; w1 = (const float*)a.in[16] + (size_t)l * DM * DFF; N = DFF; K = DM; nkt = 32; mode = 2; gk = (const float*)a.in[14] + l * DM; WT = (bf16_t*)(wsb + WS_W13); }
        else { r -= I_13; w0 = (const float*)a.in[17] + (size_t)l * DFF * DM; N = DM; K = DFF; nkt = 88; WT = (bf16_t*)(wsb + WS_W2); }
        const int kt = r % nkt, rt = r / nkt, r0 = rt * 64, k0 = kt * 64;
        __syncthreads();
        if (mode == 1) {
#pragma unroll
            for (int e = 0; e < 8; ++e) { const int idx = tid + 512 * e, rl = idx & 63, kl = idx >> 6, rr = r0 + rl, k = k0 + kl;
                const int hh = rr / 192, ee = rr % 192; const int col = ee < 128 ? hh * 192 + ee : hh * 192 + 128 + ((ee - 128) & 1) * 32 + ((ee - 128) >> 1);
                tile[kl * 65 + rl] = w0[(size_t)k * N + col]; }
        } else {
#pragma unroll
            for (int e = 0; e < 2; ++e) { const int idx = tid + 512 * e, r4 = (idx & 15) * 4, kl = idx >> 4, rr = r0 + r4, k = k0 + kl;
                f32x4 v = {0.f, 0.f, 0.f, 0.f};
                if (mode == 0) { if (rr < N) v = *(const f32x4*)(w0 + (size_t)k * N + rr); }
                else { const int g = rr >> 5, n = (rr >> 4) & 1, i = rr & 15; v = *(const f32x4*)((n ? w1 : w0) + (size_t)k * N + 16 * g + i); }
                if (gk) v = v * gk[k];
                tile[kl * 65 + r4] = v[0]; tile[kl * 65 + r4 + 1] = v[1]; tile[kl * 65 + r4 + 2] = v[2]; tile[kl * 65 + r4 + 3] = v[3]; }
        }
        __syncthreads();
        { const int k8 = tid & 7, rl = tid >> 3;
          u32x4 w; w.x = pk2(tile[(8 * k8 + 0) * 65 + rl], tile[(8 * k8 + 1) * 65 + rl]); w.y = pk2(tile[(8 * k8 + 2) * 65 + rl], tile[(8 * k8 + 3) * 65 + rl]);
          w.z = pk2(tile[(8 * k8 + 4) * 65 + rl], tile[(8 * k8 + 5) * 65 + rl]); w.w = pk2(tile[(8 * k8 + 6) * 65 + rl], tile[(8 * k8 + 7) * 65 + rl]);
          *(u32x4*)(WT + (size_t)(r0 + rl) * K + k0 + 8 * k8) = w; }
    }
    __syncthreads();
}
__device__ __forceinline__ void tables_phase(const KArgs& a) {
    unsigned char* const wsb = opq(a.ws);
    const int tid = opaque_tid();
    const int* pos = (const int*)a.in[1];
    float* cs = (float*)(wsb + WS_COS); float* sn = (float*)(wsb + WS_SIN);
    const int gt = blockIdx.x * 512 + tid, ngt = gridDim.x * 512;
    for (int idx = gt; idx < M * 32; idx += ngt) { const int tok = idx >> 5, i = idx & 31;
        const float inv = 1.0f / exp2f((float)(2 * i) * (1.f / 64.f) * 13.287712379549449f);
        const float ang = (float)pos[tok] * inv;
        double rev = (double)ang * 0.15915494309189535; rev -= rint(rev);
        const float f = (float)rev;
        cs[idx] = __builtin_amdgcn_cosf(f); sn[idx] = __builtin_amdgcn_sinf(f); }
    if (blockIdx.x == 0) { const float* lg = (const float*)a.in[6]; float* lb = (float*)(wsb + WS_LB);
        for (int p = tid; p < 2 * 512; p += 512) { const int dir = p >> 9, c = p & 511;
            float mx = -1e30f;
#pragma unroll
            for (int l = 0; l < DEPTH; ++l) mx = fmaxf(mx, lg[(dir * DEPTH + l) * 512 + c]);
            float den = 0.f;
#pragma unroll
            for (int l = 0; l < DEPTH; ++l) den += __expf(lg[(dir * DEPTH + l) * 512 + c] - mx);
            float cum = 0.f;
#pragma unroll
            for (int l = 0; l < DEPTH; ++l) { if (l > 0) cum += __expf(lg[(dir * DEPTH + l) * 512 + c] - mx) / den; lb[(dir * DEPTH + l) * 512 + c] = cum; } } }
}
__device__ __forceinline__ void mla_prep(const KArgs& a, int l) {
    unsigned char* const wsb = opq(a.ws);
    const int tid = opaque_tid(), lane = tid & 63, gw = blockIdx.x * 8 + (tid >> 6), ngw = gridDim.x * 8;
    bf16_t* u = (bf16_t*)(wsb + WS_U); bf16_t* kr = (bf16_t*)(wsb + WS_KR);
    const float* cs = (const float*)(wsb + WS_COS); const float* sn = (const float*)(wsb + WS_SIN);
    const float* gq = (const float*)a.in[8] + l * 512 + lane * 8; const float* gkv = (const float*)a.in[10] + l * 512 + lane * 8;
    const f32x4 gq0 = *(const f32x4*)gq, gq1 = *(const f32x4*)(gq + 4), gk0 = *(const f32x4*)gkv, gk1 = *(const f32x4*)(gkv + 4);
    const float gqv[8] = {gq0[0], gq0[1], gq0[2], gq0[3], gq1[0], gq1[1], gq1[2], gq1[3]}, gkv8[8] = {gk0[0], gk0[1], gk0[2], gk0[3], gk1[0], gk1[1], gk1[2], gk1[3]};
    for (int tok0 = gw; tok0 < M; tok0 += 2 * ngw) {
        bf16x8 raw[2][2]; float x1[2], x2[2], c[2], s[2]; bool ok[2];
#pragma unroll
        for (int j = 0; j < 2; ++j) { const int tok = tok0 + j * ngw; ok[j] = tok < M; const int tk = ok[j] ? tok : tok0; bf16_t* ur = u + (size_t)tk * DINP;
            raw[j][0] = *(const bf16x8*)(ur + C_CQ + lane * 8); raw[j][1] = *(const bf16x8*)(ur + C_CKV + lane * 8);
            x1[j] = bf2f(ur[C_KR + (lane & 31)]); x2[j] = bf2f(ur[C_KR + 32 + (lane & 31)]); c[j] = cs[(size_t)tk * 32 + (lane & 31)]; s[j] = sn[(size_t)tk * 32 + (lane & 31)]; }
#pragma unroll
        for (int j = 0; j < 2; ++j) { const int tok = tok0 + j * ngw; if (!ok[j]) continue; bf16_t* ur = u + (size_t)tok * DINP;
#pragma unroll
            for (int w = 0; w < 2; ++w) { float f[8]; unpack8(raw[j][w], f); float ssq = 0.f;
#pragma unroll
                for (int e = 0; e < 8; ++e) ssq += f[e] * f[e];
                const float rstd = rsqrtf(wave_sum(ssq) * (1.f / 512.f) + EPS);
#pragma unroll
                for (int e = 0; e < 8; ++e) f[e] = f[e] * rstd * (w ? gkv8[e] : gqv[e]);
                *(bf16x8*)(ur + (w ? C_CKV : C_CQ) + lane * 8) = pack8(f); }
            if (lane < 32) *(unsigned*)(kr + (size_t)tok * 64 + 2 * lane) = pk2(x1[j] * c[j] - x2[j] * s[j], x2[j] * c[j] + x1[j] * s[j]); }
    }
}

#define XB_TMO      128
#define XB_XCNT(j)  (256  + 64 * (j))
#define XB_XSUB(j)  (1280 + 64 * (j))
#define XB_XGEN(j)  (2304 + 64 * (j))
#define XB_TOP      3328
#define XB_TOPGEN   3392
#define XCD_BAR_WORDS 3456
#define XB_SPIN_CAP (1u << 18)

__device__ __forceinline__ unsigned xb_ld(unsigned* p)              { return __hip_atomic_load(p, __ATOMIC_RELAXED, __HIP_MEMORY_SCOPE_AGENT); }
__device__ __forceinline__ unsigned xb_add(unsigned* p, unsigned v) { return __hip_atomic_fetch_add(p, v, __ATOMIC_RELAXED, __HIP_MEMORY_SCOPE_AGENT); }
__device__ __forceinline__ unsigned xb_xcc_id() { return (unsigned)__builtin_amdgcn_s_getreg((3 << 11) | 20) & 0xFu; }
#define XB_SPIN(cond, bar) do { unsigned _sp = 0; while (cond) { __builtin_amdgcn_s_sleep(1); \
    if ((++_sp & 255u) == 0u) { if (xb_ld(&(bar)[XB_TMO])) break; if (_sp > XB_SPIN_CAP) { atomicAdd(&(bar)[XB_TMO], 1u); break; } } } } while (0)

struct XcdBarrier {
    unsigned* bar; unsigned x;
    volatile LAS unsigned* st;
};

__device__ __forceinline__ XcdBarrier xcd_barrier_post(unsigned* bar, volatile LAS unsigned* st) {
    XcdBarrier b; b.bar = bar; b.x = xb_xcc_id(); b.st = st;
    if (threadIdx.x == 0) (void)xb_add(&bar[XB_XCNT(b.x)], 1u);
    return b;
}
__device__ __forceinline__ void xcd_barrier_complete(unsigned* bar, unsigned x, unsigned& nloc, unsigned& nx) {
    const unsigned G = gridDim.x * gridDim.y * gridDim.z;
    unsigned sum, cnt, mine, sp = 0u;
    for (;;) {
        sum = 0u; cnt = 0u; mine = 0u;
#pragma unroll
        for (unsigned j = 0; j < 16; ++j) { const unsigned c = xb_ld(&bar[XB_XCNT(j)]); sum += c; cnt += (c > 0u) ? 1u : 0u; mine = (j == x) ? c : mine; }
        if (sum == G) break;
        __builtin_amdgcn_s_sleep(1);
        if ((++sp & 255u) == 0u) { if (xb_ld(&bar[XB_TMO])) break; if (sp > XB_SPIN_CAP) { atomicAdd(&bar[XB_TMO], 1u); break; } }
    }
    nloc = mine > 0u ? mine : 1u; nx = cnt > 0u ? cnt : 1u;
}

__device__ __forceinline__ void xcd_barrier(const XcdBarrier& b) {
    asm volatile("s_waitcnt vmcnt(0)" ::: "memory");
    __syncthreads();
    if (threadIdx.x == 0) {
        unsigned* bar = b.bar;
        __builtin_amdgcn_s_waitcnt(0);
        unsigned nloc = b.st[0], nx = b.st[1];
        if (nloc == 0u) { xcd_barrier_complete(bar, b.x, nloc, nx); b.st[0] = nloc; b.st[1] = nx; }
        const unsigned old = xb_add(&bar[XB_XSUB(b.x)], 1u);
        const unsigned gen = old / nloc;
        if (old + 1u == (gen + 1u) * nloc) {
            __builtin_amdgcn_fence(__ATOMIC_RELEASE, "agent");
            asm volatile("s_waitcnt vmcnt(0)" ::: "memory");
            const unsigned og = xb_add(&bar[XB_TOP], 1u);
            const unsigned tg = og / nx;
            if (og + 1u == (tg + 1u) * nx) xb_add(&bar[XB_TOPGEN], 1u);
            else XB_SPIN(xb_ld(&bar[XB_TOPGEN]) == tg, bar);
            __builtin_amdgcn_fence(__ATOMIC_ACQUIRE, "agent");
            xb_add(&bar[XB_XGEN(b.x)], 1u);
            asm volatile("s_waitcnt vmcnt(0)" ::: "memory");
        } else {
            XB_SPIN(xb_ld(&bar[XB_XGEN(b.x)]) == gen, bar);
            __builtin_amdgcn_fence(__ATOMIC_ACQUIRE, "agent");
            asm volatile("s_waitcnt vmcnt(0)" ::: "memory");
        }
    }
    __syncthreads();
}
__global__ void __launch_bounds__(512, 2) mega_fwd(KArgs a) {
    extern __shared__ __attribute__((aligned(16))) unsigned char smem[];
    cg::grid_group grid = cg::this_grid();
    LAS unsigned char* lds = (LAS unsigned char*)smem;
    const int G = gridDim.x, bx = blockIdx.x;
    const float* x = (const float*)a.in[0];
    grid.sync();
    if (threadIdx.x < 16) ((LAS unsigned*)(lds + 131072))[threadIdx.x] = 0u;
    __syncthreads();
    (void)xcd_barrier_post((unsigned*)(a.ws + WS_BAR), (volatile LAS unsigned*)(lds + 131072));
#define GBAR() do { XcdBarrier xb_; xb_.bar = (unsigned*)(opq(a.ws) + WS_BAR); xb_.x = xb_xcc_id(); xb_.st = (volatile LAS unsigned*)(lds + 131072); xcd_barrier(xb_); } while (0)

#if PH_MISC
    tables_phase(a);
    convert_weights(a, 0, lds);
#if PROBE_CVT_REP > 1
    convert_weights(a, 0, lds);
#endif
#endif
    { float* rz = (float*)(opq(a.ws) + WS_RSQ); for (int z_ = bx * 512 + opaque_tid(); z_ < 4 * M; z_ += G * 512) rz[z_] = 0.f; }
    cast_rows_bf16(x, (bf16_t*)(opq(a.ws) + WS_XN), (float*)(opq(a.ws) + WS_RSQ) + 4 * M);
    GBAR();
#pragma unroll 1
    for (int l = 0; l < DEPTH; ++l) {
        if (l > 0) {
#if PH_MISC
            convert_weights(a, l, lds);
#if PROBE_CVT_REP > 1
            convert_weights(a, l, lds);
#endif
#endif
            GBAR();
        }
        { pg8::Gemm g{(const bf16_t*)(opq(a.ws) + WS_XN), (const bf16_t*)(opq(a.ws) + WS_WIN), M, DINP, DM, DM, DM}; pg8::StaticOrder S; S.init(M, DINP, G, bx);
          pg8::EpiU E{(bf16_t*)(opq(a.ws) + WS_U), DINP, (const float*)(opq(a.ws) + WS_RSQ) + (size_t)(l == 0 ? 4 : 2 + (l - 1)) * M};
          __syncthreads(); if (PH_GEMM & 1) pg8::gemm_phase<pg8::EpiU, pg8::StaticOrder, true, true>(lds, g, S, E);
#if PROBE_GEMM_REP > 1
          __syncthreads(); if (PH_GEMM & 1) pg8::gemm_phase<pg8::EpiU, pg8::StaticOrder, true, true>(lds, g, S, E);
#endif
 }
        GBAR();
#if PH_MISC
        mla_prep(a, l);
#endif
#if PH_S1
        for (int it = bx; it < 4096; it += G) scan::pass1_item<1>(a, l, it, lds);
        for (int it = bx; it < 4096; it += G) scan::pass1_item<0>(a, l, it, lds);
#if PROBE_SCAN_REP > 1
        for (int it = bx; it < 4096; it += G) scan::pass1_item<1>(a, l, it, lds);
        for (int it = bx; it < 4096; it += G) scan::pass1_item<0>(a, l, it, lds);
#endif
#endif
        GBAR();
#if PH_S2
        for (int t = bx * 512 + opaque_tid(); t < 131072; t += G * 512) scan::pass2_triple(a, t);
#endif
        { pg8::Gemm g{(const bf16_t*)(opq(a.ws) + WS_U) + C_CQ, (const bf16_t*)(opq(a.ws) + WS_WQB), M, 1536, 512, DINP, 512}; pg8::StaticOrder S; S.init(M, 1536, G, bx);
          pg8::EpiQ E{(bf16_t*)(opq(a.ws) + WS_Q), (const float*)(opq(a.ws) + WS_COS), (const float*)(opq(a.ws) + WS_SIN)};
          __syncthreads(); if (PH_GEMM & 2) pg8::gemm_phase<pg8::EpiQ, pg8::StaticOrder, true, true>(lds, g, S, E);
#if PROBE_GEMM_REP > 1
          __syncthreads(); if (PH_GEMM & 2) pg8::gemm_phase<pg8::EpiQ, pg8::StaticOrder, true, true>(lds, g, S, E);
#endif
 }
        { pg8::Gemm g{(const bf16_t*)(opq(a.ws) + WS_U) + C_CKV, (const bf16_t*)(opq(a.ws) + WS_WKVB), M, 2048, 512, DINP, 512}; pg8::StaticOrder S; S.init(M, 2048, G, bx);
          pg8::EpiKV E{(bf16_t*)(opq(a.ws) + WS_KN), (bf16_t*)(opq(a.ws) + WS_V)};
          __syncthreads(); if (PH_GEMM & 4) pg8::gemm_phase<pg8::EpiKV, pg8::StaticOrder, true, true>(lds, g, S, E);
#if PROBE_GEMM_REP > 1
          __syncthreads(); if (PH_GEMM & 4) pg8::gemm_phase<pg8::EpiKV, pg8::StaticOrder, true, true>(lds, g, S, E);
#endif
 }
        GBAR();
        { const bool x8 = (G % 8) == 0; const int xcd = bx & 7, slot = bx >> 3, nslot = G >> 3;
          for (int pr = 0; pr < (x8 ? 2 : 16); ++pr) { const int p = x8 ? xcd + 8 * pr : pr, b = p >> 3, h = p & 7;
            for (int qb = x8 ? slot : bx; qb < 64; qb += x8 ? nslot : G) {
              const bf16_t* Qb = (const bf16_t*)(opq(a.ws) + WS_Q) + ((size_t)(b * 8 + h) * T + (size_t)qb * 256) * 192;
              const bf16_t* Kn = (const bf16_t*)(opq(a.ws) + WS_KN) + (size_t)(b * 8 + h) * T * 128;
              const bf16_t* Kr = (const bf16_t*)(opq(a.ws) + WS_KR) + (size_t)b * T * 64;
              const bf16_t* Vh = (const bf16_t*)(opq(a.ws) + WS_V) + (size_t)(b * 8 + h) * T * 128;
              bf16_t* Ob = (bf16_t*)(opq(a.ws) + WS_XN) + ((size_t)b * T + (size_t)qb * 256) * DM + 1024 + h * 128;
#if PH_ATT
              for (int rep_ = 0; rep_ < PROBE_ATT_REP; ++rep_) att::attn_unit(Qb, Kn, Kr, Vh, Ob, (char*)smem);
#else
              { const int t_ = opaque_tid(); bf16_t* zp = Ob + (size_t)(t_ >> 1) * DM + (t_ & 1) * 64; (void)Qb; (void)Kn; (void)Kr; (void)Vh;
                for (int z_ = 0; z_ < 8; ++z_) *(u32x4*)(zp + z_ * 8) = (u32x4){0u, 0u, 0u, 0u}; }
#endif
 } } }
#if PH_S3
        for (int it = bx; it < 2048; it += G) scan::pass3_item<1>(a, l, it, lds);
        for (int it = bx; it < 2048; it += G) scan::pass3_item<0>(a, l, it, lds);
#if PROBE_SCAN_REP > 1
        for (int it = bx; it < 2048; it += G) scan::pass3_item<1>(a, l, it, lds);
        for (int it = bx; it < 2048; it += G) scan::pass3_item<0>(a, l, it, lds);
#endif
#else
        { bf16_t* mz = (bf16_t*)(opq(a.ws) + WS_XN); for (size_t z_ = (size_t)bx * 512 + opaque_tid(); z_ < (size_t)M * 128; z_ += (size_t)G * 512) *(u32x4*)(mz + (z_ >> 7) * DM + (z_ & 127) * 8) = (u32x4){0u, 0u, 0u, 0u}; }
#endif
        GBAR();
        { pg8::Gemm g{(const bf16_t*)(opq(a.ws) + WS_XN), (const bf16_t*)(opq(a.ws) + WS_WOUT), M, DM, DM, DM, DM}; pg8::StaticOrder S; S.init(M, DM, G, bx);
          pg8::EpiRes E{l == 0 ? x : (const float*)a.out, a.out, (bf16_t*)(opq(a.ws) + WS_HB), (float*)(opq(a.ws) + WS_RSQ) + (size_t)l * M};
          __syncthreads(); if (PH_GEMM & 8) pg8::gemm_phase<pg8::EpiRes, pg8::StaticOrder, true, true>(lds, g, S, E); }
        GBAR();
        { pg8::Gemm g{(const bf16_t*)(opq(a.ws) + WS_HB), (const bf16_t*)(opq(a.ws) + WS_W13), M, 2 * DFF, DM, DM, DM}; pg8::StaticOrder S; S.init(M, 2 * DFF, G, bx);
          pg8::EpiSwi E{(bf16_t*)(opq(a.ws) + WS_HID), (const float*)(opq(a.ws) + WS_RSQ) + (size_t)l * M};
          __syncthreads(); if (PH_GEMM & 16) pg8::gemm_phase<pg8::EpiSwi, pg8::StaticOrder, true, true>(lds, g, S, E);
#if PROBE_GEMM_REP > 1
          __syncthreads(); if (PH_GEMM & 16) pg8::gemm_phase<pg8::EpiSwi, pg8::StaticOrder, true, true>(lds, g, S, E);
#endif
 }
        GBAR();
        { pg8::Gemm g{(const bf16_t*)(opq(a.ws) + WS_HID), (const bf16_t*)(opq(a.ws) + WS_W2), M, DM, DFF, DFF, DFF}; pg8::StaticOrder S; S.init(M, DM, G, bx);
          pg8::EpiRes E{(const float*)a.out, a.out, (bf16_t*)(opq(a.ws) + WS_XN), (float*)(opq(a.ws) + WS_RSQ) + (size_t)(2 + l) * M};
          __syncthreads(); if (PH_GEMM & 32) pg8::gemm_phase<pg8::EpiRes, pg8::StaticOrder, true, true>(lds, g, S, E); }
        GBAR();
    }
    rmsnorm_rows_f32_inplace(a.out, (const float*)a.in[18]);
}

extern "C" void kernel_launch(void* const* d_in, const int* in_sizes, int n_in, void* d_out, int out_size, void* d_ws, size_t ws_size, hipStream_t stream) {
    static int grid = 0;
    if (grid == 0) {
        if (n_in != 19 || out_size != M * DM || ws_size < WS_END) { fprintf(stderr, "kernel_launch: unexpected shapes (n_in %d out %d ws %zu)\n", n_in, out_size, ws_size); grid = -1; return; }
        int dev = 0, cus = 0, per_cu = 0;
        hipGetDevice(&dev); hipDeviceGetAttribute(&cus, hipDeviceAttributeMultiprocessorCount, dev);
        if (hipFuncSetAttribute((const void*)mega_fwd, hipFuncAttributeMaxDynamicSharedMemorySize, LDS_BYTES) != hipSuccess) { fprintf(stderr, "kernel_launch: hipFuncSetAttribute failed\n"); grid = -1; return; }
        if (hipOccupancyMaxActiveBlocksPerMultiprocessor(&per_cu, (const void*)mega_fwd, 512, LDS_BYTES) != hipSuccess || per_cu < 1) { fprintf(stderr, "kernel_launch: occupancy query says %d\n", per_cu); per_cu = 1; }
        (void)hipGetLastError();
        grid = cus * (per_cu > 1 ? 1 : per_cu);
    }
    if (grid < 0) return;
    KArgs a{};
    for (int i = 0; i < 19; ++i) a.in[i] = d_in[i];
    a.out = (float*)d_out; a.ws = (unsigned char*)d_ws;
    if (hipMemsetAsync((char*)d_ws + WS_BAR, 0, 16384, stream) != hipSuccess) { fprintf(stderr, "kernel_launch: memset failed\n"); return; }
    void* args[] = {&a};
    hipError_t e = hipLaunchCooperativeKernel((const void*)mega_fwd, dim3(grid), dim3(512), args, LDS_BYTES, stream);
    if (e != hipSuccess) fprintf(stderr, "kernel_launch: cooperative launch failed: %s (grid %d)\n", hipGetErrorString(e), grid);
}
```

```cpp
#include <hip/hip_runtime.h>
#include <hip/hip_cooperative_groups.h>
#include <cstdint>
#include <cstdio>
namespace cg = cooperative_groups;
#ifndef PROBE_GEMM_REP
#define PROBE_GEMM_REP 1
#endif
#ifndef PROBE_SCAN_REP
#define PROBE_SCAN_REP 1
#endif
#ifndef PROBE_CVT_REP
#define PROBE_CVT_REP 1
#endif
#ifndef PROBE_ATT_REP
#define PROBE_ATT_REP 1
#endif
#ifndef PH_ATT
#define PH_ATT 1
#endif
#ifndef PH_S1
#define PH_S1 1
#endif
#ifndef PH_S2
#define PH_S2 1
#endif
#ifndef PH_S3
#define PH_S3 1
#endif
#ifndef PH_GEMM
#define PH_GEMM 63
#endif
#ifndef PH_MISC
#define PH_MISC 1
#endif

#define LAS __attribute__((address_space(3)))
typedef unsigned short bf16_t;
typedef short bf16x8 __attribute__((ext_vector_type(8)));
typedef short s16x4 __attribute__((ext_vector_type(4)));
typedef float f32x2 __attribute__((ext_vector_type(2)));
typedef float f32x4 __attribute__((ext_vector_type(4)));
typedef float f32x16 __attribute__((ext_vector_type(16)));
typedef unsigned u32x2 __attribute__((ext_vector_type(2)));
typedef unsigned u32x4 __attribute__((ext_vector_type(4)));

constexpr int NB = 2, T = 16384, M = NB * T, DM = 2048, DIN = 5216, DINP = 5376, DFF = 5632, DEPTH = 2;
constexpr int C_GQ = 0, C_GK = 256, C_GV = 512, C_GAF = 1024, C_GAB = 1040, C_GG = 1056, C_HQ = 1568, C_HFF = 2080, C_HFB = 2592, C_HI = 3104, C_HG = 3616,
              C_CQ = 4128, C_CKV = 4640, C_KR = 5152;
constexpr float EPS = 1e-6f;
constexpr int NCH = T / 64;
constexpr size_t MiB = 1048576;
constexpr size_t WS_WIN = 0, WS_WQB = 21 * MiB, WS_WKVB = WS_WQB + 3 * MiB / 2, WS_WOUT = WS_WKVB + 2 * MiB, WS_W13 = WS_WOUT + 8 * MiB, WS_W2 = WS_W13 + 44 * MiB;
constexpr size_t WS_XN = 99 * MiB, WS_U = 227 * MiB, WS_Q = 563 * MiB, WS_KN = 659 * MiB, WS_V = 723 * MiB, WS_KR = 787 * MiB, WS_SG = 791 * MiB, WS_SH = 855 * MiB,
                 WS_DG = 983 * MiB, WS_DH = 984 * MiB, WS_COS = 986 * MiB, WS_SIN = 990 * MiB, WS_LB = 994 * MiB, WS_BAR = 995 * MiB, WS_RSQ = WS_BAR + 16384, WS_SLOT = 996 * MiB, WS_END = 1012 * MiB, WS_HB = WS_U, WS_HID = WS_U + 128 * MiB;
static_assert(WS_W2 + 22 * MiB <= WS_XN, "weights");
constexpr int LDS_BYTES = 131072 + 64;

struct KArgs { const void* in[19]; float* out; unsigned char* ws; };

__device__ __forceinline__ float bf2f(unsigned v) { return __uint_as_float(v << 16); }
__device__ __forceinline__ unsigned f2bf(float f) { unsigned u = __float_as_uint(f); return (u + 0x7fffu + ((u >> 16) & 1u)) >> 16; }
__device__ __forceinline__ unsigned pk2(float lo, float hi) { return f2bf(lo) | (f2bf(hi) << 16); }
typedef __bf16 bf16x2_t __attribute__((ext_vector_type(2)));
__device__ __forceinline__ unsigned cvt_pk_bf16(float lo, float hi) { f32x2 v = {lo, hi}; bf16x2_t b = __builtin_convertvector(v, bf16x2_t); return __builtin_bit_cast(unsigned, b); }
__device__ __forceinline__ float wave_sum(float v) {
#pragma unroll
    for (int o = 1; o < 64; o <<= 1) v += __shfl_xor(v, o);
    return v;
}
__device__ __forceinline__ unsigned char* opq(unsigned char* q) { asm volatile("" : "+s"(q)); return q; }
__device__ __forceinline__ int opaque_tid() { int t = threadIdx.x; asm volatile("" : "+v"(t)); return t; }
#define DBGF(ws_, cond_, bit_) do { if (cond_) atomicOr((unsigned*)((ws_) + WS_BAR) + 32, (unsigned)(bit_)); } while (0)
__device__ __forceinline__ bool badf(float v) { return !(fabsf(v) < 1e30f); }
__device__ __forceinline__ float sigmoid_(float z) { return __builtin_amdgcn_rcpf(1.f + __expf(-z)); }
__device__ __forceinline__ float silu_(float z) { return z * sigmoid_(z); }
__device__ __forceinline__ float logsigmoid_(float z) { return fminf(z, 0.f) - __logf(1.f + __expf(-fabsf(z))); }
__device__ __forceinline__ void unpack8(bf16x8 v, float* f) {
#pragma unroll
    for (int e = 0; e < 8; ++e) f[e] = bf2f((unsigned)(unsigned short)v[e]);
}
__device__ __forceinline__ bf16x8 pack8(const float* f) {
    u32x4 w = {cvt_pk_bf16(f[0], f[1]), cvt_pk_bf16(f[2], f[3]), cvt_pk_bf16(f[4], f[5]), cvt_pk_bf16(f[6], f[7])};
    return __builtin_bit_cast(bf16x8, w);
}

namespace pg8 {
#define PG8_LAS __attribute__((address_space(3)))
constexpr int BM = 256, BK = 64, HALF = 128, HTB = HALF * BK * 2, STAGE_BYTES = 8 * HTB, NXCD = 8, WGM = 8;
__host__ __device__ __forceinline__ int lds_byte(int r, int c) { const int st = (r >> 4) * 2 + (c >> 5), rr = r & 15, cc = c & 31, ob = rr * 64 + cc * 2; return st * 1024 + (ob ^ (((ob >> 9) & 1) << 5)); }
__host__ __device__ __forceinline__ void stage_rc(int b, int& R, int& C) { const int st = b / 1024, sb = b % 1024, swz = sb ^ (((sb >> 9) & 1) << 5); R = (st >> 1) * 16 + swz / 64; C = (st & 1) * 32 + (swz % 64) / 2; }
__host__ __device__ __forceinline__ int perm32(int rho) { const int n = rho >> 4, i = rho & 15; return 8 * (i >> 2) + 4 * n + (i & 3); }
struct Unit { int pm, pn; };
struct Gemm { const bf16_t* A; const bf16_t* Bt; int M, N, K, lda, ldb; };
struct StaticOrder {
    int nM, nN, nwg, G, c;
    __host__ __device__ void init(int M_, int N_, int G_, int c_) { nM = M_ / BM; nN = N_ / BM; nwg = nM * nN; G = G_; c = c_; }
    __host__ __device__ bool next(int i, Unit& u) const {
        const long L = (long)i * G + c; if (L >= nwg) return false;
        int wgid = (int)L; { const int q = nwg / NXCD, r = nwg % NXCD, xcd = wgid % NXCD, off = wgid / NXCD; wgid = (xcd < r ? xcd * (q + 1) : r * (q + 1) + (xcd - r) * q) + off; }
        const int nig = WGM * nN, gid = wgid / nig, fm = gid * WGM, gsz = (nM - fm) < WGM ? (nM - fm) : WGM;
        u.pm = fm + ((wgid % nig) % gsz); u.pn = (wgid % nig) / gsz; return true;
    }
    __device__ __forceinline__ void a_ready(const Unit&) const {}
    __device__ __forceinline__ void done(const Unit&) const {}
};
template <class Epi, class Sched, bool ALIGN_EPI = false, bool SP2 = false>
__device__ __forceinline__ void gemm_phase(PG8_LAS unsigned char* lds, const Gemm g, const Sched& S, const Epi& E) {
    const int tid = opaque_tid(), wid = __builtin_amdgcn_readfirstlane(tid >> 6), lane = tid & 63, wr = wid >> 2, wc = wid & 3, fr = lane & 15, fq = lane >> 4;
    const int K = g.K, nt = K / BK;
    unsigned voffA[2], voffB[2];
#pragma unroll
    for (int i = 0; i < 2; ++i) { int R, C; stage_rc(tid * 16 + i * 8192, R, C); const int Rb = Epi::PERM ? ((R & ~31) + perm32(R & 31)) : R;
        voffA[i] = (unsigned)(R * g.lda + C) * 2u; voffB[i] = (unsigned)(Rb * g.ldb + C) * 2u; }
    const size_t kstep = (size_t)(BK * 2);
    const size_t hstepA = (size_t)HALF * g.lda * 2, hstepB = (size_t)HALF * g.ldb * 2;
    const size_t tstepA = 2 * hstepA, tstepB = 2 * hstepB;
    const unsigned ldsw = (unsigned)wid * 1024u;
    const int aoff = lds_byte(wr * 64 + fr, fq * 8), boff = lds_byte(wc * 32 + fr, fq * 8);
#define PG8_SA(b, h) (((b) * 2 + (h)) * HTB)
#define PG8_SB(b, h) ((4 + (b) * 2 + (h)) * HTB)
#define PG8_STAGE(bufoff, gbase, voff) do { _Pragma("unroll") for (int _i = 0; _i < 2; ++_i) \
        __builtin_amdgcn_global_load_lds((const unsigned*)((const char*)(gbase) + (voff)[_i]), (PG8_LAS unsigned*)(lds + (bufoff) + ldsw + _i * 8192), 16, 0, 0); } while (0)
#define PG8_LDA(dst, b, h) do { _Pragma("unroll") for (int m = 0; m < 4; ++m) _Pragma("unroll") for (int k = 0; k < 2; ++k) dst[m][k] = *(const PG8_LAS bf16x8*)(lds + PG8_SA(b, h) + aoff + m * 2048 + k * 1024); } while (0)
#define PG8_LDB(dst, b, h) do { _Pragma("unroll") for (int n = 0; n < 2; ++n) _Pragma("unroll") for (int k = 0; k < 2; ++k) dst[n][k] = *(const PG8_LAS bf16x8*)(lds + PG8_SB(b, h) + boff + n * 2048 + k * 1024); } while (0)
#define PG8_MMA(ai, bj, At, Bt) do { __builtin_amdgcn_s_setprio(1); _Pragma("unroll") for (int m = 0; m < 4; ++m) _Pragma("unroll") for (int n = 0; n < 2; ++n) _Pragma("unroll") for (int k = 0; k < 2; ++k) \
        acc[ai][bj][m][n] = __builtin_amdgcn_mfma_f32_16x16x32_bf16(Bt[n][k], At[m][k], acc[ai][bj][m][n], 0, 0, 0); __builtin_amdgcn_s_setprio(0); } while (0)
#define PG8_WAIT_V(n) asm volatile("s_waitcnt vmcnt(" #n ")" ::: "memory")
#define PG8_WAIT_L(n) asm volatile("s_waitcnt lgkmcnt(" #n ")" ::: "memory")
#define PG8_BAR __builtin_amdgcn_s_barrier()
#define PG8_SCHED __builtin_amdgcn_sched_barrier(0)
    Unit cur, nxt; int ui = 0;
    if (!S.next(0, cur)) return;
    f32x4 acc[2][2][4][2];
#pragma unroll
    for (int a = 0; a < 2; ++a)
#pragma unroll
        for (int b = 0; b < 2; ++b)
#pragma unroll
            for (int m = 0; m < 4; ++m)
#pragma unroll
                for (int n = 0; n < 2; ++n) acc[a][b][m][n] = (f32x4){0.f, 0.f, 0.f, 0.f};
    bf16x8 At[4][2], B0[2][2], B1[2][2];
    const char* cA = (const char*)g.A + (size_t)cur.pm * tstepA; const char* cB = (const char*)g.Bt + (size_t)cur.pn * tstepB;
    S.a_ready(cur);
    if constexpr (SP2) {
        PG8_STAGE(PG8_SB(0, 0), cB, voffB); PG8_STAGE(PG8_SB(0, 1), cB + hstepB, voffB); PG8_STAGE(PG8_SA(0, 0), cA, voffA); PG8_STAGE(PG8_SA(0, 1), cA + hstepA, voffA);
        if (wr == 1) PG8_BAR;
        PG8_WAIT_V(2); PG8_BAR;
        PG8_STAGE(PG8_SB(1, 0), cB + kstep, voffB); PG8_STAGE(PG8_SA(1, 0), cA + kstep, voffA); PG8_STAGE(PG8_SB(1, 1), cB + hstepB + kstep, voffB);
        PG8_WAIT_V(6); PG8_BAR;
    } else {
        PG8_STAGE(PG8_SB(0, 0), cB, voffB); PG8_STAGE(PG8_SA(0, 0), cA, voffA); PG8_STAGE(PG8_SB(0, 1), cB + hstepB, voffB); PG8_STAGE(PG8_SA(0, 1), cA + hstepA, voffA);
        if (wr == 1) PG8_BAR;
        PG8_WAIT_V(4); PG8_BAR;
        PG8_STAGE(PG8_SB(1, 0), cB + kstep, voffB); PG8_STAGE(PG8_SA(1, 0), cA + kstep, voffA); PG8_STAGE(PG8_SB(1, 1), cB + hstepB + kstep, voffB);
        PG8_WAIT_V(6); PG8_BAR;
    }
    for (;;) {
        const bool has_next = S.next(ui + 1, nxt);
        const char* nA = has_next ? (const char*)g.A + (size_t)nxt.pm * tstepA : cA; const char* nB = has_next ? (const char*)g.Bt + (size_t)nxt.pn * tstepB : cB;
        for (int t = 0; t < nt; t += 2) {
            const bool last = (t == nt - 2);
            const char* a1 = cA + (size_t)(t + 1) * kstep;
            const char* a2 = last ? nA : cA + (size_t)(t + 2) * kstep; const char* b2 = last ? nB : cB + (size_t)(t + 2) * kstep;
            const char* a3 = a2 + kstep; const char* b3 = b2 + kstep;
            if (last && has_next) S.a_ready(nxt);
            if constexpr (SP2) {
            PG8_LDB(B0, 0, 0); PG8_LDB(B1, 0, 1); PG8_SCHED; PG8_LDA(At, 0, 0); PG8_STAGE(PG8_SA(1, 1), a1 + hstepA, voffA);
            PG8_WAIT_V(8); PG8_WAIT_L(0); PG8_BAR; PG8_MMA(0, 0, At, B0); PG8_MMA(0, 1, At, B1); PG8_BAR; PG8_SCHED;
            PG8_LDA(At, 0, 1); PG8_STAGE(PG8_SB(0, 0), b2, voffB); PG8_STAGE(PG8_SB(0, 1), b2 + hstepB, voffB); PG8_STAGE(PG8_SA(0, 0), a2, voffA);
            PG8_WAIT_V(8); PG8_WAIT_L(0); PG8_BAR; PG8_MMA(1, 0, At, B0); PG8_MMA(1, 1, At, B1); PG8_BAR; PG8_SCHED;
            PG8_LDB(B0, 1, 0); PG8_LDB(B1, 1, 1); PG8_SCHED; PG8_LDA(At, 1, 0); PG8_STAGE(PG8_SA(0, 1), a2 + hstepA, voffA);
            PG8_WAIT_V(8); PG8_WAIT_L(0); PG8_BAR; PG8_MMA(0, 0, At, B0); PG8_MMA(0, 1, At, B1); PG8_BAR; PG8_SCHED;
            PG8_LDA(At, 1, 1); PG8_STAGE(PG8_SB(1, 0), b3, voffB); PG8_STAGE(PG8_SB(1, 1), b3 + hstepB, voffB); PG8_STAGE(PG8_SA(1, 0), a3, voffA);
            PG8_WAIT_V(8); PG8_WAIT_L(0); PG8_BAR; PG8_MMA(1, 0, At, B0); PG8_MMA(1, 1, At, B1); PG8_BAR; PG8_SCHED;
            } else {
            PG8_LDB(B0, 0, 0); PG8_SCHED; PG8_LDA(At, 0, 0); PG8_STAGE(PG8_SA(1, 1), a1 + hstepA, voffA);
            PG8_WAIT_L(8); PG8_BAR; PG8_WAIT_L(0); PG8_MMA(0, 0, At, B0); PG8_BAR; PG8_SCHED;
            PG8_LDB(B1, 0, 1); PG8_STAGE(PG8_SB(0, 0), b2, voffB);
            PG8_BAR; PG8_WAIT_L(0); PG8_MMA(0, 1, At, B1); PG8_BAR;
            PG8_LDA(At, 0, 1); PG8_STAGE(PG8_SA(0, 0), a2, voffA);
            PG8_BAR; PG8_WAIT_L(0); PG8_MMA(1, 0, At, B0); PG8_BAR; PG8_SCHED;
            PG8_STAGE(PG8_SB(0, 1), b2 + hstepB, voffB);
            PG8_WAIT_V(6); PG8_BAR; PG8_MMA(1, 1, At, B1); PG8_BAR;
            PG8_LDB(B0, 1, 0); PG8_SCHED; PG8_LDA(At, 1, 0); PG8_STAGE(PG8_SA(0, 1), a2 + hstepA, voffA);
            PG8_WAIT_L(8); PG8_BAR; PG8_WAIT_L(0); PG8_MMA(0, 0, At, B0); PG8_BAR; PG8_SCHED;
            PG8_LDB(B1, 1, 1); PG8_STAGE(PG8_SB(1, 0), b3, voffB);
            PG8_BAR; PG8_WAIT_L(0); PG8_MMA(0, 1, At, B1); PG8_BAR;
            PG8_LDA(At, 1, 1); PG8_STAGE(PG8_SA(1, 0), a3, voffA);
            PG8_BAR; PG8_WAIT_L(0); PG8_MMA(1, 0, At, B0); PG8_BAR; PG8_SCHED;
            PG8_STAGE(PG8_SB(1, 1), b3 + hstepB, voffB);
            PG8_WAIT_V(6); PG8_BAR; PG8_MMA(1, 1, At, B1); PG8_BAR;
            }
        }
        if constexpr (ALIGN_EPI) { if (wr == 0) PG8_BAR; }
        if constexpr (!Epi::AFTER_DRAIN) { E(acc, cur, wr, wc, fr, fq); S.done(cur); }
        if (!has_next) break;
#pragma unroll
        for (int a = 0; a < 2; ++a)
#pragma unroll
            for (int b = 0; b < 2; ++b)
#pragma unroll
                for (int m = 0; m < 4; ++m)
#pragma unroll
                    for (int n = 0; n < 2; ++n) acc[a][b][m][n] = (f32x4){0.f, 0.f, 0.f, 0.f};
        cur = nxt; cA = nA; cB = nB; ++ui;
        if constexpr (ALIGN_EPI) { if (wr == 1) PG8_BAR; }
    }
    PG8_WAIT_V(0);
    if constexpr (!ALIGN_EPI) { if (wr == 0) PG8_BAR; }
    PG8_BAR;
    if constexpr (Epi::AFTER_DRAIN) { E.fused(acc, cur, wr, wc, fr, fq, lds, wid, lane); S.done(cur); }
#undef PG8_SA
#undef PG8_SB
#undef PG8_STAGE
#undef PG8_LDA
#undef PG8_LDB
#undef PG8_MMA
#undef PG8_WAIT_V
#undef PG8_WAIT_L
#undef PG8_BAR
#undef PG8_SCHED
}
__device__ __forceinline__ float row_stat(const float* plain, const float* slots, int row, int fq) {
    if (plain) return plain[row];
    const f32x4 a = *(const f32x4*)(slots + (size_t)row * 32 + fq * 8), b = *(const f32x4*)(slots + (size_t)row * 32 + fq * 8 + 4);
    float s = ((a[0] + a[1]) + (a[2] + a[3])) + ((b[0] + b[1]) + (b[2] + b[3]));
    s += __shfl_xor(s, 16); s += __shfl_xor(s, 32);
    return s;
}
struct EpiU {
    static constexpr bool PERM = true, AFTER_DRAIN = false;
    bf16_t* O; int ldc; const float* rsq; const float* slots;
    __device__ __forceinline__ void operator()(const f32x4 (&acc)[2][2][4][2], const Unit& u, int wr, int wc, int fr, int fq) const {
        const int row0 = u.pm * BM + wr * 64 + fr, col0 = u.pn * BM + wc * 32 + 8 * fq;
        float rsv[2][4];
#pragma unroll
        for (int ai = 0; ai < 2; ++ai)
#pragma unroll
            for (int m = 0; m < 4; ++m) rsv[ai][m] = row_stat(rsq, slots, row0 + ai * HALF + m * 16, fq);
#pragma unroll
        for (int ai = 0; ai < 2; ++ai)
#pragma unroll
            for (int m = 0; m < 4; ++m) { bf16_t* rowp = O + (size_t)(row0 + ai * HALF + m * 16) * ldc + col0;
                const float rs = rsqrtf(rsv[ai][m] * (1.f / DM) + EPS);
#pragma unroll
                for (int bj = 0; bj < 2; ++bj) { const f32x4 v0 = acc[ai][bj][m][0] * rs, v1 = acc[ai][bj][m][1] * rs;
                    u32x4 w; w.x = cvt_pk_bf16(v0[0], v0[1]); w.y = cvt_pk_bf16(v0[2], v0[3]); w.z = cvt_pk_bf16(v1[0], v1[1]); w.w = cvt_pk_bf16(v1[2], v1[3]);
                    *(u32x4*)(rowp + bj * HALF) = w; } }
    }
};
struct EpiQ {
    static constexpr bool PERM = true, AFTER_DRAIN = false;
    bf16_t* Q; const float* cs; const float* sn;
    __device__ __forceinline__ void operator()(const f32x4 (&acc)[2][2][4][2], const Unit& u, int wr, int wc, int fr, int fq) const {
        const int row0 = u.pm * BM + wr * 64 + fr;
#pragma unroll
        for (int ai = 0; ai < 2; ++ai) {
            f32x4 ccv[4][2], ssv[4][2];
#pragma unroll
            for (int m = 0; m < 4; ++m)
#pragma unroll
                for (int bj = 0; bj < 2; ++bj) { const int row = row0 + ai * HALF + m * 16, e = (u.pn * BM + bj * HALF + wc * 32 + 8 * fq) % 192, i0 = e >= 128 ? (e - 128) >> 1 : 0;
                    ccv[m][bj] = *(const f32x4*)(cs + (size_t)row * 32 + i0); ssv[m][bj] = *(const f32x4*)(sn + (size_t)row * 32 + i0); }
#pragma unroll
            for (int m = 0; m < 4; ++m) { const int row = row0 + ai * HALF + m * 16, b = row / T, t = row % T;
#pragma unroll
                for (int bj = 0; bj < 2; ++bj) { const int c = u.pn * BM + bj * HALF + wc * 32 + 8 * fq, hh = c / 192, e = c % 192;
                    const f32x4 v0 = acc[ai][bj][m][0], v1 = acc[ai][bj][m][1];
                    float vals[8] = {v0[0], v0[1], v0[2], v0[3], v1[0], v1[1], v1[2], v1[3]};
                    if (e >= 128) { const f32x4 cc = ccv[m][bj], ss = ssv[m][bj];
#pragma unroll
                        for (int p = 0; p < 4; ++p) { const float x1 = vals[2 * p], x2 = vals[2 * p + 1]; vals[2 * p] = x1 * cc[p] - x2 * ss[p]; vals[2 * p + 1] = x2 * cc[p] + x1 * ss[p]; } }
                    constexpr float QS = 0.07216878364870322f * 1.4426950408889634f;
#pragma unroll
                    for (int p_ = 0; p_ < 8; ++p_) vals[p_] *= QS;
                    u32x4 w; w.x = cvt_pk_bf16(vals[0], vals[1]); w.y = cvt_pk_bf16(vals[2], vals[3]); w.z = cvt_pk_bf16(vals[4], vals[5]); w.w = cvt_pk_bf16(vals[6], vals[7]);
                    *(u32x4*)(Q + ((size_t)(b * 8 + hh) * T + t) * 192 + e) = w; } } }
    }
};
struct EpiKV {
    static constexpr bool PERM = true, AFTER_DRAIN = false;
    bf16_t* KN; bf16_t* V;
    __device__ __forceinline__ void operator()(const f32x4 (&acc)[2][2][4][2], const Unit& u, int wr, int wc, int fr, int fq) const {
        const int row0 = u.pm * BM + wr * 64 + fr, e = wc * 32 + 8 * fq;
#pragma unroll
        for (int ai = 0; ai < 2; ++ai)
#pragma unroll
            for (int m = 0; m < 4; ++m) { const int row = row0 + ai * HALF + m * 16, b = row / T, t = row % T;
                const size_t off = ((size_t)(b * 8 + u.pn) * T + t) * 128 + e;
#pragma unroll
                for (int bj = 0; bj < 2; ++bj) { const f32x4 v0 = acc[ai][bj][m][0], v1 = acc[ai][bj][m][1];
                    u32x4 w; w.x = cvt_pk_bf16(v0[0], v0[1]); w.y = cvt_pk_bf16(v0[2], v0[3]); w.z = cvt_pk_bf16(v1[0], v1[1]); w.w = cvt_pk_bf16(v1[2], v1[3]);
                    *(u32x4*)((bj ? V : KN) + off) = w; } }
    }
};
struct EpiSwi {
    static constexpr bool PERM = false, AFTER_DRAIN = false;
    bf16_t* H; const float* rsq; const float* slots;
    __device__ __forceinline__ void operator()(const f32x4 (&acc)[2][2][4][2], const Unit& u, int wr, int wc, int fr, int fq) const {
        const int row0 = u.pm * BM + wr * 64 + fr;
        float rsv[2][4];
#pragma unroll
        for (int ai = 0; ai < 2; ++ai)
#pragma unroll
            for (int m = 0; m < 4; ++m) rsv[ai][m] = row_stat(rsq, slots, row0 + ai * HALF + m * 16, fq);
#pragma unroll
        for (int ai = 0; ai < 2; ++ai)
#pragma unroll
            for (int m = 0; m < 4; ++m) { bf16_t* rowp = H + (size_t)(row0 + ai * HALF + m * 16) * DFF;
                const float rs = rsqrtf(rsv[ai][m] * (1.f / DM) + EPS);
#pragma unroll
                for (int bj = 0; bj < 2; ++bj) { const f32x4 a = acc[ai][bj][m][0] * rs, g = acc[ai][bj][m][1] * rs;
                    const int col = 16 * (8 * u.pn + 4 * bj + wc) + 4 * fq;
                    u32x2 w; w.x = cvt_pk_bf16(silu_(a[0]) * g[0], silu_(a[1]) * g[1]); w.y = cvt_pk_bf16(silu_(a[2]) * g[2], silu_(a[3]) * g[3]);
                    *(u32x2*)(rowp + col) = w; } }
    }
};
struct EpiRes {
    static constexpr bool PERM = false, AFTER_DRAIN = false;
    const void* base; int base_f32; bf16_t* h1; bf16_t* h2; float* rsq;
    __device__ __forceinline__ void operator()(const f32x4 (&acc)[2][2][4][2], const Unit& u, int wr, int wc, int fr, int fq) const {
        const int row0 = u.pm * BM + wr * 64 + fr, col0 = u.pn * BM + wc * 32 + 4 * fq;
#pragma unroll
        for (int ai = 0; ai < 2; ++ai) {
            f32x4 bs[4][2][2];
            if (base_f32) {
#pragma unroll
                for (int m = 0; m < 4; ++m) { const size_t off = (size_t)(row0 + ai * HALF + m * 16) * DM + col0;
#pragma unroll
                    for (int bj = 0; bj < 2; ++bj)
#pragma unroll
                        for (int n = 0; n < 2; ++n) bs[m][bj][n] = *(const f32x4*)((const float*)base + off + bj * HALF + n * 16); }
            } else {
                u32x2 bw[4][2][2];
#pragma unroll
                for (int m = 0; m < 4; ++m) { const size_t off = (size_t)(row0 + ai * HALF + m * 16) * DM + col0;
#pragma unroll
                    for (int bj = 0; bj < 2; ++bj)
#pragma unroll
                        for (int n = 0; n < 2; ++n) bw[m][bj][n] = *(const u32x2*)((const bf16_t*)base + off + bj * HALF + n * 16); }
#pragma unroll
                for (int m = 0; m < 4; ++m)
#pragma unroll
                    for (int bj = 0; bj < 2; ++bj)
#pragma unroll
                        for (int n = 0; n < 2; ++n) { const u32x2 w = bw[m][bj][n];
                            bs[m][bj][n] = (f32x4){__uint_as_float(w.x << 16), __uint_as_float(w.x & 0xffff0000u), __uint_as_float(w.y << 16), __uint_as_float(w.y & 0xffff0000u)}; }
            }
#pragma unroll
            for (int m = 0; m < 4; ++m) { const size_t off = (size_t)(row0 + ai * HALF + m * 16) * DM + col0; float ss = 0.f;
#pragma unroll
                for (int bj = 0; bj < 2; ++bj)
#pragma unroll
                    for (int n = 0; n < 2; ++n) { const f32x4 o = bs[m][bj][n] + acc[ai][bj][m][n];
                        u32x2 w; w.x = cvt_pk_bf16(o[0], o[1]); w.y = cvt_pk_bf16(o[2], o[3]);
                        *(u32x2*)(h1 + off + bj * HALF + n * 16) = w;
                        if (h2) *(u32x2*)(h2 + off + bj * HALF + n * 16) = w;
                        ss += (o[0] * o[0] + o[1] * o[1]) + (o[2] * o[2] + o[3] * o[3]); }
                ss += __shfl_xor(ss, 16); ss += __shfl_xor(ss, 32);
                if (fq == 0) rsq[(size_t)(row0 + ai * HALF + m * 16) * 32 + u.pn * 4 + wc] = ss; } }
    }
};

}
namespace att {
constexpr int KVBLK = 64;
constexpr float SCALE = 0.07216878364870322f;
constexpr float THR = 8.f;
constexpr int SHM_V = KVBLK * 128 * 2, SHM_K = KVBLK * 192 * 2;
#ifndef ATT_SDEPTH
#define ATT_SDEPTH 1
#endif
constexpr int SDEPTH = ATT_SDEPTH;
#define KSWZ(row, colB) ((row) * 384 + ((colB) ^ (((row) & 7) << 4)))
#define SBAR() __builtin_amdgcn_sched_barrier(0)
__device__ __forceinline__ int crow(int r, int hi) { return (r & 3) + 8 * (r >> 2) + 4 * hi; }
__device__ __forceinline__ unsigned cvtpk(float lo, float hi) { return cvt_pk_bf16(lo, hi); }
template <bool FIRST>
__device__ __forceinline__ void partialSM(f32x16& p0, f32x16& p1, float& m_reg, float& alpha) {
  constexpr float THR2 = THR * 1.4426950408889634f;
  float pmax = p0[0];
#pragma unroll
  for (int r = 1; r < 16; ++r) pmax = fmaxf(pmax, p0[r]);
#pragma unroll
  for (int r = 0; r < 16; ++r) pmax = fmaxf(pmax, p1[r]);
  { auto rr = __builtin_amdgcn_permlane32_swap(__float_as_uint(pmax), __float_as_uint(pmax), false, false);
    pmax = fmaxf(__uint_as_float(rr[0]), __uint_as_float(rr[1])); }
  if (!FIRST && __builtin_expect(__all(pmax <= THR2), 1)) { alpha = 1.f; }
  else { const float d = FIRST ? pmax : fmaxf(pmax, 0.f); alpha = FIRST ? 1.f : __builtin_amdgcn_exp2f(-d); m_reg += d;
#pragma unroll
    for (int r = 0; r < 16; ++r) p0[r] -= d;
#pragma unroll
    for (int r = 0; r < 16; ++r) p1[r] -= d; }
#pragma unroll
  for (int r = 0; r < 16; ++r) p0[r] = __builtin_amdgcn_exp2f(p0[r]);
}
__device__ __forceinline__ void finishSM(f32x16& p0, f32x16& p1, float alpha, float& l_reg, bf16x8& pa0, bf16x8& pa1, bf16x8& pa2, bf16x8& pa3) {
#pragma unroll
  for (int r = 0; r < 16; ++r) p1[r] = __builtin_amdgcn_exp2f(p1[r]);
  float ps = 0;
#pragma unroll
  for (int r = 0; r < 16; ++r) ps += p0[r];
#pragma unroll
  for (int r = 0; r < 16; ++r) ps += p1[r];
  { auto rr = __builtin_amdgcn_permlane32_swap(__float_as_uint(ps), __float_as_uint(ps), false, false);
    ps = __uint_as_float(rr[0]) + __uint_as_float(rr[1]); }
  l_reg = l_reg * alpha + ps;
#define PK4(P, BASE, OUT) do { unsigned a0 = cvtpk(P[BASE + 0], P[BASE + 1]), a1 = cvtpk(P[BASE + 2], P[BASE + 3]);   \
    unsigned b0 = cvtpk(P[BASE + 4], P[BASE + 5]), b1 = cvtpk(P[BASE + 6], P[BASE + 7]);                              \
    auto r0 = __builtin_amdgcn_permlane32_swap(a0, b0, false, false); auto r1 = __builtin_amdgcn_permlane32_swap(a1, b1, false, false); \
    u32x4 w = {r0[0], r1[0], r0[1], r1[1]}; OUT = __builtin_bit_cast(bf16x8, w); } while (0)
  PK4(p0, 0, pa0); PK4(p0, 8, pa1); PK4(p1, 0, pa2); PK4(p1, 8, pa3);
#undef PK4
}
__device__ __forceinline__ void qkt(f32x16& p0, f32x16& p1, const char* Ks, const bf16x8* qr, const char* qL, int r32, int hi, float negm) {
#pragma unroll
  for (int r = 0; r < 16; ++r) { p0[r] = negm; p1[r] = negm; }
#pragma unroll
  for (int d0 = 0; d0 < 12; ++d0) { int cb = (d0 * 16 + hi * 8) * 2;
    bf16x8 b0 = *reinterpret_cast<const bf16x8*>(Ks + KSWZ(r32, cb));
    bf16x8 b1 = *reinterpret_cast<const bf16x8*>(Ks + KSWZ(32 + r32, cb));
    const bf16x8 q = d0 < 8 ? qr[d0 < 8 ? d0 : 0] : *reinterpret_cast<const bf16x8*>(qL + (d0 - 8) * 1024);
    p0 = __builtin_amdgcn_mfma_f32_32x32x16_bf16(b0, q, p0, 0, 0, 0);
    p1 = __builtin_amdgcn_mfma_f32_32x32x16_bf16(b1, q, p1, 0, 0, 0); }
}
__device__ __forceinline__ int v_st(int k, int c) { const int kk = (k & ~0xC) | ((k & 4) << 1) | ((k & 8) >> 1); return ((kk >> 3) * 4 + (c >> 5)) * 512 + ((kk & 7) * 32 + (c & 31)) * 2; }
__device__ __forceinline__ int v_rd_base(int lane) { return ((lane & 3) << 3) | (((lane >> 2) & 3) << 6) | (((lane >> 4) & 1) << 5) | (((lane >> 5) & 1) << 8); }
constexpr int v_rd_off(int d0, int ks, int half) { return d0 * 512 + ks * 4096 + half * 2048; }
template <int OFF> __device__ __forceinline__ s16x4 tr_read(int vb) {
  s16x4 r; asm volatile("ds_read_b64_tr_b16 %0, %1 offset:%2" : "=&v"(r) : "v"(vb), "i"(OFF) : "memory"); return r;
}
template <int D0> __device__ __forceinline__ void pv_one(f32x16& od, int vb, bf16x8 pa0, bf16x8 pa1, bf16x8 pa2, bf16x8 pa3) {
  const s16x4 l0 = tr_read<v_rd_off(D0, 0, 0)>(vb), h0 = tr_read<v_rd_off(D0, 0, 1)>(vb), l1 = tr_read<v_rd_off(D0, 1, 0)>(vb), h1 = tr_read<v_rd_off(D0, 1, 1)>(vb);
  const s16x4 l2 = tr_read<v_rd_off(D0, 2, 0)>(vb), h2 = tr_read<v_rd_off(D0, 2, 1)>(vb), l3 = tr_read<v_rd_off(D0, 3, 0)>(vb), h3 = tr_read<v_rd_off(D0, 3, 1)>(vb);
  asm volatile("s_waitcnt lgkmcnt(0)" ::: "memory"); SBAR();
#define PK(L, H) (bf16x8){L[0], L[1], L[2], L[3], H[0], H[1], H[2], H[3]}
  od = __builtin_amdgcn_mfma_f32_32x32x16_bf16(pa0, PK(l0, h0), od, 0, 0, 0);
  od = __builtin_amdgcn_mfma_f32_32x32x16_bf16(pa1, PK(l1, h1), od, 0, 0, 0);
  od = __builtin_amdgcn_mfma_f32_32x32x16_bf16(pa2, PK(l2, h2), od, 0, 0, 0);
  od = __builtin_amdgcn_mfma_f32_32x32x16_bf16(pa3, PK(l3, h3), od, 0, 0, 0);
#undef PK
}
__device__ __forceinline__ void pv_d0(f32x16* o, int vb, bf16x8 pa0, bf16x8 pa1, bf16x8 pa2, bf16x8 pa3) {
  pv_one<0>(o[0], vb, pa0, pa1, pa2, pa3); pv_one<1>(o[1], vb, pa0, pa1, pa2, pa3); pv_one<2>(o[2], vb, pa0, pa1, pa2, pa3); pv_one<3>(o[3], vb, pa0, pa1, pa2, pa3);
}
__device__ __forceinline__ void attn_unit(const bf16_t* __restrict__ Qb, const bf16_t* __restrict__ Kn, const bf16_t* __restrict__ Kr, const bf16_t* __restrict__ Vh,
                                          bf16_t* __restrict__ Ob, char* lds) {
  const int tid = opaque_tid(), wid = tid >> 6, lane = tid & 63, r32 = lane & 31, hi = lane >> 5;
  char* V_lds = lds; char* K_lds = lds + 2 * SHM_V;
  float* ws = (float*)(lds + 2 * SHM_V + 2 * SHM_K) + wid * 64; float* li_l = ws; float* al_l = ws + 32;
  float m_reg = 0.f, l_reg = 0; f32x16 o[4] = {}; bf16x8 qr[8];
  char* qL = lds + 2 * SHM_V + 2 * SHM_K + 2048 + wid * 4096 + lane * 16;
  const bf16_t* Qw = Qb + (long)(wid * 32 + r32) * 192 + hi * 8;
#pragma unroll
  for (int d0 = 0; d0 < 8; ++d0) qr[d0] = *reinterpret_cast<const bf16x8*>(Qw + d0 * 16);
#pragma unroll
  for (int d0 = 8; d0 < 12; ++d0) *reinterpret_cast<bf16x8*>(qL + (d0 - 8) * 1024) = *reinterpret_cast<const bf16x8*>(Qw + d0 * 16);
  const int sr = tid >> 4, sc = (tid & 15) * 8, vst0 = v_st(sr, sc), vst1 = v_st(32 + sr, sc);
  const int rr = tid >> 3, rc = (tid & 7) * 8;
  const int kst0 = KSWZ(sr, sc * 2), kst1 = KSWZ(32 + sr, sc * 2), kst2 = KSWZ(rr, 256 + rc * 2);
  const int vb0 = (int)(uintptr_t)V_lds + v_rd_base(lane);
  struct { bf16x8 vs0, vs1, ks0, ks1, ks2; } sr_[SDEPTH];
#define SLOAD(i, k0) do { sr_[i].vs0 = *(const bf16x8*)(&Vh[(long)((k0) + sr) * 128 + sc]); sr_[i].vs1 = *(const bf16x8*)(&Vh[(long)((k0) + 32 + sr) * 128 + sc]); \
    sr_[i].ks0 = *(const bf16x8*)(&Kn[(long)((k0) + sr) * 128 + sc]); sr_[i].ks1 = *(const bf16x8*)(&Kn[(long)((k0) + 32 + sr) * 128 + sc]); \
    sr_[i].ks2 = *(const bf16x8*)(&Kr[(long)((k0) + rr) * 64 + rc]); } while (0)
#define SWRITE(b, i) do { *(bf16x8*)(V_lds + (b) * SHM_V + vst0) = sr_[i].vs0; *(bf16x8*)(V_lds + (b) * SHM_V + vst1) = sr_[i].vs1; \
    *(bf16x8*)(K_lds + (b) * SHM_K + kst0) = sr_[i].ks0; *(bf16x8*)(K_lds + (b) * SHM_K + kst1) = sr_[i].ks1; *(bf16x8*)(K_lds + (b) * SHM_K + kst2) = sr_[i].ks2; } while (0)
#define SWAIT() do { if constexpr (SDEPTH == 2) asm volatile("s_waitcnt vmcnt(5)" ::: "memory"); else asm volatile("s_waitcnt vmcnt(0)" ::: "memory"); } while (0)
#define RESC(a) do { if (__any((a) < 1.f)) { if (hi == 0) al_l[r32] = (a); asm volatile("s_waitcnt lgkmcnt(0)" ::: "memory"); \
    _Pragma("unroll") for (int d = 0; d < 4; ++d) _Pragma("unroll") for (int r = 0; r < 16; ++r) o[d][r] *= al_l[crow(r, hi)]; } } while (0)
  f32x16 pA0, pA1, pB0, pB1; float alA, alB; bf16x8 pa0, pa1, pa2, pa3; const int NT = T / KVBLK;
  constexpr int SE = 0, SO = SDEPTH - 1;
  SLOAD(SE, 0); asm volatile("s_waitcnt vmcnt(0)" ::: "memory"); SWRITE(0, SE); __syncthreads();
  qkt(pA0, pA1, K_lds, qr, qL, r32, hi, 0.f); partialSM<true>(pA0, pA1, m_reg, alA);
  SLOAD(SO, KVBLK); if constexpr (SDEPTH == 2) { if (2 < NT) SLOAD(SE, 2 * KVBLK); }
  SWAIT(); SWRITE(1, SO); __syncthreads();
  for (int j = 1; j + 1 < NT; j += 2) {
    SBAR(); qkt(pB0, pB1, K_lds + SHM_K, qr, qL, r32, hi, -m_reg);
    finishSM(pA0, pA1, alA, l_reg, pa0, pa1, pa2, pa3); SBAR();
    SLOAD(SO, (j + SDEPTH) * KVBLK); SBAR();
    pv_d0(o, vb0, pa0, pa1, pa2, pa3); partialSM<false>(pB0, pB1, m_reg, alB);
    __syncthreads(); SWAIT(); SWRITE(0, SE);
    RESC(alB); __syncthreads();
    SBAR(); qkt(pA0, pA1, K_lds, qr, qL, r32, hi, -m_reg);
    finishSM(pB0, pB1, alB, l_reg, pa0, pa1, pa2, pa3); SBAR();
    if (SDEPTH == 1 || j + 3 < NT) SLOAD(SE, (j + 1 + SDEPTH) * KVBLK); SBAR();
    pv_d0(o, vb0 + (int)SHM_V, pa0, pa1, pa2, pa3); partialSM<false>(pA0, pA1, m_reg, alA);
    __syncthreads(); SWAIT(); SWRITE(1, SO);
    RESC(alA); __syncthreads();
  }
  SBAR(); qkt(pB0, pB1, K_lds + SHM_K, qr, qL, r32, hi, -m_reg);
  finishSM(pA0, pA1, alA, l_reg, pa0, pa1, pa2, pa3); SBAR();
  pv_d0(o, vb0, pa0, pa1, pa2, pa3); partialSM<false>(pB0, pB1, m_reg, alB);
  __syncthreads(); RESC(alB);
  finishSM(pB0, pB1, alB, l_reg, pa0, pa1, pa2, pa3); SBAR();
  pv_d0(o, vb0 + (int)SHM_V, pa0, pa1, pa2, pa3);
  if (hi == 0) li_l[r32] = l_reg; asm volatile("s_waitcnt lgkmcnt(0)" ::: "memory");
  float rli[16];
#pragma unroll
  for (int r = 0; r < 16; ++r) rli[r] = __builtin_amdgcn_rcpf(li_l[crow(r, hi)]);
  bf16_t* Ow = Ob + (long)(wid * 32) * DM;
#pragma unroll
  for (int r = 0; r < 16; ++r) { int orow = crow(r, hi);
#pragma unroll
    for (int d0 = 0; d0 < 4; ++d0) Ow[(long)orow * DM + d0 * 32 + r32] = (bf16_t)f2bf(o[d0][r] * rli[r]); }
#undef SLOAD
#undef SWRITE
#undef SWAIT
#undef RESC
  __syncthreads();
}
}
namespace scan {
constexpr int LDT = 72;
constexpr int SC_G = 0, SC_K = 33792, SC_QT = SC_K + 17408, SC_QG = SC_QT + 17408, SC_VT = SC_QG + 17408, SC_P = SC_VT + 18432, SC_SEG = SC_P + 9216, SC_RSQ = SC_SEG + 4096,
              SC_END = SC_RSQ + 2048, SC_KDT = SC_QT;
static_assert(SC_END <= LDS_BYTES, "scan LDS");

template <int TYPE> struct Cfg { static constexpr int DK = TYPE ? 128 : 64, LDG = DK + 4, LDK_ = DK + 8, ND8 = DK / 8; };

struct LgRaw { bf16x8 a0, a1, k; };
template <int TYPE>
__device__ __forceinline__ LgRaw lg_issue(const bf16_t* u, int h, int dir, size_t tok0, int tid) {
    LgRaw r;
    if constexpr (TYPE == 1) {
        const int i0 = tid >> 4, d8 = tid & 15, col = (dir ? C_HFB : C_HFF) + h * 128 + d8 * 8;
        r.a0 = *(const bf16x8*)(u + (tok0 + i0) * DINP + col); r.a1 = *(const bf16x8*)(u + (tok0 + 32 + i0) * DINP + col); r.k = r.a0;
    } else {
        const int i = tid >> 3, d8 = tid & 7; const bf16_t* ur = u + (tok0 + i) * DINP;
        r.a0 = *(const bf16x8*)(ur + (dir ? C_GAB : C_GAF)); r.a1 = *(const bf16x8*)(ur + (dir ? C_GAB : C_GAF) + 8); r.k = *(const bf16x8*)(ur + C_GK + h * 64 + d8 * 8);
    }
    return r;
}
template <int TYPE>
__device__ __forceinline__ void lg_compute(const KArgs& a, unsigned char* wsb, int l, int h, int dir, const LgRaw& raw, LAS unsigned char* lds, int tid) {
    using C = Cfg<TYPE>;
    LAS float* G = (LAS float*)(lds + SC_G); LAS bf16_t* Kb = (LAS bf16_t*)(lds + SC_K);
    if constexpr (TYPE == 1) {
        const float* lbp = (const float*)(wsb + WS_LB) + (dir * DEPTH + l) * 512 + h * 128;
        const int d8 = tid & 15;
        const f32x4 lb0 = *(const f32x4*)(lbp + d8 * 8), lb1 = *(const f32x4*)(lbp + d8 * 8 + 4);
        const float lb[8] = {lb0[0], lb0[1], lb0[2], lb0[3], lb1[0], lb1[1], lb1[2], lb1[3]};
#pragma unroll
        for (int e2 = 0; e2 < 2; ++e2) { const int i = (tid >> 4) + 32 * e2;
            float z[8], lg[8], kk[8]; unpack8(e2 ? raw.a1 : raw.a0, z);
#pragma unroll
            for (int e = 0; e < 8; ++e) { const float sg = sigmoid_(fmaxf(z[e], -80.f)); lg[e] = __logf(lb[e] + (1.f - lb[e]) * sg); kk[e] = (1.f - lb[e]) * (1.f - sg); }
            *(LAS f32x4*)(G + i * C::LDG + d8 * 8) = (f32x4){lg[0], lg[1], lg[2], lg[3]}; *(LAS f32x4*)(G + i * C::LDG + d8 * 8 + 4) = (f32x4){lg[4], lg[5], lg[6], lg[7]};
            *(LAS bf16x8*)(Kb + i * C::LDK_ + d8 * 8) = pack8(kk); }
    } else {
        const int i = tid >> 3, d8 = tid & 7;
        float ua[16]; unpack8(raw.a0, ua); unpack8(raw.a1, ua + 8);
        const float* up = (const float*)a.in[3] + (size_t)((l * 2 + dir) * 16) * 256 + h * 64 + d8 * 8;
        const float* bs = (const float*)a.in[4] + (l * 2 + dir) * 256 + h * 64 + d8 * 8;
        f32x4 z0 = *(const f32x4*)bs, z1 = *(const f32x4*)(bs + 4);
#pragma unroll
        for (int r = 0; r < 16; ++r) { z0 += ua[r] * *(const f32x4*)(up + r * 256); z1 += ua[r] * *(const f32x4*)(up + r * 256 + 4); }
        f32x4 g0, g1;
#pragma unroll
        for (int e = 0; e < 4; ++e) { g0[e] = logsigmoid_(z0[e]) * (1.f / 16.f); g1[e] = logsigmoid_(z1[e]) * (1.f / 16.f); }
        *(LAS f32x4*)(G + i * C::LDG + d8 * 8) = g0; *(LAS f32x4*)(G + i * C::LDG + d8 * 8 + 4) = g1;
        *(LAS bf16x8*)(Kb + i * C::LDK_ + d8 * 8) = raw.k;
    }
}
template <int TYPE>
__device__ __forceinline__ void cumsum_g(int dir, LAS unsigned char* lds, int tid) {
    using C = Cfg<TYPE>; constexpr int NSEG = 512 / C::DK, SEGL = 64 / NSEG;
    LAS float* G = (LAS float*)(lds + SC_G); LAS float* SG = (LAS float*)(lds + SC_SEG);
    const int d = tid % C::DK, seg = tid / C::DK;
    __syncthreads();
    float run = 0.f;
#pragma unroll
    for (int ii = 0; ii < SEGL; ++ii) { const int i = seg * SEGL + (dir ? SEGL - 1 - ii : ii); run += G[i * C::LDG + d]; G[i * C::LDG + d] = run; }
    SG[seg * 128 + d] = run;
    __syncthreads();
    float off = 0.f;
#pragma unroll
    for (int s = 0; s < NSEG; ++s) { const bool before = dir ? (s > seg) : (s < seg); if (before) off += SG[s * 128 + d]; }
#pragma unroll
    for (int ii = 0; ii < SEGL; ++ii) { const int i = seg * SEGL + ii; G[i * C::LDG + d] += off; }
    __syncthreads();
}
struct VRaw { bf16x8 x0, x1; };
__device__ __forceinline__ VRaw vT_issue(const bf16_t* vsrc, int tid) {
    const int i0 = tid >> 4, v8 = tid & 15; VRaw r;
    r.x0 = *(const bf16x8*)(vsrc + (size_t)i0 * DINP + v8 * 8); r.x1 = *(const bf16x8*)(vsrc + (size_t)(32 + i0) * DINP + v8 * 8); return r;
}
__device__ __forceinline__ void vT_write(const VRaw& r, LAS unsigned char* lds, int tid) {
    LAS bf16_t* VT = (LAS bf16_t*)(lds + SC_VT);
    const int v8 = tid & 15;
#pragma unroll
    for (int e2 = 0; e2 < 2; ++e2) { const int i = (tid >> 4) + 32 * e2; const bf16x8 x = e2 ? r.x1 : r.x0; const int pc = ((((i >> 3) ^ (v8 & 7)) << 3) | (i & 7));
#pragma unroll
        for (int e = 0; e < 8; ++e) VT[(v8 * 8 + e) * LDT + pc] = (bf16_t)x[e]; }
}
__device__ __forceinline__ bf16x8 vt_frag(LAS bf16_t* VT, int v, int c8) {
    return *(LAS bf16x8*)(VT + v * LDT + ((c8 ^ ((v >> 3) & 7)) << 3));
}

template <int TYPE>
__device__ __forceinline__ void pass1_item(const KArgs& a, int l, int item, LAS unsigned char* lds) {
    unsigned char* const wsb = opq(a.ws);
    const int tid = opaque_tid();
    using C = Cfg<TYPE>; constexpr int DK = C::DK;
    const int c = item & (NCH - 1), dir = (item >> 8) & 1, h = (item >> 9) & 3, b = item >> 11;
    const size_t tok0 = (size_t)b * T + (size_t)c * 64;
    const bf16_t* u = (const bf16_t*)(wsb + WS_U);
    const int wid = tid >> 6, lane = tid & 63, fr = lane & 15, fq = lane >> 4;
    __syncthreads();
    { const LgRaw raw = lg_issue<TYPE>(u, h, dir, tok0, tid); const VRaw vr = vT_issue(u + tok0 * DINP + (TYPE ? C_HI : C_GV) + h * 128, tid);
      lg_compute<TYPE>(a, wsb, l, h, dir, raw, lds, tid); vT_write(vr, lds, tid); }
    cumsum_g<TYPE>(dir, lds, tid);
    LAS float* G = (LAS float*)(lds + SC_G); LAS bf16_t* Kb = (LAS bf16_t*)(lds + SC_K); LAS bf16_t* KDT = (LAS bf16_t*)(lds + SC_KDT); LAS bf16_t* VT = (LAS bf16_t*)(lds + SC_VT);
    const int last = dir ? 0 : 63;
    float* Dout = (float*)(wsb + (TYPE ? WS_DH : WS_DG)) + (size_t)item * DK;
#pragma unroll
    for (int e2 = 0; e2 < DK / 64; ++e2) { const int task = tid + 512 * e2, i = task & 63, d8 = task >> 6;
        const f32x4 g0 = *(LAS f32x4*)(G + i * C::LDG + d8 * 8), g1 = *(LAS f32x4*)(G + i * C::LDG + d8 * 8 + 4);
        const f32x4 t0 = *(LAS f32x4*)(G + last * C::LDG + d8 * 8), t1 = *(LAS f32x4*)(G + last * C::LDG + d8 * 8 + 4);
        float kk[8]; unpack8(*(LAS bf16x8*)(Kb + i * C::LDK_ + d8 * 8), kk);
#pragma unroll
        for (int e = 0; e < 8; ++e) { const float gg = e < 4 ? g0[e] : g1[e - 4], tt = e < 4 ? t0[e] : t1[e - 4];
            KDT[(d8 * 8 + e) * LDT + i] = (bf16_t)f2bf(kk[e] * __expf(tt - gg)); }
        if (i == 0) { *(f32x4*)(Dout + d8 * 8) = (f32x4){__expf(t0[0]), __expf(t0[1]), __expf(t0[2]), __expf(t0[3])};
                      *(f32x4*)(Dout + d8 * 8 + 4) = (f32x4){__expf(t1[0]), __expf(t1[1]), __expf(t1[2]), __expf(t1[3])}; } }
    __syncthreads();
    bf16_t* ST = (bf16_t*)(wsb + (TYPE ? WS_SH : WS_SG)) + (size_t)item * 128 * DK;
    const bf16x8 b0 = vt_frag(VT, wid * 16 + fr, fq), b1 = vt_frag(VT, wid * 16 + fr, 4 + fq);
#pragma unroll
    for (int dt = 0; dt < DK / 16; ++dt) {
        const bf16x8 a0 = *(LAS bf16x8*)(KDT + (dt * 16 + fr) * LDT + fq * 8), a1 = *(LAS bf16x8*)(KDT + (dt * 16 + fr) * LDT + 32 + fq * 8);
        f32x4 acc = {0.f, 0.f, 0.f, 0.f};
        acc = __builtin_amdgcn_mfma_f32_16x16x32_bf16(a0, b0, acc, 0, 0, 0);
        acc = __builtin_amdgcn_mfma_f32_16x16x32_bf16(a1, b1, acc, 0, 0, 0);
        u32x2 w; w.x = cvt_pk_bf16(acc[0], acc[1]); w.y = cvt_pk_bf16(acc[2], acc[3]);
        *(u32x2*)(ST + (size_t)(wid * 16 + fr) * DK + dt * 16 + fq * 4) = w;
    }
}

struct P2Chain { bf16_t* st; const float* dp; size_t sstride; int dstride; int dir; };
__device__ __forceinline__ P2Chain p2_chain(unsigned char* wsb, int type, int E) {
    const int DK = type ? 128 : 64, IPI = 128 * DK;
    const int chain = E / IPI, e = E % IPI;
    P2Chain c; c.st = (bf16_t*)(wsb + (type ? WS_SH : WS_SG)) + (size_t)chain * NCH * IPI + e;
    c.dp = (const float*)(wsb + (type ? WS_DH : WS_DG)) + (size_t)chain * NCH * DK + (e % DK);
    c.sstride = (size_t)IPI; c.dstride = DK; c.dir = chain & 1; return c;
}
__device__ __forceinline__ void pass2_triple(const KArgs& a, int t) {
    unsigned char* const wsb = opq(a.ws);
    const P2Chain c0 = p2_chain(wsb, 1, t), c1 = p2_chain(wsb, 1, t + 131072), c2 = p2_chain(wsb, 0, t);
    float s0 = 0.f, s1 = 0.f, s2 = 0.f;
    unsigned short uA[3][4], uB[3][4]; float dA[3][4], dB[3][4];
#define P2_CI(c, s) ((c).dir ? NCH - 1 - (s) : (s))
#define P2_LOAD(U, D, sb) do { _Pragma("unroll") for (int k = 0; k < 4; ++k) { \
        const int i0_ = P2_CI(c0, (sb) + k), i1_ = P2_CI(c1, (sb) + k), i2_ = P2_CI(c2, (sb) + k); \
        U[0][k] = c0.st[(size_t)i0_ * c0.sstride]; D[0][k] = c0.dp[(size_t)i0_ * c0.dstride]; \
        U[1][k] = c1.st[(size_t)i1_ * c1.sstride]; D[1][k] = c1.dp[(size_t)i1_ * c1.dstride]; \
        U[2][k] = c2.st[(size_t)i2_ * c2.sstride]; D[2][k] = c2.dp[(size_t)i2_ * c2.dstride]; } } while (0)
#define P2_STEP(U, D, sb) do { _Pragma("unroll") for (int k = 0; k < 4; ++k) { \
        const int i0_ = P2_CI(c0, (sb) + k), i1_ = P2_CI(c1, (sb) + k), i2_ = P2_CI(c2, (sb) + k); \
        c0.st[(size_t)i0_ * c0.sstride] = (bf16_t)f2bf(s0); s0 = D[0][k] * s0 + bf2f(U[0][k]); \
        c1.st[(size_t)i1_ * c1.sstride] = (bf16_t)f2bf(s1); s1 = D[1][k] * s1 + bf2f(U[1][k]); \
        c2.st[(size_t)i2_ * c2.sstride] = (bf16_t)f2bf(s2); s2 = D[2][k] * s2 + bf2f(U[2][k]); } } while (0)
    P2_LOAD(uA, dA, 0);
#pragma unroll 1
    for (int sb = 0; sb < NCH; sb += 8) {
        P2_LOAD(uB, dB, sb + 4);
        P2_STEP(uA, dA, sb);
        if (sb + 8 < NCH) P2_LOAD(uA, dA, sb + 8);
        P2_STEP(uB, dB, sb + 4);
    }
#undef P2_CI
#undef P2_LOAD
#undef P2_STEP
}

template <int TYPE>
__device__ __forceinline__ void pass3_item(const KArgs& a, int l, int item, LAS unsigned char* lds) {
    unsigned char* const wsb = opq(a.ws);
    const int tid = opaque_tid();
    using C = Cfg<TYPE>; constexpr int DK = C::DK;
    const int c = item & (NCH - 1), h = (item >> 8) & 3, b = item >> 10;
    const size_t tok0 = (size_t)b * T + (size_t)c * 64;
    const bf16_t* u = (const bf16_t*)(wsb + WS_U);
    const int wid = tid >> 6, lane = tid & 63, fr = lane & 15, fq = lane >> 4;
    LAS float* G = (LAS float*)(lds + SC_G); LAS bf16_t* Kb = (LAS bf16_t*)(lds + SC_K); LAS bf16_t* QT = (LAS bf16_t*)(lds + SC_QT); LAS bf16_t* QG = (LAS bf16_t*)(lds + SC_QG);
    LAS bf16_t* VT = (LAS bf16_t*)(lds + SC_VT); LAS bf16_t* P = (LAS bf16_t*)(lds + SC_P); LAS float* RSQ = (LAS float*)(lds + SC_RSQ);
    const VRaw vr = vT_issue(u + tok0 * DINP + (TYPE ? C_HI : C_GV) + h * 128, tid);
    bf16x8 qraw[DK / 64];
#pragma unroll
    for (int e2 = 0; e2 < DK / 64; ++e2) { const int task = tid + 512 * e2, i = task / C::ND8, d8 = task % C::ND8;
        qraw[e2] = *(const bf16x8*)(u + (tok0 + i) * DINP + (TYPE ? C_HQ + h * 128 : C_GQ + h * 64) + d8 * 8); }
    const LgRaw raw0 = lg_issue<TYPE>(u, h, 0, tok0, tid), raw1 = lg_issue<TYPE>(u, h, 1, tok0, tid);
    __syncthreads();
    vT_write(vr, lds, tid);
    float qf[DK / 64][8];
#pragma unroll
    for (int e2 = 0; e2 < DK / 64; ++e2) { unpack8(qraw[e2], qf[e2]);
#pragma unroll
        for (int e = 0; e < 8; ++e) qf[e2][e] = TYPE ? silu_(qf[e2][e]) : qf[e2][e] * 0.125f; }
    f32x4 o[4];
#pragma unroll
    for (int it = 0; it < 4; ++it) o[it] = (f32x4){0.f, 0.f, 0.f, 0.f};
#pragma unroll 1
    for (int dir = 0; dir < 2; ++dir) {
        const int sitem = ((b * 4 + h) * 2 + dir) * NCH + c;
        const bf16_t* ST = (const bf16_t*)(wsb + (TYPE ? WS_SH : WS_SG)) + (size_t)sitem * 128 * DK + (size_t)(wid * 16 + fr) * DK + fq * 8;
        bf16x8 sf[DK / 32];
#pragma unroll
        for (int ks = 0; ks < DK / 32; ++ks) sf[ks] = *(const bf16x8*)(ST + ks * 32);
        if (dir) __syncthreads();
        { LgRaw rw; rw.a0 = dir ? raw1.a0 : raw0.a0; rw.a1 = dir ? raw1.a1 : raw0.a1; rw.k = dir ? raw1.k : raw0.k; lg_compute<TYPE>(a, wsb, l, h, dir, rw, lds, tid); }
        cumsum_g<TYPE>(dir, lds, tid);
#pragma unroll
        for (int e2 = 0; e2 < DK / 64; ++e2) { const int task = tid + 512 * e2, i = task / C::ND8, d8 = task % C::ND8;
            const f32x4 g0 = *(LAS f32x4*)(G + i * C::LDG + d8 * 8), g1 = *(LAS f32x4*)(G + i * C::LDG + d8 * 8 + 4);
            const f32x4 m0 = *(LAS f32x4*)(G + 32 * C::LDG + d8 * 8), m1 = *(LAS f32x4*)(G + 32 * C::LDG + d8 * 8 + 4);
            float kk[8], qq[8], qt[8], qg[8]; unpack8(*(LAS bf16x8*)(Kb + i * C::LDK_ + d8 * 8), kk);
#pragma unroll
            for (int e = 0; e < 8; ++e) qq[e] = qf[e2][e];
#pragma unroll
            for (int e = 0; e < 8; ++e) { const float gg = e < 4 ? g0[e] : g1[e - 4], gm = e < 4 ? m0[e] : m1[e - 4];
                const float q = qq[e];
                qt[e] = q * __expf(gg - gm); qg[e] = q * __expf(gg); kk[e] = kk[e] * __expf(gm - gg); }
            *(LAS bf16x8*)(QT + i * C::LDK_ + d8 * 8) = pack8(qt); *(LAS bf16x8*)(QG + i * C::LDK_ + d8 * 8) = pack8(qg); *(LAS bf16x8*)(Kb + i * C::LDK_ + d8 * 8) = pack8(kk); }
        __syncthreads();
        { const int it = wid >> 1;
#pragma unroll
          for (int jj = 0; jj < 2; ++jj) { const int jt = 2 * (wid & 1) + jj;
            f32x4 acc = {0.f, 0.f, 0.f, 0.f};
#pragma unroll
            for (int ks = 0; ks < DK / 32; ++ks) {
                const bf16x8 af = *(LAS bf16x8*)(QT + (it * 16 + fr) * C::LDK_ + ks * 32 + fq * 8), bfr = *(LAS bf16x8*)(Kb + (jt * 16 + fr) * C::LDK_ + ks * 32 + fq * 8);
                acc = __builtin_amdgcn_mfma_f32_16x16x32_bf16(af, bfr, acc, 0, 0, 0); }
#pragma unroll
            for (int r = 0; r < 4; ++r) { const int i = it * 16 + fq * 4 + r, j = jt * 16 + fr; const bool keep = dir ? (j >= i) : (j <= i);
                P[i * LDT + j] = (bf16_t)f2bf(keep ? acc[r] : 0.f); } } }
        __syncthreads();
        const bf16x8 vb0 = vt_frag(VT, wid * 16 + fr, fq), vb1 = vt_frag(VT, wid * 16 + fr, 4 + fq);
#pragma unroll
        for (int it = 0; it < 4; ++it) {
            const bf16x8 p0 = *(LAS bf16x8*)(P + (it * 16 + fr) * LDT + fq * 8), p1 = *(LAS bf16x8*)(P + (it * 16 + fr) * LDT + 32 + fq * 8);
            o[it] = __builtin_amdgcn_mfma_f32_16x16x32_bf16(p0, vb0, o[it], 0, 0, 0);
            o[it] = __builtin_amdgcn_mfma_f32_16x16x32_bf16(p1, vb1, o[it], 0, 0, 0);
#pragma unroll
            for (int ks = 0; ks < DK / 32; ++ks) { const bf16x8 af = *(LAS bf16x8*)(QG + (it * 16 + fr) * C::LDK_ + ks * 32 + fq * 8);
                o[it] = __builtin_amdgcn_mfma_f32_16x16x32_bf16(af, sf[ks], o[it], 0, 0, 0); }
        }
    }
#pragma unroll
    for (int it = 0; it < 4; ++it)
#pragma unroll
        for (int r = 0; r < 4; ++r) { float s = o[it][r] * o[it][r];
            s += __builtin_bit_cast(float, __builtin_amdgcn_update_dpp(0, __builtin_bit_cast(int, s), 0xB1, 0xF, 0xF, true));
            s += __builtin_bit_cast(float, __builtin_amdgcn_update_dpp(0, __builtin_bit_cast(int, s), 0x4E, 0xF, 0xF, true));
            s += __builtin_bit_cast(float, __builtin_amdgcn_update_dpp(0, __builtin_bit_cast(int, s), 0x141, 0xF, 0xF, true));
            s += __builtin_bit_cast(float, __builtin_amdgcn_update_dpp(0, __builtin_bit_cast(int, s), 0x140, 0xF, 0xF, true));
            RSQ[wid * 64 + it * 16 + fq * 4 + r] = s; }
    __syncthreads();
    LAS float* RSTD = (LAS float*)(lds + SC_SEG);
    if (tid < 64) { float s = 0.f;
#pragma unroll
        for (int w = 0; w < 8; ++w) s += RSQ[w * 64 + tid];
        RSTD[tid] = rsqrtf(s * (1.f / 128.f) + EPS); }
    __syncthreads();
    const float gain = ((const float*)a.in[TYPE ? 7 : 5])[l * 128 + wid * 16 + fr];
    bf16_t* mix = (bf16_t*)(wsb + WS_XN);
    float gtv[4][4];
#pragma unroll
    for (int it = 0; it < 4; ++it)
#pragma unroll
        for (int r = 0; r < 4; ++r) gtv[it][r] = bf2f(u[(tok0 + it * 16 + fq * 4 + r) * DINP + (TYPE ? C_HG : C_GG) + h * 128 + wid * 16 + fr]);
#pragma unroll
    for (int it = 0; it < 4; ++it)
#pragma unroll
        for (int r = 0; r < 4; ++r) { const int i = it * 16 + fq * 4 + r;
            const float rstd = RSTD[i];
            const float gt = gtv[it][r];
            const float yv = o[it][r] * rstd * gain * silu_(gt);
            mix[(tok0 + i) * DM + (TYPE ? 512 : 0) + h * 128 + wid * 16 + fr] = (bf16_t)f2bf(yv); }
}
}
__device__ __forceinline__ void rmsnorm_rows_bf16(const float* src, const float* gain, bf16_t* dst) {
    const int tid = opaque_tid(), lane = tid & 63, gw = blockIdx.x * 8 + (tid >> 6), ngw = gridDim.x * 8;
    for (int m = gw; m < M; m += ngw) {
        const f32x4* xr = (const f32x4*)(src + (size_t)m * DM) + lane;
        f32x4 v[8]; float s = 0.f;
#pragma unroll
        for (int j = 0; j < 8; ++j) { v[j] = xr[64 * j]; s += (v[j][0] * v[j][0] + v[j][1] * v[j][1]) + (v[j][2] * v[j][2] + v[j][3] * v[j][3]); }
        const float rstd = rsqrtf(wave_sum(s) * (1.f / DM) + EPS);
        u32x2* o8 = (u32x2*)(dst + (size_t)m * DM) + lane;
#pragma unroll
        for (int j = 0; j < 8; ++j) { const f32x4 g = ((const f32x4*)gain)[lane + 64 * j];
            u32x2 w; w.x = cvt_pk_bf16(v[j][0] * rstd * g[0], v[j][1] * rstd * g[1]); w.y = cvt_pk_bf16(v[j][2] * rstd * g[2], v[j][3] * rstd * g[3]); o8[64 * j] = w; }
    }
}
__device__ __forceinline__ void cast_rows_bf16(const float* src, bf16_t* dst, float* rsq) {
    const int tid = opaque_tid(), lane = tid & 63, gw = blockIdx.x * 8 + (tid >> 6), ngw = gridDim.x * 8;
    for (int m = gw; m < M; m += ngw) {
        const f32x4* xr = (const f32x4*)(src + (size_t)m * DM) + lane;
        f32x4 v[8]; float s = 0.f;
#pragma unroll
        for (int j = 0; j < 8; ++j) { v[j] = xr[64 * j]; s += (v[j][0] * v[j][0] + v[j][1] * v[j][1]) + (v[j][2] * v[j][2] + v[j][3] * v[j][3]); }
        s = wave_sum(s);
        if (lane == 0) rsq[m] = s;
        u32x2* o8 = (u32x2*)(dst + (size_t)m * DM) + lane;
#pragma unroll
        for (int j = 0; j < 8; ++j) { u32x2 w; w.x = cvt_pk_bf16(v[j][0], v[j][1]); w.y = cvt_pk_bf16(v[j][2], v[j][3]); o8[64 * j] = w; }
    }
}
__device__ __forceinline__ void rmsnorm_rows_bf16_to_f32(const bf16_t* src, const float* gain, float* dst) {
    const int tid = opaque_tid(), lane = tid & 63, gw = blockIdx.x * 8 + (tid >> 6), ngw = gridDim.x * 8;
    for (int m = gw; m < M; m += ngw) {
        const bf16x8* xr = (const bf16x8*)(src + (size_t)m * DM) + lane;
        float v[4][8]; float s = 0.f;
#pragma unroll
        for (int j = 0; j < 4; ++j) { unpack8(xr[64 * j], v[j]);
#pragma unroll
            for (int e = 0; e < 8; ++e) s += v[j][e] * v[j][e]; }
        const float rstd = rsqrtf(wave_sum(s) * (1.f / DM) + EPS);
#pragma unroll
        for (int j = 0; j < 4; ++j) { const int c = (lane + 64 * j) * 8; const f32x4 g0 = *(const f32x4*)(gain + c), g1 = *(const f32x4*)(gain + c + 4);
            f32x4 o0 = {v[j][0] * rstd * g0[0], v[j][1] * rstd * g0[1], v[j][2] * rstd * g0[2], v[j][3] * rstd * g0[3]};
            f32x4 o1 = {v[j][4] * rstd * g1[0], v[j][5] * rstd * g1[1], v[j][6] * rstd * g1[2], v[j][7] * rstd * g1[3]};
            *(f32x4*)(dst + (size_t)m * DM + c) = o0; *(f32x4*)(dst + (size_t)m * DM + c + 4) = o1; }
    }
}
__device__ __forceinline__ void rmsnorm_rows_f32_inplace(float* buf, const float* gain) {
    const int tid = opaque_tid(), lane = tid & 63, gw = blockIdx.x * 8 + (tid >> 6), ngw = gridDim.x * 8;
    for (int m = gw; m < M; m += ngw) {
        f32x4* xr = (f32x4*)(buf + (size_t)m * DM) + lane;
        f32x4 v[8]; float s = 0.f;
#pragma unroll
        for (int j = 0; j < 8; ++j) { v[j] = xr[64 * j]; s += (v[j][0] * v[j][0] + v[j][1] * v[j][1]) + (v[j][2] * v[j][2] + v[j][3] * v[j][3]); }
        const float rstd = rsqrtf(wave_sum(s) * (1.f / DM) + EPS);
#pragma unroll
        for (int j = 0; j < 8; ++j) { const f32x4 g = ((const f32x4*)gain)[lane + 64 * j]; xr[64 * j] = v[j] * rstd * g; }
    }
}
__device__ __forceinline__ void convert_weights(const KArgs& a, int l, LAS unsigned char* lds) {
    unsigned char* const wsb = opq(a.ws);
    const int tid = opaque_tid();
    LAS float* tile = (LAS float*)lds;
    constexpr int I_IN = 32 * 84, I_QB = 8 * 24, I_KVB = 8 * 32, I_OUT = 32 * 32, I_13 = 32 * 176, I_2 = 88 * 32, NIT = I_IN + I_QB + I_KVB + I_OUT + I_13 + I_2;
    for (int it = blockIdx.x; it < NIT; it += gridDim.x) {
        int r = it, mode = 0, N, K, nkt; const float* w0; const float* w1 = nullptr; const float* gk = nullptr; bf16_t* WT;
        if (r < I_IN) { w0 = (const float*)a.in[2] + (size_t)l * DM * DIN; N = DIN; K = DM; nkt = 32; gk = (const float*)a.in[13] + l * DM; WT = (bf16_t*)(wsb + WS_WIN); }
        else if ((r -= I_IN) < I_QB) { w0 = (const float*)a.in[9] + (size_t)l * 512 * 1536; N = 1536; K = 512; nkt = 8; mode = 1; WT = (bf16_t*)(wsb + WS_WQB); }
        else if ((r -= I_QB) < I_KVB) { w0 = (const float*)a.in[11] + (size_t)l * 512 * 2048; N = 2048; K = 512; nkt = 8; WT = (bf16_t*)(wsb + WS_WKVB); }
        else if ((r -= I_KVB) < I_OUT) { w0 = (const float*)a.in[12] + (size_t)l * DM * DM; N = DM; K = DM; nkt = 32; WT = (bf16_t*)(wsb + WS_WOUT); }
        else if ((r -= I_OUT) < I_13) { w0 = (const float*)a.in[15] + (size_t)l * DM * DFF; w1 = (const float*)a.in[16] + (size_t)l * DM * DFF; N = DFF; K = DM; nkt = 32; mode = 2; gk = (const float*)a.in[14] + l * DM; WT = (bf16_t*)(wsb + WS_W13); }
        else { r -= I_13; w0 = (const float*)a.in[17] + (size_t)l * DFF * DM; N = DM; K = DFF; nkt = 88; WT = (bf16_t*)(wsb + WS_W2); }
        const int kt = r % nkt, rt = r / nkt, r0 = rt * 64, k0 = kt * 64;
        __syncthreads();
        if (mode == 1) {
#pragma unroll
            for (int e = 0; e < 8; ++e) { const int idx = tid + 512 * e, rl = idx & 63, kl = idx >> 6, rr = r0 + rl, k = k0 + kl;
                const int hh = rr / 192, ee = rr % 192; const int col = ee < 128 ? hh * 192 + ee : hh * 192 + 128 + ((ee - 128) & 1) * 32 + ((ee - 128) >> 1);
                tile[kl * 65 + rl] = w0[(size_t)k * N + col]; }
        } else {
#pragma unroll
            for (int e = 0; e < 2; ++e) { const int idx = tid + 512 * e, r4 = (idx & 15) * 4, kl = idx >> 4, rr = r0 + r4, k = k0 + kl;
                f32x4 v = {0.f, 0.f, 0.f, 0.f};
                if (mode == 0) { if (rr < N) v = *(const f32x4*)(w0 + (size_t)k * N + rr); }
                else { const int g = rr >> 5, n = (rr >> 4) & 1, i = rr & 15; v = *(const f32x4*)((n ? w1 : w0) + (size_t)k * N + 16 * g + i); }
                if (gk) v = v * gk[k];
                tile[kl * 65 + r4] = v[0]; tile[kl * 65 + r4 + 1] = v[1]; tile[kl * 65 + r4 + 2] = v[2]; tile[kl * 65 + r4 + 3] = v[3]; }
        }
        __syncthreads();
        { const int k8 = tid & 7, rl = tid >> 3;
          u32x4 w; w.x = pk2(tile[(8 * k8 + 0) * 65 + rl], tile[(8 * k8 + 1) * 65 + rl]); w.y = pk2(tile[(8 * k8 + 2) * 65 + rl], tile[(8 * k8 + 3) * 65 + rl]);
          w.z = pk2(tile[(8 * k8 + 4) * 65 + rl], tile[(8 * k8 + 5) * 65 + rl]); w.w = pk2(tile[(8 * k8 + 6) * 65 + rl], tile[(8 * k8 + 7) * 65 + rl]);
          *(u32x4*)(WT + (size_t)(r0 + rl) * K + k0 + 8 * k8) = w; }
    }
    __syncthreads();
}
__device__ __forceinline__ void tables_phase(const KArgs& a) {
    unsigned char* const wsb = opq(a.ws);
    const int tid = opaque_tid();
    const int* pos = (const int*)a.in[1];
    float* cs = (float*)(wsb + WS_COS); float* sn = (float*)(wsb + WS_SIN);
    const int gt = blockIdx.x * 512 + tid, ngt = gridDim.x * 512;
    for (int idx = gt; idx < M * 32; idx += ngt) { const int tok = idx >> 5, i = idx & 31;
        const float inv = 1.0f / exp2f((float)(2 * i) * (1.f / 64.f) * 13.287712379549449f);
        const float ang = (float)pos[tok] * inv;
        double rev = (double)ang * 0.15915494309189535; rev -= rint(rev);
        const float f = (float)rev;
        cs[idx] = __builtin_amdgcn_cosf(f); sn[idx] = __builtin_amdgcn_sinf(f); }
    if (blockIdx.x == 0) { const float* lg = (const float*)a.in[6]; float* lb = (float*)(wsb + WS_LB);
        for (int p = tid; p < 2 * 512; p += 512) { const int dir = p >> 9, c = p & 511;
            float mx = -1e30f;
#pragma unroll
            for (int l = 0; l < DEPTH; ++l) mx = fmaxf(mx, lg[(dir * DEPTH + l) * 512 + c]);
            float den = 0.f;
#pragma unroll
            for (int l = 0; l < DEPTH; ++l) den += __expf(lg[(dir * DEPTH + l) * 512 + c] - mx);
            float cum = 0.f;
#pragma unroll
            for (int l = 0; l < DEPTH; ++l) { if (l > 0) cum += __expf(lg[(dir * DEPTH + l) * 512 + c] - mx) / den; lb[(dir * DEPTH + l) * 512 + c] = cum; } } }
}
__device__ __forceinline__ void mla_prep(const KArgs& a, int l) {
    unsigned char* const wsb = opq(a.ws);
    const int tid = opaque_tid(), lane = tid & 63, gw = blockIdx.x * 8 + (tid >> 6), ngw = gridDim.x * 8;
    bf16_t* u = (bf16_t*)(wsb + WS_U); bf16_t* kr = (bf16_t*)(wsb + WS_KR);
    const float* cs = (const float*)(wsb + WS_COS); const float* sn = (const float*)(wsb + WS_SIN);
    const float* gq = (const float*)a.in[8] + l * 512 + lane * 8; const float* gkv = (const float*)a.in[10] + l * 512 + lane * 8;
    const f32x4 gq0 = *(const f32x4*)gq, gq1 = *(const f32x4*)(gq + 4), gk0 = *(const f32x4*)gkv, gk1 = *(const f32x4*)(gkv + 4);
    const float gqv[8] = {gq0[0], gq0[1], gq0[2], gq0[3], gq1[0], gq1[1], gq1[2], gq1[3]}, gkv8[8] = {gk0[0], gk0[1], gk0[2], gk0[3], gk1[0], gk1[1], gk1[2], gk1[3]};
    for (int tok0 = gw; tok0 < M; tok0 += 2 * ngw) {
        bf16x8 raw[2][2]; float x1[2], x2[2], c[2], s[2]; bool ok[2];
#pragma unroll
        for (int j = 0; j < 2; ++j) { const int tok = tok0 + j * ngw; ok[j] = tok < M; const int tk = ok[j] ? tok : tok0; bf16_t* ur = u + (size_t)tk * DINP;
            raw[j][0] = *(const bf16x8*)(ur + C_CQ + lane * 8); raw[j][1] = *(const bf16x8*)(ur + C_CKV + lane * 8);
            x1[j] = bf2f(ur[C_KR + (lane & 31)]); x2[j] = bf2f(ur[C_KR + 32 + (lane & 31)]); c[j] = cs[(size_t)tk * 32 + (lane & 31)]; s[j] = sn[(size_t)tk * 32 + (lane & 31)]; }
#pragma unroll
        for (int j = 0; j < 2; ++j) { const int tok = tok0 + j * ngw; if (!ok[j]) continue; bf16_t* ur = u + (size_t)tok * DINP;
#pragma unroll
            for (int w = 0; w < 2; ++w) { float f[8]; unpack8(raw[j][w], f); float ssq = 0.f;
#pragma unroll
                for (int e = 0; e < 8; ++e) ssq += f[e] * f[e];
                const float rstd = rsqrtf(wave_sum(ssq) * (1.f / 512.f) + EPS);
#pragma unroll
                for (int e = 0; e < 8; ++e) f[e] = f[e] * rstd * (w ? gkv8[e] : gqv[e]);
                *(bf16x8*)(ur + (w ? C_CKV : C_CQ) + lane * 8) = pack8(f); }
            if (lane < 32) *(unsigned*)(kr + (size_t)tok * 64 + 2 * lane) = pk2(x1[j] * c[j] - x2[j] * s[j], x2[j] * c[j] + x1[j] * s[j]); }
    }
}

#define XB_TMO      128
#define XB_XCNT(j)  (256  + 64 * (j))
#define XB_XSUB(j)  (1280 + 64 * (j))
#define XB_XGEN(j)  (2304 + 64 * (j))
#define XB_TOP      3328
#define XB_TOPGEN   3392
#define XCD_BAR_WORDS 3456
#define XB_SPIN_CAP (1u << 18)

__device__ __forceinline__ unsigned xb_ld(unsigned* p)              { return __hip_atomic_load(p, __ATOMIC_RELAXED, __HIP_MEMORY_SCOPE_AGENT); }
__device__ __forceinline__ unsigned xb_add(unsigned* p, unsigned v) { return __hip_atomic_fetch_add(p, v, __ATOMIC_RELAXED, __HIP_MEMORY_SCOPE_AGENT); }
__device__ __forceinline__ unsigned xb_xcc_id() { return (unsigned)__builtin_amdgcn_s_getreg((3 << 11) | 20) & 0xFu; }
#define XB_SPIN(cond, bar) do { unsigned _sp = 0; while (cond) { __builtin_amdgcn_s_sleep(1); \
    if ((++_sp & 255u) == 0u) { if (xb_ld(&(bar)[XB_TMO])) break; if (_sp > XB_SPIN_CAP) { atomicAdd(&(bar)[XB_TMO], 1u); break; } } } } while (0)

struct XcdBarrier {
    unsigned* bar; unsigned x;
    volatile LAS unsigned* st;
};

__device__ __forceinline__ XcdBarrier xcd_barrier_post(unsigned* bar, volatile LAS unsigned* st) {
    XcdBarrier b; b.bar = bar; b.x = xb_xcc_id(); b.st = st;
    if (threadIdx.x == 0) (void)xb_add(&bar[XB_XCNT(b.x)], 1u);
    return b;
}
__device__ __forceinline__ void xcd_barrier_complete(unsigned* bar, unsigned x, unsigned& nloc, unsigned& nx) {
    const unsigned G = gridDim.x * gridDim.y * gridDim.z;
    unsigned sum, cnt, mine, sp = 0u;
    for (;;) {
        sum = 0u; cnt = 0u; mine = 0u;
#pragma unroll
        for (unsigned j = 0; j < 16; ++j) { const unsigned c = xb_ld(&bar[XB_XCNT(j)]); sum += c; cnt += (c > 0u) ? 1u : 0u; mine = (j == x) ? c : mine; }
        if (sum == G) break;
        __builtin_amdgcn_s_sleep(1);
        if ((++sp & 255u) == 0u) { if (xb_ld(&bar[XB_TMO])) break; if (sp > XB_SPIN_CAP) { atomicAdd(&bar[XB_TMO], 1u); break; } }
    }
    nloc = mine > 0u ? mine : 1u; nx = cnt > 0u ? cnt : 1u;
}

__device__ __forceinline__ void xcd_barrier(const XcdBarrier& b) {
    asm volatile("s_waitcnt vmcnt(0)" ::: "memory");
    __syncthreads();
    if (threadIdx.x == 0) {
        unsigned* bar = b.bar;
        __builtin_amdgcn_s_waitcnt(0);
        unsigned nloc = b.st[0], nx = b.st[1];
        if (nloc == 0u) { xcd_barrier_complete(bar, b.x, nloc, nx); b.st[0] = nloc; b.st[1] = nx; }
        const unsigned old = xb_add(&bar[XB_XSUB(b.x)], 1u);
        const unsigned gen = old / nloc;
        if (old + 1u == (gen + 1u) * nloc) {
            __builtin_amdgcn_fence(__ATOMIC_RELEASE, "agent");
            asm volatile("s_waitcnt vmcnt(0)" ::: "memory");
            const unsigned og = xb_add(&bar[XB_TOP], 1u);
            const unsigned tg = og / nx;
            if (og + 1u == (tg + 1u) * nx) xb_add(&bar[XB_TOPGEN], 1u);
            else XB_SPIN(xb_ld(&bar[XB_TOPGEN]) == tg, bar);
            __builtin_amdgcn_fence(__ATOMIC_ACQUIRE, "agent");
            xb_add(&bar[XB_XGEN(b.x)], 1u);
            asm volatile("s_waitcnt vmcnt(0)" ::: "memory");
        } else {
            XB_SPIN(xb_ld(&bar[XB_XGEN(b.x)]) == gen, bar);
            __builtin_amdgcn_fence(__ATOMIC_ACQUIRE, "agent");
            asm volatile("s_waitcnt vmcnt(0)" ::: "memory");
        }
    }
    __syncthreads();
}
__device__ __forceinline__ void reduce_slots(const float* slots, float* rsq) {
    for (int row = blockIdx.x * 512 + opaque_tid(); row < M; row += gridDim.x * 512) {
        const f32x4* s4 = (const f32x4*)(slots + (size_t)row * 32); float s = 0.f;
#pragma unroll
        for (int j = 0; j < 8; ++j) { const f32x4 v = s4[j]; s += (v[0] + v[1]) + (v[2] + v[3]); }
        rsq[row] = s; }
}
__global__ void __launch_bounds__(512, 2) mega_fwd(KArgs a) {
    extern __shared__ __attribute__((aligned(16))) unsigned char smem[];
    cg::grid_group grid = cg::this_grid();
    LAS unsigned char* lds = (LAS unsigned char*)smem;
    const int G = gridDim.x, bx = blockIdx.x;
    const float* x = (const float*)a.in[0];
    grid.sync();
    if (threadIdx.x < 16) ((LAS unsigned*)(lds + 131072))[threadIdx.x] = 0u;
    __syncthreads();
    (void)xcd_barrier_post((unsigned*)(a.ws + WS_BAR), (volatile LAS unsigned*)(lds + 131072));
#define GBAR() do { XcdBarrier xb_; xb_.bar = (unsigned*)(opq(a.ws) + WS_BAR); xb_.x = xb_xcc_id(); xb_.st = (volatile LAS unsigned*)(lds + 131072); xcd_barrier(xb_); } while (0)

#if PH_MISC
    tables_phase(a);
    convert_weights(a, 0, lds);
#if PROBE_CVT_REP > 1
    convert_weights(a, 0, lds);
#endif
#endif
    cast_rows_bf16(x, (bf16_t*)(opq(a.ws) + WS_XN), (float*)(opq(a.ws) + WS_RSQ) + 4 * M);
    GBAR();
#pragma unroll 1
    for (int l = 0; l < DEPTH; ++l) {
        if (l > 0) {
#if PH_MISC
            convert_weights(a, l, lds);
            reduce_slots((const float*)(opq(a.ws) + WS_SLOT) + (size_t)(2 + (l - 1)) * M * 32, (float*)(opq(a.ws) + WS_RSQ) + (size_t)(2 + (l - 1)) * M);
#if PROBE_CVT_REP > 1
            convert_weights(a, l, lds);
#endif
#endif
            GBAR();
        }
        { pg8::Gemm g{(const bf16_t*)(opq(a.ws) + WS_XN), (const bf16_t*)(opq(a.ws) + WS_WIN), M, DINP, DM, DM, DM}; pg8::StaticOrder S; S.init(M, DINP, G, bx);
          pg8::EpiU E{(bf16_t*)(opq(a.ws) + WS_U), DINP, (const float*)(opq(a.ws) + WS_RSQ) + (size_t)(l == 0 ? 4 : 2 + (l - 1)) * M, nullptr};
          __syncthreads(); if (PH_GEMM & 1) pg8::gemm_phase<pg8::EpiU, pg8::StaticOrder, true, true>(lds, g, S, E);
#if PROBE_GEMM_REP > 1
          __syncthreads(); if (PH_GEMM & 1) pg8::gemm_phase<pg8::EpiU, pg8::StaticOrder, true, true>(lds, g, S, E);
#endif
 }
        GBAR();
#if PH_MISC
        mla_prep(a, l);
#endif
#if PH_S1
        for (int it = bx; it < 4096; it += G) scan::pass1_item<1>(a, l, it, lds);
        for (int it = bx; it < 4096; it += G) scan::pass1_item<0>(a, l, it, lds);
#if PROBE_SCAN_REP > 1
        for (int it = bx; it < 4096; it += G) scan::pass1_item<1>(a, l, it, lds);
        for (int it = bx; it < 4096; it += G) scan::pass1_item<0>(a, l, it, lds);
#endif
#endif
        GBAR();
#if PH_S2
        for (int t = bx * 512 + opaque_tid(); t < 131072; t += G * 512) scan::pass2_triple(a, t);
#endif
        { pg8::Gemm g{(const bf16_t*)(opq(a.ws) + WS_U) + C_CQ, (const bf16_t*)(opq(a.ws) + WS_WQB), M, 1536, 512, DINP, 512}; pg8::StaticOrder S; S.init(M, 1536, G, bx);
          pg8::EpiQ E{(bf16_t*)(opq(a.ws) + WS_Q), (const float*)(opq(a.ws) + WS_COS), (const float*)(opq(a.ws) + WS_SIN)};
          __syncthreads(); if (PH_GEMM & 2) pg8::gemm_phase<pg8::EpiQ, pg8::StaticOrder, true, true>(lds, g, S, E);
#if PROBE_GEMM_REP > 1
          __syncthreads(); if (PH_GEMM & 2) pg8::gemm_phase<pg8::EpiQ, pg8::StaticOrder, true, true>(lds, g, S, E);
#endif
 }
        { pg8::Gemm g{(const bf16_t*)(opq(a.ws) + WS_U) + C_CKV, (const bf16_t*)(opq(a.ws) + WS_WKVB), M, 2048, 512, DINP, 512}; pg8::StaticOrder S; S.init(M, 2048, G, bx);
          pg8::EpiKV E{(bf16_t*)(opq(a.ws) + WS_KN), (bf16_t*)(opq(a.ws) + WS_V)};
          __syncthreads(); if (PH_GEMM & 4) pg8::gemm_phase<pg8::EpiKV, pg8::StaticOrder, true, true>(lds, g, S, E);
#if PROBE_GEMM_REP > 1
          __syncthreads(); if (PH_GEMM & 4) pg8::gemm_phase<pg8::EpiKV, pg8::StaticOrder, true, true>(lds, g, S, E);
#endif
 }
        GBAR();
        { const bool x8 = (G % 8) == 0; const int xcd = bx & 7, slot = bx >> 3, nslot = G >> 3;
          for (int pr = 0; pr < (x8 ? 2 : 16); ++pr) { const int p = x8 ? xcd + 8 * pr : pr, b = p >> 3, h = p & 7;
            for (int qb = x8 ? slot : bx; qb < 64; qb += x8 ? nslot : G) {
              const bf16_t* Qb = (const bf16_t*)(opq(a.ws) + WS_Q) + ((size_t)(b * 8 + h) * T + (size_t)qb * 256) * 192;
              const bf16_t* Kn = (const bf16_t*)(opq(a.ws) + WS_KN) + (size_t)(b * 8 + h) * T * 128;
              const bf16_t* Kr = (const bf16_t*)(opq(a.ws) + WS_KR) + (size_t)b * T * 64;
              const bf16_t* Vh = (const bf16_t*)(opq(a.ws) + WS_V) + (size_t)(b * 8 + h) * T * 128;
              bf16_t* Ob = (bf16_t*)(opq(a.ws) + WS_XN) + ((size_t)b * T + (size_t)qb * 256) * DM + 1024 + h * 128;
#if PH_ATT
              for (int rep_ = 0; rep_ < PROBE_ATT_REP; ++rep_) att::attn_unit(Qb, Kn, Kr, Vh, Ob, (char*)smem);
#else
              { const int t_ = opaque_tid(); bf16_t* zp = Ob + (size_t)(t_ >> 1) * DM + (t_ & 1) * 64; (void)Qb; (void)Kn; (void)Kr; (void)Vh;
                for (int z_ = 0; z_ < 8; ++z_) *(u32x4*)(zp + z_ * 8) = (u32x4){0u, 0u, 0u, 0u}; }
#endif
 } } }
#if PH_S3
        for (int it = bx; it < 2048; it += G) scan::pass3_item<1>(a, l, it, lds);
        for (int it = bx; it < 2048; it += G) scan::pass3_item<0>(a, l, it, lds);
#if PROBE_SCAN_REP > 1
        for (int it = bx; it < 2048; it += G) scan::pass3_item<1>(a, l, it, lds);
        for (int it = bx; it < 2048; it += G) scan::pass3_item<0>(a, l, it, lds);
#endif
#else
        { bf16_t* mz = (bf16_t*)(opq(a.ws) + WS_XN); for (size_t z_ = (size_t)bx * 512 + opaque_tid(); z_ < (size_t)M * 128; z_ += (size_t)G * 512) *(u32x4*)(mz + (z_ >> 7) * DM + (z_ & 127) * 8) = (u32x4){0u, 0u, 0u, 0u}; }
#endif
        GBAR();
        { pg8::Gemm g{(const bf16_t*)(opq(a.ws) + WS_XN), (const bf16_t*)(opq(a.ws) + WS_WOUT), M, DM, DM, DM, DM}; pg8::StaticOrder S; S.init(M, DM, G, bx);
          pg8::EpiRes E{l == 0 ? (const void*)x : (const void*)a.out, l == 0 ? 1 : 0, (bf16_t*)(opq(a.ws) + WS_HB), nullptr, (float*)(opq(a.ws) + WS_SLOT) + (size_t)l * M * 32};
          __syncthreads(); if (PH_GEMM & 8) pg8::gemm_phase<pg8::EpiRes, pg8::StaticOrder, true, true>(lds, g, S, E); }
        GBAR();
        reduce_slots((const float*)(opq(a.ws) + WS_SLOT) + (size_t)l * M * 32, (float*)(opq(a.ws) + WS_RSQ) + (size_t)l * M);
        GBAR();
        { pg8::Gemm g{(const bf16_t*)(opq(a.ws) + WS_HB), (const bf16_t*)(opq(a.ws) + WS_W13), M, 2 * DFF, DM, DM, DM}; pg8::StaticOrder S; S.init(M, 2 * DFF, G, bx);
          pg8::EpiSwi E{(bf16_t*)(opq(a.ws) + WS_HID), (const float*)(opq(a.ws) + WS_RSQ) + (size_t)l * M, nullptr};
          __syncthreads(); if (PH_GEMM & 16) pg8::gemm_phase<pg8::EpiSwi, pg8::StaticOrder, true, true>(lds, g, S, E);
#if PROBE_GEMM_REP > 1
          __syncthreads(); if (PH_GEMM & 16) pg8::gemm_phase<pg8::EpiSwi, pg8::StaticOrder, true, true>(lds, g, S, E);
#endif
 }
        GBAR();
        { pg8::Gemm g{(const bf16_t*)(opq(a.ws) + WS_HID), (const bf16_t*)(opq(a.ws) + WS_W2), M, DM, DFF, DFF, DFF}; pg8::StaticOrder S; S.init(M, DM, G, bx);
          pg8::EpiRes E{(const void*)(opq(a.ws) + WS_HB), 0, (bf16_t*)(opq(a.ws) + WS_XN), l + 1 < DEPTH ? (bf16_t*)a.out : nullptr, (float*)(opq(a.ws) + WS_SLOT) + (size_t)(2 + l) * M * 32};
          __syncthreads(); if (PH_GEMM & 32) pg8::gemm_phase<pg8::EpiRes, pg8::StaticOrder, true, true>(lds, g, S, E); }
        GBAR();
    }
    rmsnorm_rows_bf16_to_f32((const bf16_t*)(opq(a.ws) + WS_XN), (const float*)a.in[18], a.out);
}

extern "C" void kernel_launch(void* const* d_in, const int* in_sizes, int n_in, void* d_out, int out_size, void* d_ws, size_t ws_size, hipStream_t stream) {
    static int grid = 0;
    if (grid == 0) {
        if (n_in != 19 || out_size != M * DM || ws_size < WS_END) { fprintf(stderr, "kernel_launch: unexpected shapes (n_in %d out %d ws %zu)\n", n_in, out_size, ws_size); grid = -1; return; }
        int dev = 0, cus = 0, per_cu = 0;
        hipGetDevice(&dev); hipDeviceGetAttribute(&cus, hipDeviceAttributeMultiprocessorCount, dev);
        if (hipFuncSetAttribute((const void*)mega_fwd, hipFuncAttributeMaxDynamicSharedMemorySize, LDS_BYTES) != hipSuccess) { fprintf(stderr, "kernel_launch: hipFuncSetAttribute failed\n"); grid = -1; return; }
        if (hipOccupancyMaxActiveBlocksPerMultiprocessor(&per_cu, (const void*)mega_fwd, 512, LDS_BYTES) != hipSuccess || per_cu < 1) { fprintf(stderr, "kernel_launch: occupancy query says %d\n", per_cu); per_cu = 1; }
        (void)hipGetLastError();
        grid = cus * (per_cu > 1 ? 1 : per_cu);
    }
    if (grid < 0) return;
    KArgs a{};
    for (int i = 0; i < 19; ++i) a.in[i] = d_in[i];
    a.out = (float*)d_out; a.ws = (unsigned char*)d_ws;
    if (hipMemsetAsync((char*)d_ws + WS_BAR, 0, 16384, stream) != hipSuccess) { fprintf(stderr, "kernel_launch: memset failed\n"); return; }
    void* args[] = {&a};
    hipError_t e = hipLaunchCooperativeKernel((const void*)mega_fwd, dim3(grid), dim3(512), args, LDS_BYTES, stream);
    if (e != hipSuccess) fprintf(stderr, "kernel_launch: cooperative launch failed: %s (grid %d)\n", hipGetErrorString(e), grid);
}
```

```cpp
#include <hip/hip_runtime.h>
#include <hip/hip_cooperative_groups.h>
#include <cstdint>
#include <cstdio>
namespace cg = cooperative_groups;
#ifndef PROBE_GEMM_REP
#define PROBE_GEMM_REP 1
#endif
#ifndef PROBE_SCAN_REP
#define PROBE_SCAN_REP 1
#endif
#ifndef PROBE_CVT_REP
#define PROBE_CVT_REP 1
#endif
#ifndef PROBE_ATT_REP
#define PROBE_ATT_REP 1
#endif
#ifndef PH_ATT
#define PH_ATT 1
#endif
#ifndef PH_S1
#define PH_S1 1
#endif
#ifndef PH_S2
#define PH_S2 1
#endif
#ifndef PH_S3
#define PH_S3 1
#endif
#ifndef PH_GEMM
#define PH_GEMM 63
#endif
#ifndef PH_MISC
#define PH_MISC 1
#endif

#define LAS __attribute__((address_space(3)))
typedef unsigned short bf16_t;
typedef short bf16x8 __attribute__((ext_vector_type(8)));
typedef short s16x4 __attribute__((ext_vector_type(4)));
typedef float f32x2 __attribute__((ext_vector_type(2)));
typedef float f32x4 __attribute__((ext_vector_type(4)));
typedef float f32x16 __attribute__((ext_vector_type(16)));
typedef unsigned u32x2 __attribute__((ext_vector_type(2)));
typedef unsigned u32x4 __attribute__((ext_vector_type(4)));

constexpr int NB = 2, T = 16384, M = NB * T, DM = 2048, DIN = 5216, DINP = 5376, DFF = 5632, DEPTH = 2;
constexpr int C_GQ = 0, C_GK = 256, C_GV = 512, C_GAF = 1024, C_GAB = 1040, C_GG = 1056, C_HQ = 1568, C_HFF = 2080, C_HFB = 2592, C_HI = 3104, C_HG = 3616,
              C_CQ = 4128, C_CKV = 4640, C_KR = 5152;
constexpr float EPS = 1e-6f;
constexpr int NCH = T / 64;
constexpr size_t MiB = 1048576;
constexpr size_t WS_WIN = 0, WS_WQB = 21 * MiB, WS_WKVB = WS_WQB + 3 * MiB / 2, WS_WOUT = WS_WKVB + 2 * MiB, WS_W13 = WS_WOUT + 8 * MiB, WS_W2 = WS_W13 + 44 * MiB;
constexpr size_t WS_XN = 99 * MiB, WS_U = 227 * MiB, WS_Q = 563 * MiB, WS_KN = 659 * MiB, WS_V = 723 * MiB, WS_KR = 787 * MiB, WS_SG = 791 * MiB, WS_SH = 855 * MiB,
                 WS_DG = 983 * MiB, WS_DH = 984 * MiB, WS_COS = 986 * MiB, WS_SIN = 990 * MiB, WS_LB = 994 * MiB, WS_BAR = 995 * MiB, WS_RSQ = WS_BAR + 16384, WS_SLOT = 996 * MiB, WS_END = 1012 * MiB, WS_HB = WS_U, WS_HID = WS_U + 128 * MiB;
static_assert(WS_W2 + 22 * MiB <= WS_XN, "weights");
constexpr int LDS_BYTES = 131072 + 64;

struct KArgs { const void* in[19]; float* out; unsigned char* ws; };

__device__ __forceinline__ float bf2f(unsigned v) { return __uint_as_float(v << 16); }
__device__ __forceinline__ unsigned f2bf(float f) { unsigned u = __float_as_uint(f); return (u + 0x7fffu + ((u >> 16) & 1u)) >> 16; }
__device__ __forceinline__ unsigned pk2(float lo, float hi) { return f2bf(lo) | (f2bf(hi) << 16); }
typedef __bf16 bf16x2_t __attribute__((ext_vector_type(2)));
__device__ __forceinline__ unsigned cvt_pk_bf16(float lo, float hi) { f32x2 v = {lo, hi}; bf16x2_t b = __builtin_convertvector(v, bf16x2_t); return __builtin_bit_cast(unsigned, b); }
__device__ __forceinline__ float wave_sum(float v) {
#pragma unroll
    for (int o = 1; o < 64; o <<= 1) v += __shfl_xor(v, o);
    return v;
}
__device__ __forceinline__ unsigned char* opq(unsigned char* q) { asm volatile("" : "+s"(q)); return q; }
__device__ __forceinline__ int opaque_tid() { int t = threadIdx.x; asm volatile("" : "+v"(t)); return t; }
#define DBGF(ws_, cond_, bit_) do { if (cond_) atomicOr((unsigned*)((ws_) + WS_BAR) + 32, (unsigned)(bit_)); } while (0)
__device__ __forceinline__ bool badf(float v) { return !(fabsf(v) < 1e30f); }
__device__ __forceinline__ float sigmoid_(float z) { return __builtin_amdgcn_rcpf(1.f + __expf(-z)); }
__device__ __forceinline__ float silu_(float z) { return z * sigmoid_(z); }
__device__ __forceinline__ float logsigmoid_(float z) { return fminf(z, 0.f) - __logf(1.f + __expf(-fabsf(z))); }
__device__ __forceinline__ void unpack8(bf16x8 v, float* f) {
#pragma unroll
    for (int e = 0; e < 8; ++e) f[e] = bf2f((unsigned)(unsigned short)v[e]);
}
__device__ __forceinline__ bf16x8 pack8(const float* f) {
    u32x4 w = {cvt_pk_bf16(f[0], f[1]), cvt_pk_bf16(f[2], f[3]), cvt_pk_bf16(f[4], f[5]), cvt_pk_bf16(f[6], f[7])};
    return __builtin_bit_cast(bf16x8, w);
}

namespace pg8 {
#define PG8_LAS __attribute__((address_space(3)))
constexpr int BM = 256, BK = 64, HALF = 128, HTB = HALF * BK * 2, STAGE_BYTES = 8 * HTB, NXCD = 8, WGM = 8;
__host__ __device__ __forceinline__ int lds_byte(int r, int c) { const int st = (r >> 4) * 2 + (c >> 5), rr = r & 15, cc = c & 31, ob = rr * 64 + cc * 2; return st * 1024 + (ob ^ (((ob >> 9) & 1) << 5)); }
__host__ __device__ __forceinline__ void stage_rc(int b, int& R, int& C) { const int st = b / 1024, sb = b % 1024, swz = sb ^ (((sb >> 9) & 1) << 5); R = (st >> 1) * 16 + swz / 64; C = (st & 1) * 32 + (swz % 64) / 2; }
__host__ __device__ __forceinline__ int perm32(int rho) { const int n = rho >> 4, i = rho & 15; return 8 * (i >> 2) + 4 * n + (i & 3); }
struct Unit { int pm, pn; };
struct Gemm { const bf16_t* A; const bf16_t* Bt; int M, N, K, lda, ldb; };
struct StaticOrder {
    int nM, nN, nwg, G, c;
    __host__ __device__ void init(int M_, int N_, int G_, int c_) { nM = M_ / BM; nN = N_ / BM; nwg = nM * nN; G = G_; c = c_; }
    __host__ __device__ bool next(int i, Unit& u) const {
        const long L = (long)i * G + c; if (L >= nwg) return false;
        int wgid = (int)L; { const int q = nwg / NXCD, r = nwg % NXCD, xcd = wgid % NXCD, off = wgid / NXCD; wgid = (xcd < r ? xcd * (q + 1) : r * (q + 1) + (xcd - r) * q) + off; }
        const int nig = WGM * nN, gid = wgid / nig, fm = gid * WGM, gsz = (nM - fm) < WGM ? (nM - fm) : WGM;
        u.pm = fm + ((wgid % nig) % gsz); u.pn = (wgid % nig) / gsz; return true;
    }
    __device__ __forceinline__ void a_ready(const Unit&) const {}
    __device__ __forceinline__ void done(const Unit&) const {}
};
template <class Epi, class Sched, bool ALIGN_EPI = false, bool SP2 = false>
__device__ __forceinline__ void gemm_phase(PG8_LAS unsigned char* lds, const Gemm g, const Sched& S, const Epi& E) {
    const int tid = opaque_tid(), wid = __builtin_amdgcn_readfirstlane(tid >> 6), lane = tid & 63, wr = wid >> 2, wc = wid & 3, fr = lane & 15, fq = lane >> 4;
    const int K = g.K, nt = K / BK;
    unsigned voffA[2], voffB[2];
#pragma unroll
    for (int i = 0; i < 2; ++i) { int R, C; stage_rc(tid * 16 + i * 8192, R, C); const int Rb = Epi::PERM ? ((R & ~31) + perm32(R & 31)) : R;
        voffA[i] = (unsigned)(R * g.lda + C) * 2u; voffB[i] = (unsigned)(Rb * g.ldb + C) * 2u; }
    const size_t kstep = (size_t)(BK * 2);
    const size_t hstepA = (size_t)HALF * g.lda * 2, hstepB = (size_t)HALF * g.ldb * 2;
    const size_t tstepA = 2 * hstepA, tstepB = 2 * hstepB;
    const unsigned ldsw = (unsigned)wid * 1024u;
    const int aoff = lds_byte(wr * 64 + fr, fq * 8), boff = lds_byte(wc * 32 + fr, fq * 8);
#define PG8_SA(b, h) (((b) * 2 + (h)) * HTB)
#define PG8_SB(b, h) ((4 + (b) * 2 + (h)) * HTB)
#define PG8_STAGE(bufoff, gbase, voff) do { _Pragma("unroll") for (int _i = 0; _i < 2; ++_i) \
        __builtin_amdgcn_global_load_lds((const unsigned*)((const char*)(gbase) + (voff)[_i]), (PG8_LAS unsigned*)(lds + (bufoff) + ldsw + _i * 8192), 16, 0, 0); } while (0)
#define PG8_LDA(dst, b, h) do { _Pragma("unroll") for (int m = 0; m < 4; ++m) _Pragma("unroll") for (int k = 0; k < 2; ++k) dst[m][k] = *(const PG8_LAS bf16x8*)(lds + PG8_SA(b, h) + aoff + m * 2048 + k * 1024); } while (0)
#define PG8_LDB(dst, b, h) do { _Pragma("unroll") for (int n = 0; n < 2; ++n) _Pragma("unroll") for (int k = 0; k < 2; ++k) dst[n][k] = *(const PG8_LAS bf16x8*)(lds + PG8_SB(b, h) + boff + n * 2048 + k * 1024); } while (0)
#define PG8_MMA(ai, bj, At, Bt) do { __builtin_amdgcn_s_setprio(1); _Pragma("unroll") for (int m = 0; m < 4; ++m) _Pragma("unroll") for (int n = 0; n < 2; ++n) _Pragma("unroll") for (int k = 0; k < 2; ++k) \
        acc[ai][bj][m][n] = __builtin_amdgcn_mfma_f32_16x16x32_bf16(Bt[n][k], At[m][k], acc[ai][bj][m][n], 0, 0, 0); __builtin_amdgcn_s_setprio(0); } while (0)
#define PG8_WAIT_V(n) asm volatile("s_waitcnt vmcnt(" #n ")" ::: "memory")
#define PG8_WAIT_L(n) asm volatile("s_waitcnt lgkmcnt(" #n ")" ::: "memory")
#define PG8_BAR __builtin_amdgcn_s_barrier()
#define PG8_SCHED __builtin_amdgcn_sched_barrier(0)
    Unit cur, nxt; int ui = 0;
    if (!S.next(0, cur)) return;
    f32x4 acc[2][2][4][2];
#pragma unroll
    for (int a = 0; a < 2; ++a)
#pragma unroll
        for (int b = 0; b < 2; ++b)
#pragma unroll
            for (int m = 0; m < 4; ++m)
#pragma unroll
                for (int n = 0; n < 2; ++n) acc[a][b][m][n] = (f32x4){0.f, 0.f, 0.f, 0.f};
    bf16x8 At[4][2], B0[2][2], B1[2][2];
    const char* cA = (const char*)g.A + (size_t)cur.pm * tstepA; const char* cB = (const char*)g.Bt + (size_t)cur.pn * tstepB;
    S.a_ready(cur);
    if constexpr (SP2) {
        PG8_STAGE(PG8_SB(0, 0), cB, voffB); PG8_STAGE(PG8_SB(0, 1), cB + hstepB, voffB); PG8_STAGE(PG8_SA(0, 0), cA, voffA); PG8_STAGE(PG8_SA(0, 1), cA + hstepA, voffA);
        if (wr == 1) PG8_BAR;
        PG8_WAIT_V(2); PG8_BAR;
        PG8_STAGE(PG8_SB(1, 0), cB + kstep, voffB); PG8_STAGE(PG8_SA(1, 0), cA + kstep, voffA); PG8_STAGE(PG8_SB(1, 1), cB + hstepB + kstep, voffB);
        PG8_WAIT_V(6); PG8_BAR;
    } else {
        PG8_STAGE(PG8_SB(0, 0), cB, voffB); PG8_STAGE(PG8_SA(0, 0), cA, voffA); PG8_STAGE(PG8_SB(0, 1), cB + hstepB, voffB); PG8_STAGE(PG8_SA(0, 1), cA + hstepA, voffA);
        if (wr == 1) PG8_BAR;
        PG8_WAIT_V(4); PG8_BAR;
        PG8_STAGE(PG8_SB(1, 0), cB + kstep, voffB); PG8_STAGE(PG8_SA(1, 0), cA + kstep, voffA); PG8_STAGE(PG8_SB(1, 1), cB + hstepB + kstep, voffB);
        PG8_WAIT_V(6); PG8_BAR;
    }
    for (;;) {
        const bool has_next = S.next(ui + 1, nxt);
        const char* nA = has_next ? (const char*)g.A + (size_t)nxt.pm * tstepA : cA; const char* nB = has_next ? (const char*)g.Bt + (size_t)nxt.pn * tstepB : cB;
        for (int t = 0; t < nt; t += 2) {
            const bool last = (t == nt - 2);
            const char* a1 = cA + (size_t)(t + 1) * kstep;
            const char* a2 = last ? nA : cA + (size_t)(t + 2) * kstep; const char* b2 = last ? nB : cB + (size_t)(t + 2) * kstep;
            const char* a3 = a2 + kstep; const char* b3 = b2 + kstep;
            if (last && has_next) S.a_ready(nxt);
            if constexpr (SP2) {
            PG8_LDB(B0, 0, 0); PG8_LDB(B1, 0, 1); PG8_SCHED; PG8_LDA(At, 0, 0); PG8_STAGE(PG8_SA(1, 1), a1 + hstepA, voffA);
            PG8_WAIT_V(8); PG8_WAIT_L(0); PG8_BAR; PG8_MMA(0, 0, At, B0); PG8_MMA(0, 1, At, B1); PG8_BAR; PG8_SCHED;
            PG8_LDA(At, 0, 1); PG8_STAGE(PG8_SB(0, 0), b2, voffB); PG8_STAGE(PG8_SB(0, 1), b2 + hstepB, voffB); PG8_STAGE(PG8_SA(0, 0), a2, voffA);
            PG8_WAIT_V(8); PG8_WAIT_L(0); PG8_BAR; PG8_MMA(1, 0, At, B0); PG8_MMA(1, 1, At, B1); PG8_BAR; PG8_SCHED;
            PG8_LDB(B0, 1, 0); PG8_LDB(B1, 1, 1); PG8_SCHED; PG8_LDA(At, 1, 0); PG8_STAGE(PG8_SA(0, 1), a2 + hstepA, voffA);
            PG8_WAIT_V(8); PG8_WAIT_L(0); PG8_BAR; PG8_MMA(0, 0, At, B0); PG8_MMA(0, 1, At, B1); PG8_BAR; PG8_SCHED;
            PG8_LDA(At, 1, 1); PG8_STAGE(PG8_SB(1, 0), b3, voffB); PG8_STAGE(PG8_SB(1, 1), b3 + hstepB, voffB); PG8_STAGE(PG8_SA(1, 0), a3, voffA);
            PG8_WAIT_V(8); PG8_WAIT_L(0); PG8_BAR; PG8_MMA(1, 0, At, B0); PG8_MMA(1, 1, At, B1); PG8_BAR; PG8_SCHED;
            } else {
            PG8_LDB(B0, 0, 0); PG8_SCHED; PG8_LDA(At, 0, 0); PG8_STAGE(PG8_SA(1, 1), a1 + hstepA, voffA);
            PG8_WAIT_L(8); PG8_BAR; PG8_WAIT_L(0); PG8_MMA(0, 0, At, B0); PG8_BAR; PG8_SCHED;
            PG8_LDB(B1, 0, 1); PG8_STAGE(PG8_SB(0, 0), b2, voffB);
            PG8_BAR; PG8_WAIT_L(0); PG8_MMA(0, 1, At, B1); PG8_BAR;
            PG8_LDA(At, 0, 1); PG8_STAGE(PG8_SA(0, 0), a2, voffA);
            PG8_BAR; PG8_WAIT_L(0); PG8_MMA(1, 0, At, B0); PG8_BAR; PG8_SCHED;
            PG8_STAGE(PG8_SB(0, 1), b2 + hstepB, voffB);
            PG8_WAIT_V(6); PG8_BAR; PG8_MMA(1, 1, At, B1); PG8_BAR;
            PG8_LDB(B0, 1, 0); PG8_SCHED; PG8_LDA(At, 1, 0); PG8_STAGE(PG8_SA(0, 1), a2 + hstepA, voffA);
            PG8_WAIT_L(8); PG8_BAR; PG8_WAIT_L(0); PG8_MMA(0, 0, At, B0); PG8_BAR; PG8_SCHED;
            PG8_LDB(B1, 1, 1); PG8_STAGE(PG8_SB(1, 0), b3, voffB);
            PG8_BAR; PG8_WAIT_L(0); PG8_MMA(0, 1, At, B1); PG8_BAR;
            PG8_LDA(At, 1, 1); PG8_STAGE(PG8_SA(1, 0), a3, voffA);
            PG8_BAR; PG8_WAIT_L(0); PG8_MMA(1, 0, At, B0); PG8_BAR; PG8_SCHED;
            PG8_STAGE(PG8_SB(1, 1), b3 + hstepB, voffB);
            PG8_WAIT_V(6); PG8_BAR; PG8_MMA(1, 1, At, B1); PG8_BAR;
            }
        }
        if constexpr (ALIGN_EPI) { if (wr == 0) PG8_BAR; }
        if constexpr (!Epi::AFTER_DRAIN) { E(acc, cur, wr, wc, fr, fq); S.done(cur); }
        if (!has_next) break;
#pragma unroll
        for (int a = 0; a < 2; ++a)
#pragma unroll
            for (int b = 0; b < 2; ++b)
#pragma unroll
                for (int m = 0; m < 4; ++m)
#pragma unroll
                    for (int n = 0; n < 2; ++n) acc[a][b][m][n] = (f32x4){0.f, 0.f, 0.f, 0.f};
        cur = nxt; cA = nA; cB = nB; ++ui;
        if constexpr (ALIGN_EPI) { if (wr == 1) PG8_BAR; }
    }
    PG8_WAIT_V(0);
    if constexpr (!ALIGN_EPI) { if (wr == 0) PG8_BAR; }
    PG8_BAR;
    if constexpr (Epi::AFTER_DRAIN) { E.fused(acc, cur, wr, wc, fr, fq, lds, wid, lane); S.done(cur); }
#undef PG8_SA
#undef PG8_SB
#undef PG8_STAGE
#undef PG8_LDA
#undef PG8_LDB
#undef PG8_MMA
#undef PG8_WAIT_V
#undef PG8_WAIT_L
#undef PG8_BAR
#undef PG8_SCHED
}
__device__ __forceinline__ float row_stat(const float* plain, const float* slots, int row, int fq) {
    if (plain) return plain[row];
    const f32x4 a = *(const f32x4*)(slots + (size_t)row * 32 + fq * 8), b = *(const f32x4*)(slots + (size_t)row * 32 + fq * 8 + 4);
    float s = ((a[0] + a[1]) + (a[2] + a[3])) + ((b[0] + b[1]) + (b[2] + b[3]));
    s += __shfl_xor(s, 16); s += __shfl_xor(s, 32);
    return s;
}
struct EpiU {
    static constexpr bool PERM = true, AFTER_DRAIN = false;
    bf16_t* O; int ldc; const float* rsq; const float* slots;
    __device__ __forceinline__ void operator()(const f32x4 (&acc)[2][2][4][2], const Unit& u, int wr, int wc, int fr, int fq) const {
        const int row0 = u.pm * BM + wr * 64 + fr, col0 = u.pn * BM + wc * 32 + 8 * fq;
        float rsv[2][4];
#pragma unroll
        for (int ai = 0; ai < 2; ++ai)
#pragma unroll
            for (int m = 0; m < 4; ++m) rsv[ai][m] = row_stat(rsq, slots, row0 + ai * HALF + m * 16, fq);
#pragma unroll
        for (int ai = 0; ai < 2; ++ai)
#pragma unroll
            for (int m = 0; m < 4; ++m) { bf16_t* rowp = O + (size_t)(row0 + ai * HALF + m * 16) * ldc + col0;
                const float rs = rsqrtf(rsv[ai][m] * (1.f / DM) + EPS);
#pragma unroll
                for (int bj = 0; bj < 2; ++bj) { const f32x4 v0 = acc[ai][bj][m][0] * rs, v1 = acc[ai][bj][m][1] * rs;
                    u32x4 w; w.x = cvt_pk_bf16(v0[0], v0[1]); w.y = cvt_pk_bf16(v0[2], v0[3]); w.z = cvt_pk_bf16(v1[0], v1[1]); w.w = cvt_pk_bf16(v1[2], v1[3]);
                    *(u32x4*)(rowp + bj * HALF) = w; } }
    }
};
struct EpiQ {
    static constexpr bool PERM = true, AFTER_DRAIN = false;
    bf16_t* Q; const float* cs; const float* sn;
    __device__ __forceinline__ void operator()(const f32x4 (&acc)[2][2][4][2], const Unit& u, int wr, int wc, int fr, int fq) const {
        const int row0 = u.pm * BM + wr * 64 + fr;
#pragma unroll
        for (int ai = 0; ai < 2; ++ai) {
            f32x4 ccv[4][2], ssv[4][2];
#pragma unroll
            for (int m = 0; m < 4; ++m)
#pragma unroll
                for (int bj = 0; bj < 2; ++bj) { const int row = row0 + ai * HALF + m * 16, e = (u.pn * BM + bj * HALF + wc * 32 + 8 * fq) % 192, i0 = e >= 128 ? (e - 128) >> 1 : 0;
                    ccv[m][bj] = *(const f32x4*)(cs + (size_t)row * 32 + i0); ssv[m][bj] = *(const f32x4*)(sn + (size_t)row * 32 + i0); }
#pragma unroll
            for (int m = 0; m < 4; ++m) { const int row = row0 + ai * HALF + m * 16, b = row / T, t = row % T;
#pragma unroll
                for (int bj = 0; bj < 2; ++bj) { const int c = u.pn * BM + bj * HALF + wc * 32 + 8 * fq, hh = c / 192, e = c % 192;
                    const f32x4 v0 = acc[ai][bj][m][0], v1 = acc[ai][bj][m][1];
                    float vals[8] = {v0[0], v0[1], v0[2], v0[3], v1[0], v1[1], v1[2], v1[3]};
                    if (e >= 128) { const f32x4 cc = ccv[m][bj], ss = ssv[m][bj];
#pragma unroll
                        for (int p = 0; p < 4; ++p) { const float x1 = vals[2 * p], x2 = vals[2 * p + 1]; vals[2 * p] = x1 * cc[p] - x2 * ss[p]; vals[2 * p + 1] = x2 * cc[p] + x1 * ss[p]; } }
                    constexpr float QS = 0.07216878364870322f * 1.4426950408889634f;
#pragma unroll
                    for (int p_ = 0; p_ < 8; ++p_) vals[p_] *= QS;
                    u32x4 w; w.x = cvt_pk_bf16(vals[0], vals[1]); w.y = cvt_pk_bf16(vals[2], vals[3]); w.z = cvt_pk_bf16(vals[4], vals[5]); w.w = cvt_pk_bf16(vals[6], vals[7]);
                    *(u32x4*)(Q + ((size_t)(b * 8 + hh) * T + t) * 192 + e) = w; } } }
    }
};
struct EpiKV {
    static constexpr bool PERM = true, AFTER_DRAIN = false;
    bf16_t* KN; bf16_t* V;
    __device__ __forceinline__ void operator()(const f32x4 (&acc)[2][2][4][2], const Unit& u, int wr, int wc, int fr, int fq) const {
        const int row0 = u.pm * BM + wr * 64 + fr, e = wc * 32 + 8 * fq;
#pragma unroll
        for (int ai = 0; ai < 2; ++ai)
#pragma unroll
            for (int m = 0; m < 4; ++m) { const int row = row0 + ai * HALF + m * 16, b = row / T, t = row % T;
                const size_t off = ((size_t)(b * 8 + u.pn) * T + t) * 128 + e;
#pragma unroll
                for (int bj = 0; bj < 2; ++bj) { const f32x4 v0 = acc[ai][bj][m][0], v1 = acc[ai][bj][m][1];
                    u32x4 w; w.x = cvt_pk_bf16(v0[0], v0[1]); w.y = cvt_pk_bf16(v0[2], v0[3]); w.z = cvt_pk_bf16(v1[0], v1[1]); w.w = cvt_pk_bf16(v1[2], v1[3]);
                    *(u32x4*)((bj ? V : KN) + off) = w; } }
    }
};
struct EpiSwi {
    static constexpr bool PERM = false, AFTER_DRAIN = false;
    bf16_t* H; const float* rsq; const float* slots;
    __device__ __forceinline__ void operator()(const f32x4 (&acc)[2][2][4][2], const Unit& u, int wr, int wc, int fr, int fq) const {
        const int row0 = u.pm * BM + wr * 64 + fr;
        float rsv[2][4];
#pragma unroll
        for (int ai = 0; ai < 2; ++ai)
#pragma unroll
            for (int m = 0; m < 4; ++m) rsv[ai][m] = row_stat(rsq, slots, row0 + ai * HALF + m * 16, fq);
#pragma unroll
        for (int ai = 0; ai < 2; ++ai)
#pragma unroll
            for (int m = 0; m < 4; ++m) { bf16_t* rowp = H + (size_t)(row0 + ai * HALF + m * 16) * DFF;
                const float rs = rsqrtf(rsv[ai][m] * (1.f / DM) + EPS);
#pragma unroll
                for (int bj = 0; bj < 2; ++bj) { const f32x4 a = acc[ai][bj][m][0] * rs, g = acc[ai][bj][m][1] * rs;
                    const int col = 16 * (8 * u.pn + 4 * bj + wc) + 4 * fq;
                    u32x2 w; w.x = cvt_pk_bf16(silu_(a[0]) * g[0], silu_(a[1]) * g[1]); w.y = cvt_pk_bf16(silu_(a[2]) * g[2], silu_(a[3]) * g[3]);
                    *(u32x2*)(rowp + col) = w; } }
    }
};
struct EpiRes {
    static constexpr bool PERM = false, AFTER_DRAIN = false;
    const void* base; int base_f32; bf16_t* h1; bf16_t* h2; float* rsq;
    __device__ __forceinline__ void operator()(const f32x4 (&acc)[2][2][4][2], const Unit& u, int wr, int wc, int fr, int fq) const {
        const int row0 = u.pm * BM + wr * 64 + fr, col0 = u.pn * BM + wc * 32 + 4 * fq;
#pragma unroll
        for (int ai = 0; ai < 2; ++ai) {
            f32x4 bs[4][2][2];
            if (base_f32) {
#pragma unroll
                for (int m = 0; m < 4; ++m) { const size_t off = (size_t)(row0 + ai * HALF + m * 16) * DM + col0;
#pragma unroll
                    for (int bj = 0; bj < 2; ++bj)
#pragma unroll
                        for (int n = 0; n < 2; ++n) bs[m][bj][n] = *(const f32x4*)((const float*)base + off + bj * HALF + n * 16); }
            } else {
                u32x2 bw[4][2][2];
#pragma unroll
                for (int m = 0; m < 4; ++m) { const size_t off = (size_t)(row0 + ai * HALF + m * 16) * DM + col0;
#pragma unroll
                    for (int bj = 0; bj < 2; ++bj)
#pragma unroll
                        for (int n = 0; n < 2; ++n) bw[m][bj][n] = *(const u32x2*)((const bf16_t*)base + off + bj * HALF + n * 16); }
#pragma unroll
                for (int m = 0; m < 4; ++m)
#pragma unroll
                    for (int bj = 0; bj < 2; ++bj)
#pragma unroll
                        for (int n = 0; n < 2; ++n) { const u32x2 w = bw[m][bj][n];
                            bs[m][bj][n] = (f32x4){__uint_as_float(w.x << 16), __uint_as_float(w.x & 0xffff0000u), __uint_as_float(w.y << 16), __uint_as_float(w.y & 0xffff0000u)}; }
            }
#pragma unroll
            for (int m = 0; m < 4; ++m) { const size_t off = (size_t)(row0 + ai * HALF + m * 16) * DM + col0; float ss = 0.f;
#pragma unroll
                for (int bj = 0; bj < 2; ++bj)
#pragma unroll
                    for (int n = 0; n < 2; ++n) { const f32x4 o = bs[m][bj][n] + acc[ai][bj][m][n];
                        u32x2 w; w.x = cvt_pk_bf16(o[0], o[1]); w.y = cvt_pk_bf16(o[2], o[3]);
                        *(u32x2*)(h1 + off + bj * HALF + n * 16) = w;
                        if (h2) *(u32x2*)(h2 + off + bj * HALF + n * 16) = w;
                        ss += (o[0] * o[0] + o[1] * o[1]) + (o[2] * o[2] + o[3] * o[3]); }
                ss += __shfl_xor(ss, 16); ss += __shfl_xor(ss, 32);
                if (fq == 0) rsq[(size_t)(row0 + ai * HALF + m * 16) * 32 + u.pn * 4 + wc] = ss; } }
    }
};

}
namespace att {
constexpr int KVBLK = 64;
constexpr float SCALE = 0.07216878364870322f;
constexpr float THR = 8.f;
constexpr int SHM_V = KVBLK * 128 * 2, SHM_K = KVBLK * 192 * 2;
#ifndef ATT_SDEPTH
#define ATT_SDEPTH 1
#endif
constexpr int SDEPTH = ATT_SDEPTH;
#define KSWZ(row, colB) ((row) * 384 + ((colB) ^ (((row) & 7) << 4)))
#define SBAR() __builtin_amdgcn_sched_barrier(0)
__device__ __forceinline__ int crow(int r, int hi) { return (r & 3) + 8 * (r >> 2) + 4 * hi; }
__device__ __forceinline__ unsigned cvtpk(float lo, float hi) { return cvt_pk_bf16(lo, hi); }
template <bool FIRST>
__device__ __forceinline__ void partialSM(f32x16& p0, f32x16& p1, float& m_reg, float& alpha) {
  constexpr float THR2 = THR * 1.4426950408889634f;
  float pmax = p0[0];
#pragma unroll
  for (int r = 1; r < 16; ++r) pmax = fmaxf(pmax, p0[r]);
#pragma unroll
  for (int r = 0; r < 16; ++r) pmax = fmaxf(pmax, p1[r]);
  { auto rr = __builtin_amdgcn_permlane32_swap(__float_as_uint(pmax), __float_as_uint(pmax), false, false);
    pmax = fmaxf(__uint_as_float(rr[0]), __uint_as_float(rr[1])); }
  if (!FIRST && __builtin_expect(__all(pmax <= THR2), 1)) { alpha = 1.f; }
  else { const float d = FIRST ? pmax : fmaxf(pmax, 0.f); alpha = FIRST ? 1.f : __builtin_amdgcn_exp2f(-d); m_reg += d;
#pragma unroll
    for (int r = 0; r < 16; ++r) p0[r] -= d;
#pragma unroll
    for (int r = 0; r < 16; ++r) p1[r] -= d; }
#pragma unroll
  for (int r = 0; r < 16; ++r) p0[r] = __builtin_amdgcn_exp2f(p0[r]);
}
__device__ __forceinline__ void finishSM(f32x16& p0, f32x16& p1, float alpha, float& l_reg, bf16x8& pa0, bf16x8& pa1, bf16x8& pa2, bf16x8& pa3) {
#pragma unroll
  for (int r = 0; r < 16; ++r) p1[r] = __builtin_amdgcn_exp2f(p1[r]);
  float ps = 0;
#pragma unroll
  for (int r = 0; r < 16; ++r) ps += p0[r];
#pragma unroll
  for (int r = 0; r < 16; ++r) ps += p1[r];
  { auto rr = __builtin_amdgcn_permlane32_swap(__float_as_uint(ps), __float_as_uint(ps), false, false);
    ps = __uint_as_float(rr[0]) + __uint_as_float(rr[1]); }
  l_reg = l_reg * alpha + ps;
#define PK4(P, BASE, OUT) do { unsigned a0 = cvtpk(P[BASE + 0], P[BASE + 1]), a1 = cvtpk(P[BASE + 2], P[BASE + 3]);   \
    unsigned b0 = cvtpk(P[BASE + 4], P[BASE + 5]), b1 = cvtpk(P[BASE + 6], P[BASE + 7]);                              \
    auto r0 = __builtin_amdgcn_permlane32_swap(a0, b0, false, false); auto r1 = __builtin_amdgcn_permlane32_swap(a1, b1, false, false); \
    u32x4 w = {r0[0], r1[0], r0[1], r1[1]}; OUT = __builtin_bit_cast(bf16x8, w); } while (0)
  PK4(p0, 0, pa0); PK4(p0, 8, pa1); PK4(p1, 0, pa2); PK4(p1, 8, pa3);
#undef PK4
}
__device__ __forceinline__ void qkt(f32x16& p0, f32x16& p1, const char* Ks, const bf16x8* qr, const char* qL, int r32, int hi, float negm) {
#pragma unroll
  for (int r = 0; r < 16; ++r) { p0[r] = negm; p1[r] = negm; }
#pragma unroll
  for (int d0 = 0; d0 < 12; ++d0) { int cb = (d0 * 16 + hi * 8) * 2;
    bf16x8 b0 = *reinterpret_cast<const bf16x8*>(Ks + KSWZ(r32, cb));
    bf16x8 b1 = *reinterpret_cast<const bf16x8*>(Ks + KSWZ(32 + r32, cb));
    const bf16x8 q = d0 < 8 ? qr[d0 < 8 ? d0 : 0] : *reinterpret_cast<const bf16x8*>(qL + (d0 - 8) * 1024);
    p0 = __builtin_amdgcn_mfma_f32_32x32x16_bf16(b0, q, p0, 0, 0, 0);
    p1 = __builtin_amdgcn_mfma_f32_32x32x16_bf16(b1, q, p1, 0, 0, 0); }
}
__device__ __forceinline__ int v_st(int k, int c) { const int kk = (k & ~0xC) | ((k & 4) << 1) | ((k & 8) >> 1); return ((kk >> 3) * 4 + (c >> 5)) * 512 + ((kk & 7) * 32 + (c & 31)) * 2; }
__device__ __forceinline__ int v_rd_base(int lane) { return ((lane & 3) << 3) | (((lane >> 2) & 3) << 6) | (((lane >> 4) & 1) << 5) | (((lane >> 5) & 1) << 8); }
constexpr int v_rd_off(int d0, int ks, int half) { return d0 * 512 + ks * 4096 + half * 2048; }
template <int OFF> __device__ __forceinline__ s16x4 tr_read(int vb) {
  s16x4 r; asm volatile("ds_read_b64_tr_b16 %0, %1 offset:%2" : "=&v"(r) : "v"(vb), "i"(OFF) : "memory"); return r;
}
template <int D0> __device__ __forceinline__ void pv_one(f32x16& od, int vb, bf16x8 pa0, bf16x8 pa1, bf16x8 pa2, bf16x8 pa3) {
  const s16x4 l0 = tr_read<v_rd_off(D0, 0, 0)>(vb), h0 = tr_read<v_rd_off(D0, 0, 1)>(vb), l1 = tr_read<v_rd_off(D0, 1, 0)>(vb), h1 = tr_read<v_rd_off(D0, 1, 1)>(vb);
  const s16x4 l2 = tr_read<v_rd_off(D0, 2, 0)>(vb), h2 = tr_read<v_rd_off(D0, 2, 1)>(vb), l3 = tr_read<v_rd_off(D0, 3, 0)>(vb), h3 = tr_read<v_rd_off(D0, 3, 1)>(vb);
  asm volatile("s_waitcnt lgkmcnt(0)" ::: "memory"); SBAR();
#define PK(L, H) (bf16x8){L[0], L[1], L[2], L[3], H[0], H[1], H[2], H[3]}
  od = __builtin_amdgcn_mfma_f32_32x32x16_bf16(pa0, PK(l0, h0), od, 0, 0, 0);
  od = __builtin_amdgcn_mfma_f32_32x32x16_bf16(pa1, PK(l1, h1), od, 0, 0, 0);
  od = __builtin_amdgcn_mfma_f32_32x32x16_bf16(pa2, PK(l2, h2), od, 0, 0, 0);
  od = __builtin_amdgcn_mfma_f32_32x32x16_bf16(pa3, PK(l3, h3), od, 0, 0, 0);
#undef PK
}
__device__ __forceinline__ void pv_d0(f32x16* o, int vb, bf16x8 pa0, bf16x8 pa1, bf16x8 pa2, bf16x8 pa3) {
  pv_one<0>(o[0], vb, pa0, pa1, pa2, pa3); pv_one<1>(o[1], vb, pa0, pa1, pa2, pa3); pv_one<2>(o[2], vb, pa0, pa1, pa2, pa3); pv_one<3>(o[3], vb, pa0, pa1, pa2, pa3);
}
__device__ __forceinline__ void attn_unit(const bf16_t* __restrict__ Qb, const bf16_t* __restrict__ Kn, const bf16_t* __restrict__ Kr, const bf16_t* __restrict__ Vh,
                                          bf16_t* __restrict__ Ob, char* lds) {
  const int tid = opaque_tid(), wid = tid >> 6, lane = tid & 63, r32 = lane & 31, hi = lane >> 5;
  char* V_lds = lds; char* K_lds = lds + 2 * SHM_V;
  float* ws = (float*)(lds + 2 * SHM_V + 2 * SHM_K) + wid * 64; float* li_l = ws; float* al_l = ws + 32;
  float m_reg = 0.f, l_reg = 0; f32x16 o[4] = {}; bf16x8 qr[8];
  char* qL = lds + 2 * SHM_V + 2 * SHM_K + 2048 + wid * 4096 + lane * 16;
  const bf16_t* Qw = Qb + (long)(wid * 32 + r32) * 192 + hi * 8;
#pragma unroll
  for (int d0 = 0; d0 < 8; ++d0) qr[d0] = *reinterpret_cast<const bf16x8*>(Qw + d0 * 16);
#pragma unroll
  for (int d0 = 8; d0 < 12; ++d0) *reinterpret_cast<bf16x8*>(qL + (d0 - 8) * 1024) = *reinterpret_cast<const bf16x8*>(Qw + d0 * 16);
  const int sr = tid >> 4, sc = (tid & 15) * 8, vst0 = v_st(sr, sc), vst1 = v_st(32 + sr, sc);
  const int rr = tid >> 3, rc = (tid & 7) * 8;
  const int kst0 = KSWZ(sr, sc * 2), kst1 = KSWZ(32 + sr, sc * 2), kst2 = KSWZ(rr, 256 + rc * 2);
  const int vb0 = (int)(uintptr_t)V_lds + v_rd_base(lane);
  struct { bf16x8 vs0, vs1, ks0, ks1, ks2; } sr_[SDEPTH];
#define SLOAD(i, k0) do { sr_[i].vs0 = *(const bf16x8*)(&Vh[(long)((k0) + sr) * 128 + sc]); sr_[i].vs1 = *(const bf16x8*)(&Vh[(long)((k0) + 32 + sr) * 128 + sc]); \
    sr_[i].ks0 = *(const bf16x8*)(&Kn[(long)((k0) + sr) * 128 + sc]); sr_[i].ks1 = *(const bf16x8*)(&Kn[(long)((k0) + 32 + sr) * 128 + sc]); \
    sr_[i].ks2 = *(const bf16x8*)(&Kr[(long)((k0) + rr) * 64 + rc]); } while (0)
#define SWRITE(b, i) do { *(bf16x8*)(V_lds + (b) * SHM_V + vst0) = sr_[i].vs0; *(bf16x8*)(V_lds + (b) * SHM_V + vst1) = sr_[i].vs1; \
    *(bf16x8*)(K_lds + (b) * SHM_K + kst0) = sr_[i].ks0; *(bf16x8*)(K_lds + (b) * SHM_K + kst1) = sr_[i].ks1; *(bf16x8*)(K_lds + (b) * SHM_K + kst2) = sr_[i].ks2; } while (0)
#define SWAIT() do { if constexpr (SDEPTH == 2) asm volatile("s_waitcnt vmcnt(5)" ::: "memory"); else asm volatile("s_waitcnt vmcnt(0)" ::: "memory"); } while (0)
#define RESC(a) do { if (__any((a) < 1.f)) { if (hi == 0) al_l[r32] = (a); asm volatile("s_waitcnt lgkmcnt(0)" ::: "memory"); \
    _Pragma("unroll") for (int d = 0; d < 4; ++d) _Pragma("unroll") for (int r = 0; r < 16; ++r) o[d][r] *= al_l[crow(r, hi)]; } } while (0)
  f32x16 pA0, pA1, pB0, pB1; float alA, alB; bf16x8 pa0, pa1, pa2, pa3; const int NT = T / KVBLK;
  constexpr int SE = 0, SO = SDEPTH - 1;
  SLOAD(SE, 0); asm volatile("s_waitcnt vmcnt(0)" ::: "memory"); SWRITE(0, SE); __syncthreads();
  qkt(pA0, pA1, K_lds, qr, qL, r32, hi, 0.f); partialSM<true>(pA0, pA1, m_reg, alA);
  SLOAD(SO, KVBLK); if constexpr (SDEPTH == 2) { if (2 < NT) SLOAD(SE, 2 * KVBLK); }
  SWAIT(); SWRITE(1, SO); __syncthreads();
  for (int j = 1; j + 1 < NT; j += 2) {
    SBAR(); qkt(pB0, pB1, K_lds + SHM_K, qr, qL, r32, hi, -m_reg);
    finishSM(pA0, pA1, alA, l_reg, pa0, pa1, pa2, pa3); SBAR();
    SLOAD(SO, (j + SDEPTH) * KVBLK); SBAR();
    pv_d0(o, vb0, pa0, pa1, pa2, pa3); partialSM<false>(pB0, pB1, m_reg, alB);
    __syncthreads(); SWAIT(); SWRITE(0, SE);
    RESC(alB); __syncthreads();
    SBAR(); qkt(pA0, pA1, K_lds, qr, qL, r32, hi, -m_reg);
    finishSM(pB0, pB1, alB, l_reg, pa0, pa1, pa2, pa3); SBAR();
    if (SDEPTH == 1 || j + 3 < NT) SLOAD(SE, (j + 1 + SDEPTH) * KVBLK); SBAR();
    pv_d0(o, vb0 + (int)SHM_V, pa0, pa1, pa2, pa3); partialSM<false>(pA0, pA1, m_reg, alA);
    __syncthreads(); SWAIT(); SWRITE(1, SO);
    RESC(alA); __syncthreads();
  }
  SBAR(); qkt(pB0, pB1, K_lds + SHM_K, qr, qL, r32, hi, -m_reg);
  finishSM(pA0, pA1, alA, l_reg, pa0, pa1, pa2, pa3); SBAR();
  pv_d0(o, vb0, pa0, pa1, pa2, pa3); partialSM<false>(pB0, pB1, m_reg, alB);
  __syncthreads(); RESC(alB);
  finishSM(pB0, pB1, alB, l_reg, pa0, pa1, pa2, pa3); SBAR();
  pv_d0(o, vb0 + (int)SHM_V, pa0, pa1, pa2, pa3);
  if (hi == 0) li_l[r32] = l_reg; asm volatile("s_waitcnt lgkmcnt(0)" ::: "memory");
  float rli[16];
#pragma unroll
  for (int r = 0; r < 16; ++r) rli[r] = __builtin_amdgcn_rcpf(li_l[crow(r, hi)]);
  bf16_t* Ow = Ob + (long)(wid * 32) * DM;
#pragma unroll
  for (int r = 0; r < 16; ++r) { int orow = crow(r, hi);
#pragma unroll
    for (int d0 = 0; d0 < 4; ++d0) Ow[(long)orow * DM + d0 * 32 + r32] = (bf16_t)f2bf(o[d0][r] * rli[r]); }
#undef SLOAD
#undef SWRITE
#undef SWAIT
#undef RESC
  __syncthreads();
}
}
namespace scan {
constexpr int LDT = 72;
constexpr int SC_G = 0, SC_K = 33792, SC_QT = SC_K + 17408, SC_QG = SC_QT + 17408, SC_VT = SC_QG + 17408, SC_P = SC_VT + 18432, SC_SEG = SC_P + 9216, SC_RSQ = SC_SEG + 4096,
              SC_END = SC_RSQ + 2048, SC_KDT = SC_QT;
static_assert(SC_END <= LDS_BYTES, "scan LDS");

template <int TYPE> struct Cfg { static constexpr int DK = TYPE ? 128 : 64, LDG = DK + 4, LDK_ = DK + 8, ND8 = DK / 8; };

struct LgRaw { bf16x8 a0, a1, k; };
template <int TYPE>
__device__ __forceinline__ LgRaw lg_issue(const bf16_t* u, int h, int dir, size_t tok0, int tid) {
    LgRaw r;
    if constexpr (TYPE == 1) {
        const int i0 = tid >> 4, d8 = tid & 15, col = (dir ? C_HFB : C_HFF) + h * 128 + d8 * 8;
        r.a0 = *(const bf16x8*)(u + (tok0 + i0) * DINP + col); r.a1 = *(const bf16x8*)(u + (tok0 + 32 + i0) * DINP + col); r.k = r.a0;
    } else {
        const int i = tid >> 3, d8 = tid & 7; const bf16_t* ur = u + (tok0 + i) * DINP;
        r.a0 = *(const bf16x8*)(ur + (dir ? C_GAB : C_GAF)); r.a1 = *(const bf16x8*)(ur + (dir ? C_GAB : C_GAF) + 8); r.k = *(const bf16x8*)(ur + C_GK + h * 64 + d8 * 8);
    }
    return r;
}
template <int TYPE>
__device__ __forceinline__ void lg_compute(const KArgs& a, unsigned char* wsb, int l, int h, int dir, const LgRaw& raw, LAS unsigned char* lds, int tid) {
    using C = Cfg<TYPE>;
    LAS float* G = (LAS float*)(lds + SC_G); LAS bf16_t* Kb = (LAS bf16_t*)(lds + SC_K);
    if constexpr (TYPE == 1) {
        const float* lbp = (const float*)(wsb + WS_LB) + (dir * DEPTH + l) * 512 + h * 128;
        const int d8 = tid & 15;
        const f32x4 lb0 = *(const f32x4*)(lbp + d8 * 8), lb1 = *(const f32x4*)(lbp + d8 * 8 + 4);
        const float lb[8] = {lb0[0], lb0[1], lb0[2], lb0[3], lb1[0], lb1[1], lb1[2], lb1[3]};
#pragma unroll
        for (int e2 = 0; e2 < 2; ++e2) { const int i = (tid >> 4) + 32 * e2;
            float z[8], lg[8], kk[8]; unpack8(e2 ? raw.a1 : raw.a0, z);
#pragma unroll
            for (int e = 0; e < 8; ++e) { const float sg = sigmoid_(fmaxf(z[e], -80.f)); lg[e] = __logf(lb[e] + (1.f - lb[e]) * sg); kk[e] = (1.f - lb[e]) * (1.f - sg); }
            *(LAS f32x4*)(G + i * C::LDG + d8 * 8) = (f32x4){lg[0], lg[1], lg[2], lg[3]}; *(LAS f32x4*)(G + i * C::LDG + d8 * 8 + 4) = (f32x4){lg[4], lg[5], lg[6], lg[7]};
            *(LAS bf16x8*)(Kb + i * C::LDK_ + d8 * 8) = pack8(kk); }
    } else {
        const int i = tid >> 3, d8 = tid & 7;
        float ua[16]; unpack8(raw.a0, ua); unpack8(raw.a1, ua + 8);
        const float* up = (const float*)a.in[3] + (size_t)((l * 2 + dir) * 16) * 256 + h * 64 + d8 * 8;
        const float* bs = (const float*)a.in[4] + (l * 2 + dir) * 256 + h * 64 + d8 * 8;
        f32x4 z0 = *(const f32x4*)bs, z1 = *(const f32x4*)(bs + 4);
#pragma unroll
        for (int r = 0; r < 16; ++r) { z0 += ua[r] * *(const f32x4*)(up + r * 256); z1 += ua[r] * *(const f32x4*)(up + r * 256 + 4); }
        f32x4 g0, g1;
#pragma unroll
        for (int e = 0; e < 4; ++e) { g0[e] = logsigmoid_(z0[e]) * (1.f / 16.f); g1[e] = logsigmoid_(z1[e]) * (1.f / 16.f); }
        *(LAS f32x4*)(G + i * C::LDG + d8 * 8) = g0; *(LAS f32x4*)(G + i * C::LDG + d8 * 8 + 4) = g1;
        *(LAS bf16x8*)(Kb + i * C::LDK_ + d8 * 8) = raw.k;
    }
}
template <int TYPE>
__device__ __forceinline__ void cumsum_g(int dir, LAS unsigned char* lds, int tid) {
    using C = Cfg<TYPE>; constexpr int NSEG = 512 / C::DK, SEGL = 64 / NSEG;
    LAS float* G = (LAS float*)(lds + SC_G); LAS float* SG = (LAS float*)(lds + SC_SEG);
    const int d = tid % C::DK, seg = tid / C::DK;
    __syncthreads();
    float run = 0.f;
#pragma unroll
    for (int ii = 0; ii < SEGL; ++ii) { const int i = seg * SEGL + (dir ? SEGL - 1 - ii : ii); run += G[i * C::LDG + d]; G[i * C::LDG + d] = run; }
    SG[seg * 128 + d] = run;
    __syncthreads();
    float off = 0.f;
#pragma unroll
    for (int s = 0; s < NSEG; ++s) { const bool before = dir ? (s > seg) : (s < seg); if (before) off += SG[s * 128 + d]; }
#pragma unroll
    for (int ii = 0; ii < SEGL; ++ii) { const int i = seg * SEGL + ii; G[i * C::LDG + d] += off; }
    __syncthreads();
}
struct VRaw { bf16x8 x0, x1; };
__device__ __forceinline__ VRaw vT_issue(const bf16_t* vsrc, int tid) {
    const int i0 = tid >> 4, v8 = tid & 15; VRaw r;
    r.x0 = *(const bf16x8*)(vsrc + (size_t)i0 * DINP + v8 * 8); r.x1 = *(const bf16x8*)(vsrc + (size_t)(32 + i0) * DINP + v8 * 8); return r;
}
__device__ __forceinline__ void vT_write(const VRaw& r, LAS unsigned char* lds, int tid) {
    LAS bf16_t* VT = (LAS bf16_t*)(lds + SC_VT);
    const int v8 = tid & 15;
#pragma unroll
    for (int e2 = 0; e2 < 2; ++e2) { const int i = (tid >> 4) + 32 * e2; const bf16x8 x = e2 ? r.x1 : r.x0; const int pc = ((((i >> 3) ^ (v8 & 7)) << 3) | (i & 7));
#pragma unroll
        for (int e = 0; e < 8; ++e) VT[(v8 * 8 + e) * LDT + pc] = (bf16_t)x[e]; }
}
__device__ __forceinline__ bf16x8 vt_frag(LAS bf16_t* VT, int v, int c8) {
    return *(LAS bf16x8*)(VT + v * LDT + ((c8 ^ ((v >> 3) & 7)) << 3));
}

template <int TYPE>
__device__ __forceinline__ void pass1_item(const KArgs& a, int l, int item, LAS unsigned char* lds) {
    unsigned char* const wsb = opq(a.ws);
    const int tid = opaque_tid();
    using C = Cfg<TYPE>; constexpr int DK = C::DK;
    const int c = item & (NCH - 1), dir = (item >> 8) & 1, h = (item >> 9) & 3, b = item >> 11;
    const size_t tok0 = (size_t)b * T + (size_t)c * 64;
    const bf16_t* u = (const bf16_t*)(wsb + WS_U);
    const int wid = tid >> 6, lane = tid & 63, fr = lane & 15, fq = lane >> 4;
    __syncthreads();
    { const LgRaw raw = lg_issue<TYPE>(u, h, dir, tok0, tid); const VRaw vr = vT_issue(u + tok0 * DINP + (TYPE ? C_HI : C_GV) + h * 128, tid);
      lg_compute<TYPE>(a, wsb, l, h, dir, raw, lds, tid); vT_write(vr, lds, tid); }
    cumsum_g<TYPE>(dir, lds, tid);
    LAS float* G = (LAS float*)(lds + SC_G); LAS bf16_t* Kb = (LAS bf16_t*)(lds + SC_K); LAS bf16_t* KDT = (LAS bf16_t*)(lds + SC_KDT); LAS bf16_t* VT = (LAS bf16_t*)(lds + SC_VT);
    const int last = dir ? 0 : 63;
    float* Dout = (float*)(wsb + (TYPE ? WS_DH : WS_DG)) + (size_t)item * DK;
#pragma unroll
    for (int e2 = 0; e2 < DK / 64; ++e2) { const int task = tid + 512 * e2, i = task & 63, d8 = task >> 6;
        const f32x4 g0 = *(LAS f32x4*)(G + i * C::LDG + d8 * 8), g1 = *(LAS f32x4*)(G + i * C::LDG + d8 * 8 + 4);
        const f32x4 t0 = *(LAS f32x4*)(G + last * C::LDG + d8 * 8), t1 = *(LAS f32x4*)(G + last * C::LDG + d8 * 8 + 4);
        float kk[8]; unpack8(*(LAS bf16x8*)(Kb + i * C::LDK_ + d8 * 8), kk);
#pragma unroll
        for (int e = 0; e < 8; ++e) { const float gg = e < 4 ? g0[e] : g1[e - 4], tt = e < 4 ? t0[e] : t1[e - 4];
            KDT[(d8 * 8 + e) * LDT + i] = (bf16_t)f2bf(kk[e] * __expf(tt - gg)); }
        if (i == 0) { *(f32x4*)(Dout + d8 * 8) = (f32x4){__expf(t0[0]), __expf(t0[1]), __expf(t0[2]), __expf(t0[3])};
                      *(f32x4*)(Dout + d8 * 8 + 4) = (f32x4){__expf(t1[0]), __expf(t1[1]), __expf(t1[2]), __expf(t1[3])}; } }
    __syncthreads();
    bf16_t* ST = (bf16_t*)(wsb + (TYPE ? WS_SH : WS_SG)) + (size_t)item * 128 * DK;
    const bf16x8 b0 = vt_frag(VT, wid * 16 + fr, fq), b1 = vt_frag(VT, wid * 16 + fr, 4 + fq);
#pragma unroll
    for (int dt = 0; dt < DK / 16; ++dt) {
        const bf16x8 a0 = *(LAS bf16x8*)(KDT + (dt * 16 + fr) * LDT + fq * 8), a1 = *(LAS bf16x8*)(KDT + (dt * 16 + fr) * LDT + 32 + fq * 8);
        f32x4 acc = {0.f, 0.f, 0.f, 0.f};
        acc = __builtin_amdgcn_mfma_f32_16x16x32_bf16(a0, b0, acc, 0, 0, 0);
        acc = __builtin_amdgcn_mfma_f32_16x16x32_bf16(a1, b1, acc, 0, 0, 0);
        u32x2 w; w.x = cvt_pk_bf16(acc[0], acc[1]); w.y = cvt_pk_bf16(acc[2], acc[3]);
        *(u32x2*)(ST + (size_t)(wid * 16 + fr) * DK + dt * 16 + fq * 4) = w;
    }
}

struct P2Chain { bf16_t* st; const float* dp; size_t sstride; int dstride; int dir; };
__device__ __forceinline__ P2Chain p2_chain(unsigned char* wsb, int type, int E) {
    const int DK = type ? 128 : 64, IPI = 128 * DK;
    const int chain = E / IPI, e = E % IPI;
    P2Chain c; c.st = (bf16_t*)(wsb + (type ? WS_SH : WS_SG)) + (size_t)chain * NCH * IPI + e;
    c.dp = (const float*)(wsb + (type ? WS_DH : WS_DG)) + (size_t)chain * NCH * DK + (e % DK);
    c.sstride = (size_t)IPI; c.dstride = DK; c.dir = chain & 1; return c;
}
__device__ __forceinline__ void pass2_triple(const KArgs& a, int t) {
    unsigned char* const wsb = opq(a.ws);
    const P2Chain c0 = p2_chain(wsb, 1, t), c1 = p2_chain(wsb, 1, t + 131072), c2 = p2_chain(wsb, 0, t);
    float s0 = 0.f, s1 = 0.f, s2 = 0.f;
    unsigned short uA[3][4], uB[3][4]; float dA[3][4], dB[3][4];
#define P2_CI(c, s) ((c).dir ? NCH - 1 - (s) : (s))
#define P2_LOAD(U, D, sb) do { _Pragma("unroll") for (int k = 0; k < 4; ++k) { \
        const int i0_ = P2_CI(c0, (sb) + k), i1_ = P2_CI(c1, (sb) + k), i2_ = P2_CI(c2, (sb) + k); \
        U[0][k] = c0.st[(size_t)i0_ * c0.sstride]; D[0][k] = c0.dp[(size_t)i0_ * c0.dstride]; \
        U[1][k] = c1.st[(size_t)i1_ * c1.sstride]; D[1][k] = c1.dp[(size_t)i1_ * c1.dstride]; \
        U[2][k] = c2.st[(size_t)i2_ * c2.sstride]; D[2][k] = c2.dp[(size_t)i2_ * c2.dstride]; } } while (0)
#define P2_STEP(U, D, sb) do { _Pragma("unroll") for (int k = 0; k < 4; ++k) { \
        const int i0_ = P2_CI(c0, (sb) + k), i1_ = P2_CI(c1, (sb) + k), i2_ = P2_CI(c2, (sb) + k); \
        c0.st[(size_t)i0_ * c0.sstride] = (bf16_t)f2bf(s0); s0 = D[0][k] * s0 + bf2f(U[0][k]); \
        c1.st[(size_t)i1_ * c1.sstride] = (bf16_t)f2bf(s1); s1 = D[1][k] * s1 + bf2f(U[1][k]); \
        c2.st[(size_t)i2_ * c2.sstride] = (bf16_t)f2bf(s2); s2 = D[2][k] * s2 + bf2f(U[2][k]); } } while (0)
    P2_LOAD(uA, dA, 0);
#pragma unroll 1
    for (int sb = 0; sb < NCH; sb += 8) {
        P2_LOAD(uB, dB, sb + 4);
        P2_STEP(uA, dA, sb);
        if (sb + 8 < NCH) P2_LOAD(uA, dA, sb + 8);
        P2_STEP(uB, dB, sb + 4);
    }
#undef P2_CI
#undef P2_LOAD
#undef P2_STEP
}

template <int TYPE>
__device__ __forceinline__ void pass3_item(const KArgs& a, int l, int item, LAS unsigned char* lds) {
    unsigned char* const wsb = opq(a.ws);
    const int tid = opaque_tid();
    using C = Cfg<TYPE>; constexpr int DK = C::DK;
    const int c = item & (NCH - 1), h = (item >> 8) & 3, b = item >> 10;
    const size_t tok0 = (size_t)b * T + (size_t)c * 64;
    const bf16_t* u = (const bf16_t*)(wsb + WS_U);
    const int wid = tid >> 6, lane = tid & 63, fr = lane & 15, fq = lane >> 4;
    LAS float* G = (LAS float*)(lds + SC_G); LAS bf16_t* Kb = (LAS bf16_t*)(lds + SC_K); LAS bf16_t* QT = (LAS bf16_t*)(lds + SC_QT); LAS bf16_t* QG = (LAS bf16_t*)(lds + SC_QG);
    LAS bf16_t* VT = (LAS bf16_t*)(lds + SC_VT); LAS bf16_t* P = (LAS bf16_t*)(lds + SC_P); LAS float* RSQ = (LAS float*)(lds + SC_RSQ);
    const VRaw vr = vT_issue(u + tok0 * DINP + (TYPE ? C_HI : C_GV) + h * 128, tid);
    bf16x8 qraw[DK / 64];
#pragma unroll
    for (int e2 = 0; e2 < DK / 64; ++e2) { const int task = tid + 512 * e2, i = task / C::ND8, d8 = task % C::ND8;
        qraw[e2] = *(const bf16x8*)(u + (tok0 + i) * DINP + (TYPE ? C_HQ + h * 128 : C_GQ + h * 64) + d8 * 8); }
    const LgRaw raw0 = lg_issue<TYPE>(u, h, 0, tok0, tid), raw1 = lg_issue<TYPE>(u, h, 1, tok0, tid);
    __syncthreads();
    vT_write(vr, lds, tid);
    float qf[DK / 64][8];
#pragma unroll
    for (int e2 = 0; e2 < DK / 64; ++e2) { unpack8(qraw[e2], qf[e2]);
#pragma unroll
        for (int e = 0; e < 8; ++e) qf[e2][e] = TYPE ? silu_(qf[e2][e]) : qf[e2][e] * 0.125f; }
    f32x4 o[4];
#pragma unroll
    for (int it = 0; it < 4; ++it) o[it] = (f32x4){0.f, 0.f, 0.f, 0.f};
#pragma unroll 1
    for (int dir = 0; dir < 2; ++dir) {
        const int sitem = ((b * 4 + h) * 2 + dir) * NCH + c;
        const bf16_t* ST = (const bf16_t*)(wsb + (TYPE ? WS_SH : WS_SG)) + (size_t)sitem * 128 * DK + (size_t)(wid * 16 + fr) * DK + fq * 8;
        bf16x8 sf[DK / 32];
#pragma unroll
        for (int ks = 0; ks < DK / 32; ++ks) sf[ks] = *(const bf16x8*)(ST + ks * 32);
        if (dir) __syncthreads();
        { LgRaw rw; rw.a0 = dir ? raw1.a0 : raw0.a0; rw.a1 = dir ? raw1.a1 : raw0.a1; rw.k = dir ? raw1.k : raw0.k; lg_compute<TYPE>(a, wsb, l, h, dir, rw, lds, tid); }
        cumsum_g<TYPE>(dir, lds, tid);
#pragma unroll
        for (int e2 = 0; e2 < DK / 64; ++e2) { const int task = tid + 512 * e2, i = task / C::ND8, d8 = task % C::ND8;
            const f32x4 g0 = *(LAS f32x4*)(G + i * C::LDG + d8 * 8), g1 = *(LAS f32x4*)(G + i * C::LDG + d8 * 8 + 4);
            const f32x4 m0 = *(LAS f32x4*)(G + 32 * C::LDG + d8 * 8), m1 = *(LAS f32x4*)(G + 32 * C::LDG + d8 * 8 + 4);
            float kk[8], qq[8], qt[8], qg[8]; unpack8(*(LAS bf16x8*)(Kb + i * C::LDK_ + d8 * 8), kk);
#pragma unroll
            for (int e = 0; e < 8; ++e) qq[e] = qf[e2][e];
#pragma unroll
            for (int e = 0; e < 8; ++e) { const float gg = e < 4 ? g0[e] : g1[e - 4], gm = e < 4 ? m0[e] : m1[e - 4];
                const float q = qq[e];
                qt[e] = q * __expf(gg - gm); qg[e] = q * __expf(gg); kk[e] = kk[e] * __expf(gm - gg); }
            *(LAS bf16x8*)(QT + i * C::LDK_ + d8 * 8) = pack8(qt); *(LAS bf16x8*)(QG + i * C::LDK_ + d8 * 8) = pack8(qg); *(LAS bf16x8*)(Kb + i * C::LDK_ + d8 * 8) = pack8(kk); }
        __syncthreads();
        { const int it = wid >> 1;
#pragma unroll
          for (int jj = 0; jj < 2; ++jj) { const int jt = 2 * (wid & 1) + jj;
            f32x4 acc = {0.f, 0.f, 0.f, 0.f};
#pragma unroll
            for (int ks = 0; ks < DK / 32; ++ks) {
                const bf16x8 af = *(LAS bf16x8*)(QT + (it * 16 + fr) * C::LDK_ + ks * 32 + fq * 8), bfr = *(LAS bf16x8*)(Kb + (jt * 16 + fr) * C::LDK_ + ks * 32 + fq * 8);
                acc = __builtin_amdgcn_mfma_f32_16x16x32_bf16(af, bfr, acc, 0, 0, 0); }
#pragma unroll
            for (int r = 0; r < 4; ++r) { const int i = it * 16 + fq * 4 + r, j = jt * 16 + fr; const bool keep = dir ? (j >= i) : (j <= i);
                P[i * LDT + j] = (bf16_t)f2bf(keep ? acc[r] : 0.f); } } }
        __syncthreads();
        const bf16x8 vb0 = vt_frag(VT, wid * 16 + fr, fq), vb1 = vt_frag(VT, wid * 16 + fr, 4 + fq);
#pragma unroll
        for (int it = 0; it < 4; ++it) {
            const bf16x8 p0 = *(LAS bf16x8*)(P + (it * 16 + fr) * LDT + fq * 8), p1 = *(LAS bf16x8*)(P + (it * 16 + fr) * LDT + 32 + fq * 8);
            o[it] = __builtin_amdgcn_mfma_f32_16x16x32_bf16(p0, vb0, o[it], 0, 0, 0);
            o[it] = __builtin_amdgcn_mfma_f32_16x16x32_bf16(p1, vb1, o[it], 0, 0, 0);
#pragma unroll
            for (int ks = 0; ks < DK / 32; ++ks) { const bf16x8 af = *(LAS bf16x8*)(QG + (it * 16 + fr) * C::LDK_ + ks * 32 + fq * 8);
                o[it] = __builtin_amdgcn_mfma_f32_16x16x32_bf16(af, sf[ks], o[it], 0, 0, 0); }
        }
    }
#pragma unroll
    for (int it = 0; it < 4; ++it)
#pragma unroll
        for (int r = 0; r < 4; ++r) { float s = o[it][r] * o[it][r];
            s += __builtin_bit_cast(float, __builtin_amdgcn_update_dpp(0, __builtin_bit_cast(int, s), 0xB1, 0xF, 0xF, true));
            s += __builtin_bit_cast(float, __builtin_amdgcn_update_dpp(0, __builtin_bit_cast(int, s), 0x4E, 0xF, 0xF, true));
            s += __builtin_bit_cast(float, __builtin_amdgcn_update_dpp(0, __builtin_bit_cast(int, s), 0x141, 0xF, 0xF, true));
            s += __builtin_bit_cast(float, __builtin_amdgcn_update_dpp(0, __builtin_bit_cast(int, s), 0x140, 0xF, 0xF, true));
            RSQ[wid * 64 + it * 16 + fq * 4 + r] = s; }
    __syncthreads();
    LAS float* RSTD = (LAS float*)(lds + SC_SEG);
    if (tid < 64) { float s = 0.f;
#pragma unroll
        for (int w = 0; w < 8; ++w) s += RSQ[w * 64 + tid];
        RSTD[tid] = rsqrtf(s * (1.f / 128.f) + EPS); }
    __syncthreads();
    const float gain = ((const float*)a.in[TYPE ? 7 : 5])[l * 128 + wid * 16 + fr];
    bf16_t* mix = (bf16_t*)(wsb + WS_XN);
    float gtv[4][4];
#pragma unroll
    for (int it = 0; it < 4; ++it)
#pragma unroll
        for (int r = 0; r < 4; ++r) gtv[it][r] = bf2f(u[(tok0 + it * 16 + fq * 4 + r) * DINP + (TYPE ? C_HG : C_GG) + h * 128 + wid * 16 + fr]);
#pragma unroll
    for (int it = 0; it < 4; ++it)
#pragma unroll
        for (int r = 0; r < 4; ++r) { const int i = it * 16 + fq * 4 + r;
            const float rstd = RSTD[i];
            const float gt = gtv[it][r];
            const float yv = o[it][r] * rstd * gain * silu_(gt);
            mix[(tok0 + i) * DM + (TYPE ? 512 : 0) + h * 128 + wid * 16 + fr] = (bf16_t)f2bf(yv); }
}
}
__device__ __forceinline__ void rmsnorm_rows_bf16(const float* src, const float* gain, bf16_t* dst) {
    const int tid = opaque_tid(), lane = tid & 63, gw = blockIdx.x * 8 + (tid >> 6), ngw = gridDim.x * 8;
    for (int m = gw; m < M; m += ngw) {
        const f32x4* xr = (const f32x4*)(src + (size_t)m * DM) + lane;
        f32x4 v[8]; float s = 0.f;
#pragma unroll
        for (int j = 0; j < 8; ++j) { v[j] = xr[64 * j]; s += (v[j][0] * v[j][0] + v[j][1] * v[j][1]) + (v[j][2] * v[j][2] + v[j][3] * v[j][3]); }
        const float rstd = rsqrtf(wave_sum(s) * (1.f / DM) + EPS);
        u32x2* o8 = (u32x2*)(dst + (size_t)m * DM) + lane;
#pragma unroll
        for (int j = 0; j < 8; ++j) { const f32x4 g = ((const f32x4*)gain)[lane + 64 * j];
            u32x2 w; w.x = cvt_pk_bf16(v[j][0] * rstd * g[0], v[j][1] * rstd * g[1]); w.y = cvt_pk_bf16(v[j][2] * rstd * g[2], v[j][3] * rstd * g[3]); o8[64 * j] = w; }
    }
}
__device__ __forceinline__ void cast_rows_bf16(const float* src, bf16_t* dst, float* rsq) {
    const int tid = opaque_tid(), lane = tid & 63, gw = blockIdx.x * 8 + (tid >> 6), ngw = gridDim.x * 8;
    for (int m = gw; m < M; m += ngw) {
        const f32x4* xr = (const f32x4*)(src + (size_t)m * DM) + lane;
        f32x4 v[8]; float s = 0.f;
#pragma unroll
        for (int j = 0; j < 8; ++j) { v[j] = xr[64 * j]; s += (v[j][0] * v[j][0] + v[j][1] * v[j][1]) + (v[j][2] * v[j][2] + v[j][3] * v[j][3]); }
        s = wave_sum(s);
        if (lane == 0) rsq[m] = s;
        u32x2* o8 = (u32x2*)(dst + (size_t)m * DM) + lane;
#pragma unroll
        for (int j = 0; j < 8; ++j) { u32x2 w; w.x = cvt_pk_bf16(v[j][0], v[j][1]); w.y = cvt_pk_bf16(v[j][2], v[j][3]); o8[64 * j] = w; }
    }
}
__device__ __forceinline__ void rmsnorm_rows_bf16_to_f32(const bf16_t* src, const float* gain, float* dst) {
    const int tid = opaque_tid(), lane = tid & 63, gw = blockIdx.x * 8 + (tid >> 6), ngw = gridDim.x * 8;
    for (int m = gw; m < M; m += ngw) {
        const bf16x8* xr = (const bf16x8*)(src + (size_t)m * DM) + lane;
        float v[4][8]; float s = 0.f;
#pragma unroll
        for (int j = 0; j < 4; ++j) { unpack8(xr[64 * j], v[j]);
#pragma unroll
            for (int e = 0; e < 8; ++e) s += v[j][e] * v[j][e]; }
        const float rstd = rsqrtf(wave_sum(s) * (1.f / DM) + EPS);
#pragma unroll
        for (int j = 0; j < 4; ++j) { const int c = (lane + 64 * j) * 8; const f32x4 g0 = *(const f32x4*)(gain + c), g1 = *(const f32x4*)(gain + c + 4);
            f32x4 o0 = {v[j][0] * rstd * g0[0], v[j][1] * rstd * g0[1], v[j][2] * rstd * g0[2], v[j][3] * rstd * g0[3]};
            f32x4 o1 = {v[j][4] * rstd * g1[0], v[j][5] * rstd * g1[1], v[j][6] * rstd * g1[2], v[j][7] * rstd * g1[3]};
            *(f32x4*)(dst + (size_t)m * DM + c) = o0; *(f32x4*)(dst + (size_t)m * DM + c + 4) = o1; }
    }
}
__device__ __forceinline__ void rmsnorm_rows_f32_inplace(float* buf, const float* gain) {
    const int tid = opaque_tid(), lane = tid & 63, gw = blockIdx.x * 8 + (tid >> 6), ngw = gridDim.x * 8;
    for (int m = gw; m < M; m += ngw) {
        f32x4* xr = (f32x4*)(buf + (size_t)m * DM) + lane;
        f32x4 v[8]; float s = 0.f;
#pragma unroll
        for (int j = 0; j < 8; ++j) { v[j] = xr[64 * j]; s += (v[j][0] * v[j][0] + v[j][1] * v[j][1]) + (v[j][2] * v[j][2] + v[j][3] * v[j][3]); }
        const float rstd = rsqrtf(wave_sum(s) * (1.f / DM) + EPS);
#pragma unroll
        for (int j = 0; j < 8; ++j) { const f32x4 g = ((const f32x4*)gain)[lane + 64 * j]; xr[64 * j] = v[j] * rstd * g; }
    }
}
__device__ __forceinline__ void convert_weights(const KArgs& a, int l, LAS unsigned char* lds) {
    unsigned char* const wsb = opq(a.ws);
    const int tid = opaque_tid();
    LAS float* tile = (LAS float*)lds;
    constexpr int I_IN = 32 * 84, I_QB = 8 * 24, I_KVB = 8 * 32, I_OUT = 32 * 32, I_13 = 32 * 176, I_2 = 88 * 32, NIT = I_IN + I_QB + I_KVB + I_OUT + I_13 + I_2;
    for (int it = blockIdx.x; it < NIT; it += gridDim.x) {
        int r = it, mode = 0, N, K, nkt; const float* w0; const float* w1 = nullptr; const float* gk = nullptr; bf16_t* WT;
        if (r < I_IN) { w0 = (const float*)a.in[2] + (size_t)l * DM * DIN; N = DIN; K = DM; nkt = 32; gk = (const float*)a.in[13] + l * DM; WT = (bf16_t*)(wsb + WS_WIN); }
        else if ((r -= I_IN) < I_QB) { w0 = (const float*)a.in[9] + (size_t)l * 512 * 1536; N = 1536; K = 512; nkt = 8; mode = 1; WT = (bf16_t*)(wsb + WS_WQB); }
        else if ((r -= I_QB) < I_KVB) { w0 = (const float*)a.in[11] + (size_t)l * 512 * 2048; N = 2048; K = 512; nkt = 8; WT = (bf16_t*)(wsb + WS_WKVB); }
        else if ((r -= I_KVB) < I_OUT) { w0 = (const float*)a.in[12] + (size_t)l * DM * DM; N = DM; K = DM; nkt = 32; WT = (bf16_t*)(wsb + WS_WOUT); }
        else if ((r -= I_OUT) < I_13) { w0 = (const float*)a.in[15] + (size_t)l * DM * DFF; w1 = (const float*)a.in[16] + (size_t)l * DM * DFF; N = DFF; K = DM; nkt = 32; mode = 2; gk = (const float*)a.in[14] + l * DM; WT = (bf16_t*)(wsb + WS_W13); }
        else { r -= I_13; w0 = (const float*)a.in[17] + (size_t)l * DFF * DM; N = DM; K = DFF; nkt = 88; WT = (bf16_t*)(wsb + WS_W2); }
        const int kt = r % nkt, rt = r / nkt, r0 = rt * 64, k0 = kt * 64;
        __syncthreads();
        if (mode == 1) {
#pragma unroll
            for (int e = 0; e < 8; ++e) { const int idx = tid + 512 * e, rl = idx & 63, kl = idx >> 6, rr = r0 + rl, k = k0 + kl;
                const int hh = rr / 192, ee = rr % 192; const int col = ee < 128 ? hh * 192 + ee : hh * 192 + 128 + ((ee - 128) & 1) * 32 + ((ee - 128) >> 1);
                tile[kl * 65 + rl] = w0[(size_t)k * N + col]; }
        } else {
#pragma unroll
            for (int e = 0; e < 2; ++e) { const int idx = tid + 512 * e, r4 = (idx & 15) * 4, kl = idx >> 4, rr = r0 + r4, k = k0 + kl;
                f32x4 v = {0.f, 0.f, 0.f, 0.f};
                if (mode == 0) { if (rr < N) v = *(const f32x4*)(w0 + (size_t)k * N + rr); }
                else { const int g = rr >> 5, n = (rr >> 4) & 1, i = rr & 15; v = *(const f32x4*)((n ? w1 : w0) + (size_t)k * N + 16 * g + i); }
                if (gk) v = v * gk[k];
                tile[kl * 65 + r4] = v[0]; tile[kl * 65 + r4 + 1] = v[1]; tile[kl * 65 + r4 + 2] = v[2]; tile[kl * 65 + r4 + 3] = v[3]; }
        }
        __syncthreads();
        { const int k8 = tid & 7, rl = tid >> 3;
          u32x4 w; w.x = pk2(tile[(8 * k8 + 0) * 65 + rl], tile[(8 * k8 + 1) * 65 + rl]); w.y = pk2(tile[(8 * k8 + 2) * 65 + rl], tile[(8 * k8 + 3) * 65 + rl]);
          w.z = pk2(tile[(8 * k8 + 4) * 65 + rl], tile[(8 * k8 + 5) * 65 + rl]); w.w = pk2(tile[(8 * k8 + 6) * 65 + rl], tile[(8 * k8 + 7) * 65 + rl]);
          *(u32x4*)(WT + (size_t)(r0 + rl) * K + k0 + 8 * k8) = w; }
    }
    __syncthreads();
}
__device__ __forceinline__ void tables_phase(const KArgs& a) {
    unsigned char* const wsb = opq(a.ws);
    const int tid = opaque_tid();
    const int* pos = (const int*)a.in[1];
    float* cs = (float*)(wsb + WS_COS); float* sn = (float*)(wsb + WS_SIN);
    const int gt = blockIdx.x * 512 + tid, ngt = gridDim.x * 512;
    for (int idx = gt; idx < M * 32; idx += ngt) { const int tok = idx >> 5, i = idx & 31;
        const float inv = 1.0f / exp2f((float)(2 * i) * (1.f / 64.f) * 13.287712379549449f);
        const float ang = (float)pos[tok] * inv;
        double rev = (double)ang * 0.15915494309189535; rev -= rint(rev);
        const float f = (float)rev;
        cs[idx] = __builtin_amdgcn_cosf(f); sn[idx] = __builtin_amdgcn_sinf(f); }
    if (blockIdx.x == 0) { const float* lg = (const float*)a.in[6]; float* lb = (float*)(wsb + WS_LB);
        for (int p = tid; p < 2 * 512; p += 512) { const int dir = p >> 9, c = p & 511;
            float mx = -1e30f;
#pragma unroll
            for (int l = 0; l < DEPTH; ++l) mx = fmaxf(mx, lg[(dir * DEPTH + l) * 512 + c]);
            float den = 0.f;
#pragma unroll
            for (int l = 0; l < DEPTH; ++l) den += __expf(lg[(dir * DEPTH + l) * 512 + c] - mx);
            float cum = 0.f;
#pragma unroll
            for (int l = 0; l < DEPTH; ++l) { if (l > 0) cum += __expf(lg[(dir * DEPTH + l) * 512 + c] - mx) / den; lb[(dir * DEPTH + l) * 512 + c] = cum; } } }
}
__device__ __forceinline__ void mla_prep(const KArgs& a, int l) {
    unsigned char* const wsb = opq(a.ws);
    const int tid = opaque_tid(), lane = tid & 63, gw = blockIdx.x * 8 + (tid >> 6), ngw = gridDim.x * 8;
    bf16_t* u = (bf16_t*)(wsb + WS_U); bf16_t* kr = (bf16_t*)(wsb + WS_KR);
    const float* cs = (const float*)(wsb + WS_COS); const float* sn = (const float*)(wsb + WS_SIN);
    const float* gq = (const float*)a.in[8] + l * 512 + lane * 8; const float* gkv = (const float*)a.in[10] + l * 512 + lane * 8;
    const f32x4 gq0 = *(const f32x4*)gq, gq1 = *(const f32x4*)(gq + 4), gk0 = *(const f32x4*)gkv, gk1 = *(const f32x4*)(gkv + 4);
    const float gqv[8] = {gq0[0], gq0[1], gq0[2], gq0[3], gq1[0], gq1[1], gq1[2], gq1[3]}, gkv8[8] = {gk0[0], gk0[1], gk0[2], gk0[3], gk1[0], gk1[1], gk1[2], gk1[3]};
    for (int tok0 = gw; tok0 < M; tok0 += 2 * ngw) {
        bf16x8 raw[2][2]; float x1[2], x2[2], c[2], s[2]; bool ok[2];
#pragma unroll
        for (int j = 0; j < 2; ++j) { const int tok = tok0 + j * ngw; ok[j] = tok < M; const int tk = ok[j] ? tok : tok0; bf16_t* ur = u + (size_t)tk * DINP;
            raw[j][0] = *(const bf16x8*)(ur + C_CQ + lane * 8); raw[j][1] = *(const bf16x8*)(ur + C_CKV + lane * 8);
            x1[j] = bf2f(ur[C_KR + (lane & 31)]); x2[j] = bf2f(ur[C_KR + 32 + (lane & 31)]); c[j] = cs[(size_t)tk * 32 + (lane & 31)]; s[j] = sn[(size_t)tk * 32 + (lane & 31)]; }
#pragma unroll
        for (int j = 0; j < 2; ++j) { const int tok = tok0 + j * ngw; if (!ok[j]) continue; bf16_t* ur = u + (size_t)tok * DINP;
#pragma unroll
            for (int w = 0; w < 2; ++w) { float f[8]; unpack8(raw[j][w], f); float ssq = 0.f;
#pragma unroll
                for (int e = 0; e < 8; ++e) ssq += f[e] * f[e];
                const float rstd = rsqrtf(wave_sum(ssq) * (1.f / 512.f) + EPS);
#pragma unroll
                for (int e = 0; e < 8; ++e) f[e] = f[e] * rstd * (w ? gkv8[e] : gqv[e]);
                *(bf16x8*)(ur + (w ? C_CKV : C_CQ) + lane * 8) = pack8(f); }
            if (lane < 32) *(unsigned*)(kr + (size_t)tok * 64 + 2 * lane) = pk2(x1[j] * c[j] - x2[j] * s[j], x2[j] * c[j] + x1[j] * s[j]); }
    }
}

#define XB_TMO      128
#define XB_XCNT(j)  (256  + 64 * (j))
#define XB_XSUB(j)  (1280 + 64 * (j))
#define XB_XGEN(j)  (2304 + 64 * (j))
#define XB_TOP      3328
#define XB_TOPGEN   3392
#define XCD_BAR_WORDS 3456
#define XB_SPIN_CAP (1u << 18)

__device__ __forceinline__ unsigned xb_ld(unsigned* p)              { return __hip_atomic_load(p, __ATOMIC_RELAXED, __HIP_MEMORY_SCOPE_AGENT); }
__device__ __forceinline__ unsigned xb_add(unsigned* p, unsigned v) { return __hip_atomic_fetch_add(p, v, __ATOMIC_RELAXED, __HIP_MEMORY_SCOPE_AGENT); }
__device__ __forceinline__ unsigned xb_xcc_id() { return (unsigned)__builtin_amdgcn_s_getreg((3 << 11) | 20) & 0xFu; }
#define XB_SPIN(cond, bar) do { unsigned _sp = 0; while (cond) { __builtin_amdgcn_s_sleep(1); \
    if ((++_sp & 255u) == 0u) { if (xb_ld(&(bar)[XB_TMO])) break; if (_sp > XB_SPIN_CAP) { atomicAdd(&(bar)[XB_TMO], 1u); break; } } } } while (0)

struct XcdBarrier {
    unsigned* bar; unsigned x;
    volatile LAS unsigned* st;
};

__device__ __forceinline__ XcdBarrier xcd_barrier_post(unsigned* bar, volatile LAS unsigned* st) {
    XcdBarrier b; b.bar = bar; b.x = xb_xcc_id(); b.st = st;
    if (threadIdx.x == 0) (void)xb_add(&bar[XB_XCNT(b.x)], 1u);
    return b;
}
__device__ __forceinline__ void xcd_barrier_complete(unsigned* bar, unsigned x, unsigned& nloc, unsigned& nx) {
    const unsigned G = gridDim.x * gridDim.y * gridDim.z;
    unsigned sum, cnt, mine, sp = 0u;
    for (;;) {
        sum = 0u; cnt = 0u; mine = 0u;
#pragma unroll
        for (unsigned j = 0; j < 16; ++j) { const unsigned c = xb_ld(&bar[XB_XCNT(j)]); sum += c; cnt += (c > 0u) ? 1u : 0u; mine = (j == x) ? c : mine; }
        if (sum == G) break;
        __builtin_amdgcn_s_sleep(1);
        if ((++sp & 255u) == 0u) { if (xb_ld(&bar[XB_TMO])) break; if (sp > XB_SPIN_CAP) { atomicAdd(&bar[XB_TMO], 1u); break; } }
    }
    nloc = mine > 0u ? mine : 1u; nx = cnt > 0u ? cnt : 1u;
}

__device__ __forceinline__ void xcd_barrier(const XcdBarrier& b) {
    asm volatile("s_waitcnt vmcnt(0)" ::: "memory");
    __syncthreads();
    if (threadIdx.x == 0) {
        unsigned* bar = b.bar;
        __builtin_amdgcn_s_waitcnt(0);
        unsigned nloc = b.st[0], nx = b.st[1];
        if (nloc == 0u) { xcd_barrier_complete(bar, b.x, nloc, nx); b.st[0] = nloc; b.st[1] = nx; }
        const unsigned old = xb_add(&bar[XB_XSUB(b.x)], 1u);
        const unsigned gen = old / nloc;
        if (old + 1u == (gen + 1u) * nloc) {
            __builtin_amdgcn_fence(__ATOMIC_RELEASE, "agent");
            asm volatile("s_waitcnt vmcnt(0)" ::: "memory");
            const unsigned og = xb_add(&bar[XB_TOP], 1u);
            const unsigned tg = og / nx;
            if (og + 1u == (tg + 1u) * nx) xb_add(&bar[XB_TOPGEN], 1u);
            else XB_SPIN(xb_ld(&bar[XB_TOPGEN]) == tg, bar);
            __builtin_amdgcn_fence(__ATOMIC_ACQUIRE, "agent");
            xb_add(&bar[XB_XGEN(b.x)], 1u);
            asm volatile("s_waitcnt vmcnt(0)" ::: "memory");
        } else {
            XB_SPIN(xb_ld(&bar[XB_XGEN(b.x)]) == gen, bar);
            __builtin_amdgcn_fence(__ATOMIC_ACQUIRE, "agent");
            asm volatile("s_waitcnt vmcnt(0)" ::: "memory");
        }
    }
    __syncthreads();
}
__device__ __forceinline__ void reduce_slots(const float* slots, float* rsq) {
    for (int row = blockIdx.x * 512 + opaque_tid(); row < M; row += gridDim.x * 512) {
        const f32x4* s4 = (const f32x4*)(slots + (size_t)row * 32); float s = 0.f;
#pragma unroll
        for (int j = 0; j < 8; ++j) { const f32x4 v = s4[j]; s += (v[0] + v[1]) + (v[2] + v[3]); }
        rsq[row] = s; }
}
__global__ void __launch_bounds__(512, 2) mega_fwd(KArgs a) {
    extern __shared__ __attribute__((aligned(16))) unsigned char smem[];
    cg::grid_group grid = cg::this_grid();
    LAS unsigned char* lds = (LAS unsigned char*)smem;
    const int G = gridDim.x, bx = blockIdx.x;
    const float* x = (const float*)a.in[0];
    grid.sync();
    if (threadIdx.x < 16) ((LAS unsigned*)(lds + 131072))[threadIdx.x] = 0u;
    __syncthreads();
    (void)xcd_barrier_post((unsigned*)(a.ws + WS_BAR), (volatile LAS unsigned*)(lds + 131072));
#define GBAR() do { XcdBarrier xb_; xb_.bar = (unsigned*)(opq(a.ws) + WS_BAR); xb_.x = xb_xcc_id(); xb_.st = (volatile LAS unsigned*)(lds + 131072); xcd_barrier(xb_); } while (0)

#if PH_MISC
    tables_phase(a);
    convert_weights(a, 0, lds);
#if PROBE_CVT_REP > 1
    convert_weights(a, 0, lds);
#endif
#endif
    cast_rows_bf16(x, (bf16_t*)(opq(a.ws) + WS_XN), (float*)(opq(a.ws) + WS_RSQ) + 4 * M);
    GBAR();
#pragma unroll 1
    for (int l = 0; l < DEPTH; ++l) {
        if (l > 0) {
#if PH_MISC
            convert_weights(a, l, lds);
            reduce_slots((const float*)(opq(a.ws) + WS_SLOT) + (size_t)(2 + (l - 1)) * M * 32, (float*)(opq(a.ws) + WS_RSQ) + (size_t)(2 + (l - 1)) * M);
#if PROBE_CVT_REP > 1
            convert_weights(a, l, lds);
#endif
#endif
            GBAR();
        }
        { pg8::Gemm g{l == 0 ? (const bf16_t*)(opq(a.ws) + WS_XN) : (const bf16_t*)a.out, (const bf16_t*)(opq(a.ws) + WS_WIN), M, DINP, DM, DM, DM};   pg8::StaticOrder S; S.init(M, DINP, G, bx);
          pg8::EpiU E{(bf16_t*)(opq(a.ws) + WS_U), DINP, (const float*)(opq(a.ws) + WS_RSQ) + (size_t)(l == 0 ? 4 : 2 + (l - 1)) * M, nullptr};
          __syncthreads(); if (PH_GEMM & 1) pg8::gemm_phase<pg8::EpiU, pg8::StaticOrder, true, true>(lds, g, S, E);
#if PROBE_GEMM_REP > 1
          __syncthreads(); if (PH_GEMM & 1) pg8::gemm_phase<pg8::EpiU, pg8::StaticOrder, true, true>(lds, g, S, E);
#endif
 }
        GBAR();
#if PH_MISC
        mla_prep(a, l);
#endif
#if PH_S1
        for (int it = bx; it < 4096; it += G) scan::pass1_item<1>(a, l, it, lds);
        for (int it = bx; it < 4096; it += G) scan::pass1_item<0>(a, l, it, lds);
#if PROBE_SCAN_REP > 1
        for (int it = bx; it < 4096; it += G) scan::pass1_item<1>(a, l, it, lds);
        for (int it = bx; it < 4096; it += G) scan::pass1_item<0>(a, l, it, lds);
#endif
#endif
        GBAR();
#if PH_S2
        for (int t = bx * 512 + opaque_tid(); t < 131072; t += G * 512) scan::pass2_triple(a, t);
#endif
        { pg8::Gemm g{(const bf16_t*)(opq(a.ws) + WS_U) + C_CQ, (const bf16_t*)(opq(a.ws) + WS_WQB), M, 1536, 512, DINP, 512}; pg8::StaticOrder S; S.init(M, 1536, G, bx);
          pg8::EpiQ E{(bf16_t*)(opq(a.ws) + WS_Q), (const float*)(opq(a.ws) + WS_COS), (const float*)(opq(a.ws) + WS_SIN)};
          __syncthreads(); if (PH_GEMM & 2) pg8::gemm_phase<pg8::EpiQ, pg8::StaticOrder, true, true>(lds, g, S, E);
#if PROBE_GEMM_REP > 1
          __syncthreads(); if (PH_GEMM & 2) pg8::gemm_phase<pg8::EpiQ, pg8::StaticOrder, true, true>(lds, g, S, E);
#endif
 }
        { pg8::Gemm g{(const bf16_t*)(opq(a.ws) + WS_U) + C_CKV, (const bf16_t*)(opq(a.ws) + WS_WKVB), M, 2048, 512, DINP, 512}; pg8::StaticOrder S; S.init(M, 2048, G, bx);
          pg8::EpiKV E{(bf16_t*)(opq(a.ws) + WS_KN), (bf16_t*)(opq(a.ws) + WS_V)};
          __syncthreads(); if (PH_GEMM & 4) pg8::gemm_phase<pg8::EpiKV, pg8::StaticOrder, true, true>(lds, g, S, E);
#if PROBE_GEMM_REP > 1
          __syncthreads(); if (PH_GEMM & 4) pg8::gemm_phase<pg8::EpiKV, pg8::StaticOrder, true, true>(lds, g, S, E);
#endif
 }
        GBAR();
        { const bool x8 = (G % 8) == 0; const int xcd = bx & 7, slot = bx >> 3, nslot = G >> 3;
          for (int pr = 0; pr < (x8 ? 2 : 16); ++pr) { const int p = x8 ? xcd + 8 * pr : pr, b = p >> 3, h = p & 7;
            for (int qb = x8 ? slot : bx; qb < 64; qb += x8 ? nslot : G) {
              const bf16_t* Qb = (const bf16_t*)(opq(a.ws) + WS_Q) + ((size_t)(b * 8 + h) * T + (size_t)qb * 256) * 192;
              const bf16_t* Kn = (const bf16_t*)(opq(a.ws) + WS_KN) + (size_t)(b * 8 + h) * T * 128;
              const bf16_t* Kr = (const bf16_t*)(opq(a.ws) + WS_KR) + (size_t)b * T * 64;
              const bf16_t* Vh = (const bf16_t*)(opq(a.ws) + WS_V) + (size_t)(b * 8 + h) * T * 128;
              bf16_t* Ob = (bf16_t*)(opq(a.ws) + WS_XN) + ((size_t)b * T + (size_t)qb * 256) * DM + 1024 + h * 128;
#if PH_ATT
              for (int rep_ = 0; rep_ < PROBE_ATT_REP; ++rep_) att::attn_unit(Qb, Kn, Kr, Vh, Ob, (char*)smem);
#else
              { const int t_ = opaque_tid(); bf16_t* zp = Ob + (size_t)(t_ >> 1) * DM + (t_ & 1) * 64; (void)Qb; (void)Kn; (void)Kr; (void)Vh;
                for (int z_ = 0; z_ < 8; ++z_) *(u32x4*)(zp + z_ * 8) = (u32x4){0u, 0u, 0u, 0u}; }
#endif
 } } }
#if PH_S3
        for (int it = bx; it < 2048; it += G) scan::pass3_item<1>(a, l, it, lds);
        for (int it = bx; it < 2048; it += G) scan::pass3_item<0>(a, l, it, lds);
#if PROBE_SCAN_REP > 1
        for (int it = bx; it < 2048; it += G) scan::pass3_item<1>(a, l, it, lds);
        for (int it = bx; it < 2048; it += G) scan::pass3_item<0>(a, l, it, lds);
#endif
#else
        { bf16_t* mz = (bf16_t*)(opq(a.ws) + WS_XN); for (size_t z_ = (size_t)bx * 512 + opaque_tid(); z_ < (size_t)M * 128; z_ += (size_t)G * 512) *(u32x4*)(mz + (z_ >> 7) * DM + (z_ & 127) * 8) = (u32x4){0u, 0u, 0u, 0u}; }
#endif
        GBAR();
        { pg8::Gemm g{(const bf16_t*)(opq(a.ws) + WS_XN), (const bf16_t*)(opq(a.ws) + WS_WOUT), M, DM, DM, DM, DM}; pg8::StaticOrder S; S.init(M, DM, G, bx);
          pg8::EpiRes E{l == 0 ? (const void*)x : (const void*)a.out, l == 0 ? 1 : 0, (bf16_t*)(opq(a.ws) + WS_HB), nullptr, (float*)(opq(a.ws) + WS_SLOT) + (size_t)l * M * 32};
          __syncthreads(); if (PH_GEMM & 8) pg8::gemm_phase<pg8::EpiRes, pg8::StaticOrder, true, true>(lds, g, S, E); }
        GBAR();
        reduce_slots((const float*)(opq(a.ws) + WS_SLOT) + (size_t)l * M * 32, (float*)(opq(a.ws) + WS_RSQ) + (size_t)l * M);
        GBAR();
        { pg8::Gemm g{(const bf16_t*)(opq(a.ws) + WS_HB), (const bf16_t*)(opq(a.ws) + WS_W13), M, 2 * DFF, DM, DM, DM}; pg8::StaticOrder S; S.init(M, 2 * DFF, G, bx);
          pg8::EpiSwi E{(bf16_t*)(opq(a.ws) + WS_HID), (const float*)(opq(a.ws) + WS_RSQ) + (size_t)l * M, nullptr};
          __syncthreads(); if (PH_GEMM & 16) pg8::gemm_phase<pg8::EpiSwi, pg8::StaticOrder, true, true>(lds, g, S, E);
#if PROBE_GEMM_REP > 1
          __syncthreads(); if (PH_GEMM & 16) pg8::gemm_phase<pg8::EpiSwi, pg8::StaticOrder, true, true>(lds, g, S, E);
#endif
 }
        GBAR();
        { pg8::Gemm g{(const bf16_t*)(opq(a.ws) + WS_HID), (const bf16_t*)(opq(a.ws) + WS_W2), M, DM, DFF, DFF, DFF}; pg8::StaticOrder S; S.init(M, DM, G, bx);
          pg8::EpiRes E{(const void*)(opq(a.ws) + WS_HB), 0, l + 1 < DEPTH ? (bf16_t*)a.out : (bf16_t*)(opq(a.ws) + WS_XN), nullptr, (float*)(opq(a.ws) + WS_SLOT) + (size_t)(2 + l) * M * 32};
          __syncthreads(); if (PH_GEMM & 32) pg8::gemm_phase<pg8::EpiRes, pg8::StaticOrder, true, true>(lds, g, S, E); }
        GBAR();
    }
    rmsnorm_rows_bf16_to_f32((const bf16_t*)(opq(a.ws) + WS_XN), (const float*)a.in[18], a.out);
}

extern "C" void kernel_launch(void* const* d_in, const int* in_sizes, int n_in, void* d_out, int out_size, void* d_ws, size_t ws_size, hipStream_t stream) {
    static int grid = 0;
    if (grid == 0) {
        if (n_in != 19 || out_size != M * DM || ws_size < WS_END) { fprintf(stderr, "kernel_launch: unexpected shapes (n_in %d out %d ws %zu)\n", n_in, out_size, ws_size); grid = -1; return; }
        int dev = 0, cus = 0, per_cu = 0;
        hipGetDevice(&dev); hipDeviceGetAttribute(&cus, hipDeviceAttributeMultiprocessorCount, dev);
        if (hipFuncSetAttribute((const void*)mega_fwd, hipFuncAttributeMaxDynamicSharedMemorySize, LDS_BYTES) != hipSuccess) { fprintf(stderr, "kernel_launch: hipFuncSetAttribute failed\n"); grid = -1; return; }
        if (hipOccupancyMaxActiveBlocksPerMultiprocessor(&per_cu, (const void*)mega_fwd, 512, LDS_BYTES) != hipSuccess || per_cu < 1) { fprintf(stderr, "kernel_launch: occupancy query says %d\n", per_cu); per_cu = 1; }
        (void)hipGetLastError();
        grid = cus * (per_cu > 1 ? 1 : per_cu);
    }
    if (grid < 0) return;
    KArgs a{};
    for (int i = 0; i < 19; ++i) a.in[i] = d_in[i];
    a.out = (float*)d_out; a.ws = (unsigned char*)d_ws;
    if (hipMemsetAsync((char*)d_ws + WS_BAR, 0, 16384, stream) != hipSuccess) { fprintf(stderr, "kernel_launch: memset failed\n"); return; }
    void* args[] = {&a};
    hipError_t e = hipLaunchCooperativeKernel((const void*)mega_fwd, dim3(grid), dim3(512), args, LDS_BYTES, stream);
    if (e != hipSuccess) fprintf(stderr, "kernel_launch: cooperative launch failed: %s (grid %d)\n", hipGetErrorString(e), grid);
}
```
